# Optimizing an MI355X kernel written in HIP

```python
import math
import jax, jax.numpy as jnp
from jax import lax
import numpy as np

D_MODEL = 1024
BATCH = 4
SEQ = 8192
DEPTH = 2

GRID_W = 64
MEM_LEN = 256
N_GROUPS = 4
GROUP_W = D_MODEL // N_GROUPS
FNET_GROUPS = 4
FNET_CH = GROUP_W // FNET_GROUPS
CONV_K = 31
GQA_HEAD_DIM = 64
GQA_Q_HEADS = GROUP_W // GQA_HEAD_DIM
GQA_KV_HEADS = 2
MLA_HEADS = 4
MLA_NOPE = 64
MLA_ROPE = 32
MLA_V = GROUP_W // MLA_HEADS
MLA_Q_RANK = 256
MLA_KV_RANK = 128
X_HEADS = 4
X_HEAD_DIM = D_MODEL // X_HEADS
N_EXPERTS = 32
TOP_K = 4
D_FF = D_MODEL
SWIGLU_LIMIT = 7.0
SWIGLU_ALPHA = 1.702
MOE_BLOCK = 256
Q_BLOCK = 128
ROPE_THETA = 10000.0
LN_EPS = 1e-5
RMS_EPS = 1e-6
DN_ALPHA = (2 * DEPTH) ** 0.25
DN_BETA = (8 * DEPTH) ** -0.25

F_COLS = GROUP_W
C_COLS = 2 * GROUP_W
GQ_Q_COLS = GQA_Q_HEADS * GQA_HEAD_DIM
GQ_KV_COLS = GQA_KV_HEADS * GQA_HEAD_DIM
IN_COLS = F_COLS + C_COLS + GQ_Q_COLS + 2 * GQ_KV_COLS + MLA_Q_RANK + MLA_KV_RANK + MLA_ROPE
SPLITS = (F_COLS,
          F_COLS + C_COLS,
          F_COLS + C_COLS + GQ_Q_COLS,
          F_COLS + C_COLS + GQ_Q_COLS + GQ_KV_COLS,
          F_COLS + C_COLS + GQ_Q_COLS + 2 * GQ_KV_COLS,
          F_COLS + C_COLS + GQ_Q_COLS + 2 * GQ_KV_COLS + MLA_Q_RANK,
          F_COLS + C_COLS + GQ_Q_COLS + 2 * GQ_KV_COLS + MLA_Q_RANK + MLA_KV_RANK)

kernel_name = "hybrid_parallel_group_encoder"


def layer_norm(x, g, b):
    xf = x.astype(jnp.float32)
    mu = jnp.mean(xf, axis=-1, keepdims=True)
    var = jnp.mean(jnp.square(xf - mu), axis=-1, keepdims=True)
    return ((xf - mu) * lax.rsqrt(var + LN_EPS)).astype(x.dtype) * g + b


def rms_norm(x, g):
    xf = x.astype(jnp.float32)
    r = lax.rsqrt(jnp.mean(jnp.square(xf), axis=-1, keepdims=True) + RMS_EPS)
    return (xf * r).astype(x.dtype) * g


def rope_tables(pos, dim):
    inv = ROPE_THETA ** (-jnp.arange(0, dim, 2, dtype=jnp.float32) / dim)
    ang = pos.astype(jnp.float32)[:, None] * inv[None, :]
    return (jnp.cos(ang), jnp.sin(ang))


def apply_rope(x, cos, sin):
    half = x.shape[-1] // 2
    c = cos[:, None, :].astype(x.dtype)
    s = sin[:, None, :].astype(x.dtype)
    x1, x2 = x[..., :half], x[..., half:]
    return jnp.concatenate([x1 * c - x2 * s, x2 * c + x1 * s], axis=-1)


def axial_rope(x, tabs):
    cos_r, sin_r, cos_c, sin_c = tabs
    half = x.shape[-1] // 2
    return jnp.concatenate([apply_rope(x[..., :half], cos_r, sin_r),
                            apply_rope(x[..., half:], cos_c, sin_c)], axis=-1)


def blocked_attention(q, k, v, scale):
    B, S, Hq, dk = q.shape
    Hkv = k.shape[2]
    G = Hq // Hkv
    dv = v.shape[-1]
    nb = S // Q_BLOCK
    qb = q.reshape(B, nb, Q_BLOCK, Hkv, G, dk).transpose(1, 0, 2, 3, 4, 5)

    def one_block(qblk):
        s = jnp.einsum('bqhgd,bkhd->bhgqk', qblk, k).astype(jnp.float32) * scale
        p = jax.nn.softmax(s, axis=-1).astype(v.dtype)
        return jnp.einsum('bhgqk,bkhd->bqhgd', p, v)

    o = lax.map(one_block, qb)
    return o.transpose(1, 0, 2, 3, 4, 5).reshape(B, S, Hq * dv)


def hybrid_mixer(h, rope_g, rope_m, w_in, w_f, b_f, dw_w, dw_b, cg, cb, w_pw, b_pw,
                 qg, kg, mqg, w_uq, mkg, w_ukv, grp_g, w_o):
    B, S, _ = h.shape
    z = h @ w_in
    zf, zc, zq, zk, zv, zcq, zckv, zkr = jnp.split(z, SPLITS, axis=-1)

    u = zf.reshape(B, S, FNET_GROUPS, FNET_CH).astype(jnp.float32)
    yf = jnp.fft.fft2(u, axes=(1, 3)).real.astype(h.dtype).reshape(B, S, GROUP_W) @ w_f + b_f

    a, g = jnp.split(zc, 2, axis=-1)
    u = a * jax.nn.sigmoid(g)
    u = lax.conv_general_dilated(u, dw_w[:, None, :], (1,), [(CONV_K // 2, CONV_K // 2)],
                                 dimension_numbers=('NWC', 'WIO', 'NWC'),
                                 feature_group_count=GROUP_W) + dw_b
    yc = jax.nn.silu(layer_norm(u, cg, cb)) @ w_pw + b_pw

    q = rms_norm(zq.reshape(B, S, GQA_Q_HEADS, GQA_HEAD_DIM), qg)
    k = rms_norm(zk.reshape(B, S, GQA_KV_HEADS, GQA_HEAD_DIM), kg)
    v = zv.reshape(B, S, GQA_KV_HEADS, GQA_HEAD_DIM)
    yg = blocked_attention(axial_rope(q, rope_g), axial_rope(k, rope_g), v, GQA_HEAD_DIM ** -0.5)

    qm = (rms_norm(zcq, mqg) @ w_uq).reshape(B, S, MLA_HEADS, MLA_NOPE + MLA_ROPE)
    kvm = (rms_norm(zckv, mkg) @ w_ukv).reshape(B, S, MLA_HEADS, MLA_NOPE + MLA_V)
    q_nope, q_rope = qm[..., :MLA_NOPE], qm[..., MLA_NOPE:]
    k_nope, vm = kvm[..., :MLA_NOPE], kvm[..., MLA_NOPE:]
    k_rope = axial_rope(zkr[:, :, None, :], rope_m)
    qm = jnp.concatenate([q_nope, axial_rope(q_rope, rope_m)], axis=-1)
    km = jnp.concatenate([k_nope, jnp.broadcast_to(k_rope, (B, S, MLA_HEADS, MLA_ROPE))], axis=-1)
    ym = blocked_attention(qm, km, vm, (MLA_NOPE + MLA_ROPE) ** -0.5)

    y = rms_norm(jnp.stack([yf, yc, yg, ym], axis=2), grp_g).reshape(B, S, D_MODEL)
    return y @ w_o


def memory_cross_attention(h, mem, w_xq, w_xk, w_xv, w_xo):
    B, S, _ = h.shape
    M = mem.shape[1]
    q = (h @ w_xq).reshape(B, S, X_HEADS, X_HEAD_DIM)
    k = (mem @ w_xk).reshape(B, M, X_HEADS, X_HEAD_DIM)
    v = (mem @ w_xv).reshape(B, M, X_HEADS, X_HEAD_DIM)
    return blocked_attention(q, k, v, X_HEAD_DIM ** -0.5) @ w_xo


def routed_experts(h, w_router, b_router, w_gu, b_gu, w_down, b_down):
    B, S, D = h.shape
    T = B * S
    xt = h.reshape(T, D)
    logits = (xt @ w_router + b_router).astype(jnp.float32)
    top_v, top_i = lax.top_k(logits, TOP_K)
    gates = jax.nn.softmax(top_v, axis=-1).astype(h.dtype)

    N = T * TOP_K
    flat_e = top_i.reshape(N)
    order = jnp.argsort(flat_e)
    sorted_e = flat_e[order]
    counts = jnp.bincount(flat_e, length=N_EXPERTS)
    padded = ((counts + MOE_BLOCK - 1) // MOE_BLOCK) * MOE_BLOCK
    start = jnp.cumsum(counts) - counts
    pend = jnp.cumsum(padded)
    pstart = pend - padded
    dest = pstart[sorted_e] + (jnp.arange(N) - start[sorted_e])
    n_blocks = -(-N // MOE_BLOCK) + N_EXPERTS
    P = n_blocks * MOE_BLOCK
    slot_tok = jnp.zeros((P,), jnp.int32).at[dest].set((order // TOP_K).astype(jnp.int32))
    slot_w = jnp.zeros((P,), h.dtype).at[dest].set(gates.reshape(N)[order])
    block_e = jnp.minimum(jnp.searchsorted(pend, jnp.arange(n_blocks) * MOE_BLOCK, side='right'),
                          N_EXPERTS - 1)
    xs = xt[slot_tok].reshape(n_blocks, MOE_BLOCK, D)

    def expert_block(args):
        xb, e = args
        gu = xb @ w_gu[e] + b_gu[e]
        gate, up = gu[:, :D_FF], gu[:, D_FF:]
        gate = jnp.minimum(gate, SWIGLU_LIMIT)
        up = jnp.clip(up, -SWIGLU_LIMIT, SWIGLU_LIMIT)
        act = (up + 1.0) * (gate * jax.nn.sigmoid(SWIGLU_ALPHA * gate))
        return act @ w_down[e] + b_down[e]

    ys = lax.map(expert_block, (xs, block_e)).reshape(P, D)
    out = jnp.zeros((T, D), h.dtype).at[slot_tok].add(ys * slot_w[:, None])
    return out.reshape(B, S, D)


def setup_inputs(seed: int = 0) -> dict:
    key = jax.random.key(seed)
    ks = iter(jax.random.split(key, 48))
    L, D, E, F, G = DEPTH, D_MODEL, N_EXPERTS, D_FF, GROUP_W

    def nrm(shape, scale):
        return jax.random.normal(next(ks), shape, jnp.float32) * scale

    def gain(shape):
        return 1.0 + nrm(shape, 0.02)

    return {
        "x": nrm((BATCH, SEQ, D), 1.0),
        "mem": nrm((BATCH, MEM_LEN, D), 1.0),
        "ln_in_g": gain((D,)),
        "ln_in_b": nrm((D,), 0.02),
        "w_in": nrm((L, D, IN_COLS), D ** -0.5),
        "w_f": nrm((L, G, G), G ** -0.5),
        "b_f": nrm((L, G), 0.02),
        "dw_w": nrm((L, CONV_K, G), CONV_K ** -0.5),
        "dw_b": nrm((L, G), 0.02),
        "conv_ln_g": gain((L, G)),
        "conv_ln_b": nrm((L, G), 0.02),
        "w_pw": nrm((L, G, G), G ** -0.5),
        "b_pw": nrm((L, G), 0.02),
        "q_norm_g": gain((L, GQA_HEAD_DIM)),
        "k_norm_g": gain((L, GQA_HEAD_DIM)),
        "mla_q_norm_g": gain((L, MLA_Q_RANK)),
        "w_uq": nrm((L, MLA_Q_RANK, MLA_HEADS * (MLA_NOPE + MLA_ROPE)), MLA_Q_RANK ** -0.5),
        "mla_kv_norm_g": gain((L, MLA_KV_RANK)),
        "w_ukv": nrm((L, MLA_KV_RANK, MLA_HEADS * (MLA_NOPE + MLA_V)), MLA_KV_RANK ** -0.5),
        "grp_norm_g": gain((L, N_GROUPS, G)),
        "w_o": nrm((L, D, D), D ** -0.5 * DN_BETA),
        "ln1_g": gain((L, D)),
        "ln1_b": nrm((L, D), 0.02),
        "w_xq": nrm((L, D, D), D ** -0.5),
        "w_xk": nrm((L, D, D), D ** -0.5),
        "w_xv": nrm((L, D, D), D ** -0.5),
        "w_xo": nrm((L, D, D), D ** -0.5 * DN_BETA),
        "ln2_g": gain((L, D)),
        "ln2_b": nrm((L, D), 0.02),
        "w_router": nrm((L, D, E), D ** -0.5),
        "b_router": nrm((L, E), 0.01),
        "w_gu": nrm((L, E, D, 2 * F), D ** -0.5),
        "b_gu": nrm((L, E, 2 * F), 0.02),
        "w_down": nrm((L, E, F, D), F ** -0.5 * DN_BETA),
        "b_down": nrm((L, E, D), 0.02),
        "ln3_g": gain((L, D)),
        "ln3_b": nrm((L, D), 0.02),
    }


def reference(x, mem, ln_in_g, ln_in_b, w_in, w_f, b_f, dw_w, dw_b, conv_ln_g, conv_ln_b,
              w_pw, b_pw, q_norm_g, k_norm_g, mla_q_norm_g, w_uq, mla_kv_norm_g, w_ukv,
              grp_norm_g, w_o, ln1_g, ln1_b, w_xq, w_xk, w_xv, w_xo, ln2_g, ln2_b,
              w_router, b_router, w_gu, b_gu, w_down, b_down, ln3_g, ln3_b):
    S = x.shape[1]
    ROWS = S // GRID_W
    row = jnp.repeat(jnp.arange(ROWS, dtype=jnp.int32), GRID_W)
    col = jnp.tile(jnp.arange(GRID_W, dtype=jnp.int32), ROWS)
    rope_g = rope_tables(row, GQA_HEAD_DIM // 2) + rope_tables(col, GQA_HEAD_DIM // 2)
    rope_m = rope_tables(row, MLA_ROPE // 2) + rope_tables(col, MLA_ROPE // 2)

    h = layer_norm(x, ln_in_g, ln_in_b)
    for l in range(DEPTH):
        mix = hybrid_mixer(h, rope_g, rope_m, w_in[l], w_f[l], b_f[l], dw_w[l], dw_b[l],
                           conv_ln_g[l], conv_ln_b[l], w_pw[l], b_pw[l], q_norm_g[l], k_norm_g[l],
                           mla_q_norm_g[l], w_uq[l], mla_kv_norm_g[l], w_ukv[l], grp_norm_g[l], w_o[l])
        h = layer_norm(DN_ALPHA * h + mix, ln1_g[l], ln1_b[l])
        xa = memory_cross_attention(h, mem, w_xq[l], w_xk[l], w_xv[l], w_xo[l])
        h = layer_norm(DN_ALPHA * h + xa, ln2_g[l], ln2_b[l])
        ff = routed_experts(h, w_router[l], b_router[l], w_gu[l], b_gu[l], w_down[l], b_down[l])
        h = layer_norm(DN_ALPHA * h + ff, ln3_g[l], ln3_b[l])
    return h
```

```cpp
#include <hip/hip_runtime.h>
#include <cstdio>
#include <cstdint>

#ifndef N_LAUNCH_MODE
#define N_LAUNCH_MODE 1
#endif

#define LAS __attribute__((address_space(3)))
#define GAS __attribute__((address_space(1)))
typedef unsigned short bf16_t;
typedef short bf16x8 __attribute__((ext_vector_type(8)));
typedef float f32x4 __attribute__((ext_vector_type(4)));
typedef float f32x2 __attribute__((ext_vector_type(2)));
typedef float f32x16 __attribute__((ext_vector_type(16)));
typedef unsigned u32x4 __attribute__((ext_vector_type(4)));
typedef unsigned u32x2 __attribute__((ext_vector_type(2)));
typedef GAS unsigned gu32;
#define RLX_AGENT __ATOMIC_RELAXED, __HIP_MEMORY_SCOPE_AGENT
#define LDS_WAIT() asm volatile("s_waitcnt lgkmcnt(0)" ::: "memory")
#define VM_WAIT() asm volatile("s_waitcnt vmcnt(0)" ::: "memory")

constexpr int NB = 4, SEQ = 8192, T = NB * SEQ, D = 1024, MEML = 256, NE = 32, TOPK = 4, NLAYER = 2;
constexpr int ZC = 1792;
constexpr int ZC_CA = 256, ZC_CG = 512, ZC_Q = 768, ZC_K = 1024, ZC_V = 1152, ZC_CQ = 1280, ZC_CKV = 1536, ZC_KR = 1664;
constexpr int INC = 1696;
constexpr float LOG2E = 1.4426950408889634f;
constexpr float DN_ALPHA = 1.4142135623730951f;
constexpr float LN_EPS = 1e-5f, RMS_EPS = 1e-6f;
constexpr float QSCALE_G = 0.125f * LOG2E;
constexpr float QSCALE_M = 0.10206207261596575f * LOG2E;
constexpr float QSCALE_X = 0.0625f * LOG2E;
constexpr int MOE_MAXBLK = T * TOPK / 256 + NE;
constexpr int MOE_ROWS = MOE_MAXBLK * 256;

constexpr size_t MiB = 1u << 20;
constexpr size_t WS_CTL = 0, CTL_ZERO_BYTES = 1 * MiB;
constexpr size_t WS_W = 1 * MiB, WL_SIZE = 208 * MiB;
constexpr size_t WL_IN = 0, WL_MLA = 4 * MiB, WL_FC = 5 * MiB, WL_RT = 5 * MiB + 512 * 1024, WL_O = 6 * MiB, WL_XQ = 8 * MiB, WL_XK = 10 * MiB, WL_XV = 12 * MiB,
                 WL_XO = 14 * MiB, WL_GU = 16 * MiB, WL_DN = 144 * MiB;
constexpr size_t WS_MEMB = 418 * MiB, WS_KX = 420 * MiB, WS_VXT = 424 * MiB;
constexpr size_t WS_ROUTE = 428 * MiB;
constexpr size_t WS_H = 430 * MiB, WS_HB = 558 * MiB, WS_F = 622 * MiB, WS_R = 750 * MiB;
constexpr size_t R_Z = 0, R_FC = 112 * MiB, R_QG = 144 * MiB, R_KG = 160 * MiB, R_CQKV = 168 * MiB, R_KR = 192 * MiB, R_QKVM = 194 * MiB, R_YMIX = 258 * MiB, R_Y = 386 * MiB;
constexpr size_t R_XQ = 0, R_SC = 64 * MiB, R_PB = 192 * MiB, R_XO = 256 * MiB;
constexpr size_t R_XS = 0, R_ACT = 272 * MiB;
constexpr size_t WS_END = WS_R + 544 * MiB;
constexpr int CW_TMO = 0, CW_CODE = 1, CW_BAR = 4096, CW_CNT = 16384, MAXWG = 256, CW_TOK = 65536;

constexpr int NTHREADS = 512, NWAVES = 8;
constexpr int LDS_BYTES = 147456;
constexpr int MISC_OFF = 147456 - 256;

__device__ __forceinline__ unsigned f2bf(float f) { unsigned u = __builtin_bit_cast(unsigned, f); return (u + 0x7fffu + ((u >> 16) & 1u)) >> 16; }
__device__ __forceinline__ unsigned pk2i(float lo, float hi) { return f2bf(lo) | (f2bf(hi) << 16); }
typedef __bf16 hwbf2 __attribute__((ext_vector_type(2))); typedef float hwf2 __attribute__((ext_vector_type(2)));
__device__ __forceinline__ unsigned pk2(float lo, float hi) { const hwf2 v = {lo, hi}; return __builtin_bit_cast(unsigned, __builtin_convertvector(v, hwbf2)); }
__device__ __forceinline__ float bf2f(unsigned b) { return __builtin_bit_cast(float, b << 16); }
__device__ __forceinline__ float bflo(unsigned w) { return __builtin_bit_cast(float, w << 16); }
__device__ __forceinline__ float bfhi(unsigned w) { return __builtin_bit_cast(float, w & 0xffff0000u); }
template <int CTRL> __device__ __forceinline__ float dppf(float v) { return __builtin_bit_cast(float, __builtin_amdgcn_update_dpp(0, __builtin_bit_cast(int, v), CTRL, 0xF, 0xF, true)); }
template <int O, bool MAX> __device__ __forceinline__ float rstep(float v) {
    float o;
    if constexpr (O == 1) o = dppf<0xB1>(v); else if constexpr (O == 2) o = dppf<0x4E>(v); else if constexpr (O == 4) o = dppf<0x141>(v); else if constexpr (O == 8) o = dppf<0x140>(v);
    else { const unsigned u = __builtin_bit_cast(unsigned, v);
        if constexpr (O == 16) { auto r = __builtin_amdgcn_permlane16_swap(u, u, false, false); v = __builtin_bit_cast(float, (unsigned)r[0]); o = __builtin_bit_cast(float, (unsigned)r[1]); }
        else { auto r = __builtin_amdgcn_permlane32_swap(u, u, false, false); v = __builtin_bit_cast(float, (unsigned)r[0]); o = __builtin_bit_cast(float, (unsigned)r[1]); } }
    return MAX ? fmaxf(v, o) : v + o;
}
template <int O> __device__ __forceinline__ float rsum(float v) { return rstep<O, false>(v); }
__device__ __forceinline__ float wave_sum(float v) { v = rsum<1>(v); v = rsum<2>(v); v = rsum<4>(v); v = rsum<8>(v); v = rsum<16>(v); return rsum<32>(v); }
__device__ __forceinline__ float wave_max(float v) { v = rstep<1, true>(v); v = rstep<2, true>(v); v = rstep<4, true>(v); v = rstep<8, true>(v); v = rstep<16, true>(v); return rstep<32, true>(v); }
__device__ __forceinline__ f32x4 ldbf4(const bf16_t* p) { const u32x2 w = *(const u32x2*)p; return (f32x4){bflo(w.x), bfhi(w.x), bflo(w.y), bfhi(w.y)}; }
__device__ __forceinline__ float sigmoidf_(float x) { return __builtin_amdgcn_rcpf(1.f + __expf(-x)); }

#define XB_TMO      128
#define XB_XCNT(j)  (256  + 64 * (j))
#define XB_XSUB(j)  (1280 + 64 * (j))
#define XB_XGEN(j)  (2304 + 64 * (j))
#define XB_TOP      3328
#define XB_TOPGEN   3392
#define XCD_BAR_WORDS 3456
#define XB_SPIN_CAP (1u << 22)
__device__ __forceinline__ unsigned xb_ld(unsigned* p)              { return __hip_atomic_load(p, __ATOMIC_RELAXED, __HIP_MEMORY_SCOPE_AGENT); }
__device__ __forceinline__ unsigned xb_add(unsigned* p, unsigned v) { return __hip_atomic_fetch_add(p, v, __ATOMIC_RELAXED, __HIP_MEMORY_SCOPE_AGENT); }
__device__ __forceinline__ unsigned xb_xcc_id() { return (unsigned)__builtin_amdgcn_s_getreg((3 << 11) | 20) & 0xFu; }
#define XB_SPIN(cond, bar) do { unsigned _sp = 0; while (cond) { __builtin_amdgcn_s_sleep(1); \
    if ((++_sp & 255u) == 0u) { if (xb_ld(&(bar)[XB_TMO])) break; if (_sp > XB_SPIN_CAP) { atomicAdd(&(bar)[XB_TMO], 1u); break; } } } } while (0)
struct XcdBarrier { unsigned* bar; unsigned x; volatile LAS unsigned* st; };
__device__ __forceinline__ XcdBarrier xcd_barrier_post(unsigned* bar, volatile LAS unsigned* st, int tid) {
    XcdBarrier b; b.bar = bar; b.x = xb_xcc_id(); b.st = st;
    if (tid == 0) (void)xb_add(&bar[XB_XCNT(b.x)], 1u);
    return b;
}
__device__ __forceinline__ void xcd_barrier_complete(unsigned* bar, unsigned x, unsigned& nloc, unsigned& nx) {
    const unsigned G = gridDim.x * gridDim.y * gridDim.z;
    unsigned sum, cnt, mine, sp = 0u;
    for (;;) {
        sum = 0u; cnt = 0u; mine = 0u;
#pragma unroll
        for (unsigned j = 0; j < 16; ++j) { const unsigned c = xb_ld(&bar[XB_XCNT(j)]); sum += c; cnt += (c > 0u) ? 1u : 0u; mine = (j == x) ? c : mine; }
        if (sum == G) break;
        __builtin_amdgcn_s_sleep(1);
        if ((++sp & 255u) == 0u) { if (xb_ld(&bar[XB_TMO])) break; if (sp > XB_SPIN_CAP) { atomicAdd(&bar[XB_TMO], 1u); break; } }
    }
    nloc = mine > 0u ? mine : 1u; nx = cnt > 0u ? cnt : 1u;
}
__device__ __forceinline__ void xcd_barrier(const XcdBarrier& b, int tid) {
    asm volatile("s_waitcnt vmcnt(0)" ::: "memory");
    __syncthreads();
    if (tid == 0) {
        unsigned* bar = b.bar;
        __builtin_amdgcn_s_waitcnt(0);
        unsigned nloc = b.st[0], nx = b.st[1];
        if (nloc == 0u) { xcd_barrier_complete(bar, b.x, nloc, nx); b.st[0] = nloc; b.st[1] = nx; }
        const unsigned old = xb_add(&bar[XB_XSUB(b.x)], 1u);
        const unsigned gen = old / nloc;
        if (old + 1u == (gen + 1u) * nloc) {
            __builtin_amdgcn_fence(__ATOMIC_RELEASE, "agent");
            asm volatile("s_waitcnt vmcnt(0)" ::: "memory");
            const unsigned og = xb_add(&bar[XB_TOP], 1u);
            const unsigned tg = og / nx;
            if (og + 1u == (tg + 1u) * nx) xb_add(&bar[XB_TOPGEN], 1u);
            else XB_SPIN(xb_ld(&bar[XB_TOPGEN]) == tg, bar);
            __builtin_amdgcn_fence(__ATOMIC_ACQUIRE, "agent");
            xb_add(&bar[XB_XGEN(b.x)], 1u);
            asm volatile("s_waitcnt vmcnt(0)" ::: "memory");
        } else {
            XB_SPIN(xb_ld(&bar[XB_XGEN(b.x)]) == gen, bar);
            __builtin_amdgcn_fence(__ATOMIC_ACQUIRE, "agent");
            asm volatile("s_waitcnt vmcnt(0)" ::: "memory");
        }
    }
    __syncthreads();
}

constexpr int EPI_BIAS_OFF = 143360;
struct Unit { int pm, pn, z; long aoff, boff; };
struct GemmDesc { const bf16_t* A; const bf16_t* Bt; int lda, ldb, K; const int* tok = nullptr; };

struct TileOrder {
    int nM, nN, nwg, G, c, mode, lda, ldb;
    __device__ __forceinline__ void init(int nM_, int nN_, int G_, int c_, int mode_, int lda_, int ldb_) { nM = nM_; nN = nN_; nwg = nM * nN; G = G_; c = c_; mode = mode_; lda = lda_; ldb = ldb_; }
    __device__ __forceinline__ bool next(int i, Unit& u) const {
        const long L = (long)i * G + c; if (L >= nwg) return false;
        int wgid = (int)L; { const int q = nwg / 8, r = nwg % 8, xcd = wgid % 8, off = wgid / 8; wgid = (xcd < r ? xcd * (q + 1) : r * (q + 1) + (xcd - r) * q) + off; }
        const int nig = 8 * nN, gid = wgid / nig, fm = gid * 8, gsz = (nM - fm) < 8 ? (nM - fm) : 8;
        u.pm = fm + ((wgid % nig) % gsz); u.pn = (wgid % nig) / gsz; u.z = 0;
        const long ar = (long)u.pm * 256 * lda;
        if (mode == 0)      { u.aoff = ar;                u.boff = (long)u.pn * 256 * ldb; }
        else if (mode == 1) { u.aoff = ar + u.pn * 256;   u.boff = (long)u.pn * 256 * ldb; }
        else if (mode == 2) { u.aoff = ar + u.pn * 256;   u.boff = (long)((u.pm >> 5) * 256) * ldb + u.pn * 256; }
        else                { u.aoff = ar + u.pn * 256;   u.boff = (long)(u.pn * 256) * ldb + (u.pm >> 5) * 256; }
        return true;
    }
};
struct PreOrder {
    int G, c;
    __device__ __forceinline__ bool next(int i, Unit& u) const {
        const int L = i * G + c; if (L >= 64) return false;
        const int which = L >> 4, t16 = L & 15, l = which >> 1, isv = which & 1;
        u.pm = t16 >> 2; u.pn = t16 & 3; u.z = which;
        const long memb = (long)(WS_MEMB / 2), wk = (long)((WS_W + l * WL_SIZE + WL_XK) / 2), wv = (long)((WS_W + l * WL_SIZE + WL_XV) / 2);
        const long ao = isv ? wv : memb, bo = isv ? memb : wk;
        u.aoff = ao + (long)u.pm * 256 * 1024; u.boff = bo + (long)u.pn * 256 * 1024; return true;
    }
};
struct MoeOrder {
    const LAS int* blk_e; int nblk, nN, G, c;
    __device__ __forceinline__ bool next(int i, Unit& u) const {
        const int x = c & 7, v = c >> 3, per = G >> 3; const long ul = (long)i * per + v; const int rb = x + 8 * (int)(ul / nN), pn = (int)(ul % nN); if (rb >= nblk) return false;
        const int e = blk_e[rb]; u.pm = rb; u.pn = pn; u.z = e;
        u.aoff = (long)rb * 256 * 1024; u.boff = ((long)e * nN * 256 + (long)pn * 256) * 1024; return true;
    }
};

__device__ __forceinline__ u32x4 pk8(const f32x4 a, const f32x4 b) { return (u32x4){pk2(a.x, a.y), pk2(a.z, a.w), pk2(b.x, b.y), pk2(b.z, b.w)}; }
struct EpiBf16 { static constexpr bool TILE = true; static constexpr int NST = 16; static constexpr int NPRE = 0; bf16_t* O; int ldo; const float* bias;
    __device__ __forceinline__ void tile(const f32x4 (&acc)[2][2][4][2], const Unit& u, int wr, int wc, int fr, int fq) const {
        const int col0 = u.pn * 256 + wc * 32 + 8 * fq; f32x4 b[2][2];
#pragma unroll
        for (int bj = 0; bj < 2; ++bj) { b[bj][0] = bias ? *(const f32x4*)(bias + col0 + bj * 128) : (f32x4){0.f, 0.f, 0.f, 0.f}; b[bj][1] = bias ? *(const f32x4*)(bias + col0 + bj * 128 + 4) : (f32x4){0.f, 0.f, 0.f, 0.f}; }
        if (bias) asm volatile("s_waitcnt vmcnt(0)" ::: "memory");
#pragma unroll
        for (int ai = 0; ai < 2; ++ai)
#pragma unroll
            for (int m = 0; m < 4; ++m) { bf16_t* rowp = O + (size_t)(u.pm * 256 + ai * 128 + wr * 64 + m * 16 + fr) * ldo + col0;
#pragma unroll
                for (int bj = 0; bj < 2; ++bj) *(u32x4*)(rowp + bj * 128) = pk8(acc[ai][bj][m][0] + b[bj][0], acc[ai][bj][m][1] + b[bj][1]); }
    }
    __device__ __forceinline__ void st4(const Unit&, int grow, int gcol, f32x4 v) const {
        if (bias) { const f32x4 b = *(const f32x4*)(bias + gcol); v += b; }
        u32x2 w; w.x = pk2(v.x, v.y); w.y = pk2(v.z, v.w); *(u32x2*)(O + (size_t)grow * ldo + gcol) = w; } };
struct EpiF32 { static constexpr bool TILE = false; static constexpr int NST = 0; static constexpr int NPRE = 0; float* O; int ldo; const float* bias0; const float* bias1;
    __device__ __forceinline__ void st4(const Unit&, int grow, int gcol, f32x4 v) const {
        if (bias0) { const f32x4 b = (gcol < 256) ? *(const f32x4*)(bias0 + gcol) : *(const f32x4*)(bias1 + gcol - 256); v += b; }
        *(f32x4*)(O + (size_t)grow * ldo + gcol) = v; } };
struct EpiPre { static constexpr bool TILE = false; static constexpr int NST = 0; static constexpr int NPRE = 0; unsigned char* ws;
    __device__ __forceinline__ void st4(const Unit& u, int grow, int gcol, f32x4 v) const {
        bf16_t* O = (bf16_t*)(ws + ((u.z & 1) ? WS_VXT : WS_KX) + (size_t)(u.z >> 1) * 2 * MiB);
        u32x2 w; w.x = pk2(v.x, v.y); w.y = pk2(v.z, v.w); *(u32x2*)(O + (size_t)grow * 1024 + gcol) = w; } };
__device__ __forceinline__ void rope2(float& x1, float& x2, float ang) { const float c = __cosf(ang), s = __sinf(ang); const float a = x1 * c - x2 * s, b = x2 * c + x1 * s; x1 = a; x2 = b; }
struct EpiGU { static constexpr bool TILE = true; static constexpr int NST = 8; static constexpr int NPRE = 1; bf16_t* O; const float* bgu; LAS unsigned char* lds;
    __device__ __forceinline__ void prefetch(const Unit& u, int wid, int lane) const {
        const float* b = bgu + (size_t)u.z * 2048 + (lane >> 5) * 1024 + u.pn * 128 + (wid & 3) * 32 + (lane & 31);
        __builtin_amdgcn_global_load_lds((const unsigned*)b, (LAS unsigned*)(lds + EPI_BIAS_OFF + wid * 256), 4, 0, 0); }
    __device__ __forceinline__ void tile(const f32x4 (&acc)[2][2][4][2], const Unit& u, int wr, int wc, int fr, int fq) const {
        const int acol = u.pn * 128 + wc * 32 + 8 * fq; const LAS float* b = (const LAS float*)(lds + EPI_BIAS_OFF + (wr * 4 + wc) * 256) + 8 * fq;
        const f32x4 bg0 = *(const LAS f32x4*)b, bg1 = *(const LAS f32x4*)(b + 4); f32x4 bu0 = *(const LAS f32x4*)(b + 32), bu1 = *(const LAS f32x4*)(b + 36);
        bu0 += 1.f; bu1 += 1.f;
#define GU_PAIR(G, U, BG, BU, I) ({ hwf2 g_ = hwf2{G[I], G[I + 1]} + hwf2{BG[I], BG[I + 1]}, u_ = hwf2{U[I], U[I + 1]} + hwf2{BU[I], BU[I + 1]};   \
            g_.x = fminf(g_.x, 7.f); g_.y = fminf(g_.y, 7.f); u_.x = __builtin_amdgcn_fmed3f(u_.x, -6.f, 8.f); u_.y = __builtin_amdgcn_fmed3f(u_.y, -6.f, 8.f);          \
            hwf2 e_ = g_ * -2.45546696f; e_.x = __builtin_amdgcn_exp2f(e_.x); e_.y = __builtin_amdgcn_exp2f(e_.y); e_ = e_ + 1.f;                                       \
            e_.x = __builtin_amdgcn_rcpf(e_.x); e_.y = __builtin_amdgcn_rcpf(e_.y); const hwf2 a_ = (g_ * u_) * e_; pk2(a_.x, a_.y); })
#pragma unroll
        for (int ai = 0; ai < 2; ++ai)
#pragma unroll
            for (int m = 0; m < 4; ++m) { const f32x4 g0 = acc[ai][0][m][0], g1 = acc[ai][0][m][1], u0 = acc[ai][1][m][0], u1 = acc[ai][1][m][1];
                u32x4 o; o.x = GU_PAIR(g0, u0, bg0, bu0, 0); o.y = GU_PAIR(g0, u0, bg0, bu0, 2); o.z = GU_PAIR(g1, u1, bg1, bu1, 0); o.w = GU_PAIR(g1, u1, bg1, bu1, 2);
                *(u32x4*)(O + (size_t)(u.pm * 256 + ai * 128 + wr * 64 + m * 16 + fr) * 1024 + acol) = o;
                __builtin_amdgcn_sched_barrier(0); }
#undef GU_PAIR
    }
    __device__ __forceinline__ void st4x2(const Unit& u, int grow, int acol, f32x4 g, f32x4 up) const {
        const float* b = bgu + (size_t)u.z * 2048; const f32x4 bg = *(const f32x4*)(b + acol), bu = *(const f32x4*)(b + 1024 + acol);
        g += bg; up += bu; f32x4 a;
#pragma unroll
        for (int i = 0; i < 4; ++i) { const float gg = fminf(g[i], 7.f), uu = fminf(fmaxf(up[i], -7.f), 7.f); a[i] = (uu + 1.f) * (gg * sigmoidf_(1.702f * gg)); }
        u32x2 w; w.x = pk2(a.x, a.y); w.y = pk2(a.z, a.w); *(u32x2*)(O + (size_t)grow * 1024 + acol) = w; } };
struct EpiDown { static constexpr bool TILE = true; static constexpr int NST = 16; static constexpr int NPRE = 1; bf16_t* O; const float* bdn; LAS unsigned char* lds;
    __device__ __forceinline__ void prefetch(const Unit& u, int wid, int lane) const {
        const float* b = bdn + (size_t)u.z * 1024 + u.pn * 256 + (lane >> 5) * 128 + (wid & 3) * 32 + (lane & 31);
        __builtin_amdgcn_global_load_lds((const unsigned*)b, (LAS unsigned*)(lds + EPI_BIAS_OFF + wid * 256), 4, 0, 0); }
    __device__ __forceinline__ void tile(const f32x4 (&acc)[2][2][4][2], const Unit& u, int wr, int wc, int fr, int fq) const {
        const int col0 = u.pn * 256 + wc * 32 + 8 * fq; const LAS float* bl = (const LAS float*)(lds + EPI_BIAS_OFF + (wr * 4 + wc) * 256) + 8 * fq; f32x4 b[2][2];
#pragma unroll
        for (int bj = 0; bj < 2; ++bj) { b[bj][0] = *(const LAS f32x4*)(bl + 32 * bj); b[bj][1] = *(const LAS f32x4*)(bl + 32 * bj + 4); }
#pragma unroll
        for (int ai = 0; ai < 2; ++ai)
#pragma unroll
            for (int m = 0; m < 4; ++m) { bf16_t* rowp = O + (size_t)(u.pm * 256 + ai * 128 + wr * 64 + m * 16 + fr) * 1024 + col0;
#pragma unroll
                for (int bj = 0; bj < 2; ++bj) *(u32x4*)(rowp + bj * 128) = pk8(acc[ai][bj][m][0] + b[bj][0], acc[ai][bj][m][1] + b[bj][1]); }
    }
    __device__ __forceinline__ void st4(const Unit& u, int grow, int gcol, f32x4 v) const {
        const f32x4 b = *(const f32x4*)(bdn + (size_t)u.z * 1024 + gcol); v += b;
        u32x2 w; w.x = pk2(v.x, v.y); w.y = pk2(v.z, v.w); *(u32x2*)(O + (size_t)grow * 1024 + gcol) = w; } };

struct EpiXS { static constexpr bool TILE = true; static constexpr int NST = 16; static constexpr int NPRE = 0; bf16_t* P; float* RS;
    __device__ __forceinline__ void tile(const f32x4 (&acc)[2][2][4][2], const Unit& u, int wr, int wc, int fr, int fq) const {
#pragma unroll
        for (int ai = 0; ai < 2; ++ai)
#pragma unroll
            for (int m = 0; m < 4; ++m) { const int grow = u.pm * 256 + ai * 128 + wr * 64 + m * 16 + fr; float rs = 0.f;
#pragma unroll
                for (int bj = 0; bj < 2; ++bj) { f32x4 p0, p1;
#pragma unroll
                    for (int i = 0; i < 4; ++i) { p0[i] = __builtin_amdgcn_exp2f(fminf(acc[ai][bj][m][0][i], 100.f)); p1[i] = __builtin_amdgcn_exp2f(fminf(acc[ai][bj][m][1][i], 100.f)); }
                    rs += ((p0.x + p0.y) + (p0.z + p0.w)) + ((p1.x + p1.y) + (p1.z + p1.w));
                    u32x4 w; w.x = pk2(p0.x, p0.y); w.y = pk2(p0.z, p0.w); w.z = pk2(p1.x, p1.y); w.w = pk2(p1.z, p1.w);
                    *(u32x4*)(P + (size_t)grow * 1024 + u.pn * 256 + bj * 128 + wc * 32 + 8 * fq) = w; }
                rs = rsum<16>(rs); rs = rsum<32>(rs);
                if (fq == 0) RS[((size_t)grow * 4 + u.pn) * 4 + wc] = rs;
                __builtin_amdgcn_sched_barrier(0); }
    } };
struct EpiXO { static constexpr bool TILE = true; static constexpr int NST = 16; static constexpr int NPRE = 0; bf16_t* O; const float* RS;
    __device__ __forceinline__ void tile(const f32x4 (&acc)[2][2][4][2], const Unit& u, int wr, int wc, int fr, int fq) const {
        const int col0 = u.pn * 256 + wc * 32 + 8 * fq; float rr[2][4];
#pragma unroll
        for (int ai = 0; ai < 2; ++ai)
#pragma unroll
            for (int m = 0; m < 4; ++m) { const int grow = u.pm * 256 + ai * 128 + wr * 64 + m * 16 + fr; const f32x4 q = *(const f32x4*)(RS + ((size_t)grow * 4 + u.pn) * 4); rr[ai][m] = __builtin_amdgcn_rcpf((q.x + q.y) + (q.z + q.w)); }
        asm volatile("s_waitcnt vmcnt(0)" ::: "memory");
#pragma unroll
        for (int ai = 0; ai < 2; ++ai)
#pragma unroll
            for (int m = 0; m < 4; ++m) { const int grow = u.pm * 256 + ai * 128 + wr * 64 + m * 16 + fr; const float r = rr[ai][m];
#pragma unroll
                for (int bj = 0; bj < 2; ++bj) *(u32x4*)(O + (size_t)grow * 1024 + col0 + bj * 128) = pk8(acc[ai][bj][m][0] * r, acc[ai][bj][m][1] * r); }
    }
    __device__ __forceinline__ void st4(const Unit&, int grow, int gcol, f32x4 v) const {
        const f32x4 q = *(const f32x4*)(RS + ((size_t)grow * 4 + (gcol >> 8)) * 4); const float r = __builtin_amdgcn_rcpf((q.x + q.y) + (q.z + q.w)); v = v * r;
        u32x2 w; w.x = pk2(v.x, v.y); w.y = pk2(v.z, v.w); *(u32x2*)(O + (size_t)grow * 1024 + gcol) = w; } };

template <bool PAIR, class Sched, class Epi>
__device__ __forceinline__ void sgemm_phase(const int tid, const GemmDesc g, const Sched& S, const Epi& E) {
    const int wid = tid >> 6, lane = tid & 63, r32 = lane & 31, hi = lane >> 5;
    Unit u;
    for (int i = 0; S.next(i, u); ++i) {
        const int grow = u.pm * 256 + wid * 32 + r32;
        const bf16_t* Ap = g.A + u.aoff + (long)(wid * 32 + r32) * g.lda + hi * 8;
        const bf16_t* Bp = g.Bt + u.boff + (long)r32 * g.ldb + hi * 8;
#pragma unroll 1
        for (int pass = 0; pass < 2; ++pass) {
            int cbs[4];
#pragma unroll
            for (int j = 0; j < 4; ++j) cbs[j] = PAIR ? ((j & 1) + 2 * pass + 4 * (j >> 1)) : (4 * pass + j);
            f32x16 acc[4];
#pragma unroll
            for (int j = 0; j < 4; ++j) acc[j] = f32x16{};
#pragma unroll 2
            for (int k0 = 0; k0 < g.K; k0 += 16) {
                const bf16x8 a = *(const bf16x8*)(Ap + k0);
#pragma unroll
                for (int j = 0; j < 4; ++j) { const bf16x8 b = *(const bf16x8*)(Bp + (long)cbs[j] * 32 * g.ldb + k0); acc[j] = __builtin_amdgcn_mfma_f32_32x32x16_bf16(b, a, acc[j], 0, 0, 0); }
            }
            if constexpr (PAIR) {
#pragma unroll
                for (int j = 0; j < 2; ++j)
#pragma unroll
                    for (int q = 0; q < 4; ++q) { const f32x4 gv = {acc[j][4 * q], acc[j][4 * q + 1], acc[j][4 * q + 2], acc[j][4 * q + 3]};
                        const f32x4 uv = {acc[j + 2][4 * q], acc[j + 2][4 * q + 1], acc[j + 2][4 * q + 2], acc[j + 2][4 * q + 3]};
                        E.st4x2(u, grow, u.pn * 128 + cbs[j] * 32 + 8 * q + 4 * hi, gv, uv); }
            } else {
#pragma unroll
                for (int j = 0; j < 4; ++j)
#pragma unroll
                    for (int q = 0; q < 4; ++q) { const f32x4 v = {acc[j][4 * q], acc[j][4 * q + 1], acc[j][4 * q + 2], acc[j][4 * q + 3]};
                        E.st4(u, grow, u.pn * 256 + cbs[j] * 32 + 8 * q + 4 * hi, v); }
            }
        }
    }
}

namespace pg8 {
constexpr int BK = 64, HALF = 128, HTB = HALF * BK * 2, STAGE_BYTES = 8 * HTB;
__device__ __forceinline__ int lds_byte(int r, int c) { const int st = (r >> 4) * 2 + (c >> 5), rr = r & 15, cc = c & 31, ob = rr * 64 + cc * 2; return st * 1024 + (ob ^ (((ob >> 9) & 1) << 5)); }
__device__ __forceinline__ void stage_rc(int b, int& R, int& C) { const int st = b / 1024, sb = b % 1024, swz = sb ^ (((sb >> 9) & 1) << 5); R = (st >> 1) * 16 + swz / 64; C = (st & 1) * 32 + (swz % 64) / 2; }
__device__ __forceinline__ int perm32(int rho) { const int n = rho >> 4, i = rho & 15; return 8 * (i >> 2) + 4 * n + (i & 3); }
template <bool PAIR, class Epi>
__device__ __forceinline__ void run_epi(const Epi& E, const f32x4 (&acc)[2][2][4][2], const Unit& u, int wr, int wc, int fr, int fq) {
    if constexpr (Epi::TILE) { E.tile(acc, u, wr, wc, fr, fq); return; } else {
#pragma unroll
    for (int ai = 0; ai < 2; ++ai)
#pragma unroll
        for (int m = 0; m < 4; ++m) { const int grow = u.pm * 256 + ai * HALF + wr * 64 + m * 16 + fr;
            if constexpr (PAIR) {
#pragma unroll
                for (int n = 0; n < 2; ++n) E.st4x2(u, grow, u.pn * 128 + wc * 32 + 8 * fq + 4 * n, acc[ai][0][m][n], acc[ai][1][m][n]);
            } else {
#pragma unroll
                for (int bj = 0; bj < 2; ++bj)
#pragma unroll
                    for (int n = 0; n < 2; ++n) E.st4(u, grow, u.pn * 256 + bj * HALF + wc * 32 + 8 * fq + 4 * n, acc[ai][bj][m][n]);
            }
            __builtin_amdgcn_sched_barrier(0); }
    }
}
template <bool PAIR, bool GATH, class Sched, class Epi>
__device__ __forceinline__ void gemm_phase(const int tid, LAS unsigned char* lds, const GemmDesc g, const Sched& S, const Epi& E) {
    const int wid = __builtin_amdgcn_readfirstlane(tid >> 6), lane = tid & 63, wr = wid >> 2, wc = wid & 3, fr = lane & 15, fq = lane >> 4;
    const int K = g.K, nt = K / BK;
    unsigned voffA[2], voffB[2]; int RA[2], CA[2];
#pragma unroll
    for (int i = 0; i < 2; ++i) { int R, C; stage_rc(tid * 16 + i * 8192, R, C); const int Rb = (R & ~31) + perm32(R & 31); RA[i] = R; CA[i] = C * 2;
        voffA[i] = (unsigned)(R * g.lda + C) * 2u; voffB[i] = (unsigned)(Rb * g.ldb + C) * 2u; }
    unsigned cvA[2][2], nvA[2][2];
#define PG8_GVOFF(U, V) do { if constexpr (GATH) { _Pragma("unroll") for (int h_ = 0; h_ < 2; ++h_) _Pragma("unroll") for (int i_ = 0; i_ < 2; ++i_) \
        V[h_][i_] = (unsigned)g.tok[(U).pm * 256 + h_ * HALF + RA[i_]] * (unsigned)(g.lda * 2) + (unsigned)CA[i_]; } } while (0)
    const size_t kstep = (size_t)(BK * 2);
    const size_t hstepA = (size_t)HALF * g.lda * 2, hstepB = (size_t)HALF * g.ldb * 2;
    const unsigned ldsw = (unsigned)wid * 1024u;
    const int aoff = lds_byte(wr * 64 + fr, fq * 8), boff = lds_byte(wc * 32 + fr, fq * 8);
#define PG8_SA(b, h) (((b) * 2 + (h)) * HTB)
#define PG8_SB(b, h) ((4 + (b) * 2 + (h)) * HTB)
#define PG8_STAGE(bufoff, gbase, voff) do { _Pragma("unroll") for (int _i = 0; _i < 2; ++_i) \
        __builtin_amdgcn_global_load_lds((const unsigned*)((const char*)(gbase) + (voff)[_i]), (LAS unsigned*)(lds + (bufoff) + ldsw + _i * 8192), 16, 0, 0); } while (0)
#define PG8_STA(b, h, base, V) do { if constexpr (GATH) PG8_STAGE(PG8_SA(b, h), base, V[h]); else PG8_STAGE(PG8_SA(b, h), (base) + (h) * hstepA, voffA); } while (0)
#define PG8_LDA(dst, b, h) do { _Pragma("unroll") for (int m = 0; m < 4; ++m) _Pragma("unroll") for (int k = 0; k < 2; ++k) dst[m][k] = *(const LAS bf16x8*)(lds + PG8_SA(b, h) + aoff + m * 2048 + k * 1024); } while (0)
#define PG8_LDB(dst, b, h) do { _Pragma("unroll") for (int n = 0; n < 2; ++n) _Pragma("unroll") for (int k = 0; k < 2; ++k) dst[n][k] = *(const LAS bf16x8*)(lds + PG8_SB(b, h) + boff + n * 2048 + k * 1024); } while (0)
#define PG8_MMA(ai, bj, At, Bt) do { __builtin_amdgcn_s_setprio(1); _Pragma("unroll") for (int m = 0; m < 4; ++m) _Pragma("unroll") for (int n = 0; n < 2; ++n) _Pragma("unroll") for (int k = 0; k < 2; ++k) \
        acc[ai][bj][m][n] = __builtin_amdgcn_mfma_f32_16x16x32_bf16(Bt[n][k], At[m][k], acc[ai][bj][m][n], 0, 0, 0); __builtin_amdgcn_s_setprio(0); } while (0)
#define PG8_WAIT_V(n) asm volatile("s_waitcnt vmcnt(" #n ")" ::: "memory")
#define PG8_WAIT_VN(n) asm volatile("s_waitcnt vmcnt(%0)" :: "n"(n) : "memory")
#define PG8_WAIT_L(n) asm volatile("s_waitcnt lgkmcnt(" #n ")" ::: "memory")
#define PG8_BAR __builtin_amdgcn_s_barrier()
#define PG8_SCHED __builtin_amdgcn_sched_barrier(0)
    Unit cur, nxt; int ui = 0;
    if (!S.next(0, cur)) return;
    bool has_next = S.next(1, nxt);
    f32x4 acc[2][2][4][2];
    float zf = 0.f; asm volatile("" : "+v"(zf)); const f32x4 Z4 = {zf, zf, zf, zf};
#pragma unroll
    for (int a = 0; a < 2; ++a)
#pragma unroll
        for (int b = 0; b < 2; ++b)
#pragma unroll
            for (int m = 0; m < 4; ++m)
#pragma unroll
                for (int n = 0; n < 2; ++n) acc[a][b][m][n] = Z4;
    bf16x8 At[4][2], B0[2][2], B1[2][2];
    const char* cA = (const char*)g.A + (GATH ? (size_t)0 : (size_t)cur.aoff * 2); const char* cB = (const char*)g.Bt + (size_t)cur.boff * 2;
    const char* nA = (has_next && !GATH) ? (const char*)g.A + (size_t)nxt.aoff * 2 : cA; const char* nB = has_next ? (const char*)g.Bt + (size_t)nxt.boff * 2 : cB;
    PG8_GVOFF(cur, cvA);
    if constexpr (GATH) { if (has_next) PG8_GVOFF(nxt, nvA); else { _Pragma("unroll") for (int h_ = 0; h_ < 2; ++h_) _Pragma("unroll") for (int i_ = 0; i_ < 2; ++i_) nvA[h_][i_] = cvA[h_][i_]; } }
    PG8_STAGE(PG8_SB(0, 0), cB, voffB); PG8_STAGE(PG8_SB(0, 1), cB + hstepB, voffB); PG8_STA(0, 0, cA, cvA); PG8_STA(0, 1, cA, cvA);
    PG8_STAGE(PG8_SB(1, 0), cB + kstep, voffB); PG8_STA(1, 0, cA + kstep, cvA); PG8_STAGE(PG8_SB(1, 1), cB + hstepB + kstep, voffB); PG8_STA(1, 1, cA + kstep, cvA);
    PG8_WAIT_V(0);
    if (wr == 1) PG8_BAR;
    PG8_BAR;
    constexpr int WX = 8 + Epi::NST + Epi::NPRE;
#define PG8_WAIT_X() do { if constexpr (WX == 8) PG8_WAIT_V(8); else { if (fst) PG8_WAIT_VN(WX); else PG8_WAIT_V(8); } } while (0)
    for (;;) {
        int fst = 1; asm volatile("" : "+s"(fst));
#pragma unroll 1
        for (int t = 0; t < nt; t += 2) {
            const bool last = (t == nt - 2);
            const char* a1 = cA + (size_t)(t + 1) * kstep;
            const char* a2 = last ? nA : cA + (size_t)(t + 2) * kstep; const char* b2 = last ? nB : cB + (size_t)(t + 2) * kstep;
            const char* a3 = a2 + kstep; const char* b3 = b2 + kstep;
            unsigned sv[2][2];
            if constexpr (GATH) { _Pragma("unroll") for (int h_ = 0; h_ < 2; ++h_) _Pragma("unroll") for (int i_ = 0; i_ < 2; ++i_) sv[h_][i_] = last ? nvA[h_][i_] : cvA[h_][i_]; }
            PG8_LDB(B0, 0, 0); PG8_LDB(B1, 0, 1); PG8_SCHED; PG8_LDA(At, 0, 0); if (!fst) PG8_STA(1, 1, a1, cvA); else { if constexpr (Epi::NPRE == 1) E.prefetch(cur, wid, lane); }
            PG8_WAIT_X(); PG8_WAIT_L(0); PG8_BAR; PG8_MMA(0, 0, At, B0); PG8_MMA(0, 1, At, B1); PG8_BAR; PG8_SCHED;
            PG8_LDA(At, 0, 1); PG8_STAGE(PG8_SB(0, 0), b2, voffB); PG8_STAGE(PG8_SB(0, 1), b2 + hstepB, voffB); PG8_STA(0, 0, a2, sv);
            PG8_WAIT_X(); PG8_WAIT_L(0); PG8_BAR; PG8_MMA(1, 0, At, B0); PG8_MMA(1, 1, At, B1); PG8_BAR; PG8_SCHED;
            PG8_LDB(B0, 1, 0); PG8_LDB(B1, 1, 1); PG8_SCHED; PG8_LDA(At, 1, 0); PG8_STA(0, 1, a2, sv);
            PG8_WAIT_X(); PG8_WAIT_L(0); PG8_BAR; PG8_MMA(0, 0, At, B0); PG8_MMA(0, 1, At, B1); PG8_BAR; PG8_SCHED;
            PG8_LDA(At, 1, 1); PG8_STAGE(PG8_SB(1, 0), b3, voffB); PG8_STAGE(PG8_SB(1, 1), b3 + hstepB, voffB); PG8_STA(1, 0, a3, sv);
            PG8_WAIT_V(8); PG8_WAIT_L(0); PG8_BAR; PG8_MMA(1, 0, At, B0); PG8_MMA(1, 1, At, B1); PG8_BAR; PG8_SCHED;
            fst = 0;
        }
        if (wr == 0) PG8_BAR;
        PG8_STA(1, 1, nA + kstep, nvA);
        Unit nn; const bool has_nn = has_next && S.next(ui + 2, nn);
        unsigned n2vA[2][2];
        if constexpr (GATH) { if (has_nn) PG8_GVOFF(nn, n2vA); else { _Pragma("unroll") for (int h_ = 0; h_ < 2; ++h_) _Pragma("unroll") for (int i_ = 0; i_ < 2; ++i_) n2vA[h_][i_] = nvA[h_][i_]; } }
        run_epi<PAIR>(E, acc, cur, wr, wc, fr, fq);
        if (!has_next) break;
#pragma unroll
        for (int a = 0; a < 2; ++a)
#pragma unroll
            for (int b = 0; b < 2; ++b)
#pragma unroll
                for (int m = 0; m < 4; ++m)
#pragma unroll
                    for (int n = 0; n < 2; ++n) acc[a][b][m][n] = Z4;
        cur = nxt; cA = nA; cB = nB; ++ui;
        if constexpr (GATH) { _Pragma("unroll") for (int h_ = 0; h_ < 2; ++h_) _Pragma("unroll") for (int i_ = 0; i_ < 2; ++i_) { cvA[h_][i_] = nvA[h_][i_]; nvA[h_][i_] = n2vA[h_][i_]; } }
        has_next = has_nn;
        if (has_nn) { nxt = nn; if constexpr (!GATH) nA = (const char*)g.A + (size_t)nn.aoff * 2; nB = (const char*)g.Bt + (size_t)nn.boff * 2; }
        if (wr == 1) PG8_BAR;
    }
#undef PG8_WAIT_X
    PG8_WAIT_V(0);
    PG8_BAR;
#undef PG8_SA
#undef PG8_SB
#undef PG8_STAGE
#undef PG8_LDA
#undef PG8_STA
#undef PG8_GVOFF
#undef PG8_LDB
#undef PG8_MMA
#undef PG8_WAIT_V
#undef PG8_WAIT_VN
#undef PG8_WAIT_L
#undef PG8_BAR
#undef PG8_SCHED
}
}

struct Args { const float* in[37]; float* out; unsigned char* ws; int lo, hi, pad0, pad1; };
enum { I_X = 0, I_MEM, I_LNIN_G, I_LNIN_B, I_WIN, I_WF, I_BF, I_DWW, I_DWB, I_CLG, I_CLB, I_WPW, I_BPW, I_QG, I_KG, I_MQG, I_WUQ, I_MKG, I_WUKV, I_GRPG, I_WO, I_LN1G, I_LN1B,
       I_WXQ, I_WXK, I_WXV, I_WXO, I_LN2G, I_LN2B, I_WR, I_BR, I_WGU, I_BGU, I_WDN, I_BDN, I_LN3G, I_LN3B };

__device__ __forceinline__ int rope_perm16(int d) { const int half = d >> 4, dd = d & 15; return half * 16 + ((dd < 8) ? 2 * dd : 2 * (dd - 8) + 1); }
__device__ __forceinline__ int rope_perm32(int d) { const int half = d >> 5, dd = d & 31; return half * 32 + ((dd < 16) ? 2 * dd : 2 * (dd - 16) + 1); }
__device__ __forceinline__ int map_row(int mode, int n) {
    switch (mode) {
    case 1: if (n < 256) return -1; if (n < 768) return n; if (n < 1152) { const int m = n - 768; return 768 + (m & ~63) + rope_perm32(m & 63); } if (n < 1664) return n; return 1664 + rope_perm16(n - 1664);
    case 2: { const int h = n / 96, p = n % 96; return h * 128 + (p < 64 ? p : 64 + rope_perm16(p - 64)); }
    case 3: return 512 + n;
    case 4: { const int half = n >> 10, m = n & 1023; return (m >> 7) * 256 + half * 128 + (m & 127); }
    default: return n;
    }
}
__device__ __forceinline__ int fnet_j(int cc) { const int jp = cc >> 1, second = cc & 1; return jp == 0 ? (second ? 32 : 0) : (second ? 64 - jp : jp); }
__device__ __forceinline__ void tr_item(const float* __restrict__ W, int N, bf16_t* dst, int ldd, int koff, const float* kgain, float scale, int mode, int rowbase, LAS float* scr, int item, int lane, int kperm = 0) {
    const int nblk = (N + 63) >> 6, kb = item / nblk, nb = item - kb * nblk, k0 = kb * 64, n0 = nb * 64;
    const int nq = (lane & 15) * 4, kq = lane >> 4;
    const bool ok = (n0 + nq) < N;
    f32x4 v[16];
#pragma unroll
    for (int i = 0; i < 16; ++i) { const int kk = 4 * i + kq; const int ksrc = kperm ? (((k0 + kk) & ~63) + fnet_j((k0 + kk) & 63)) : (k0 + kk); v[i] = ok ? *(const f32x4*)(W + (size_t)ksrc * N + n0 + nq) : (f32x4){0.f, 0.f, 0.f, 0.f}; }
#pragma unroll
    for (int i = 0; i < 16; ++i) { const int kk = 4 * i + kq; const float gs = (kgain ? kgain[k0 + kk] : 1.f) * scale;
        scr[kk * 65 + nq + 0] = v[i].x * gs; scr[kk * 65 + nq + 1] = v[i].y * gs; scr[kk * 65 + nq + 2] = v[i].z * gs; scr[kk * 65 + nq + 3] = v[i].w * gs; }
    LDS_WAIT(); asm volatile("" ::: "memory");
    const int c = lane & 7;
#pragma unroll
    for (int j = 0; j < 8; ++j) { const int n = (lane >> 3) + 8 * j;
        if (n0 + n < N) { const int row = map_row(mode, n0 + n);
            if (row >= 0) { const LAS float* s = scr + (8 * c) * 65 + n;
                u32x4 o; o.x = pk2(s[0 * 65], s[1 * 65]); o.y = pk2(s[2 * 65], s[3 * 65]); o.z = pk2(s[4 * 65], s[5 * 65]); o.w = pk2(s[6 * 65], s[7 * 65]);
                *(u32x4*)(dst + (size_t)(rowbase + row) * ldd + koff + k0 + 8 * c) = o; } } }
    LDS_WAIT(); asm volatile("" ::: "memory");
}
constexpr int IT_IN = 16 * 27, IT_UQ = 4 * 6, IT_UKV = 2 * 8, IT_F = 16, IT_SQ = 256, IT_GU = 32 * 512, IT_DN = 32 * 256;
constexpr int IT_SMALL = IT_IN + IT_UQ + IT_UKV + 2 * IT_F + 5 * IT_SQ, IT_MOE = IT_GU + IT_DN;

struct R8 { f32x4 lo, hi; };
__device__ __forceinline__ R8 unpack8(const u32x4 w) { R8 r; r.lo = (f32x4){bflo(w.x), bfhi(w.x), bflo(w.y), bfhi(w.y)}; r.hi = (f32x4){bflo(w.z), bfhi(w.z), bflo(w.w), bfhi(w.w)}; return r; }
__device__ __forceinline__ u32x4 pack8(const R8& r) { return (u32x4){pk2(r.lo.x, r.lo.y), pk2(r.lo.z, r.lo.w), pk2(r.hi.x, r.hi.y), pk2(r.hi.z, r.hi.w)}; }
__device__ __forceinline__ float hsum8(const R8& r) { return ((r.lo.x + r.lo.y) + (r.lo.z + r.lo.w)) + ((r.hi.x + r.hi.y) + (r.hi.z + r.hi.w)); }
__device__ __forceinline__ float hsq8(const R8& r) { return ((r.lo.x * r.lo.x + r.lo.y * r.lo.y) + (r.lo.z * r.lo.z + r.lo.w * r.lo.w)) + ((r.hi.x * r.hi.x + r.hi.y * r.hi.y) + (r.hi.z * r.hi.z + r.hi.w * r.hi.w)); }
template <int NR>
__device__ __forceinline__ void ln_rows(R8 (&v)[NR][2], const float* g, const float* b, int lane) {
    float mean[NR], rstd[NR];
    f32x4 gv[2][2], bv[2][2];
#pragma unroll
    for (int j = 0; j < 2; ++j) { gv[j][0] = *(const f32x4*)(g + 512 * j + 8 * lane); gv[j][1] = *(const f32x4*)(g + 512 * j + 8 * lane + 4); bv[j][0] = *(const f32x4*)(b + 512 * j + 8 * lane); bv[j][1] = *(const f32x4*)(b + 512 * j + 8 * lane + 4); }
#pragma unroll
    for (int q = 0; q < NR; ++q) mean[q] = hsum8(v[q][0]) + hsum8(v[q][1]);
#pragma unroll
    for (int q = 0; q < NR; ++q) mean[q] = rsum<2>(rsum<1>(mean[q]));
#pragma unroll
    for (int q = 0; q < NR; ++q) mean[q] = rsum<8>(rsum<4>(mean[q]));
#pragma unroll
    for (int q = 0; q < NR; ++q) mean[q] = rsum<32>(rsum<16>(mean[q]));
#pragma unroll
    for (int q = 0; q < NR; ++q) { mean[q] *= (1.f / D);
#pragma unroll
        for (int j = 0; j < 2; ++j) { v[q][j].lo = v[q][j].lo - mean[q]; v[q][j].hi = v[q][j].hi - mean[q]; }
        rstd[q] = hsq8(v[q][0]) + hsq8(v[q][1]); }
#pragma unroll
    for (int q = 0; q < NR; ++q) rstd[q] = rsum<2>(rsum<1>(rstd[q]));
#pragma unroll
    for (int q = 0; q < NR; ++q) rstd[q] = rsum<8>(rsum<4>(rstd[q]));
#pragma unroll
    for (int q = 0; q < NR; ++q) rstd[q] = rsum<32>(rsum<16>(rstd[q]));
#pragma unroll
    for (int j = 0; j < 2; ++j) { const f32x4 g0 = gv[j][0], g1 = gv[j][1], b0 = bv[j][0], b1 = bv[j][1];
#pragma unroll
        for (int q = 0; q < NR; ++q) { const float r = __builtin_amdgcn_rsqf(rstd[q] * (1.f / D) + LN_EPS); v[q][j].lo = v[q][j].lo * r * g0 + b0; v[q][j].hi = v[q][j].hi * r * g1 + b1; } }
}
__device__ __forceinline__ void store_row_bf16(bf16_t* row, const R8 (&v)[2], int lane) {
#pragma unroll
    for (int j = 0; j < 2; ++j) *(u32x4*)(row + 512 * j + 8 * lane) = pack8(v[j]);
}
__device__ __forceinline__ void store_row_f32(float* row, const R8 (&v)[2], int lane) {
#pragma unroll
    for (int j = 0; j < 2; ++j) { *(f32x4*)(row + 512 * j + 8 * lane) = v[j].lo; *(f32x4*)(row + 512 * j + 8 * lane + 4) = v[j].hi; }
}

struct MoeWItem { const float* W; bf16_t* dst; int N, mode, rowbase, k0, n0; };
__device__ __forceinline__ MoeWItem moe_w_item(const Args& a, int it) {
    MoeWItem m; const int l = it / IT_MOE; int r = it - l * IT_MOE; unsigned char* wl = a.ws + WS_W + (size_t)l * WL_SIZE; int item;
    if (r < IT_GU) { const int e = r >> 9; m.W = a.in[I_WGU] + ((size_t)l * NE + e) * 1024 * 2048; m.N = 2048; m.dst = (bf16_t*)(wl + WL_GU); m.mode = 4; m.rowbase = e * 2048; item = r & 511; }
    else { r -= IT_GU; const int e = r >> 8; m.W = a.in[I_WDN] + ((size_t)l * NE + e) * 1024 * 1024; m.N = 1024; m.dst = (bf16_t*)(wl + WL_DN); m.mode = 0; m.rowbase = e * 1024; item = r & 255; }
    const int nblk = m.N >> 6, kb = item / nblk, nb = item - kb * nblk; m.k0 = kb * 64; m.n0 = nb * 64; return m;
}
__device__ __forceinline__ void moe_w_load(const MoeWItem& m, int lane, f32x4 (&v)[16]) {
    const float* src = m.W + (size_t)(m.k0 + 2 * (lane >> 4)) * m.N + m.n0 + (lane & 15) * 4;
#pragma unroll
    for (int i = 0; i < 8; ++i) { v[2 * i] = __builtin_nontemporal_load((const f32x4*)(src + (size_t)(8 * i) * m.N)); v[2 * i + 1] = __builtin_nontemporal_load((const f32x4*)(src + (size_t)(8 * i + 1) * m.N)); }
}
__device__ __forceinline__ void moe_w_finish(const MoeWItem& m, int lane, const f32x4 (&v)[16], LAS float* scr) {
    const int l = lane & 15, kq = lane >> 4; LAS unsigned* sw = (LAS unsigned*)scr;
#pragma unroll
    for (int i = 0; i < 8; ++i) { LAS unsigned* w = sw + (4 * l) * 32 + 4 * (i ^ (l & 7)) + kq;
        w[0] = pk2(v[2 * i].x, v[2 * i + 1].x); w[32] = pk2(v[2 * i].y, v[2 * i + 1].y); w[64] = pk2(v[2 * i].z, v[2 * i + 1].z); w[96] = pk2(v[2 * i].w, v[2 * i + 1].w); }
    LDS_WAIT(); asm volatile("" ::: "memory");
    const int c = lane & 7;
#pragma unroll
    for (int j = 0; j < 8; ++j) { const int n = (lane >> 3) + 8 * j; const int row = map_row(m.mode, m.n0 + n);
        const u32x4 o = *(const LAS u32x4*)(sw + n * 32 + 4 * (c ^ ((n >> 2) & 7)));
        *(u32x4*)(m.dst + (size_t)(m.rowbase + row) * 1024 + m.k0 + 8 * c) = o; }
    LDS_WAIT(); asm volatile("" ::: "memory");
}
__device__ __forceinline__ void moe_weight_items(const int tid, const int bid, const Args& a, LAS unsigned char* lds) {
    const int lane = tid & 63, wave = tid >> 6;
    const int gw = bid * NWAVES + wave, NGW = gridDim.x * NWAVES;
    LAS float* scr = (LAS float*)(lds + wave * 16640);
    static_assert((NLAYER * IT_MOE) % (256 * NWAVES * 2) == 0, "every wave converts an even number of tiles");
    f32x4 va[16], vb[16];
    MoeWItem ma = moe_w_item(a, gw), mb; moe_w_load(ma, lane, va);
#pragma unroll 1
    for (int it = gw; it < NLAYER * IT_MOE; it += 2 * NGW) {
        mb = moe_w_item(a, it + NGW); moe_w_load(mb, lane, vb);
        moe_w_finish(ma, lane, va, scr);
        if (it + 2 * NGW < NLAYER * IT_MOE) { ma = moe_w_item(a, it + 2 * NGW); moe_w_load(ma, lane, va); }
        moe_w_finish(mb, lane, vb, scr);
    }
}
__device__ __forceinline__ void phase_pre0(const int tid, const int bid, const Args& a, LAS unsigned char* lds) {
    const int lane = tid & 63, wave = tid >> 6;
    const int gw = bid * NWAVES + wave, NGW = gridDim.x * NWAVES;
    const long gt = (long)bid * NTHREADS + tid, NGT = (long)gridDim.x * NTHREADS;
    unsigned char* ws = a.ws;
    LAS float* scr = (LAS float*)(lds + wave * 16640);
    for (int it = gw; it < NLAYER * IT_SMALL; it += NGW) {
        const int l = it / IT_SMALL; int r = it - l * IT_SMALL;
        unsigned char* wl = ws + WS_W + (size_t)l * WL_SIZE;
        if (r < IT_IN) { tr_item(a.in[I_WIN] + (size_t)l * 1024 * INC, INC, (bf16_t*)(wl + WL_IN), 1024, 0, nullptr, 1.f, 1, 0, scr, r, lane); continue; } r -= IT_IN;
        if (r < IT_UQ) { tr_item(a.in[I_WUQ] + (size_t)l * 256 * 384, 384, (bf16_t*)(wl + WL_MLA), 384, 0, a.in[I_MQG] + l * 256, QSCALE_M, 2, 0, scr, r, lane); continue; } r -= IT_UQ;
        if (r < IT_UKV) { tr_item(a.in[I_WUKV] + (size_t)l * 128 * 512, 512, (bf16_t*)(wl + WL_MLA), 384, 256, a.in[I_MKG] + l * 128, 1.f, 3, 0, scr, r, lane); continue; } r -= IT_UKV;
        if (r < IT_F) { tr_item(a.in[I_WF] + (size_t)l * 65536, 256, (bf16_t*)(wl + WL_FC), 256, 0, nullptr, 1.f, 0, 0, scr, r, lane, 1); continue; } r -= IT_F;
        if (r < IT_F) { tr_item(a.in[I_WPW] + (size_t)l * 65536, 256, (bf16_t*)(wl + WL_FC), 256, 0, nullptr, 1.f, 0, 256, scr, r, lane); continue; } r -= IT_F;
        if (r < IT_SQ) { tr_item(a.in[I_WO] + (size_t)l * D * D, D, (bf16_t*)(wl + WL_O), D, 0, a.in[I_GRPG] + l * 1024, 1.f, 0, 0, scr, r, lane); continue; } r -= IT_SQ;
        if (r < IT_SQ) { tr_item(a.in[I_WXQ] + (size_t)l * D * D, D, (bf16_t*)(wl + WL_XQ), D, 0, nullptr, QSCALE_X, 0, 0, scr, r, lane); continue; } r -= IT_SQ;
        if (r < IT_SQ) { tr_item(a.in[I_WXK] + (size_t)l * D * D, D, (bf16_t*)(wl + WL_XK), D, 0, nullptr, 1.f, 0, 0, scr, r, lane); continue; } r -= IT_SQ;
        if (r < IT_SQ) { tr_item(a.in[I_WXV] + (size_t)l * D * D, D, (bf16_t*)(wl + WL_XV), D, 0, nullptr, 1.f, 0, 0, scr, r, lane); continue; } r -= IT_SQ;
        { tr_item(a.in[I_WXO] + (size_t)l * D * D, D, (bf16_t*)(wl + WL_XO), D, 0, nullptr, 1.f, 0, 0, scr, r, lane); }
    }
    for (long idx = gt; idx < (long)NLAYER * 256 * 1024; idx += NGT) {
        const int l = (int)(idx >> 18), k = (int)(idx >> 8) & 1023, n = (int)idx & 255, g = n >> 6, cc = n & 63, jp = cc >> 1, second = cc & 1;
        const int mult = (jp == 0 && second) ? 32 : jp; const bool use_cos = (second == 0) || (jp == 0);
        const float* w = a.in[I_WIN] + ((size_t)l * 1024 + k) * INC + g * 64; float acc = 0.f;
#pragma unroll 8
        for (int c = 0; c < 64; ++c) { const float fr = (float)((mult * c) & 63) * (1.f / 64.f); const float cv = __builtin_amdgcn_cosf(fr), sv = -__builtin_amdgcn_sinf(fr); acc += w[c] * (use_cos ? cv : sv); }
        ((bf16_t*)(ws + WS_W + (size_t)l * WL_SIZE + WL_IN))[(size_t)n * 1024 + k] = (bf16_t)f2bf(acc);
    }
    for (long idx = gt; idx < (long)NLAYER * 96 * 1024; idx += NGT) { const int l = (int)(idx / (96 * 1024)); const long r = idx % (96 * 1024);
        ((bf16_t*)(ws + WS_W + (size_t)l * WL_SIZE + WL_IN))[(size_t)INC * 1024 + r] = 0; }
    for (long idx = gt; idx < (long)NLAYER * 1024 * 384; idx += NGT) { const int l = (int)(idx / (1024 * 384)); const int r = (int)(idx % (1024 * 384)), row = r / 384, k = r % 384;
        const bool pad = (row < 512) ? (k >= 256 || (row & 127) >= 96) : (k < 256);
        if (pad) ((bf16_t*)(ws + WS_W + (size_t)l * WL_SIZE + WL_MLA))[r] = 0; }
    for (long idx = gt; idx < (long)NLAYER * 32 * 1024; idx += NGT) { const int l = (int)(idx >> 15), e = (int)(idx >> 10) & 31, k = (int)idx & 1023;
        const float w = a.in[I_WR][((size_t)l * 1024 + k) * 32 + e]; const unsigned hb = f2bf(w); const unsigned lb = f2bf(w - bf2f(hb));
        bf16_t* wr = (bf16_t*)(ws + WS_W + (size_t)l * WL_SIZE + WL_RT); wr[e * 1024 + k] = (bf16_t)hb; wr[32768 + e * 1024 + k] = (bf16_t)lb; }
    for (long idx = gt; idx < (long)NB * MEML * D / 4; idx += NGT) { const f32x4 v = *(const f32x4*)(a.in[I_MEM] + idx * 4); u32x2 w; w.x = pk2(v.x, v.y); w.y = pk2(v.z, v.w); *(u32x2*)((bf16_t*)(ws + WS_MEMB) + idx * 4) = w; }
    for (int m0 = gw; m0 < T; m0 += 4 * NGW) { R8 v[4][2];
#pragma unroll
        for (int q = 0; q < 4; ++q) { const float* xr = a.in[I_X] + (size_t)(m0 + q * NGW) * D;
#pragma unroll
            for (int j = 0; j < 2; ++j) { v[q][j].lo = *(const f32x4*)(xr + 512 * j + 8 * lane); v[q][j].hi = *(const f32x4*)(xr + 512 * j + 8 * lane + 4); } }
        ln_rows<4>(v, a.in[I_LNIN_G], a.in[I_LNIN_B], lane);
#pragma unroll
        for (int q = 0; q < 4; ++q) store_row_bf16((bf16_t*)(ws + WS_HB) + (size_t)(m0 + q * NGW) * D, v[q], lane); }
}

struct LayerCtx {
    int l; unsigned char* ws; unsigned char* wl;
    bf16_t *Z, *FC, *QG, *KG, *CQKV, *KR, *QKVM, *Y, *XQ, *PB, *XO, *XS, *ACT, *YS, *HB;
    float *YMIX, *RS; bf16_t* FB;
    int *RE, *RR, *DEST, *TOK; float* GATE; unsigned* cnt;
};
__device__ __forceinline__ LayerCtx make_ctx(const Args& a, int l) {
    LayerCtx c; c.l = l; c.ws = a.ws; c.wl = a.ws + WS_W + (size_t)l * WL_SIZE; unsigned char* r = a.ws + WS_R;
    c.Z = (bf16_t*)(r + R_Z); c.FC = (bf16_t*)(r + R_FC); c.QG = (bf16_t*)(r + R_QG); c.KG = (bf16_t*)(r + R_KG); c.CQKV = (bf16_t*)(r + R_CQKV); c.KR = (bf16_t*)(r + R_KR);
    c.QKVM = (bf16_t*)(r + R_QKVM); c.YMIX = (float*)(r + R_YMIX); c.Y = (bf16_t*)(r + R_Y);
    c.XQ = (bf16_t*)(r + R_XQ); c.RS = (float*)(a.ws + WS_F + 64 * MiB); c.PB = (bf16_t*)(r + R_PB); c.XO = (bf16_t*)(r + R_XO);
    c.XS = (bf16_t*)(r + R_XS); c.ACT = (bf16_t*)(r + R_ACT); c.YS = (bf16_t*)(r + R_XS);
    c.HB = (bf16_t*)(a.ws + WS_HB); c.FB = (bf16_t*)(a.ws + WS_F);
    c.RE = (int*)(a.ws + WS_ROUTE); c.RR = c.RE + T * 4; c.GATE = (float*)(c.RR + T * 4); c.DEST = (int*)(c.GATE + T * 4);
    c.cnt = (unsigned*)(a.ws + WS_CTL) + CW_CNT + MAXWG * 32 * l; c.TOK = (int*)(a.ws + WS_CTL) + CW_TOK;
    return c;
}
constexpr float L2_THETA = 13.287712379549449f;

__device__ __forceinline__ void conv_item(const int tid, const Args& a, const LayerCtx& c, int item, LAS unsigned char* lds) {
    const int lane = tid & 63, wave = tid >> 6;
    LAS float* U = (LAS float*)lds; LAS float* CO = (LAS float*)lds;
    const int t0 = item * 64, b = t0 >> 13, s0 = t0 & (SEQ - 1);
#pragma unroll
    for (int i = 0; i < 6; ++i) { const int idx = tid + NTHREADS * i, row = idx >> 5, c8 = (idx & 31) * 8, sq = s0 - 15 + row;
        if (row < 94) { f32x4 u0 = {0.f, 0.f, 0.f, 0.f}, u1 = {0.f, 0.f, 0.f, 0.f};
            if (sq >= 0 && sq < SEQ) { const bf16_t* z = c.Z + (size_t)(b * SEQ + sq) * ZC; const R8 av = unpack8(*(const u32x4*)(z + ZC_CA + c8)), gv = unpack8(*(const u32x4*)(z + ZC_CG + c8));
#pragma unroll
                for (int e = 0; e < 4; ++e) { u0[e] = av.lo[e] * sigmoidf_(gv.lo[e]); u1[e] = av.hi[e] * sigmoidf_(gv.hi[e]); } }
            *(LAS f32x4*)(U + row * 256 + c8) = u0; *(LAS f32x4*)(U + row * 256 + c8 + 4) = u1; } }
    __syncthreads();
    { const int ch = tid & 255, half = tid >> 8; const float* dw = a.in[I_DWW] + (size_t)c.l * 31 * 256 + ch; const float bias = a.in[I_DWB][c.l * 256 + ch];
      float wv[31], win[62];
#pragma unroll
      for (int w = 0; w < 31; ++w) wv[w] = dw[w * 256];
#pragma unroll
      for (int r = 0; r < 62; ++r) win[r] = U[(half * 32 + r) * 256 + ch];
      __syncthreads();
#pragma unroll
      for (int o = 0; o < 32; ++o) { float acc = bias;
#pragma unroll
          for (int w = 0; w < 31; ++w) acc += win[o + w] * wv[w];
          CO[(half * 32 + o) * 256 + ch] = acc; } }
    __syncthreads();
    { const float* cg = a.in[I_CLG] + c.l * 256; const float* cb = a.in[I_CLB] + c.l * 256;
      const f32x4 gg = *(const f32x4*)(cg + 4 * lane), bb = *(const f32x4*)(cb + 4 * lane);
#pragma unroll
      for (int q0 = 0; q0 < 8; q0 += 4) { f32x4 x[4]; float mean[4], var[4];
#pragma unroll
          for (int q = 0; q < 4; ++q) { x[q] = *(const LAS f32x4*)(CO + (wave * 8 + q0 + q) * 256 + 4 * lane); mean[q] = (x[q].x + x[q].y) + (x[q].z + x[q].w); }
#pragma unroll
          for (int q = 0; q < 4; ++q) mean[q] = wave_sum(mean[q]);
#pragma unroll
          for (int q = 0; q < 4; ++q) { x[q] = x[q] - mean[q] * (1.f / 256.f); var[q] = (x[q].x * x[q].x + x[q].y * x[q].y) + (x[q].z * x[q].z + x[q].w * x[q].w); }
#pragma unroll
          for (int q = 0; q < 4; ++q) var[q] = wave_sum(var[q]);
#pragma unroll
          for (int q = 0; q < 4; ++q) { const float rstd = __builtin_amdgcn_rsqf(var[q] * (1.f / 256.f) + LN_EPS); f32x4 y = x[q] * rstd * gg + bb;
#pragma unroll
              for (int e = 0; e < 4; ++e) y[e] = y[e] * sigmoidf_(y[e]);
              u32x2 w; w.x = pk2(y.x, y.y); w.y = pk2(y.z, y.w); *(u32x2*)(c.FC + (size_t)(t0 + wave * 8 + q0 + q) * 512 + 256 + 4 * lane) = w; } } }
    __syncthreads();
}

struct QkRaw { u32x2 q; unsigned k; u32x2 cq; unsigned ckv; unsigned kr; };
__device__ __forceinline__ QkRaw qkprep_load(const LayerCtx& c, int t, int lane) { const bf16_t* z = c.Z + (size_t)t * ZC; QkRaw r;
    r.q = *(const u32x2*)(z + ZC_Q + 4 * lane); r.k = *(const unsigned*)(z + ZC_K + 2 * lane); r.cq = *(const u32x2*)(z + ZC_CQ + 4 * lane); r.ckv = *(const unsigned*)(z + ZC_CKV + 2 * lane);
    r.kr = (lane < 16) ? *(const unsigned*)(z + ZC_KR + 2 * lane) : 0u; return r; }
__device__ __forceinline__ void qkprep_row(const Args& a, const LayerCtx& c, int t, int lane, const QkRaw& raw) {
    const int s = t & (SEQ - 1); const float prow = (float)(s >> 6), pcol = (float)(s & 63);
    {
        const u32x2 w = raw.q; float x0 = bflo(w.x), x1 = bfhi(w.x), x2 = bflo(w.y), x3 = bfhi(w.y);
        float ss = (x0 * x0 + x1 * x1) + (x2 * x2 + x3 * x3);
        ss = rsum<1>(ss); ss = rsum<2>(ss); ss = rsum<4>(ss); ss = rsum<8>(ss);
        const float rstd = __builtin_amdgcn_rsqf(ss * (1.f / 64.f) + RMS_EPS);
        const int p = 4 * (lane & 15), half = p >> 5, i0 = (p & 31) >> 1; const float* qg = a.in[I_QG] + c.l * 64 + half * 32;
        x0 *= rstd * qg[i0]; x1 *= rstd * qg[16 + i0]; x2 *= rstd * qg[i0 + 1]; x3 *= rstd * qg[16 + i0 + 1];
        const float pos = half ? pcol : prow;
        rope2(x0, x1, pos * __builtin_amdgcn_exp2f(-(float)i0 * (L2_THETA / 16.f))); rope2(x2, x3, pos * __builtin_amdgcn_exp2f(-(float)(i0 + 1) * (L2_THETA / 16.f)));
        u32x2 o; o.x = pk2(x0 * QSCALE_G, x1 * QSCALE_G); o.y = pk2(x2 * QSCALE_G, x3 * QSCALE_G); *(u32x2*)(c.QG + (size_t)t * 256 + 4 * lane) = o;
    }
    {
        const unsigned w = raw.k; float x0 = bflo(w), x1 = bfhi(w);
        float ss = x0 * x0 + x1 * x1;
        ss = rsum<1>(ss); ss = rsum<2>(ss); ss = rsum<4>(ss); ss = rsum<8>(ss); ss = rsum<16>(ss);
        const float rstd = __builtin_amdgcn_rsqf(ss * (1.f / 64.f) + RMS_EPS);
        const int p = (2 * lane) & 63, half = p >> 5, i0 = (p & 31) >> 1; const float* kg = a.in[I_KG] + c.l * 64 + half * 32;
        x0 *= rstd * kg[i0]; x1 *= rstd * kg[16 + i0];
        rope2(x0, x1, (half ? pcol : prow) * __builtin_amdgcn_exp2f(-(float)i0 * (L2_THETA / 16.f)));
        *(unsigned*)(c.KG + (size_t)t * 128 + 2 * lane) = pk2(x0, x1);
    }
    {
        const u32x2 w = raw.cq; const float x0 = bflo(w.x), x1 = bfhi(w.x), x2 = bflo(w.y), x3 = bfhi(w.y);
        const float rstd = __builtin_amdgcn_rsqf(wave_sum((x0 * x0 + x1 * x1) + (x2 * x2 + x3 * x3)) * (1.f / 256.f) + RMS_EPS);
        u32x2 o; o.x = pk2(x0 * rstd, x1 * rstd); o.y = pk2(x2 * rstd, x3 * rstd); *(u32x2*)(c.CQKV + (size_t)t * 384 + 4 * lane) = o;
    }
    {
        const unsigned w = raw.ckv; const float x0 = bflo(w), x1 = bfhi(w);
        const float rstd = __builtin_amdgcn_rsqf(wave_sum(x0 * x0 + x1 * x1) * (1.f / 128.f) + RMS_EPS);
        *(unsigned*)(c.CQKV + (size_t)t * 384 + 256 + 2 * lane) = pk2(x0 * rstd, x1 * rstd);
    }
    if (lane < 16) {
        const unsigned w = raw.kr; float x0 = bflo(w), x1 = bfhi(w);
        const int half = lane >> 3, i0 = lane & 7;
        rope2(x0, x1, (half ? pcol : prow) * __builtin_amdgcn_exp2f(-(float)i0 * (L2_THETA / 8.f)));
        *(unsigned*)(c.KR + (size_t)t * 32 + 2 * lane) = pk2(x0, x1);
    }
}

__device__ __forceinline__ void dft_table(const int tid, LAS unsigned char* lds) {
    LAS f32x2* tw = (LAS f32x2*)lds;
    for (int m = tid; m < SEQ; m += NTHREADS) { const float x = (float)m * (1.f / 4096.f); tw[m] = (f32x2){cospif(x), sinpif(x)}; }
    __syncthreads();
}
__device__ __forceinline__ void dft_naive_unit(const int tid, const LayerCtx& c, int unit, LAS unsigned char* lds) {
    const LAS f32x2* tw = (const LAS f32x2*)lds;
    const int kk = tid >> 7, pair = tid & 127, g = pair >> 5, jp = pair & 31;
    const int b = unit >> 11, k = ((unit & 2047) << 2) + kk;
    const bf16_t* zp = c.Z + (size_t)b * SEQ * ZC + g * 64 + 2 * jp;
    float acc0 = 0.f, acc1 = 0.f; int idx = 0;
    for (int s = 0; s < SEQ; ++s) { const unsigned w = *(const unsigned*)(zp + (size_t)s * ZC); const f32x2 cs = tw[idx]; idx = (idx + k) & (SEQ - 1);
        acc0 += bflo(w) * cs.x; acc1 += bfhi(w) * (jp == 0 ? cs.x : cs.y); }
    bf16_t* o = c.FC + (size_t)(b * SEQ + k) * 512 + g * 64;
    if (jp == 0) { o[0] = (bf16_t)f2bf(acc0); o[32] = (bf16_t)f2bf(acc1); }
    else { o[jp] = (bf16_t)f2bf(acc0 + acc1); o[64 - jp] = (bf16_t)f2bf(acc0 - acc1); }
}

namespace fft {
constexpr int L_XI = 16384, L_FI = 32768, L_CS = 65536;
__device__ __forceinline__ float cosrev(float x) { return __builtin_amdgcn_cosf(x); }
__device__ __forceinline__ float sinrev(float x) { return __builtin_amdgcn_sinf(x); }
__device__ __forceinline__ void build_table(const int tid, LAS unsigned char* lds) {
#pragma unroll 1
    for (int e = tid; e < 4096; e += NTHREADS) { const int lane = e & 63, cs = (e >> 6) & 1, ks = (e >> 7) & 7, nb = e >> 10; const int k1 = 32 * nb + (lane & 31), h = lane >> 5;
        unsigned w[4];
#pragma unroll
        for (int j = 0; j < 4; ++j) { const int m0 = ((16 * ks + 8 * h + 2 * j) * k1) & 127, m1 = ((16 * ks + 8 * h + 2 * j + 1) * k1) & 127; const float f0 = (float)m0 * (1.f / 128.f), f1 = (float)m1 * (1.f / 128.f);
            w[j] = cs ? pk2(sinrev(f0), sinrev(f1)) : pk2(cosrev(f0), cosrev(f1)); }
        *(LAS u32x4*)(lds + L_CS + e * 16) = (u32x4){w[0], w[1], w[2], w[3]}; }
}
struct F64Frags { bf16x8 c[2][2], s[2][2]; };
__device__ __forceinline__ void build_f64(const int tid, F64Frags& F) {
    const int wid = tid >> 6, lane = tid & 63, r32 = lane & 31, hi = lane >> 5, k2 = 32 * (wid >> 2) + r32;
#pragma unroll
    for (int mb = 0; mb < 2; ++mb)
#pragma unroll
        for (int st = 0; st < 2; ++st) { unsigned wc[4], wsn[4];
#pragma unroll
            for (int jj = 0; jj < 4; ++jj) { const int j0 = 2 * jj, j1 = 2 * jj + 1;
                const int sa = 32 * mb + 16 * st + 8 * (j0 >> 2) + 4 * hi + (j0 & 3), sb = 32 * mb + 16 * st + 8 * (j1 >> 2) + 4 * hi + (j1 & 3);
                const float fa = (float)((sa * k2) & 63) * (1.f / 64.f), fb = (float)((sb * k2) & 63) * (1.f / 64.f);
                wc[jj] = pk2(cosrev(fa), cosrev(fb)); wsn[jj] = pk2(sinrev(fa), sinrev(fb)); }
            F.c[mb][st] = __builtin_bit_cast(bf16x8, (u32x4){wc[0], wc[1], wc[2], wc[3]}); F.s[mb][st] = __builtin_bit_cast(bf16x8, (u32x4){wsn[0], wsn[1], wsn[2], wsn[3]}); }
}
__device__ __forceinline__ bf16x8 negbf(bf16x8 x) { u32x4 w = __builtin_bit_cast(u32x4, x); w ^= 0x80008000u; return __builtin_bit_cast(bf16x8, w); }
__device__ __forceinline__ void unit(const int tid, const LayerCtx& c, const int u, LAS unsigned char* lds, const F64Frags& F) {
    const int wid = tid >> 6, lane = tid & 63, r32 = lane & 31, hi = lane >> 5, nb = wid & 3, kb = wid >> 2;
    const int b = u >> 7, g = (u >> 5) & 3, jp = u & 31;
    const bf16_t* zp = c.Z + (size_t)b * SEQ * ZC + g * 64 + 2 * jp;
#pragma unroll 4
    for (int i = 0; i < 16; ++i) { const int sx = tid + NTHREADS * i, s2 = sx & 63, s1 = sx >> 6; const unsigned w = *(const unsigned*)(zp + (size_t)sx * ZC);
        const int off = s2 * 256 + ((((s1 >> 3) ^ (s2 & 15))) << 4) + (s1 & 7) * 2;
        *(LAS unsigned short*)(lds + off) = (unsigned short)(w & 0xffffu); *(LAS unsigned short*)(lds + L_XI + off) = (unsigned short)(w >> 16); }
    __syncthreads();
    f32x16 GR[2], GI[2];
#pragma unroll
    for (int mb = 0; mb < 2; ++mb) { GR[mb] = f32x16{}; GI[mb] = f32x16{}; }
#pragma unroll
    for (int ks = 0; ks < 8; ++ks) {
        const bf16x8 cf = *(const LAS bf16x8*)(lds + L_CS + ((nb * 8 + ks) * 2 + 0) * 1024 + lane * 16), sf = *(const LAS bf16x8*)(lds + L_CS + ((nb * 8 + ks) * 2 + 1) * 1024 + lane * 16);
#pragma unroll
        for (int mb = 0; mb < 2; ++mb) { const int row = 32 * mb + r32, off = row * 256 + (((2 * ks + hi) ^ (row & 15)) << 4);
            const bf16x8 xr = *(const LAS bf16x8*)(lds + off), xi = *(const LAS bf16x8*)(lds + L_XI + off); const bf16x8 nxr = negbf(xr);
            GR[mb] = __builtin_amdgcn_mfma_f32_32x32x16_bf16(xr, cf, GR[mb], 0, 0, 0); GR[mb] = __builtin_amdgcn_mfma_f32_32x32x16_bf16(xi, sf, GR[mb], 0, 0, 0);
            GI[mb] = __builtin_amdgcn_mfma_f32_32x32x16_bf16(xi, cf, GI[mb], 0, 0, 0); GI[mb] = __builtin_amdgcn_mfma_f32_32x32x16_bf16(nxr, sf, GI[mb], 0, 0, 0); }
    }
    const int k1 = 32 * nb + r32;
    bf16x8 ar[2][2], ai[2][2];
#pragma unroll
    for (int mb = 0; mb < 2; ++mb) {
#pragma unroll
        for (int r = 0; r < 16; ++r) { const int s2v = 32 * mb + (r & 3) + 8 * (r >> 2) + 4 * hi; const float fr = (float)((s2v * k1) & (SEQ - 1)) * (1.f / 8192.f);
            const float tc = cosrev(fr), ts = sinrev(fr), gr = GR[mb][r], gi = GI[mb][r]; GR[mb][r] = gr * tc + gi * ts; GI[mb][r] = gi * tc - gr * ts; }
#pragma unroll
        for (int st = 0; st < 2; ++st) {
            const u32x4 wr = {pk2(GR[mb][8 * st], GR[mb][8 * st + 1]), pk2(GR[mb][8 * st + 2], GR[mb][8 * st + 3]), pk2(GR[mb][8 * st + 4], GR[mb][8 * st + 5]), pk2(GR[mb][8 * st + 6], GR[mb][8 * st + 7])};
            const u32x4 wi = {pk2(GI[mb][8 * st], GI[mb][8 * st + 1]), pk2(GI[mb][8 * st + 2], GI[mb][8 * st + 3]), pk2(GI[mb][8 * st + 4], GI[mb][8 * st + 5]), pk2(GI[mb][8 * st + 6], GI[mb][8 * st + 7])};
            ar[mb][st] = __builtin_bit_cast(bf16x8, wr); ai[mb][st] = __builtin_bit_cast(bf16x8, wi); }
    }
    __syncthreads();
    f32x16 ZR = f32x16{}, ZI = f32x16{};
#pragma unroll
    for (int mb = 0; mb < 2; ++mb)
#pragma unroll
        for (int st = 0; st < 2; ++st) { const bf16x8 nar = negbf(ar[mb][st]);
            ZR = __builtin_amdgcn_mfma_f32_32x32x16_bf16(ar[mb][st], F.c[mb][st], ZR, 0, 0, 0); ZR = __builtin_amdgcn_mfma_f32_32x32x16_bf16(ai[mb][st], F.s[mb][st], ZR, 0, 0, 0);
            ZI = __builtin_amdgcn_mfma_f32_32x32x16_bf16(ai[mb][st], F.c[mb][st], ZI, 0, 0, 0); ZI = __builtin_amdgcn_mfma_f32_32x32x16_bf16(nar, F.s[mb][st], ZI, 0, 0, 0); }
    { const int k2 = 32 * kb + r32;
#pragma unroll
      for (int q = 0; q < 4; ++q) { const int kk = k2 * 128 + 32 * nb + 8 * q + 4 * hi;
          *(LAS f32x4*)(lds + kk * 4) = (f32x4){ZR[4 * q], ZR[4 * q + 1], ZR[4 * q + 2], ZR[4 * q + 3]}; *(LAS f32x4*)(lds + L_FI + kk * 4) = (f32x4){ZI[4 * q], ZI[4 * q + 1], ZI[4 * q + 2], ZI[4 * q + 3]}; } }
    __syncthreads();
    bf16_t* op = c.FC + (size_t)b * SEQ * 512 + g * 64 + 2 * jp;
#pragma unroll 4
    for (int i = 0; i < 16; ++i) { const int k = tid + NTHREADS * i, kr = (SEQ - k) & (SEQ - 1);
        const float a0 = *(const LAS float*)(lds + k * 4), a1 = *(const LAS float*)(lds + kr * 4); float y0 = a0, y1 = a1;
        if (jp == 0) { const float b0 = *(const LAS float*)(lds + L_FI + k * 4), b1 = *(const LAS float*)(lds + L_FI + kr * 4); y0 = 0.5f * (a0 + a1); y1 = 0.5f * (b0 + b1); }
        *(unsigned*)(op + (size_t)k * 512) = pk2(y0, y1); }
    __syncthreads();
}
}

struct AttnSrc { const bf16_t* Q; int qp; const bf16_t* K; int kp; const bf16_t* K2; int k2p; const bf16_t* V; int vp; float* O; int op; };
template <int DK>
__device__ __forceinline__ void attn_naive_unit(const int tid, const AttnSrc& A, int q0) {
    const int row = q0 + tid;
    unsigned q[DK / 2]; float o[64];
#pragma unroll
    for (int i = 0; i < DK / 8; ++i) { const u32x4 w = *(const u32x4*)(A.Q + (size_t)row * A.qp + 8 * i); q[4 * i] = w.x; q[4 * i + 1] = w.y; q[4 * i + 2] = w.z; q[4 * i + 3] = w.w; }
    if constexpr (DK > 64) {
        const int sq = row & (SEQ - 1); const float prow = (float)(sq >> 6), pcol = (float)(sq & 63);
#pragma unroll
        for (int pr = 0; pr < 16; ++pr) { float x0 = bflo(q[32 + pr]), x1 = bfhi(q[32 + pr]);
            rope2(x0, x1, (pr < 8 ? prow : pcol) * __builtin_amdgcn_exp2f(-(float)(pr & 7) * (13.287712379549449f / 8.f))); q[32 + pr] = pk2(x0, x1); }
    }
#pragma unroll
    for (int d = 0; d < 64; ++d) o[d] = 0.f;
    float m = -1e30f, l = 0.f;
#pragma unroll 1
    for (int key = 0; key < SEQ; ++key) {
        float sc = 0.f;
#pragma unroll
        for (int i = 0; i < DK / 2; ++i) asm volatile("" : "+v"(q[i]));
#pragma unroll
        for (int i = 0; i < 8; ++i) { const u32x4 w = *(const u32x4*)(A.K + (size_t)key * A.kp + 8 * i);
            sc += bflo(q[4 * i]) * bflo(w.x) + bfhi(q[4 * i]) * bfhi(w.x) + bflo(q[4 * i + 1]) * bflo(w.y) + bfhi(q[4 * i + 1]) * bfhi(w.y)
                + bflo(q[4 * i + 2]) * bflo(w.z) + bfhi(q[4 * i + 2]) * bfhi(w.z) + bflo(q[4 * i + 3]) * bflo(w.w) + bfhi(q[4 * i + 3]) * bfhi(w.w); }
        if constexpr (DK > 64) {
#pragma unroll
            for (int i = 8; i < DK / 8; ++i) { const u32x4 w = *(const u32x4*)(A.K2 + (size_t)key * A.k2p + 8 * (i - 8));
                sc += bflo(q[4 * i]) * bflo(w.x) + bfhi(q[4 * i]) * bfhi(w.x) + bflo(q[4 * i + 1]) * bflo(w.y) + bfhi(q[4 * i + 1]) * bfhi(w.y)
                    + bflo(q[4 * i + 2]) * bflo(w.z) + bfhi(q[4 * i + 2]) * bfhi(w.z) + bflo(q[4 * i + 3]) * bflo(w.w) + bfhi(q[4 * i + 3]) * bfhi(w.w); }
        }
        if (sc > m) { const float f = __builtin_amdgcn_exp2f(m - sc); l *= f;
#pragma unroll
            for (int d = 0; d < 64; ++d) o[d] *= f;
            m = sc; }
        const float p = __builtin_amdgcn_exp2f(sc - m); l += p;
#pragma unroll
        for (int i = 0; i < 8; ++i) { const u32x4 w = *(const u32x4*)(A.V + (size_t)key * A.vp + 8 * i);
            o[8 * i] += p * bflo(w.x); o[8 * i + 1] += p * bfhi(w.x); o[8 * i + 2] += p * bflo(w.y); o[8 * i + 3] += p * bfhi(w.y); o[8 * i + 4] += p * bflo(w.z); o[8 * i + 5] += p * bfhi(w.z); o[8 * i + 6] += p * bflo(w.w); o[8 * i + 7] += p * bfhi(w.w); }
    }
    const float rl = 1.f / l; float* op = A.O + (size_t)row * A.op;
#pragma unroll
    for (int i = 0; i < 16; ++i) *(f32x4*)(op + 4 * i) = (f32x4){o[4 * i] * rl, o[4 * i + 1] * rl, o[4 * i + 2] * rl, o[4 * i + 3] * rl};
}
__device__ __forceinline__ AttnSrc gqa_src(unsigned char* ws, int b, int h) {
    AttnSrc A; const size_t r0 = (size_t)b * SEQ; unsigned char* r = ws + WS_R;
    A.Q = (const bf16_t*)(r + R_QG) + r0 * 256 + h * 64; A.qp = 256; A.K = (const bf16_t*)(r + R_KG) + r0 * 128 + (h >> 1) * 64; A.kp = 128; A.K2 = nullptr; A.k2p = 0;
    A.V = (const bf16_t*)(r + R_Z) + r0 * ZC + ZC_V + (h >> 1) * 64; A.vp = ZC; A.O = (float*)(r + R_YMIX) + r0 * 1024 + 512 + h * 64; A.op = 1024; return A;
}
__device__ __forceinline__ AttnSrc mla_src(unsigned char* ws, int b, int h) {
    AttnSrc A; const size_t r0 = (size_t)b * SEQ; unsigned char* r = ws + WS_R; const bf16_t* qkvm = (const bf16_t*)(r + R_QKVM);
    A.Q = qkvm + r0 * 1024 + h * 128; A.qp = 1024; A.K = qkvm + r0 * 1024 + 512 + h * 128; A.kp = 1024; A.K2 = (const bf16_t*)(r + R_KR) + r0 * 32; A.k2p = 32;
    A.V = qkvm + r0 * 1024 + 512 + h * 128 + 64; A.vp = 1024; A.O = (float*)(r + R_YMIX) + r0 * 1024 + 768 + h * 64; A.op = 1024; return A;
}

namespace att {
using s16x4 = __attribute__((ext_vector_type(4))) short;
constexpr float ATT_THR = 8.f;
#define ATT_SBAR() __builtin_amdgcn_sched_barrier(0)
__device__ __forceinline__ int crow(int r, int hi) { return (r & 3) + 8 * (r >> 2) + 4 * hi; }
__device__ __forceinline__ unsigned cvtpk(float lo, float hi) { unsigned r; asm volatile("v_cvt_pk_bf16_f32 %0, %1, %2" : "=v"(r) : "v"(lo), "v"(hi)); return r; }
template <int KROW> __device__ __forceinline__ int kswz(int row, int colB) { return (KROW == 128) ? row * 128 + (colB ^ (((row >> 1) & 7) << 4)) : row * 256 + (colB ^ ((row & 15) << 4)); }
__device__ __forceinline__ void partialSM(f32x16& p0, f32x16& p1, float& m_reg, f32x16& negm, float& alpha, const bool first) {
    float pa = fmaxf(fmaxf(p0[0], p0[1]), p0[2]), pb = fmaxf(fmaxf(p1[0], p1[1]), p1[2]);
#pragma unroll
    for (int r = 3; r < 15; r += 2) { pa = fmaxf(fmaxf(pa, p0[r]), p0[r + 1]); pb = fmaxf(fmaxf(pb, p1[r]), p1[r + 1]); }
    float pmax = fmaxf(fmaxf(pa, pb), fmaxf(p0[15], p1[15]));
    { auto rr = __builtin_amdgcn_permlane32_swap(__float_as_uint(pmax), __float_as_uint(pmax), false, false); pmax = fmaxf(__uint_as_float(rr[0]), __uint_as_float(rr[1])); }
    alpha = 1.f;
    if (first || !__all(pmax <= ATT_THR)) {
        const float delta = first ? pmax : fmaxf(pmax, 0.f);
        m_reg += delta; alpha = first ? 1.f : __builtin_amdgcn_exp2f(-delta);
#pragma unroll
        for (int r = 0; r < 16; ++r) { p0[r] -= delta; p1[r] -= delta; negm[r] = -m_reg; }
    }
#pragma unroll
    for (int r = 0; r < 16; ++r) p0[r] = __builtin_amdgcn_exp2f(p0[r]);
}
__device__ __forceinline__ void finishSM(f32x16& p0, f32x16& p1, bf16x8& pa0, bf16x8& pa1, bf16x8& pa2, bf16x8& pa3) {
#pragma unroll
    for (int r = 0; r < 16; ++r) p1[r] = __builtin_amdgcn_exp2f(p1[r]);
#define ATT_PK4(P, BASE, OUT) do { unsigned a0 = cvtpk(P[BASE + 0], P[BASE + 1]), a1 = cvtpk(P[BASE + 2], P[BASE + 3]);   \
    unsigned b0 = cvtpk(P[BASE + 4], P[BASE + 5]), b1 = cvtpk(P[BASE + 6], P[BASE + 7]);                              \
    auto r0 = __builtin_amdgcn_permlane32_swap(a0, b0, false, false); auto r1 = __builtin_amdgcn_permlane32_swap(a1, b1, false, false); \
    u32x4 w = {r0[0], r1[0], r0[1], r1[1]}; OUT = __builtin_bit_cast(bf16x8, w); } while (0)
    ATT_PK4(p0, 0, pa0); ATT_PK4(p0, 8, pa1); ATT_PK4(p1, 0, pa2); ATT_PK4(p1, 8, pa3);
#undef ATT_PK4
}
template <int DK, int KROW>
__device__ __forceinline__ void qkt(f32x16& p0, f32x16& p1, const LAS unsigned char* Ks, const bf16x8* qr, const f32x16& negm, int r32, int hi) {
#pragma unroll
    for (int d0 = 0; d0 < DK / 16; ++d0) { const int cb = (d0 * 16 + hi * 8) * 2;
        const bf16x8 b0 = *(const LAS bf16x8*)(Ks + kswz<KROW>(r32, cb));
        const bf16x8 b1 = *(const LAS bf16x8*)(Ks + kswz<KROW>(32 + r32, cb));
        if (d0 == 0) { p0 = __builtin_amdgcn_mfma_f32_32x32x16_bf16(b0, qr[0], negm, 0, 0, 0); p1 = __builtin_amdgcn_mfma_f32_32x32x16_bf16(b1, qr[0], negm, 0, 0, 0); }
        else { p0 = __builtin_amdgcn_mfma_f32_32x32x16_bf16(b0, qr[d0], p0, 0, 0, 0); p1 = __builtin_amdgcn_mfma_f32_32x32x16_bf16(b1, qr[d0], p1, 0, 0, 0); } }
}
__device__ __forceinline__ int v_st(int k, int c) { const int kk = (k & ~0xC) | ((k & 4) << 1) | ((k & 8) >> 1); return ((kk >> 3) * 2 + (c >> 5)) * 512 + ((kk & 7) * 32 + (c & 31)) * 2; }
__device__ __forceinline__ int v_rd_base(int lane) { return ((lane & 3) << 3) | (((lane >> 2) & 3) << 6) | (((lane >> 4) & 1) << 5) | (((lane >> 5) & 1) << 8); }
constexpr int v_rd_off(int d0, int ks, int half) { return d0 * 512 + ks * 2048 + half * 1024; }
template <int OFF> __device__ __forceinline__ s16x4 tr_read(int vb) { s16x4 r; asm volatile("ds_read_b64_tr_b16 %0, %1 offset:%2" : "=&v"(r) : "v"(vb), "i"(OFF) : "memory"); return r; }
template <int KS> __device__ __forceinline__ void pv_half(f32x16* o, int vb, bf16x8 paA, bf16x8 paB) {
    const s16x4 a0 = tr_read<v_rd_off(0, KS, 0)>(vb), b0 = tr_read<v_rd_off(0, KS, 1)>(vb), c0 = tr_read<v_rd_off(1, KS, 0)>(vb), d0 = tr_read<v_rd_off(1, KS, 1)>(vb);
    const s16x4 a1 = tr_read<v_rd_off(0, KS + 1, 0)>(vb), b1 = tr_read<v_rd_off(0, KS + 1, 1)>(vb), c1 = tr_read<v_rd_off(1, KS + 1, 0)>(vb), d1 = tr_read<v_rd_off(1, KS + 1, 1)>(vb);
    const bf16x8 ones = {0x3F80, 0x3F80, 0x3F80, 0x3F80, 0x3F80, 0x3F80, 0x3F80, 0x3F80};
    asm volatile("s_waitcnt lgkmcnt(0)" ::: "memory"); ATT_SBAR();
#define ATT_PK(L, H) (bf16x8){L[0], L[1], L[2], L[3], H[0], H[1], H[2], H[3]}
    o[0] = __builtin_amdgcn_mfma_f32_32x32x16_bf16(paA, ATT_PK(a0, b0), o[0], 0, 0, 0); o[1] = __builtin_amdgcn_mfma_f32_32x32x16_bf16(paA, ATT_PK(c0, d0), o[1], 0, 0, 0); o[2] = __builtin_amdgcn_mfma_f32_32x32x16_bf16(paA, ones, o[2], 0, 0, 0);
    o[0] = __builtin_amdgcn_mfma_f32_32x32x16_bf16(paB, ATT_PK(a1, b1), o[0], 0, 0, 0); o[1] = __builtin_amdgcn_mfma_f32_32x32x16_bf16(paB, ATT_PK(c1, d1), o[1], 0, 0, 0); o[2] = __builtin_amdgcn_mfma_f32_32x32x16_bf16(paB, ones, o[2], 0, 0, 0);
#undef ATT_PK
}
__device__ __forceinline__ void pv_d0(f32x16* o, int vb, bf16x8 pa0, bf16x8 pa1, bf16x8 pa2, bf16x8 pa3) { pv_half<0>(o, vb, pa0, pa1); pv_half<2>(o, vb, pa2, pa3); }

#define ATT_WAITBAR(N) asm volatile("s_waitcnt vmcnt(" #N ") lgkmcnt(0)\n\ts_barrier" ::: "memory")
template <int DK>
__device__ __forceinline__ void unit(const int tid, const AttnSrc& A, const int q0, LAS unsigned char* lds) {
    constexpr int QP = (DK == 64) ? 256 : 1024, KP = (DK == 64) ? 128 : 1024, K2P = 32, VP = (DK == 64) ? ZC : 1024, OP = 1024;
    constexpr int KROW = (DK == 64) ? 128 : 256, SHM_K = 64 * KROW, SHM_V = 64 * 64 * 2, ND = DK / 16, NT = SEQ / 64, NKI = SHM_K / 8192;
    const int wid = __builtin_amdgcn_readfirstlane(tid >> 6), lane = tid & 63, r32 = lane & 31, hi = lane >> 5;
    LAS unsigned char* V_lds = lds; LAS unsigned char* K_lds = lds + 3 * SHM_V;
    LAS float* al_l = (LAS float*)(lds + 3 * SHM_V + 3 * SHM_K) + wid * 32;
    float m_reg = 0.f; f32x16 o[3] = {}; f32x16 negm = f32x16{}; bf16x8 qr[ND];
    const int qrow = q0 + wid * 32 + r32;
    const bf16_t* Qw = A.Q + (size_t)qrow * QP + hi * 8;
#pragma unroll
    for (int d0 = 0; d0 < ND; ++d0) qr[d0] = *(const bf16x8*)(Qw + d0 * 16);
    if constexpr (DK > 64) {
        const int sq = qrow & (SEQ - 1); const float prow = (float)(sq >> 6), pcol = (float)(sq & 63);
#pragma unroll
        for (int d0 = 4; d0 < 6; ++d0) { u32x4 w = __builtin_bit_cast(u32x4, qr[d0]); const float pos = (d0 == 4) ? prow : pcol;
#pragma unroll
            for (int j = 0; j < 4; ++j) { float x0 = bflo(w[j]), x1 = bfhi(w[j]); rope2(x0, x1, pos * __builtin_amdgcn_exp2f(-(float)(4 * hi + j) * (13.287712379549449f / 8.f))); w[j] = pk2i(x0, x1); }
            qr[d0] = __builtin_bit_cast(bf16x8, w); }
    }
    const bf16_t* Vsrc; const bf16_t* Ksrc[NKI]; int kstepE[NKI];
    { const int kk = 8 * wid + ((lane & 31) >> 2), kv = (kk & ~0xC) | ((kk & 4) << 1) | ((kk & 8) >> 1); Vsrc = A.V + (size_t)kv * VP + 32 * (lane >> 5) + 8 * (lane & 3); }
#pragma unroll
    for (int i = 0; i < NKI; ++i) {
        if constexpr (DK == 64) { const int row = 8 * wid + (lane >> 3), chunk = (lane & 7) ^ ((row >> 1) & 7); Ksrc[i] = A.K + (size_t)row * KP + chunk * 8; kstepE[i] = KP; }
        else { const int row = 4 * (i * 8 + wid) + (lane >> 4), chunk = (lane & 15) ^ (row & 15);
            if (chunk >= 8 && chunk < 12) { Ksrc[i] = A.K2 + (size_t)row * K2P + (chunk - 8) * 8; kstepE[i] = K2P; }
            else { Ksrc[i] = A.K + (size_t)row * KP + (chunk < 8 ? chunk : 0) * 8; kstepE[i] = KP; } }
    }
    const unsigned ldsw = (unsigned)wid * 1024u;
#define ATT_DMA_V(t, slot) __builtin_amdgcn_global_load_lds((const unsigned*)(Vsrc + (size_t)(t) * 64 * VP), (LAS unsigned*)(V_lds + (slot) * SHM_V + ldsw), 16, 0, 0)
#define ATT_DMA_K(t, slot) do { _Pragma("unroll") for (int i_ = 0; i_ < NKI; ++i_) \
        __builtin_amdgcn_global_load_lds((const unsigned*)(Ksrc[i_] + (size_t)(t) * 64 * kstepE[i_]), (LAS unsigned*)(K_lds + (slot) * SHM_K + i_ * 8192 + ldsw), 16, 0, 0); } while (0)
    const int vb0 = (int)(uintptr_t)V_lds + v_rd_base(lane);
#define ATT_RESC(a) do { if (__any((a) < 1.f)) { if (hi == 0) al_l[r32] = (a); asm volatile("s_waitcnt lgkmcnt(0)" ::: "memory"); \
    _Pragma("unroll") for (int d = 0; d < 3; ++d) _Pragma("unroll") for (int r = 0; r < 16; ++r) o[d][r] *= al_l[crow(r, hi)]; } } while (0)
    f32x16 pA0, pA1, pB0, pB1; float alA, alB; bf16x8 pa0, pa1, pa2, pa3;
    ATT_DMA_K(0, 0); ATT_DMA_V(0, 0); ATT_DMA_K(1, 1);
    ATT_WAITBAR(0);
    ATT_DMA_K(2, 2); ATT_DMA_V(1, 1);
    qkt<DK, KROW>(pA0, pA1, K_lds, qr, negm, r32, hi); partialSM(pA0, pA1, m_reg, negm, alA, true);
    if constexpr (NKI == 1) ATT_WAITBAR(2); else ATT_WAITBAR(3);
#define ATT_STEP(PC0, PC1, PP0, PP1, ALC, j, SK, SV) do { \
        const bool hk_ = (j) + 2 < NT, hv_ = (j) + 1 < NT; \
        if (hk_) ATT_DMA_K((j) + 2, ((SK) + 2) % 3); if (hv_) ATT_DMA_V((j) + 1, ((SV) + 2) % 3); \
        ATT_SBAR(); qkt<DK, KROW>(PC0, PC1, K_lds + (SK) * SHM_K, qr, negm, r32, hi); \
        finishSM(PP0, PP1, pa0, pa1, pa2, pa3); ATT_SBAR(); \
        pv_d0(o, vb0 + (SV) * SHM_V, pa0, pa1, pa2, pa3); partialSM(PC0, PC1, m_reg, negm, ALC, false); \
        if (hk_) { if constexpr (NKI == 1) ATT_WAITBAR(2); else ATT_WAITBAR(3); } else if (hv_) ATT_WAITBAR(1); else ATT_WAITBAR(0); \
        ATT_RESC(ALC); } while (0)
    static_assert((NT - 2) % 6 == 0, "steps 1 .. NT-2 are a whole number of 6-step periods");
#pragma unroll 1
    for (int j = 1; j + 1 < NT; j += 6) {
        ATT_STEP(pB0, pB1, pA0, pA1, alB, j,     1, 0);
        ATT_STEP(pA0, pA1, pB0, pB1, alA, j + 1, 2, 1);
        ATT_STEP(pB0, pB1, pA0, pA1, alB, j + 2, 0, 2);
        ATT_STEP(pA0, pA1, pB0, pB1, alA, j + 3, 1, 0);
        ATT_STEP(pB0, pB1, pA0, pA1, alB, j + 4, 2, 1);
        ATT_STEP(pA0, pA1, pB0, pB1, alA, j + 5, 0, 2);
    }
    ATT_STEP(pB0, pB1, pA0, pA1, alB, NT - 1, (NT - 1) % 3, (NT - 2) % 3);
    finishSM(pB0, pB1, pa0, pa1, pa2, pa3); ATT_SBAR();
    pv_d0(o, vb0 + ((NT - 1) % 3) * SHM_V, pa0, pa1, pa2, pa3);
    float rli[16];
#pragma unroll
    for (int r = 0; r < 16; ++r) rli[r] = __builtin_amdgcn_rcpf(o[2][r]);
    float* Ow = A.O + (size_t)(q0 + wid * 32) * OP;
#pragma unroll
    for (int r = 0; r < 16; ++r) { const int orow = crow(r, hi);
#pragma unroll
        for (int d0 = 0; d0 < 2; ++d0) Ow[(size_t)orow * OP + d0 * 32 + r32] = o[d0][r] * rli[r]; }
    ATT_WAITBAR(0);
#undef ATT_DMA_V
#undef ATT_DMA_K
#undef ATT_RESC
#undef ATT_STEP
}
#undef ATT_WAITBAR
#undef ATT_SBAR
}

__device__ __forceinline__ void grpnorm_rows4(const LayerCtx& c, int t0, int tstride, int lane) {
    R8 v[4][2]; float ss[4][2];
#pragma unroll
    for (int q = 0; q < 4; ++q) { const float* x = c.YMIX + (size_t)(t0 + q * tstride) * 1024;
#pragma unroll
        for (int j = 0; j < 2; ++j) { v[q][j].lo = *(const f32x4*)(x + 512 * j + 8 * lane); v[q][j].hi = *(const f32x4*)(x + 512 * j + 8 * lane + 4); ss[q][j] = hsq8(v[q][j]); } }
#pragma unroll
    for (int q = 0; q < 4; ++q)
#pragma unroll
        for (int j = 0; j < 2; ++j) { float x = ss[q][j]; x = rsum<1>(x); x = rsum<2>(x); x = rsum<4>(x); x = rsum<8>(x); ss[q][j] = rsum<16>(x); }
#pragma unroll
    for (int q = 0; q < 4; ++q) {
#pragma unroll
        for (int j = 0; j < 2; ++j) { const float r = __builtin_amdgcn_rsqf(ss[q][j] * (1.f / 256.f) + RMS_EPS); v[q][j].lo = v[q][j].lo * r; v[q][j].hi = v[q][j].hi * r; }
        store_row_bf16(c.Y + (size_t)(t0 + q * tstride) * 1024, v[q], lane); }
}
template <int NR>
__device__ __forceinline__ void resln_load(const LayerCtx& c, int t0, int tstride, int lane, u32x4 (&hw)[NR][2], u32x4 (&fw)[NR][2]) {
#pragma unroll
    for (int q = 0; q < NR; ++q) { const bf16_t* hr = c.HB + (size_t)(t0 + q * tstride) * D; const bf16_t* fr = c.FB + (size_t)(t0 + q * tstride) * D;
#pragma unroll
        for (int j = 0; j < 2; ++j) { hw[q][j] = *(const u32x4*)(hr + 512 * j + 8 * lane); fw[q][j] = *(const u32x4*)(fr + 512 * j + 8 * lane); } }
}
template <int NR>
__device__ __forceinline__ void resln_finish(const LayerCtx& c, int t0, int tstride, const float* g, const float* b, int lane, const u32x4 (&hw)[NR][2], const u32x4 (&fw)[NR][2], R8 (&v)[NR][2]) {
#pragma unroll
    for (int q = 0; q < NR; ++q)
#pragma unroll
        for (int j = 0; j < 2; ++j) { const R8 h = unpack8(hw[q][j]), f = unpack8(fw[q][j]); v[q][j].lo = h.lo * DN_ALPHA + f.lo; v[q][j].hi = h.hi * DN_ALPHA + f.hi; }
    ln_rows<NR>(v, g, b, lane);
#pragma unroll
    for (int q = 0; q < NR; ++q) store_row_bf16(c.HB + (size_t)(t0 + q * tstride) * D, v[q], lane);
}
template <int NR>
__device__ __forceinline__ void resln_rows(const LayerCtx& c, int t0, int tstride, const float* g, const float* b, int lane, R8 (&v)[NR][2]) {
    u32x4 hw[NR][2], fw[NR][2];
    resln_load<NR>(c, t0, tstride, lane, hw, fw);
    resln_finish<NR>(c, t0, tstride, g, b, lane, hw, fw, v);
}
constexpr int RT_LO = 65536, RT_LOGT = 40960;
__device__ __forceinline__ void ln2_router_group(const int tid, const Args& a, const LayerCtx& c, const int grp, const int grp_next, LAS unsigned char* lds, const bf16x8 (&bh)[8], const bf16x8 (&bl)[8], LAS unsigned* lcnt, u32x4 (&hw)[4][2], u32x4 (&fw)[4][2]) {
    const int wid = tid >> 6, lane = tid & 63, r32 = lane & 31, hi = lane >> 5;
    const float brv = a.in[I_BR][c.l * 32 + (tid & 31)];
    { R8 v[4][2];
      resln_finish<4>(c, grp * 32 + wid * 4, 1, a.in[I_LN2G] + c.l * D, a.in[I_LN2B] + c.l * D, lane, hw, fw, v);
#pragma unroll
      for (int q = 0; q < 4; ++q) { const int row = wid * 4 + q;
#pragma unroll
          for (int j = 0; j < 2; ++j) { const int chunk = 64 * j + lane; const int off = row * 2048 + ((chunk ^ (row & 15)) << 4);
              const R8 x = v[q][j]; const unsigned h0 = f2bf(x.lo.x), h1 = f2bf(x.lo.y), h2 = f2bf(x.lo.z), h3 = f2bf(x.lo.w), h4 = f2bf(x.hi.x), h5 = f2bf(x.hi.y), h6 = f2bf(x.hi.z), h7 = f2bf(x.hi.w);
              const u32x4 wh = {h0 | (h1 << 16), h2 | (h3 << 16), h4 | (h5 << 16), h6 | (h7 << 16)};
              const u32x4 wl = {pk2(x.lo.x - bf2f(h0), x.lo.y - bf2f(h1)), pk2(x.lo.z - bf2f(h2), x.lo.w - bf2f(h3)), pk2(x.hi.x - bf2f(h4), x.hi.y - bf2f(h5)), pk2(x.hi.z - bf2f(h6), x.hi.w - bf2f(h7))};
              *(LAS u32x4*)(lds + off) = wh; *(LAS u32x4*)(lds + RT_LO + off) = wl; } } }
    resln_load<4>(c, (grp_next < T / 32 ? grp_next : grp) * 32 + wid * 4, 1, lane, hw, fw);
    __syncthreads();
    f32x16 acc = f32x16{};
#pragma unroll
    for (int ks = 0; ks < 8; ++ks) { const int chunk = 16 * wid + 2 * ks + hi; const int off = r32 * 2048 + ((chunk ^ (r32 & 15)) << 4);
        const bf16x8 ah = *(const LAS bf16x8*)(lds + off), al = *(const LAS bf16x8*)(lds + RT_LO + off);
        acc = __builtin_amdgcn_mfma_f32_32x32x16_bf16(ah, bh[ks], acc, 0, 0, 0); acc = __builtin_amdgcn_mfma_f32_32x32x16_bf16(ah, bl[ks], acc, 0, 0, 0); acc = __builtin_amdgcn_mfma_f32_32x32x16_bf16(al, bh[ks], acc, 0, 0, 0); }
    __syncthreads();
    { LAS float* red = (LAS float*)lds;
#pragma unroll
      for (int r = 0; r < 16; ++r) { const int tok = (r & 3) + 8 * (r >> 2) + 4 * hi; red[(wid * 32 + tok) * 33 + r32] = acc[r]; } }
    __syncthreads();
    { const LAS float* red = (const LAS float*)lds; LAS float* logt = (LAS float*)(lds + RT_LOGT);
#pragma unroll
      for (int i = 0; i < 2; ++i) { const int idx = tid + NTHREADS * i, tok = idx >> 5, e = idx & 31; float sres = brv;
#pragma unroll
          for (int w = 0; w < 8; ++w) sres += red[(w * 32 + tok) * 33 + e];
          logt[tok * 33 + e] = sres; } }
    __syncthreads();
    { const LAS float* logt = (const LAS float*)(lds + RT_LOGT);
#pragma unroll 1
      for (int q = 0; q < 4; ++q) { const int tok = wid * 4 + q, t = grp * 32 + tok;
          float mine = (lane < 32) ? logt[tok * 33 + lane] : -3.0e38f;
          float tv[4]; int ti[4];
#pragma unroll
          for (int k = 0; k < 4; ++k) { const float best = wave_max(mine); const unsigned long long mk = __ballot(mine == best); const int bi = __ffsll((long long)mk) - 1;
              tv[k] = best; ti[k] = bi; if (lane == bi) mine = -3.0e38f; }
          const float e1 = __expf(tv[1] - tv[0]), e2 = __expf(tv[2] - tv[0]), e3 = __expf(tv[3] - tv[0]); const float rs = 1.f / (1.f + e1 + e2 + e3);
          if (lane < 4) { const int e = lane == 0 ? ti[0] : lane == 1 ? ti[1] : lane == 2 ? ti[2] : ti[3]; const float gt = (lane == 0 ? 1.f : lane == 1 ? e1 : lane == 2 ? e2 : e3) * rs;
              const unsigned rank = __hip_atomic_fetch_add(lcnt + e, 1u, __ATOMIC_RELAXED, __HIP_MEMORY_SCOPE_WORKGROUP);
              c.RE[t * 4 + lane] = e; c.RR[t * 4 + lane] = (int)rank; c.GATE[t * 4 + lane] = gt; } } }
    __syncthreads();
}
constexpr int TBL_OFF = 131072, TBL_PSTART = TBL_OFF + 2304, TBL_NBLK = TBL_PSTART + 256, TBL_WBASE = TBL_NBLK + 64, TBL_CNT = TBL_WBASE + 128, TBL_PART = TBL_OFF + 4096, TBL_LCNT = TBL_OFF + 8192;
__device__ __forceinline__ void moe_tables(const int tid, const int bid, const LayerCtx& c, LAS unsigned char* lds) {
    LAS int* blk_e = (LAS int*)(lds + TBL_OFF); LAS int* pstart = (LAS int*)(lds + TBL_PSTART); LAS int* nblk = (LAS int*)(lds + TBL_NBLK); LAS int* wbase = (LAS int*)(lds + TBL_WBASE);
    LAS int* cntL = (LAS int*)(lds + TBL_CNT); LAS int* part = (LAS int*)(lds + TBL_PART);
    { const int e = tid & 31, pr = tid >> 5; int tot = 0, pf = 0;
#pragma unroll 4
      for (int w = pr * 16; w < pr * 16 + 16; ++w) { const int v = (int)__hip_atomic_load(c.cnt + w * 32 + e, RLX_AGENT); tot += v; pf += (w < bid) ? v : 0; }
      part[pr * 32 + e] = tot; part[512 + pr * 32 + e] = pf; }
    __syncthreads();
    if (tid < 32) { int tot = 0, pf = 0;
#pragma unroll 4
        for (int pr = 0; pr < 16; ++pr) { tot += part[pr * 32 + tid]; pf += part[512 + pr * 32 + tid]; }
        cntL[tid] = tot; wbase[tid] = pf; }
    __syncthreads();
    if (tid < 32) { int pos = 0;
#pragma unroll 1
        for (int e = 0; e < tid; ++e) pos += (cntL[e] + 255) >> 8;
        pstart[tid] = pos * 256; wbase[tid] += pos * 256;
        if (tid == 31) nblk[0] = pos + ((cntL[31] + 255) >> 8); }
    __syncthreads();
#pragma unroll 1
    for (int rb = tid; rb < MOE_MAXBLK; rb += NTHREADS) { int e = 0;
#pragma unroll 1
        for (int q = 1; q < NE; ++q) e += (pstart[q] <= rb * 256) ? 1 : 0;
        blk_e[rb] = e; }
    __syncthreads();
}
__device__ __forceinline__ void gather_rows2(const LayerCtx& c, int t0, int lane, const LAS int* wbase) {
    u32x4 hv[2][2]; int dest[2][4];
#pragma unroll
    for (int q = 0; q < 2; ++q) { const int t = t0 + q;
        hv[q][0] = *(const u32x4*)(c.HB + (size_t)t * D + 8 * lane); hv[q][1] = *(const u32x4*)(c.HB + (size_t)t * D + 512 + 8 * lane);
        const u32x4 e4 = *(const u32x4*)(c.RE + t * 4), r4 = *(const u32x4*)(c.RR + t * 4);
#pragma unroll
        for (int k = 0; k < 4; ++k) dest[q][k] = wbase[e4[k]] + (int)r4[k]; }
#pragma unroll
    for (int q = 0; q < 2; ++q) { const int t = t0 + q;
#pragma unroll
        for (int k = 0; k < 4; ++k) { *(u32x4*)(c.XS + (size_t)dest[q][k] * D + 8 * lane) = hv[q][0]; *(u32x4*)(c.XS + (size_t)dest[q][k] * D + 512 + 8 * lane) = hv[q][1]; }
        if (lane == 0) *(u32x4*)(c.DEST + t * 4) = (u32x4){(unsigned)dest[q][0], (unsigned)dest[q][1], (unsigned)dest[q][2], (unsigned)dest[q][3]}; }
}
__device__ __forceinline__ void combine_rows2(const Args& a, const LayerCtx& c, int t0, int tstride, int lane, float* out2) {
    u32x4 d4[2]; f32x4 g4[2]; u32x4 hw[2][2], yw[2][4][2];
#pragma unroll
    for (int q = 0; q < 2; ++q) { const int t = t0 + q * tstride; d4[q] = *(const u32x4*)(c.DEST + t * 4); g4[q] = *(const f32x4*)(c.GATE + t * 4);
        hw[q][0] = *(const u32x4*)(c.HB + (size_t)t * D + 8 * lane); hw[q][1] = *(const u32x4*)(c.HB + (size_t)t * D + 512 + 8 * lane); }
#pragma unroll
    for (int q = 0; q < 2; ++q)
#pragma unroll
        for (int k = 0; k < 4; ++k) { const bf16_t* y = c.YS + (size_t)d4[q][k] * D; yw[q][k][0] = *(const u32x4*)(y + 8 * lane); yw[q][k][1] = *(const u32x4*)(y + 512 + 8 * lane); }
    R8 v[2][2];
#pragma unroll
    for (int q = 0; q < 2; ++q)
#pragma unroll
        for (int j = 0; j < 2; ++j) { const R8 h = unpack8(hw[q][j]); v[q][j].lo = h.lo * DN_ALPHA; v[q][j].hi = h.hi * DN_ALPHA;
#pragma unroll
            for (int k = 0; k < 4; ++k) { const R8 y = unpack8(yw[q][k][j]); v[q][j].lo += y.lo * g4[q][k]; v[q][j].hi += y.hi * g4[q][k]; } }
    ln_rows<2>(v, a.in[I_LN3G] + c.l * D, a.in[I_LN3B] + c.l * D, lane);
#pragma unroll
    for (int q = 0; q < 2; ++q) { const int t = t0 + q * tstride; store_row_bf16(c.HB + (size_t)t * D, v[q], lane); if (out2) store_row_f32(out2 + (size_t)t * D, v[q], lane); }
}
__device__ __forceinline__ int hw_lane() { int l; asm volatile("v_mbcnt_lo_u32_b32 %0, -1, 0\n\tv_mbcnt_hi_u32_b32 %0, -1, %0" : "=v"(l)); return l; }
constexpr int NPH_LAYER = 17, NPHASES = 2 + NLAYER * NPH_LAYER;
#ifndef USE_PG8
#define USE_PG8 1
#endif
#if USE_PG8
#define GEMM_CALL(PAIR, g, S, E) do { int tid_ = tid; asm volatile("" : "+v"(tid_)); pg8::gemm_phase<PAIR, false>(tid_, lds, g, S, E); } while (0)
#define GEMM_CALL_GATHER(PAIR, g, S, E) do { int tid_ = tid; asm volatile("" : "+v"(tid_)); pg8::gemm_phase<PAIR, true>(tid_, lds, g, S, E); } while (0)
#else
#define GEMM_CALL(PAIR, g, S, E) sgemm_phase<PAIR>(tid, g, S, E)
#endif

__global__ void __launch_bounds__(NTHREADS, 2) fwd(Args a) {
    extern __shared__ __attribute__((aligned(16))) unsigned char lds_raw[];
    LAS unsigned char* lds = (LAS unsigned char*)lds_raw;
    volatile LAS unsigned* MISC = (volatile LAS unsigned*)(lds + MISC_OFF);
    const int G = gridDim.x, NGW = G * NWAVES;
    const int wave_s = __builtin_amdgcn_readfirstlane((int)threadIdx.x >> 6);
#define HW_TID() (wave_s * 64 + hw_lane())
    if (threadIdx.x < 64) MISC[threadIdx.x] = 0u;
    __syncthreads();
    unsigned* ctl = (unsigned*)(a.ws + WS_CTL);
    XcdBarrier bar; bar.bar = ctl + CW_BAR; bar.x = 0; bar.st = nullptr;
    if (N_LAUNCH_MODE == 1) bar = xcd_barrier_post(ctl + CW_BAR, MISC + 8, (int)threadIdx.x);
    const int lo = a.lo, hi = a.hi;
#define PH_TID int tid = HW_TID(); asm volatile("" : "+v"(tid)); int bid = blockIdx.x; asm volatile("" : "+s"(bid)); const __attribute__((address_space(4))) Args* ap_ = (const __attribute__((address_space(4))) Args*)__builtin_amdgcn_kernarg_segment_ptr(); asm volatile("" : "+s"(ap_)); const Args& a = *(const Args*)ap_; const int lane = tid & 63, wave = tid >> 6, gw = bid * NWAVES + wave; (void)lane; (void)gw
#define PH_BEGIN int lv = l; asm volatile("" : "+s"(lv)); PH_TID; const LayerCtx c = make_ctx(a, lv)
#define IN(k) (lo <= (k) && (k) < hi)
#define SEAM(k) do { if (N_LAUNCH_MODE == 1 && IN(k) && IN((k) + 1)) xcd_barrier(bar, HW_TID()); } while (0)

    if (IN(0)) { PH_TID; phase_pre0(tid, bid, a, lds); } SEAM(0);
    if (IN(1)) { PH_TID;
        GemmDesc g{(const bf16_t*)a.ws, (const bf16_t*)a.ws, 1024, 1024, 1024}; PreOrder S{G, bid}; EpiPre E{a.ws};
        GEMM_CALL(false, g, S, E);
    } SEAM(1);

    for (int l = 0; l < NLAYER; ++l) {
        const int pb = 2 + NPH_LAYER * l;
        if (IN(pb + 0)) { PH_BEGIN;
            GemmDesc g{c.HB, (const bf16_t*)(c.wl + WL_IN), 1024, 1024, 1024}; TileOrder S; S.init(T / 256, ZC / 256, G, bid, 0, 1024, 1024);
            EpiBf16 E{c.Z, ZC, nullptr}; GEMM_CALL(false, g, S, E);
        } SEAM(pb + 0);
        if (IN(pb + 1)) { PH_BEGIN;
            { fft::build_table(tid, lds); fft::F64Frags FF; fft::build_f64(tid, FF); __syncthreads();
              for (int u = bid; u < 512; u += G) fft::unit(tid, c, u, lds, FF); }
            __syncthreads();
            for (int it = bid; it < T / 64; it += G) conv_item(tid, a, c, it, lds);
            for (int t = gw; t < T; t += 4 * NGW) { QkRaw raw[4];
#pragma unroll
                for (int q = 0; q < 4; ++q) raw[q] = qkprep_load(c, t + q * NGW, lane);
#pragma unroll
                for (int q = 0; q < 4; ++q) qkprep_row(a, c, t + q * NGW, lane, raw[q]); }
        } SEAM(pb + 1);
        if (IN(pb + 2)) { PH_BEGIN;
            { GemmDesc g{c.CQKV, (const bf16_t*)(c.wl + WL_MLA), 384, 384, 384}; TileOrder S; S.init(T / 256, 4, G, bid, 0, 384, 384);
              EpiBf16 E{c.QKVM, 1024, nullptr}; GEMM_CALL(false, g, S, E); }
            { GemmDesc g{c.FC, (const bf16_t*)(c.wl + WL_FC), 512, 256, 256}; TileOrder S; S.init(T / 256, 2, G, bid, 1, 512, 256);
              EpiF32 E{c.YMIX, 1024, a.in[I_BF] + lv * 256, a.in[I_BPW] + lv * 256}; GEMM_CALL(false, g, S, E); }
        } SEAM(pb + 2);
        if (IN(pb + 3)) { PH_BEGIN;
            for (int U = bid; U < 1024; U += G) { const int x = U & 511, b = x >> 7, h = (x >> 5) & 3, qb = x & 31;
                if (lv == 0 && (U >> 8) == ((bid >> 3) & 3)) { int tw = tid; asm volatile("" : "+v"(tw)); moe_weight_items(tw, bid, a, lds); __syncthreads(); }
                unsigned char* wsb = a.ws; asm volatile("" : "+s"(wsb));
                int tu = tid; asm volatile("" : "+v"(tu));
                if (U < 512) { const AttnSrc A = gqa_src(wsb, b, h); att::unit<64>(tu, A, qb * 256, lds); }
                else         { const AttnSrc A = mla_src(wsb, b, h); att::unit<96>(tu, A, qb * 256, lds); } }
        } SEAM(pb + 3);
        if (IN(pb + 4)) { PH_BEGIN; for (int t = gw; t < T; t += 4 * NGW) grpnorm_rows4(c, t, NGW, lane); } SEAM(pb + 4);
        if (IN(pb + 5)) { PH_BEGIN;
            GemmDesc g{c.Y, (const bf16_t*)(c.wl + WL_O), 1024, 1024, 1024}; TileOrder S; S.init(T / 256, 4, G, bid, 0, 1024, 1024);
            EpiBf16 E{c.FB, 1024, nullptr}; GEMM_CALL(false, g, S, E);
        } SEAM(pb + 5);
        if (IN(pb + 6)) { PH_BEGIN; for (int t = gw; t < T; t += 4 * NGW) { R8 v[4][2]; resln_rows<4>(c, t, NGW, a.in[I_LN1G] + lv * D, a.in[I_LN1B] + lv * D, lane, v); } } SEAM(pb + 6);
        if (IN(pb + 7)) { PH_BEGIN;
#define WG_HANDOFF() do { asm volatile("s_waitcnt vmcnt(0)" ::: "memory"); __syncthreads(); __builtin_amdgcn_fence(__ATOMIC_ACQUIRE, "agent"); asm volatile("s_waitcnt vmcnt(0)" ::: "memory"); __syncthreads(); } while (0)
            { GemmDesc g{c.HB, (const bf16_t*)(c.wl + WL_XQ), 1024, 1024, 1024}; TileOrder S; S.init(T / 256, 4, G, bid, 0, 1024, 1024);
              EpiBf16 E{c.XQ, 1024, nullptr}; GEMM_CALL(false, g, S, E); }
            WG_HANDOFF();
            { GemmDesc g{c.XQ, (const bf16_t*)(a.ws + WS_KX + (size_t)lv * 2 * MiB), 1024, 1024, 256}; TileOrder S; S.init(T / 256, 4, G, bid, 2, 1024, 1024);
              EpiXS E{c.PB, c.RS}; GEMM_CALL(false, g, S, E); }
            WG_HANDOFF();
            { GemmDesc g{c.PB, (const bf16_t*)(a.ws + WS_VXT + (size_t)lv * 2 * MiB), 1024, 1024, 256}; TileOrder S; S.init(T / 256, 4, G, bid, 3, 1024, 1024);
              EpiXO E{c.XO, c.RS}; GEMM_CALL(false, g, S, E); }
#undef WG_HANDOFF
        } SEAM(pb + 10);
        if (IN(pb + 11)) { PH_BEGIN;
            GemmDesc g{c.XO, (const bf16_t*)(c.wl + WL_XO), 1024, 1024, 1024}; TileOrder S; S.init(T / 256, 4, G, bid, 0, 1024, 1024);
            EpiBf16 E{c.FB, 1024, nullptr}; GEMM_CALL(false, g, S, E);
        } SEAM(pb + 11);
        if (IN(pb + 12)) { PH_BEGIN; LAS unsigned* lcnt = (LAS unsigned*)(lds + TBL_LCNT);
            if (tid < 32) lcnt[tid] = 0u;
            bf16x8 bh[8], bl[8];
            { const bf16_t* wr = (const bf16_t*)(c.wl + WL_RT) + (size_t)(lane & 31) * 1024 + 128 * wave + 8 * (lane >> 5);
#pragma unroll
              for (int ks = 0; ks < 8; ++ks) { bh[ks] = *(const bf16x8*)(wr + 16 * ks); bl[ks] = *(const bf16x8*)(wr + 32768 + 16 * ks); } }
            __syncthreads();
            { u32x4 hw[4][2], fw[4][2]; static_assert(MAXWG <= T / 32, "every workgroup has a first group"); resln_load<4>(c, bid * 32 + wave * 4, 1, lane, hw, fw);
              for (int grp = bid; grp < T / 32; grp += G) ln2_router_group(tid, a, c, grp, grp + G, lds, bh, bl, lcnt, hw, fw); }
            __syncthreads();
            if (tid < 32) __hip_atomic_store(c.cnt + bid * 32 + tid, lcnt[tid], RLX_AGENT);
        } SEAM(pb + 12);
        if (IN(pb + 13)) { PH_BEGIN; moe_tables(tid, bid, c, lds); const LAS int* wbase = (const LAS int*)(lds + TBL_WBASE);
            { const int gi = tid >> 7, pr = tid & 127; const int grp = bid + G * gi;
              if (grp < T / 32) { const int t = grp * 32 + (pr >> 2), k = pr & 3; const int dest = wbase[c.RE[t * 4 + k]] + c.RR[t * 4 + k]; c.TOK[dest] = t; c.DEST[t * 4 + k] = dest; } }
        } SEAM(pb + 13);
        if (IN(pb + 14)) { PH_BEGIN;
            const int nblk = *(const LAS int*)(lds + TBL_NBLK);
            GemmDesc g{c.HB, (const bf16_t*)(c.wl + WL_GU), 1024, 1024, 1024, c.TOK}; MoeOrder S{(const LAS int*)(lds + TBL_OFF), nblk, 8, G, bid};
            EpiGU E{c.ACT, a.in[I_BGU] + (size_t)lv * NE * 2048, lds}; GEMM_CALL_GATHER(true, g, S, E);
        } SEAM(pb + 14);
        if (IN(pb + 15)) { PH_BEGIN;
            const int nblk = *(const LAS int*)(lds + TBL_NBLK);
            GemmDesc g{c.ACT, (const bf16_t*)(c.wl + WL_DN), 1024, 1024, 1024}; MoeOrder S{(const LAS int*)(lds + TBL_OFF), nblk, 4, G, bid};
            EpiDown E{c.YS, a.in[I_BDN] + (size_t)lv * NE * 1024, lds}; GEMM_CALL(false, g, S, E);
        } SEAM(pb + 15);
        if (IN(pb + 16)) { PH_BEGIN; for (int t = gw; t < T; t += 2 * NGW) combine_rows2(a, c, t, NGW, lane, (lv == NLAYER - 1) ? a.out : nullptr); } SEAM(pb + 16);
    }
#undef IN
#undef SEAM
}

extern "C" void kernel_launch(void* const* d_in, const int* in_sizes, int n_in, void* d_out, int out_size, void* d_ws, size_t ws_size, hipStream_t stream) {
    static int grid = 0;
    if (grid == 0) {
        if (n_in != 37 || in_sizes[0] != T * D || out_size != T * D || ws_size < WS_END) {
            fprintf(stderr, "kernel_launch: unexpected shapes: n_in %d in0 %d out %d ws %zu (need %zu)\n", n_in, n_in > 0 ? in_sizes[0] : -1, out_size, ws_size, (size_t)WS_END); grid = -1; return; }
        int dev = 0, cus = 0;
        if (hipGetDevice(&dev) != hipSuccess || hipDeviceGetAttribute(&cus, hipDeviceAttributeMultiprocessorCount, dev) != hipSuccess) { grid = -1; return; }
        if (hipFuncSetAttribute((const void*)fwd, hipFuncAttributeMaxDynamicSharedMemorySize, LDS_BYTES) != hipSuccess) { fprintf(stderr, "kernel_launch: hipFuncSetAttribute failed\n"); grid = -1; return; }
        int per_cu = 0;
        if (hipOccupancyMaxActiveBlocksPerMultiprocessor(&per_cu, (const void*)fwd, NTHREADS, LDS_BYTES) != hipSuccess || per_cu < 1) fprintf(stderr, "kernel_launch: occupancy query reports %d\n", per_cu);
        (void)hipGetLastError();
        grid = MAXWG;
        if (cus < MAXWG) fprintf(stderr, "kernel_launch: only %d CUs: the 256-workgroup persistent grid cannot be resident; the grid barrier will time out\n", cus);
    }
    if (grid < 0) return;
    (void)hipMemsetAsync((char*)d_ws + WS_CTL, 0, CTL_ZERO_BYTES, stream);
    Args a{};
    for (int i = 0; i < 37; ++i) a.in[i] = (const float*)d_in[i];
    a.out = (float*)d_out; a.ws = (unsigned char*)d_ws; a.pad0 = 0; a.pad1 = 0;
    if (N_LAUNCH_MODE == 1) { a.lo = 0; a.hi = NPHASES; hipLaunchKernelGGL(fwd, dim3(grid), dim3(NTHREADS), LDS_BYTES, stream, a); }
    else for (int p = 0; p < NPHASES; ++p) { a.lo = p; a.hi = p + 1; hipLaunchKernelGGL(fwd, dim3(grid), dim3(NTHREADS), LDS_BYTES, stream, a); }
    const hipError_t le = hipPeekAtLastError();
    if (le != hipSuccess) fprintf(stderr, "kernel_launch: launch failed: %s\n", hipGetErrorName(le));
}
```

```cpp
#include <hip/hip_runtime.h>
#include <cstdio>
#include <cstdint>

#ifndef N_LAUNCH_MODE
#define N_LAUNCH_MODE 1
#endif

#define LAS __attribute__((address_space(3)))
#define GAS __attribute__((address_space(1)))
typedef unsigned short bf16_t;
typedef short bf16x8 __attribute__((ext_vector_type(8)));
typedef float f32x4 __attribute__((ext_vector_type(4)));
typedef float f32x2 __attribute__((ext_vector_type(2)));
typedef float f32x16 __attribute__((ext_vector_type(16)));
typedef unsigned u32x4 __attribute__((ext_vector_type(4)));
typedef unsigned u32x2 __attribute__((ext_vector_type(2)));
typedef GAS unsigned gu32;
#define RLX_AGENT __ATOMIC_RELAXED, __HIP_MEMORY_SCOPE_AGENT
#define LDS_WAIT() asm volatile("s_waitcnt lgkmcnt(0)" ::: "memory")
#define VM_WAIT() asm volatile("s_waitcnt vmcnt(0)" ::: "memory")

constexpr int NB = 4, SEQ = 8192, T = NB * SEQ, D = 1024, MEML = 256, NE = 32, TOPK = 4, NLAYER = 2;
constexpr int ZC = 1792;
constexpr int ZC_CA = 256, ZC_CG = 512, ZC_Q = 768, ZC_K = 1024, ZC_V = 1152, ZC_CQ = 1280, ZC_CKV = 1536, ZC_KR = 1664;
constexpr int INC = 1696;
constexpr float LOG2E = 1.4426950408889634f;
constexpr float DN_ALPHA = 1.4142135623730951f;
constexpr float LN_EPS = 1e-5f, RMS_EPS = 1e-6f;
constexpr float QSCALE_G = 0.125f * LOG2E;
constexpr float QSCALE_M = 0.10206207261596575f * LOG2E;
constexpr float QSCALE_X = 0.0625f * LOG2E;
constexpr int MOE_MAXBLK = T * TOPK / 256 + NE;
constexpr int MOE_ROWS = MOE_MAXBLK * 256;

constexpr size_t MiB = 1u << 20;
constexpr size_t WS_CTL = 0, CTL_ZERO_BYTES = 1 * MiB;
constexpr size_t WS_W = 1 * MiB, WL_SIZE = 208 * MiB;
constexpr size_t WL_IN = 0, WL_MLA = 4 * MiB, WL_FC = 5 * MiB, WL_RT = 5 * MiB + 512 * 1024, WL_O = 6 * MiB, WL_XQ = 8 * MiB, WL_XK = 10 * MiB, WL_XV = 12 * MiB,
                 WL_XO = 14 * MiB, WL_GU = 16 * MiB, WL_DN = 144 * MiB;
constexpr size_t WS_MEMB = 418 * MiB, WS_KX = 420 * MiB, WS_VXT = 424 * MiB;
constexpr size_t WS_ROUTE = 428 * MiB;
constexpr size_t WS_H = 430 * MiB, WS_HB = 558 * MiB, WS_F = 622 * MiB, WS_R = 750 * MiB;
constexpr size_t R_Z = 0, R_FC = 112 * MiB, R_QG = 144 * MiB, R_KG = 160 * MiB, R_CQKV = 168 * MiB, R_KR = 192 * MiB, R_QKVM = 194 * MiB, R_YMIX = 258 * MiB, R_Y = 386 * MiB;
constexpr size_t R_XQ = 0, R_SC = 64 * MiB, R_PB = 192 * MiB, R_XO = 256 * MiB;
constexpr size_t R_XS = 0, R_ACT = 272 * MiB;
constexpr size_t WS_MT = 430 * MiB;
constexpr size_t WS_END = WS_R + 544 * MiB;
constexpr int CW_TMO = 0, CW_CODE = 1, CW_BAR = 4096, CW_CNT = 16384, MAXWG = 256, CW_TOK = 65536;

constexpr int NTHREADS = 512, NWAVES = 8;
constexpr int LDS_BYTES = 147456;
constexpr int MISC_OFF = 147456 - 256;

__device__ __forceinline__ unsigned f2bf(float f) { unsigned u = __builtin_bit_cast(unsigned, f); return (u + 0x7fffu + ((u >> 16) & 1u)) >> 16; }
__device__ __forceinline__ unsigned pk2i(float lo, float hi) { return f2bf(lo) | (f2bf(hi) << 16); }
typedef __bf16 hwbf2 __attribute__((ext_vector_type(2))); typedef float hwf2 __attribute__((ext_vector_type(2)));
__device__ __forceinline__ unsigned pk2(float lo, float hi) { const hwf2 v = {lo, hi}; return __builtin_bit_cast(unsigned, __builtin_convertvector(v, hwbf2)); }
__device__ __forceinline__ float bf2f(unsigned b) { return __builtin_bit_cast(float, b << 16); }
__device__ __forceinline__ float bflo(unsigned w) { return __builtin_bit_cast(float, w << 16); }
__device__ __forceinline__ float bfhi(unsigned w) { return __builtin_bit_cast(float, w & 0xffff0000u); }
template <int CTRL> __device__ __forceinline__ float dppf(float v) { return __builtin_bit_cast(float, __builtin_amdgcn_update_dpp(0, __builtin_bit_cast(int, v), CTRL, 0xF, 0xF, true)); }
template <int O, bool MAX> __device__ __forceinline__ float rstep(float v) {
    float o;
    if constexpr (O == 1) o = dppf<0xB1>(v); else if constexpr (O == 2) o = dppf<0x4E>(v); else if constexpr (O == 4) o = dppf<0x141>(v); else if constexpr (O == 8) o = dppf<0x140>(v);
    else { const unsigned u = __builtin_bit_cast(unsigned, v);
        if constexpr (O == 16) { auto r = __builtin_amdgcn_permlane16_swap(u, u, false, false); v = __builtin_bit_cast(float, (unsigned)r[0]); o = __builtin_bit_cast(float, (unsigned)r[1]); }
        else { auto r = __builtin_amdgcn_permlane32_swap(u, u, false, false); v = __builtin_bit_cast(float, (unsigned)r[0]); o = __builtin_bit_cast(float, (unsigned)r[1]); } }
    return MAX ? fmaxf(v, o) : v + o;
}
template <int O> __device__ __forceinline__ float rsum(float v) { return rstep<O, false>(v); }
__device__ __forceinline__ float wave_sum(float v) { v = rsum<1>(v); v = rsum<2>(v); v = rsum<4>(v); v = rsum<8>(v); v = rsum<16>(v); return rsum<32>(v); }
__device__ __forceinline__ float wave_max(float v) { v = rstep<1, true>(v); v = rstep<2, true>(v); v = rstep<4, true>(v); v = rstep<8, true>(v); v = rstep<16, true>(v); return rstep<32, true>(v); }
__device__ __forceinline__ f32x4 ldbf4(const bf16_t* p) { const u32x2 w = *(const u32x2*)p; return (f32x4){bflo(w.x), bfhi(w.x), bflo(w.y), bfhi(w.y)}; }
__device__ __forceinline__ float sigmoidf_(float x) { return __builtin_amdgcn_rcpf(1.f + __expf(-x)); }

#define XB_TMO      128
#define XB_XCNT(j)  (256  + 64 * (j))
#define XB_XSUB(j)  (1280 + 64 * (j))
#define XB_XGEN(j)  (2304 + 64 * (j))
#define XB_TOP      3328
#define XB_TOPGEN   3392
#define XCD_BAR_WORDS 3456
#define XB_SPIN_CAP (1u << 22)
__device__ __forceinline__ unsigned xb_ld(unsigned* p)              { return __hip_atomic_load(p, __ATOMIC_RELAXED, __HIP_MEMORY_SCOPE_AGENT); }
__device__ __forceinline__ unsigned xb_add(unsigned* p, unsigned v) { return __hip_atomic_fetch_add(p, v, __ATOMIC_RELAXED, __HIP_MEMORY_SCOPE_AGENT); }
__device__ __forceinline__ unsigned xb_xcc_id() { return (unsigned)__builtin_amdgcn_s_getreg((3 << 11) | 20) & 0xFu; }
#define XB_SPIN(cond, bar) do { unsigned _sp = 0; while (cond) { __builtin_amdgcn_s_sleep(1); \
    if ((++_sp & 255u) == 0u) { if (xb_ld(&(bar)[XB_TMO])) break; if (_sp > XB_SPIN_CAP) { atomicAdd(&(bar)[XB_TMO], 1u); break; } } } } while (0)
struct XcdBarrier { unsigned* bar; unsigned x; volatile LAS unsigned* st; };
__device__ __forceinline__ XcdBarrier xcd_barrier_post(unsigned* bar, volatile LAS unsigned* st, int tid) {
    XcdBarrier b; b.bar = bar; b.x = xb_xcc_id(); b.st = st;
    if (tid == 0) (void)xb_add(&bar[XB_XCNT(b.x)], 1u);
    return b;
}
__device__ __forceinline__ void xcd_barrier_complete(unsigned* bar, unsigned x, unsigned& nloc, unsigned& nx) {
    const unsigned G = gridDim.x * gridDim.y * gridDim.z;
    unsigned sum, cnt, mine, sp = 0u;
    for (;;) {
        sum = 0u; cnt = 0u; mine = 0u;
#pragma unroll
        for (unsigned j = 0; j < 16; ++j) { const unsigned c = xb_ld(&bar[XB_XCNT(j)]); sum += c; cnt += (c > 0u) ? 1u : 0u; mine = (j == x) ? c : mine; }
        if (sum == G) break;
        __builtin_amdgcn_s_sleep(1);
        if ((++sp & 255u) == 0u) { if (xb_ld(&bar[XB_TMO])) break; if (sp > XB_SPIN_CAP) { atomicAdd(&bar[XB_TMO], 1u); break; } }
    }
    nloc = mine > 0u ? mine : 1u; nx = cnt > 0u ? cnt : 1u;
}
__device__ __forceinline__ void xcd_barrier(const XcdBarrier& b, int tid) {
    asm volatile("s_waitcnt vmcnt(0)" ::: "memory");
    __syncthreads();
    if (tid == 0) {
        unsigned* bar = b.bar;
        __builtin_amdgcn_s_waitcnt(0);
        unsigned nloc = b.st[0], nx = b.st[1];
        if (nloc == 0u) { xcd_barrier_complete(bar, b.x, nloc, nx); b.st[0] = nloc; b.st[1] = nx; }
        const unsigned old = xb_add(&bar[XB_XSUB(b.x)], 1u);
        const unsigned gen = old / nloc;
        if (old + 1u == (gen + 1u) * nloc) {
            __builtin_amdgcn_fence(__ATOMIC_RELEASE, "agent");
            asm volatile("s_waitcnt vmcnt(0)" ::: "memory");
            const unsigned og = xb_add(&bar[XB_TOP], 1u);
            const unsigned tg = og / nx;
            if (og + 1u == (tg + 1u) * nx) xb_add(&bar[XB_TOPGEN], 1u);
            else XB_SPIN(xb_ld(&bar[XB_TOPGEN]) == tg, bar);
            __builtin_amdgcn_fence(__ATOMIC_ACQUIRE, "agent");
            xb_add(&bar[XB_XGEN(b.x)], 1u);
            asm volatile("s_waitcnt vmcnt(0)" ::: "memory");
        } else {
            XB_SPIN(xb_ld(&bar[XB_XGEN(b.x)]) == gen, bar);
            __builtin_amdgcn_fence(__ATOMIC_ACQUIRE, "agent");
            asm volatile("s_waitcnt vmcnt(0)" ::: "memory");
        }
    }
    __syncthreads();
}

__device__ __forceinline__ int hw_lane() { int l; asm volatile("v_mbcnt_lo_u32_b32 %0, -1, 0\n\tv_mbcnt_hi_u32_b32 %0, -1, %0" : "=v"(l)); return l; }
constexpr int XSN_PART_OFF = 141312;
constexpr int EPI_BIAS_OFF = 143360;
struct Unit { int pm, pn, z; long aoff, boff; };
struct GemmDesc { const bf16_t* A; const bf16_t* Bt; int lda, ldb, K; const int* tok = nullptr; };

struct TileOrder {
    int nM, nN, nwg, G, c, mode, lda, ldb;
    __device__ __forceinline__ void init(int nM_, int nN_, int G_, int c_, int mode_, int lda_, int ldb_) { nM = nM_; nN = nN_; nwg = nM * nN; G = G_; c = c_; mode = mode_; lda = lda_; ldb = ldb_; }
    __device__ __forceinline__ bool next(int i, Unit& u) const {
        const long L = (long)i * G + c; if (L >= nwg) return false;
        int wgid = (int)L; { const int q = nwg / 8, r = nwg % 8, xcd = wgid % 8, off = wgid / 8; wgid = (xcd < r ? xcd * (q + 1) : r * (q + 1) + (xcd - r) * q) + off; }
        const int nig = 8 * nN, gid = wgid / nig, fm = gid * 8, gsz = (nM - fm) < 8 ? (nM - fm) : 8;
        u.pm = fm + ((wgid % nig) % gsz); u.pn = (wgid % nig) / gsz; u.z = 0;
        const long ar = (long)u.pm * 256 * lda;
        if (mode == 0)      { u.aoff = ar;                u.boff = (long)u.pn * 256 * ldb; }
        else if (mode == 1) { u.aoff = ar + u.pn * 256;   u.boff = (long)u.pn * 256 * ldb; }
        else if (mode == 2) { u.aoff = ar + u.pn * 256;   u.boff = (long)((u.pm >> 5) * 256) * ldb + u.pn * 256; }
        else if (mode == 3) { u.aoff = ar + u.pn * 256;   u.boff = (long)(u.pn * 256) * ldb + (u.pm >> 5) * 256; }
        else                { u.aoff = ar;                u.boff = (long)(u.pm >> 5) * 1048576 + (long)u.pn * 256 * ldb; }
        return true;
    }
};
struct PreOrder {
    int G, c;
    __device__ __forceinline__ bool next(int i, Unit& u) const {
        const int L = i * G + c; if (L >= 64) return false;
        const int which = L >> 4, t16 = L & 15, l = which >> 1, isv = which & 1;
        u.pm = t16 >> 2; u.pn = t16 & 3; u.z = which;
        const long memb = (long)(WS_MEMB / 2), wk = (long)((WS_W + l * WL_SIZE + WL_XK) / 2), wv = (long)((WS_W + l * WL_SIZE + WL_XV) / 2);
        const long ao = memb, bo = isv ? wv : wk;
        u.aoff = ao + (long)u.pm * 256 * 1024; u.boff = bo + (long)u.pn * 256 * 1024; return true;
    }
};
struct Pre2Order {
    int G, c;
    __device__ __forceinline__ bool next(int i, Unit& u) const {
        const int L = i * G + c; if (L >= 256) return false;
        const int l = L >> 7, which = (L >> 6) & 1, b = (L >> 4) & 3, h = (L >> 2) & 3, j = L & 3;
        const long kx = (long)((WS_KX + (size_t)l * 2 * MiB) / 2), vx = (long)((WS_VXT + (size_t)l * 2 * MiB) / 2), wq = (long)((WS_W + l * WL_SIZE + WL_XQ) / 2), wo = (long)((WS_W + l * WL_SIZE + WL_XO) / 2);
        u.z = (l * 2 + which) * 4 + b;
        if (which == 0) { u.pm = h; u.pn = j; u.aoff = kx + (long)(b * 256) * 1024 + h * 256; u.boff = wq + (long)(j * 256) * 1024 + h * 256; }
        else            { u.pm = j; u.pn = h; u.aoff = wo + (long)(j * 256) * 1024 + h * 256; u.boff = vx + (long)(b * 256) * 1024 + h * 256; }
        return true;
    }
};
struct MoeOrder {
    const LAS int* blk_e; int nblk, nN, G, c;
    __device__ __forceinline__ bool next(int i, Unit& u) const {
        const int x = c & 7, v = c >> 3, per = G >> 3; const long ul = (long)i * per + v; const int rb = x + 8 * (int)(ul / nN), pn = (int)(ul % nN); if (rb >= nblk) return false;
        const int e = blk_e[rb]; u.pm = rb; u.pn = pn; u.z = e;
        u.aoff = (long)rb * 256 * 1024; u.boff = ((long)e * nN * 256 + (long)pn * 256) * 1024; return true;
    }
};

__device__ __forceinline__ u32x4 pk8(const f32x4 a, const f32x4 b) { return (u32x4){pk2(a.x, a.y), pk2(a.z, a.w), pk2(b.x, b.y), pk2(b.z, b.w)}; }
struct EpiBf16 { static constexpr bool TILE = true; static constexpr int NST = 16; static constexpr int NPRE = 0; bf16_t* O; int ldo; const float* bias;
    __device__ __forceinline__ void tile(const f32x4 (&acc)[2][2][4][2], const Unit& u, int wr, int wc, int fr, int fq) const {
        const int col0 = u.pn * 256 + wc * 32 + 8 * fq; f32x4 b[2][2];
#pragma unroll
        for (int bj = 0; bj < 2; ++bj) { b[bj][0] = bias ? *(const f32x4*)(bias + col0 + bj * 128) : (f32x4){0.f, 0.f, 0.f, 0.f}; b[bj][1] = bias ? *(const f32x4*)(bias + col0 + bj * 128 + 4) : (f32x4){0.f, 0.f, 0.f, 0.f}; }
        if (bias) asm volatile("s_waitcnt vmcnt(0)" ::: "memory");
#pragma unroll
        for (int ai = 0; ai < 2; ++ai)
#pragma unroll
            for (int m = 0; m < 4; ++m) { bf16_t* rowp = O + (size_t)(u.pm * 256 + ai * 128 + wr * 64 + m * 16 + fr) * ldo + col0;
#pragma unroll
                for (int bj = 0; bj < 2; ++bj) *(u32x4*)(rowp + bj * 128) = pk8(acc[ai][bj][m][0] + b[bj][0], acc[ai][bj][m][1] + b[bj][1]); }
    }
    __device__ __forceinline__ void st4(const Unit&, int grow, int gcol, f32x4 v) const {
        if (bias) { const f32x4 b = *(const f32x4*)(bias + gcol); v += b; }
        u32x2 w; w.x = pk2(v.x, v.y); w.y = pk2(v.z, v.w); *(u32x2*)(O + (size_t)grow * ldo + gcol) = w; } };
struct EpiF32 { static constexpr bool TILE = false; static constexpr int NST = 0; static constexpr int NPRE = 0; float* O; int ldo; const float* bias0; const float* bias1;
    __device__ __forceinline__ void st4(const Unit&, int grow, int gcol, f32x4 v) const {
        if (bias0) { const f32x4 b = (gcol < 256) ? *(const f32x4*)(bias0 + gcol) : *(const f32x4*)(bias1 + gcol - 256); v += b; }
        *(f32x4*)(O + (size_t)grow * ldo + gcol) = v; } };
struct EpiPre { static constexpr bool TILE = false; static constexpr int NST = 0; static constexpr int NPRE = 0; unsigned char* ws;
    __device__ __forceinline__ void st4(const Unit& u, int grow, int gcol, f32x4 v) const {
        bf16_t* O = (bf16_t*)(ws + ((u.z & 1) ? WS_VXT : WS_KX) + (size_t)(u.z >> 1) * 2 * MiB);
        u32x2 w; w.x = pk2(v.x, v.y); w.y = pk2(v.z, v.w); *(u32x2*)(O + (size_t)grow * 1024 + gcol) = w; } };
struct EpiPre2 { static constexpr bool TILE = false; static constexpr int NST = 0; static constexpr int NPRE = 0; unsigned char* ws;
    __device__ __forceinline__ void st4(const Unit& u, int grow, int gcol, f32x4 v) const {
        bf16_t* O = (bf16_t*)(ws + WS_MT + (size_t)u.z * 2 * MiB);
        u32x2 w; w.x = pk2(v.x, v.y); w.y = pk2(v.z, v.w); *(u32x2*)(O + (size_t)grow * 1024 + gcol) = w; } };
__device__ __forceinline__ void rope2(float& x1, float& x2, float ang) { const float c = __cosf(ang), s = __sinf(ang); const float a = x1 * c - x2 * s, b = x2 * c + x1 * s; x1 = a; x2 = b; }
struct EpiGU { static constexpr bool TILE = true; static constexpr int NST = 8; static constexpr int NPRE = 1; bf16_t* O; const float* bgu; LAS unsigned char* lds;
    __device__ __forceinline__ void prefetch(const Unit& u, int wid, int lane) const {
        const float* b = bgu + (size_t)u.z * 2048 + (lane >> 5) * 1024 + u.pn * 128 + (wid & 3) * 32 + (lane & 31);
        __builtin_amdgcn_global_load_lds((const unsigned*)b, (LAS unsigned*)(lds + EPI_BIAS_OFF + wid * 256), 4, 0, 0); }
    __device__ __forceinline__ void tile(const f32x4 (&acc)[2][2][4][2], const Unit& u, int wr, int wc, int fr, int fq) const {
        const int acol = u.pn * 128 + wc * 32 + 8 * fq; const LAS float* b = (const LAS float*)(lds + EPI_BIAS_OFF + (wr * 4 + wc) * 256) + 8 * fq;
        const f32x4 bg0 = *(const LAS f32x4*)b, bg1 = *(const LAS f32x4*)(b + 4); f32x4 bu0 = *(const LAS f32x4*)(b + 32), bu1 = *(const LAS f32x4*)(b + 36);
        bu0 += 1.f; bu1 += 1.f;
#define GU_PAIR(G, U, BG, BU, I) ({ hwf2 g_ = hwf2{G[I], G[I + 1]} + hwf2{BG[I], BG[I + 1]}, u_ = hwf2{U[I], U[I + 1]} + hwf2{BU[I], BU[I + 1]};   \
            g_.x = fminf(g_.x, 7.f); g_.y = fminf(g_.y, 7.f); u_.x = __builtin_amdgcn_fmed3f(u_.x, -6.f, 8.f); u_.y = __builtin_amdgcn_fmed3f(u_.y, -6.f, 8.f);          \
            hwf2 e_ = g_ * -2.45546696f; e_.x = __builtin_amdgcn_exp2f(e_.x); e_.y = __builtin_amdgcn_exp2f(e_.y); e_ = e_ + 1.f;                                       \
            e_.x = __builtin_amdgcn_rcpf(e_.x); e_.y = __builtin_amdgcn_rcpf(e_.y); const hwf2 a_ = (g_ * u_) * e_; pk2(a_.x, a_.y); })
#pragma unroll
        for (int ai = 0; ai < 2; ++ai)
#pragma unroll
            for (int m = 0; m < 4; ++m) { const f32x4 g0 = acc[ai][0][m][0], g1 = acc[ai][0][m][1], u0 = acc[ai][1][m][0], u1 = acc[ai][1][m][1];
                u32x4 o; o.x = GU_PAIR(g0, u0, bg0, bu0, 0); o.y = GU_PAIR(g0, u0, bg0, bu0, 2); o.z = GU_PAIR(g1, u1, bg1, bu1, 0); o.w = GU_PAIR(g1, u1, bg1, bu1, 2);
                *(u32x4*)(O + (size_t)(u.pm * 256 + ai * 128 + wr * 64 + m * 16 + fr) * 1024 + acol) = o;
                __builtin_amdgcn_sched_barrier(0); }
#undef GU_PAIR
    }
    __device__ __forceinline__ void st4x2(const Unit& u, int grow, int acol, f32x4 g, f32x4 up) const {
        const float* b = bgu + (size_t)u.z * 2048; const f32x4 bg = *(const f32x4*)(b + acol), bu = *(const f32x4*)(b + 1024 + acol);
        g += bg; up += bu; f32x4 a;
#pragma unroll
        for (int i = 0; i < 4; ++i) { const float gg = fminf(g[i], 7.f), uu = fminf(fmaxf(up[i], -7.f), 7.f); a[i] = (uu + 1.f) * (gg * sigmoidf_(1.702f * gg)); }
        u32x2 w; w.x = pk2(a.x, a.y); w.y = pk2(a.z, a.w); *(u32x2*)(O + (size_t)grow * 1024 + acol) = w; } };
struct EpiDown { static constexpr bool TILE = true; static constexpr int NST = 16; static constexpr int NPRE = 1; bf16_t* O; const float* bdn; LAS unsigned char* lds;
    __device__ __forceinline__ void prefetch(const Unit& u, int wid, int lane) const {
        const float* b = bdn + (size_t)u.z * 1024 + u.pn * 256 + (lane >> 5) * 128 + (wid & 3) * 32 + (lane & 31);
        __builtin_amdgcn_global_load_lds((const unsigned*)b, (LAS unsigned*)(lds + EPI_BIAS_OFF + wid * 256), 4, 0, 0); }
    __device__ __forceinline__ void tile(const f32x4 (&acc)[2][2][4][2], const Unit& u, int wr, int wc, int fr, int fq) const {
        const int col0 = u.pn * 256 + wc * 32 + 8 * fq; const LAS float* bl = (const LAS float*)(lds + EPI_BIAS_OFF + (wr * 4 + wc) * 256) + 8 * fq; f32x4 b[2][2];
#pragma unroll
        for (int bj = 0; bj < 2; ++bj) { b[bj][0] = *(const LAS f32x4*)(bl + 32 * bj); b[bj][1] = *(const LAS f32x4*)(bl + 32 * bj + 4); }
#pragma unroll
        for (int ai = 0; ai < 2; ++ai)
#pragma unroll
            for (int m = 0; m < 4; ++m) { bf16_t* rowp = O + (size_t)(u.pm * 256 + ai * 128 + wr * 64 + m * 16 + fr) * 1024 + col0;
#pragma unroll
                for (int bj = 0; bj < 2; ++bj) *(u32x4*)(rowp + bj * 128) = pk8(acc[ai][bj][m][0] + b[bj][0], acc[ai][bj][m][1] + b[bj][1]); }
    }
    __device__ __forceinline__ void st4(const Unit& u, int grow, int gcol, f32x4 v) const {
        const f32x4 b = *(const f32x4*)(bdn + (size_t)u.z * 1024 + gcol); v += b;
        u32x2 w; w.x = pk2(v.x, v.y); w.y = pk2(v.z, v.w); *(u32x2*)(O + (size_t)grow * 1024 + gcol) = w; } };

struct EpiXS { static constexpr bool TILE = true; static constexpr int NST = 16; static constexpr int NPRE = 0; bf16_t* P; float* RS;
    __device__ __forceinline__ void tile(const f32x4 (&acc)[2][2][4][2], const Unit& u, int wr, int wc, int fr, int fq) const {
#pragma unroll
        for (int ai = 0; ai < 2; ++ai)
#pragma unroll
            for (int m = 0; m < 4; ++m) { const int grow = u.pm * 256 + ai * 128 + wr * 64 + m * 16 + fr; float rs = 0.f;
#pragma unroll
                for (int bj = 0; bj < 2; ++bj) { f32x4 p0, p1;
#pragma unroll
                    for (int i = 0; i < 4; ++i) { p0[i] = __builtin_amdgcn_exp2f(fminf(acc[ai][bj][m][0][i], 100.f)); p1[i] = __builtin_amdgcn_exp2f(fminf(acc[ai][bj][m][1][i], 100.f)); }
                    rs += ((p0.x + p0.y) + (p0.z + p0.w)) + ((p1.x + p1.y) + (p1.z + p1.w));
                    u32x4 w; w.x = pk2(p0.x, p0.y); w.y = pk2(p0.z, p0.w); w.z = pk2(p1.x, p1.y); w.w = pk2(p1.z, p1.w);
                    *(u32x4*)(P + (size_t)grow * 1024 + u.pn * 256 + bj * 128 + wc * 32 + 8 * fq) = w; }
                rs = rsum<16>(rs); rs = rsum<32>(rs);
                if (fq == 0) RS[((size_t)grow * 4 + u.pn) * 4 + wc] = rs;
                __builtin_amdgcn_sched_barrier(0); }
    } };
struct EpiXSN { static constexpr bool TILE = true; static constexpr int NST = 16; static constexpr int NPRE = 0; bf16_t* P; LAS unsigned char* lds;
    __device__ __forceinline__ void tile(const f32x4 (&acc)[2][2][4][2], const Unit& u, int wr, int wc, int fr_, int fq_) const {
        int fr = fr_, fq = fq_; asm volatile("" : "+v"(fr), "+v"(fq));
        LAS float* part = (LAS float*)(lds + XSN_PART_OFF);
#pragma unroll
        for (int ai = 0; ai < 2; ++ai)
#pragma unroll
            for (int m = 0; m < 4; ++m) { float rs = 0.f;
#pragma unroll
                for (int bj = 0; bj < 2; ++bj)
#pragma unroll
                    for (int n = 0; n < 2; ++n) { f32x4 q;
#pragma unroll
                        for (int i = 0; i < 4; ++i) q[i] = __builtin_amdgcn_exp2f(fminf(acc[ai][bj][m][n][i], 100.f));
                        rs += (q.x + q.y) + (q.z + q.w); }
                rs = rsum<16>(rs); rs = rsum<32>(rs);
                if (fq == 0) part[(ai * 128 + wr * 64 + m * 16 + fr) * 4 + wc] = rs;
                __builtin_amdgcn_sched_barrier(0); }
        asm volatile("s_waitcnt lgkmcnt(0)\n\ts_barrier" ::: "memory");
        float cap = 100.f; asm volatile("" : "+v"(cap));
#pragma unroll
        for (int ai = 0; ai < 2; ++ai)
#pragma unroll
            for (int m = 0; m < 4; ++m) { const int lrow = ai * 128 + wr * 64 + m * 16 + fr; const f32x4 t = *(const LAS f32x4*)(part + lrow * 4); const float r = __builtin_amdgcn_rcpf((t.x + t.y) + (t.z + t.w));
#pragma unroll
                for (int bj = 0; bj < 2; ++bj) { f32x4 q0, q1;
#pragma unroll
                    for (int i = 0; i < 4; ++i) { q0[i] = __builtin_amdgcn_exp2f(fminf(acc[ai][bj][m][0][i], cap)) * r; q1[i] = __builtin_amdgcn_exp2f(fminf(acc[ai][bj][m][1][i], cap)) * r; }
                    *(u32x4*)(P + (size_t)(u.pm * 256 + lrow) * 1024 + u.pn * 256 + bj * 128 + wc * 32 + 8 * fq) = pk8(q0, q1); }
                __builtin_amdgcn_sched_barrier(0); }
    } };
struct EpiXO { static constexpr bool TILE = true; static constexpr int NST = 16; static constexpr int NPRE = 0; bf16_t* O; const float* RS;
    __device__ __forceinline__ void tile(const f32x4 (&acc)[2][2][4][2], const Unit& u, int wr, int wc, int fr, int fq) const {
        const int col0 = u.pn * 256 + wc * 32 + 8 * fq; float rr[2][4];
#pragma unroll
        for (int ai = 0; ai < 2; ++ai)
#pragma unroll
            for (int m = 0; m < 4; ++m) { const int grow = u.pm * 256 + ai * 128 + wr * 64 + m * 16 + fr; const f32x4 q = *(const f32x4*)(RS + ((size_t)grow * 4 + u.pn) * 4); rr[ai][m] = __builtin_amdgcn_rcpf((q.x + q.y) + (q.z + q.w)); }
        asm volatile("s_waitcnt vmcnt(0)" ::: "memory");
#pragma unroll
        for (int ai = 0; ai < 2; ++ai)
#pragma unroll
            for (int m = 0; m < 4; ++m) { const int grow = u.pm * 256 + ai * 128 + wr * 64 + m * 16 + fr; const float r = rr[ai][m];
#pragma unroll
                for (int bj = 0; bj < 2; ++bj) *(u32x4*)(O + (size_t)grow * 1024 + col0 + bj * 128) = pk8(acc[ai][bj][m][0] * r, acc[ai][bj][m][1] * r); }
    }
    __device__ __forceinline__ void st4(const Unit&, int grow, int gcol, f32x4 v) const {
        const f32x4 q = *(const f32x4*)(RS + ((size_t)grow * 4 + (gcol >> 8)) * 4); const float r = __builtin_amdgcn_rcpf((q.x + q.y) + (q.z + q.w)); v = v * r;
        u32x2 w; w.x = pk2(v.x, v.y); w.y = pk2(v.z, v.w); *(u32x2*)(O + (size_t)grow * 1024 + gcol) = w; } };

template <bool PAIR, class Sched, class Epi>
__device__ __forceinline__ void sgemm_phase(const int tid, const GemmDesc g, const Sched& S, const Epi& E) {
    const int wid = tid >> 6, lane = tid & 63, r32 = lane & 31, hi = lane >> 5;
    Unit u;
    for (int i = 0; S.next(i, u); ++i) {
        const int grow = u.pm * 256 + wid * 32 + r32;
        const bf16_t* Ap = g.A + u.aoff + (long)(wid * 32 + r32) * g.lda + hi * 8;
        const bf16_t* Bp = g.Bt + u.boff + (long)r32 * g.ldb + hi * 8;
#pragma unroll 1
        for (int pass = 0; pass < 2; ++pass) {
            int cbs[4];
#pragma unroll
            for (int j = 0; j < 4; ++j) cbs[j] = PAIR ? ((j & 1) + 2 * pass + 4 * (j >> 1)) : (4 * pass + j);
            f32x16 acc[4];
#pragma unroll
            for (int j = 0; j < 4; ++j) acc[j] = f32x16{};
#pragma unroll 2
            for (int k0 = 0; k0 < g.K; k0 += 16) {
                const bf16x8 a = *(const bf16x8*)(Ap + k0);
#pragma unroll
                for (int j = 0; j < 4; ++j) { const bf16x8 b = *(const bf16x8*)(Bp + (long)cbs[j] * 32 * g.ldb + k0); acc[j] = __builtin_amdgcn_mfma_f32_32x32x16_bf16(b, a, acc[j], 0, 0, 0); }
            }
            if constexpr (PAIR) {
#pragma unroll
                for (int j = 0; j < 2; ++j)
#pragma unroll
                    for (int q = 0; q < 4; ++q) { const f32x4 gv = {acc[j][4 * q], acc[j][4 * q + 1], acc[j][4 * q + 2], acc[j][4 * q + 3]};
                        const f32x4 uv = {acc[j + 2][4 * q], acc[j + 2][4 * q + 1], acc[j + 2][4 * q + 2], acc[j + 2][4 * q + 3]};
                        E.st4x2(u, grow, u.pn * 128 + cbs[j] * 32 + 8 * q + 4 * hi, gv, uv); }
            } else {
#pragma unroll
                for (int j = 0; j < 4; ++j)
#pragma unroll
                    for (int q = 0; q < 4; ++q) { const f32x4 v = {acc[j][4 * q], acc[j][4 * q + 1], acc[j][4 * q + 2], acc[j][4 * q + 3]};
                        E.st4(u, grow, u.pn * 256 + cbs[j] * 32 + 8 * q + 4 * hi, v); }
            }
        }
    }
}

namespace pg8 {
constexpr int BK = 64, HALF = 128, HTB = HALF * BK * 2, STAGE_BYTES = 8 * HTB;
__device__ __forceinline__ int lds_byte(int r, int c) { const int st = (r >> 4) * 2 + (c >> 5), rr = r & 15, cc = c & 31, ob = rr * 64 + cc * 2; return st * 1024 + (ob ^ (((ob >> 9) & 1) << 5)); }
__device__ __forceinline__ void stage_rc(int b, int& R, int& C) { const int st = b / 1024, sb = b % 1024, swz = sb ^ (((sb >> 9) & 1) << 5); R = (st >> 1) * 16 + swz / 64; C = (st & 1) * 32 + (swz % 64) / 2; }
__device__ __forceinline__ int perm32(int rho) { const int n = rho >> 4, i = rho & 15; return 8 * (i >> 2) + 4 * n + (i & 3); }
template <bool PAIR, class Epi>
__device__ __forceinline__ void run_epi(const Epi& E, const f32x4 (&acc)[2][2][4][2], const Unit& u, int wr, int wc, int fr, int fq) {
    if constexpr (Epi::TILE) { E.tile(acc, u, wr, wc, fr, fq); return; } else {
#pragma unroll
    for (int ai = 0; ai < 2; ++ai)
#pragma unroll
        for (int m = 0; m < 4; ++m) { const int grow = u.pm * 256 + ai * HALF + wr * 64 + m * 16 + fr;
            if constexpr (PAIR) {
#pragma unroll
                for (int n = 0; n < 2; ++n) E.st4x2(u, grow, u.pn * 128 + wc * 32 + 8 * fq + 4 * n, acc[ai][0][m][n], acc[ai][1][m][n]);
            } else {
#pragma unroll
                for (int bj = 0; bj < 2; ++bj)
#pragma unroll
                    for (int n = 0; n < 2; ++n) E.st4(u, grow, u.pn * 256 + bj * HALF + wc * 32 + 8 * fq + 4 * n, acc[ai][bj][m][n]);
            }
            __builtin_amdgcn_sched_barrier(0); }
    }
}
template <bool PAIR, bool GATH, class Sched, class Epi>
__device__ __forceinline__ void gemm_phase(const int tid, LAS unsigned char* lds, const GemmDesc g, const Sched& S, const Epi& E) {
    const int wid = __builtin_amdgcn_readfirstlane(tid >> 6), lane = tid & 63, wr = wid >> 2, wc = wid & 3, fr = lane & 15, fq = lane >> 4;
    const int K = g.K, nt = K / BK;
    unsigned voffA[2], voffB[2]; int RA[2], CA[2];
#define PG8_VOFFS() do { const int t_ = wid * 64 + hw_lane(); _Pragma("unroll") for (int i = 0; i < 2; ++i) { int R, C; stage_rc(t_ * 16 + i * 8192, R, C); const int Rb = (R & ~31) + perm32(R & 31); RA[i] = R; CA[i] = C * 2; \
        voffA[i] = (unsigned)(R * g.lda + C) * 2u; voffB[i] = (unsigned)(Rb * g.ldb + C) * 2u; } } while (0)
    PG8_VOFFS();
    unsigned cvA[2][2], nvA[2][2];
#define PG8_GVOFF(U, V) do { if constexpr (GATH) { _Pragma("unroll") for (int h_ = 0; h_ < 2; ++h_) _Pragma("unroll") for (int i_ = 0; i_ < 2; ++i_) \
        V[h_][i_] = (unsigned)g.tok[(U).pm * 256 + h_ * HALF + RA[i_]] * (unsigned)(g.lda * 2) + (unsigned)CA[i_]; } } while (0)
    const size_t kstep = (size_t)(BK * 2);
    const size_t hstepA = (size_t)HALF * g.lda * 2, hstepB = (size_t)HALF * g.ldb * 2;
    const unsigned ldsw = (unsigned)wid * 1024u;
    const int aoff = lds_byte(wr * 64 + fr, fq * 8), boff = lds_byte(wc * 32 + fr, fq * 8);
#define PG8_SA(b, h) (((b) * 2 + (h)) * HTB)
#define PG8_SB(b, h) ((4 + (b) * 2 + (h)) * HTB)
#define PG8_STAGE(bufoff, gbase, voff) do { _Pragma("unroll") for (int _i = 0; _i < 2; ++_i) \
        __builtin_amdgcn_global_load_lds((const unsigned*)((const char*)(gbase) + (voff)[_i]), (LAS unsigned*)(lds + (bufoff) + ldsw + _i * 8192), 16, 0, 0); } while (0)
#define PG8_STA(b, h, base, V) do { if constexpr (GATH) PG8_STAGE(PG8_SA(b, h), base, V[h]); else PG8_STAGE(PG8_SA(b, h), (base) + (h) * hstepA, voffA); } while (0)
#define PG8_LDA(dst, b, h) do { _Pragma("unroll") for (int m = 0; m < 4; ++m) _Pragma("unroll") for (int k = 0; k < 2; ++k) dst[m][k] = *(const LAS bf16x8*)(lds + PG8_SA(b, h) + aoff + m * 2048 + k * 1024); } while (0)
#define PG8_LDB(dst, b, h) do { _Pragma("unroll") for (int n = 0; n < 2; ++n) _Pragma("unroll") for (int k = 0; k < 2; ++k) dst[n][k] = *(const LAS bf16x8*)(lds + PG8_SB(b, h) + boff + n * 2048 + k * 1024); } while (0)
#define PG8_MMA(ai, bj, At, Bt) do { __builtin_amdgcn_s_setprio(1); _Pragma("unroll") for (int m = 0; m < 4; ++m) _Pragma("unroll") for (int n = 0; n < 2; ++n) _Pragma("unroll") for (int k = 0; k < 2; ++k) \
        acc[ai][bj][m][n] = __builtin_amdgcn_mfma_f32_16x16x32_bf16(Bt[n][k], At[m][k], acc[ai][bj][m][n], 0, 0, 0); __builtin_amdgcn_s_setprio(0); } while (0)
#define PG8_WAIT_V(n) asm volatile("s_waitcnt vmcnt(" #n ")" ::: "memory")
#define PG8_WAIT_VN(n) asm volatile("s_waitcnt vmcnt(%0)" :: "n"(n) : "memory")
#define PG8_WAIT_L(n) asm volatile("s_waitcnt lgkmcnt(" #n ")" ::: "memory")
#define PG8_BAR __builtin_amdgcn_s_barrier()
#define PG8_SCHED __builtin_amdgcn_sched_barrier(0)
    Unit cur, nxt; int ui = 0;
    if (!S.next(0, cur)) return;
    bool has_next = S.next(1, nxt);
    f32x4 acc[2][2][4][2];
    float zf = 0.f; asm volatile("" : "+v"(zf)); const f32x4 Z4 = {zf, zf, zf, zf};
#pragma unroll
    for (int a = 0; a < 2; ++a)
#pragma unroll
        for (int b = 0; b < 2; ++b)
#pragma unroll
            for (int m = 0; m < 4; ++m)
#pragma unroll
                for (int n = 0; n < 2; ++n) acc[a][b][m][n] = Z4;
    bf16x8 At[4][2], B0[2][2], B1[2][2];
    const char* cA = (const char*)g.A + (GATH ? (size_t)0 : (size_t)cur.aoff * 2); const char* cB = (const char*)g.Bt + (size_t)cur.boff * 2;
    const char* nA = (has_next && !GATH) ? (const char*)g.A + (size_t)nxt.aoff * 2 : cA; const char* nB = has_next ? (const char*)g.Bt + (size_t)nxt.boff * 2 : cB;
    PG8_GVOFF(cur, cvA);
    if constexpr (GATH) { if (has_next) PG8_GVOFF(nxt, nvA); else { _Pragma("unroll") for (int h_ = 0; h_ < 2; ++h_) _Pragma("unroll") for (int i_ = 0; i_ < 2; ++i_) nvA[h_][i_] = cvA[h_][i_]; } }
    PG8_STAGE(PG8_SB(0, 0), cB, voffB); PG8_STAGE(PG8_SB(0, 1), cB + hstepB, voffB); PG8_STA(0, 0, cA, cvA); PG8_STA(0, 1, cA, cvA);
    PG8_STAGE(PG8_SB(1, 0), cB + kstep, voffB); PG8_STA(1, 0, cA + kstep, cvA); PG8_STAGE(PG8_SB(1, 1), cB + hstepB + kstep, voffB); PG8_STA(1, 1, cA + kstep, cvA);
    PG8_WAIT_V(0);
    if (wr == 1) PG8_BAR;
    PG8_BAR;
    constexpr int WX = 8 + Epi::NST + Epi::NPRE;
#define PG8_WAIT_X() do { if constexpr (WX == 8) PG8_WAIT_V(8); else { if (fst) PG8_WAIT_VN(WX); else PG8_WAIT_V(8); } } while (0)
    for (;;) {
        int fst = 1; asm volatile("" : "+s"(fst));
#pragma unroll 1
        for (int t = 0; t < nt; t += 2) {
            const bool last = (t == nt - 2);
            const char* a1 = cA + (size_t)(t + 1) * kstep;
            const char* a2 = last ? nA : cA + (size_t)(t + 2) * kstep; const char* b2 = last ? nB : cB + (size_t)(t + 2) * kstep;
            const char* a3 = a2 + kstep; const char* b3 = b2 + kstep;
            unsigned sv[2][2];
            if constexpr (GATH) { _Pragma("unroll") for (int h_ = 0; h_ < 2; ++h_) _Pragma("unroll") for (int i_ = 0; i_ < 2; ++i_) sv[h_][i_] = last ? nvA[h_][i_] : cvA[h_][i_]; }
            PG8_LDB(B0, 0, 0); PG8_LDB(B1, 0, 1); PG8_SCHED; PG8_LDA(At, 0, 0); if (!fst) PG8_STA(1, 1, a1, cvA); else { if constexpr (Epi::NPRE == 1) E.prefetch(cur, wid, lane); }
            PG8_WAIT_X(); PG8_WAIT_L(0); PG8_BAR; PG8_MMA(0, 0, At, B0); PG8_MMA(0, 1, At, B1); PG8_BAR; PG8_SCHED;
            PG8_LDA(At, 0, 1); PG8_STAGE(PG8_SB(0, 0), b2, voffB); PG8_STAGE(PG8_SB(0, 1), b2 + hstepB, voffB); PG8_STA(0, 0, a2, sv);
            PG8_WAIT_X(); PG8_WAIT_L(0); PG8_BAR; PG8_MMA(1, 0, At, B0); PG8_MMA(1, 1, At, B1); PG8_BAR; PG8_SCHED;
            PG8_LDB(B0, 1, 0); PG8_LDB(B1, 1, 1); PG8_SCHED; PG8_LDA(At, 1, 0); PG8_STA(0, 1, a2, sv);
            PG8_WAIT_X(); PG8_WAIT_L(0); PG8_BAR; PG8_MMA(0, 0, At, B0); PG8_MMA(0, 1, At, B1); PG8_BAR; PG8_SCHED;
            PG8_LDA(At, 1, 1); PG8_STAGE(PG8_SB(1, 0), b3, voffB); PG8_STAGE(PG8_SB(1, 1), b3 + hstepB, voffB); PG8_STA(1, 0, a3, sv);
            PG8_WAIT_V(8); PG8_WAIT_L(0); PG8_BAR; PG8_MMA(1, 0, At, B0); PG8_MMA(1, 1, At, B1); PG8_BAR; PG8_SCHED;
            fst = 0;
        }
        if (wr == 0) PG8_BAR;
        PG8_STA(1, 1, nA + kstep, nvA);
        Unit nn; const bool has_nn = has_next && S.next(ui + 2, nn);
        unsigned n2vA[2][2];
        if constexpr (GATH) { if (has_nn) PG8_GVOFF(nn, n2vA); else { _Pragma("unroll") for (int h_ = 0; h_ < 2; ++h_) _Pragma("unroll") for (int i_ = 0; i_ < 2; ++i_) n2vA[h_][i_] = nvA[h_][i_]; } }
        { const int le_ = hw_lane(); run_epi<PAIR>(E, acc, cur, wr, wc, le_ & 15, le_ >> 4); }
        if (!has_next) break;
#pragma unroll
        for (int a = 0; a < 2; ++a)
#pragma unroll
            for (int b = 0; b < 2; ++b)
#pragma unroll
                for (int m = 0; m < 4; ++m)
#pragma unroll
                    for (int n = 0; n < 2; ++n) acc[a][b][m][n] = Z4;
        PG8_VOFFS();
        cur = nxt; cA = nA; cB = nB; ++ui;
        if constexpr (GATH) { _Pragma("unroll") for (int h_ = 0; h_ < 2; ++h_) _Pragma("unroll") for (int i_ = 0; i_ < 2; ++i_) { cvA[h_][i_] = nvA[h_][i_]; nvA[h_][i_] = n2vA[h_][i_]; } }
        has_next = has_nn;
        if (has_nn) { nxt = nn; if constexpr (!GATH) nA = (const char*)g.A + (size_t)nn.aoff * 2; nB = (const char*)g.Bt + (size_t)nn.boff * 2; }
        if (wr == 1) PG8_BAR;
    }
#undef PG8_WAIT_X
#undef PG8_VOFFS
    PG8_WAIT_V(0);
    PG8_BAR;
#undef PG8_SA
#undef PG8_SB
#undef PG8_STAGE
#undef PG8_LDA
#undef PG8_STA
#undef PG8_GVOFF
#undef PG8_LDB
#undef PG8_MMA
#undef PG8_WAIT_V
#undef PG8_WAIT_VN
#undef PG8_WAIT_L
#undef PG8_BAR
#undef PG8_SCHED
}
}

struct Args { const float* in[37]; float* out; unsigned char* ws; int lo, hi, pad0, pad1; };
enum { I_X = 0, I_MEM, I_LNIN_G, I_LNIN_B, I_WIN, I_WF, I_BF, I_DWW, I_DWB, I_CLG, I_CLB, I_WPW, I_BPW, I_QG, I_KG, I_MQG, I_WUQ, I_MKG, I_WUKV, I_GRPG, I_WO, I_LN1G, I_LN1B,
       I_WXQ, I_WXK, I_WXV, I_WXO, I_LN2G, I_LN2B, I_WR, I_BR, I_WGU, I_BGU, I_WDN, I_BDN, I_LN3G, I_LN3B };

__device__ __forceinline__ int rope_perm16(int d) { const int half = d >> 4, dd = d & 15; return half * 16 + ((dd < 8) ? 2 * dd : 2 * (dd - 8) + 1); }
__device__ __forceinline__ int rope_perm32(int d) { const int half = d >> 5, dd = d & 31; return half * 32 + ((dd < 16) ? 2 * dd : 2 * (dd - 16) + 1); }
__device__ __forceinline__ int map_row(int mode, int n) {
    switch (mode) {
    case 1: if (n < 256) return -1; if (n < 768) return n; if (n < 1152) { const int m = n - 768; return 768 + (m & ~63) + rope_perm32(m & 63); } if (n < 1664) return n; return 1664 + rope_perm16(n - 1664);
    case 2: { const int h = n / 96, p = n % 96; return h * 128 + (p < 64 ? p : 64 + rope_perm16(p - 64)); }
    case 3: return 512 + n;
    case 4: { const int half = n >> 10, m = n & 1023; return (m >> 7) * 256 + half * 128 + (m & 127); }
    default: return n;
    }
}
__device__ __forceinline__ void cp_item(const float* __restrict__ W, bf16_t* dst, float scale, int item, int lane) {
    const int r0 = (item >> 4) * 64 + (lane >> 4), c0 = (item & 15) * 64 + (lane & 15) * 4;
#pragma unroll
    for (int i = 0; i < 16; ++i) { const f32x4 v = *(const f32x4*)(W + (size_t)(r0 + 4 * i) * 1024 + c0) * scale; u32x2 w; w.x = pk2(v.x, v.y); w.y = pk2(v.z, v.w); *(u32x2*)(dst + (size_t)(r0 + 4 * i) * 1024 + c0) = w; }
}
__device__ __forceinline__ int fnet_j(int cc) { const int jp = cc >> 1, second = cc & 1; return jp == 0 ? (second ? 32 : 0) : (second ? 64 - jp : jp); }
__device__ __forceinline__ void tr_item(const float* __restrict__ W, int N, bf16_t* dst, int ldd, int koff, const float* kgain, float scale, int mode, int rowbase, LAS float* scr, int item, int lane, int kperm = 0) {
    const int nblk = (N + 63) >> 6, kb = item / nblk, nb = item - kb * nblk, k0 = kb * 64, n0 = nb * 64;
    const int nq = (lane & 15) * 4, kq = lane >> 4;
    const bool ok = (n0 + nq) < N;
    f32x4 v[16];
#pragma unroll
    for (int i = 0; i < 16; ++i) { const int kk = 4 * i + kq; const int ksrc = kperm ? (((k0 + kk) & ~63) + fnet_j((k0 + kk) & 63)) : (k0 + kk); v[i] = ok ? *(const f32x4*)(W + (size_t)ksrc * N + n0 + nq) : (f32x4){0.f, 0.f, 0.f, 0.f}; }
#pragma unroll
    for (int i = 0; i < 16; ++i) { const int kk = 4 * i + kq; const float gs = (kgain ? kgain[k0 + kk] : 1.f) * scale;
        scr[kk * 65 + nq + 0] = v[i].x * gs; scr[kk * 65 + nq + 1] = v[i].y * gs; scr[kk * 65 + nq + 2] = v[i].z * gs; scr[kk * 65 + nq + 3] = v[i].w * gs; }
    LDS_WAIT(); asm volatile("" ::: "memory");
    const int c = lane & 7;
#pragma unroll
    for (int j = 0; j < 8; ++j) { const int n = (lane >> 3) + 8 * j;
        if (n0 + n < N) { const int row = map_row(mode, n0 + n);
            if (row >= 0) { const LAS float* s = scr + (8 * c) * 65 + n;
                u32x4 o; o.x = pk2(s[0 * 65], s[1 * 65]); o.y = pk2(s[2 * 65], s[3 * 65]); o.z = pk2(s[4 * 65], s[5 * 65]); o.w = pk2(s[6 * 65], s[7 * 65]);
                *(u32x4*)(dst + (size_t)(rowbase + row) * ldd + koff + k0 + 8 * c) = o; } } }
    LDS_WAIT(); asm volatile("" ::: "memory");
}
constexpr int IT_IN = 16 * 27, IT_UQ = 4 * 6, IT_UKV = 2 * 8, IT_F = 16, IT_SQ = 256, IT_GU = 32 * 512, IT_DN = 32 * 256;
constexpr int IT_SMALL = IT_IN + IT_UQ + IT_UKV + 2 * IT_F + 5 * IT_SQ, IT_MOE = IT_GU + IT_DN;

struct R8 { f32x4 lo, hi; };
__device__ __forceinline__ R8 unpack8(const u32x4 w) { R8 r; r.lo = (f32x4){bflo(w.x), bfhi(w.x), bflo(w.y), bfhi(w.y)}; r.hi = (f32x4){bflo(w.z), bfhi(w.z), bflo(w.w), bfhi(w.w)}; return r; }
__device__ __forceinline__ u32x4 pack8(const R8& r) { return (u32x4){pk2(r.lo.x, r.lo.y), pk2(r.lo.z, r.lo.w), pk2(r.hi.x, r.hi.y), pk2(r.hi.z, r.hi.w)}; }
__device__ __forceinline__ float hsum8(const R8& r) { return ((r.lo.x + r.lo.y) + (r.lo.z + r.lo.w)) + ((r.hi.x + r.hi.y) + (r.hi.z + r.hi.w)); }
__device__ __forceinline__ float hsq8(const R8& r) { return ((r.lo.x * r.lo.x + r.lo.y * r.lo.y) + (r.lo.z * r.lo.z + r.lo.w * r.lo.w)) + ((r.hi.x * r.hi.x + r.hi.y * r.hi.y) + (r.hi.z * r.hi.z + r.hi.w * r.hi.w)); }
template <int NR>
__device__ __forceinline__ void ln_rows(R8 (&v)[NR][2], const float* g, const float* b, int lane) {
    float mean[NR], rstd[NR];
#pragma unroll
    for (int q = 0; q < NR; ++q) mean[q] = hsum8(v[q][0]) + hsum8(v[q][1]);
#pragma unroll
    for (int q = 0; q < NR; ++q) mean[q] = rsum<2>(rsum<1>(mean[q]));
#pragma unroll
    for (int q = 0; q < NR; ++q) mean[q] = rsum<8>(rsum<4>(mean[q]));
#pragma unroll
    for (int q = 0; q < NR; ++q) mean[q] = rsum<32>(rsum<16>(mean[q]));
#pragma unroll
    for (int q = 0; q < NR; ++q) { mean[q] *= (1.f / D);
#pragma unroll
        for (int j = 0; j < 2; ++j) { v[q][j].lo = v[q][j].lo - mean[q]; v[q][j].hi = v[q][j].hi - mean[q]; }
        rstd[q] = hsq8(v[q][0]) + hsq8(v[q][1]); }
#pragma unroll
    for (int q = 0; q < NR; ++q) rstd[q] = rsum<2>(rsum<1>(rstd[q]));
#pragma unroll
    for (int q = 0; q < NR; ++q) rstd[q] = rsum<8>(rsum<4>(rstd[q]));
#pragma unroll
    for (int q = 0; q < NR; ++q) rstd[q] = rsum<32>(rsum<16>(rstd[q]));
#pragma unroll
    for (int j = 0; j < 2; ++j) { const f32x4 g0 = *(const f32x4*)(g + 512 * j + 8 * lane), g1 = *(const f32x4*)(g + 512 * j + 8 * lane + 4), b0 = *(const f32x4*)(b + 512 * j + 8 * lane), b1 = *(const f32x4*)(b + 512 * j + 8 * lane + 4);
#pragma unroll
        for (int q = 0; q < NR; ++q) { const float r = __builtin_amdgcn_rsqf(rstd[q] * (1.f / D) + LN_EPS); v[q][j].lo = v[q][j].lo * r * g0 + b0; v[q][j].hi = v[q][j].hi * r * g1 + b1; } }
}
__device__ __forceinline__ void store_row_bf16(bf16_t* row, const R8 (&v)[2], int lane) {
#pragma unroll
    for (int j = 0; j < 2; ++j) *(u32x4*)(row + 512 * j + 8 * lane) = pack8(v[j]);
}
__device__ __forceinline__ void store_row_f32(float* row, const R8 (&v)[2], int lane) {
#pragma unroll
    for (int j = 0; j < 2; ++j) { *(f32x4*)(row + 512 * j + 8 * lane) = v[j].lo; *(f32x4*)(row + 512 * j + 8 * lane + 4) = v[j].hi; }
}

struct MoeWItem { const float* W; bf16_t* dst; int N, mode, rowbase, k0, n0; };
__device__ __forceinline__ MoeWItem moe_w_item(const Args& a, int it) {
    MoeWItem m; const int l = it / IT_MOE; int r = it - l * IT_MOE; unsigned char* wl = a.ws + WS_W + (size_t)l * WL_SIZE; int item;
    if (r < IT_GU) { const int e = r >> 9; m.W = a.in[I_WGU] + ((size_t)l * NE + e) * 1024 * 2048; m.N = 2048; m.dst = (bf16_t*)(wl + WL_GU); m.mode = 4; m.rowbase = e * 2048; item = r & 511; }
    else { r -= IT_GU; const int e = r >> 8; m.W = a.in[I_WDN] + ((size_t)l * NE + e) * 1024 * 1024; m.N = 1024; m.dst = (bf16_t*)(wl + WL_DN); m.mode = 0; m.rowbase = e * 1024; item = r & 255; }
    const int nblk = m.N >> 6, kb = item / nblk, nb = item - kb * nblk; m.k0 = kb * 64; m.n0 = nb * 64; return m;
}
__device__ __forceinline__ void moe_w_load(const MoeWItem& m, int lane, f32x4 (&v)[16]) {
    const float* src = m.W + (size_t)(m.k0 + 2 * (lane >> 4)) * m.N + m.n0 + (lane & 15) * 4;
#pragma unroll
    for (int i = 0; i < 8; ++i) { v[2 * i] = __builtin_nontemporal_load((const f32x4*)(src + (size_t)(8 * i) * m.N)); v[2 * i + 1] = __builtin_nontemporal_load((const f32x4*)(src + (size_t)(8 * i + 1) * m.N)); }
}
__device__ __forceinline__ void moe_w_finish(const MoeWItem& m, int lane, const f32x4 (&v)[16], LAS float* scr) {
    const int l = lane & 15, kq = lane >> 4; LAS unsigned* sw = (LAS unsigned*)scr;
#pragma unroll
    for (int i = 0; i < 8; ++i) { LAS unsigned* w = sw + (4 * l) * 32 + 4 * (i ^ (l & 7)) + kq;
        w[0] = pk2(v[2 * i].x, v[2 * i + 1].x); w[32] = pk2(v[2 * i].y, v[2 * i + 1].y); w[64] = pk2(v[2 * i].z, v[2 * i + 1].z); w[96] = pk2(v[2 * i].w, v[2 * i + 1].w); }
    LDS_WAIT(); asm volatile("" ::: "memory");
    const int c = lane & 7;
#pragma unroll
    for (int j = 0; j < 8; ++j) { const int n = (lane >> 3) + 8 * j; const int row = map_row(m.mode, m.n0 + n);
        const u32x4 o = *(const LAS u32x4*)(sw + n * 32 + 4 * (c ^ ((n >> 2) & 7)));
        *(u32x4*)(m.dst + (size_t)(m.rowbase + row) * 1024 + m.k0 + 8 * c) = o; }
    LDS_WAIT(); asm volatile("" ::: "memory");
}
__device__ __forceinline__ void moe_weight_items(const int tid, const int bid, const Args& a, LAS unsigned char* lds) {
    const int lane = tid & 63, wave = tid >> 6;
    const int gw = bid * NWAVES + wave, NGW = gridDim.x * NWAVES;
    LAS float* scr = (LAS float*)(lds + wave * 16640);
    static_assert((NLAYER * IT_MOE) % (256 * NWAVES * 2) == 0, "every wave converts an even number of tiles");
    f32x4 va[16], vb[16];
    MoeWItem ma = moe_w_item(a, gw), mb; moe_w_load(ma, lane, va);
#pragma unroll 1
    for (int it = gw; it < NLAYER * IT_MOE; it += 2 * NGW) {
        mb = moe_w_item(a, it + NGW); moe_w_load(mb, lane, vb);
        moe_w_finish(ma, lane, va, scr);
        if (it + 2 * NGW < NLAYER * IT_MOE) { ma = moe_w_item(a, it + 2 * NGW); moe_w_load(ma, lane, va); }
        moe_w_finish(mb, lane, vb, scr);
    }
}
__device__ __forceinline__ void phase_pre0(const int tid, const int bid, const Args& a, LAS unsigned char* lds) {
    const int lane = tid & 63, wave = tid >> 6;
    const int gw = bid * NWAVES + wave, NGW = gridDim.x * NWAVES;
    const long gt = (long)bid * NTHREADS + tid, NGT = (long)gridDim.x * NTHREADS;
    unsigned char* ws = a.ws;
    LAS float* scr = (LAS float*)(lds + wave * 16640);
    for (int it = gw; it < NLAYER * IT_SMALL; it += NGW) {
        const int l = it / IT_SMALL; int r = it - l * IT_SMALL;
        unsigned char* wl = ws + WS_W + (size_t)l * WL_SIZE;
        if (r < IT_IN) { tr_item(a.in[I_WIN] + (size_t)l * 1024 * INC, INC, (bf16_t*)(wl + WL_IN), 1024, 0, nullptr, 1.f, 1, 0, scr, r, lane); continue; } r -= IT_IN;
        if (r < IT_UQ) { tr_item(a.in[I_WUQ] + (size_t)l * 256 * 384, 384, (bf16_t*)(wl + WL_MLA), 384, 0, a.in[I_MQG] + l * 256, QSCALE_M, 2, 0, scr, r, lane); continue; } r -= IT_UQ;
        if (r < IT_UKV) { tr_item(a.in[I_WUKV] + (size_t)l * 128 * 512, 512, (bf16_t*)(wl + WL_MLA), 384, 256, a.in[I_MKG] + l * 128, 1.f, 3, 0, scr, r, lane); continue; } r -= IT_UKV;
        if (r < IT_F) { tr_item(a.in[I_WF] + (size_t)l * 65536, 256, (bf16_t*)(wl + WL_FC), 256, 0, nullptr, 1.f, 0, 0, scr, r, lane, 1); continue; } r -= IT_F;
        if (r < IT_F) { tr_item(a.in[I_WPW] + (size_t)l * 65536, 256, (bf16_t*)(wl + WL_FC), 256, 0, nullptr, 1.f, 0, 256, scr, r, lane); continue; } r -= IT_F;
        if (r < IT_SQ) { tr_item(a.in[I_WO] + (size_t)l * D * D, D, (bf16_t*)(wl + WL_O), D, 0, a.in[I_GRPG] + l * 1024, 1.f, 0, 0, scr, r, lane); continue; } r -= IT_SQ;
        if (r < IT_SQ) { cp_item(a.in[I_WXQ] + (size_t)l * D * D, (bf16_t*)(wl + WL_XQ), QSCALE_X, r, lane); continue; } r -= IT_SQ;
        if (r < IT_SQ) { tr_item(a.in[I_WXK] + (size_t)l * D * D, D, (bf16_t*)(wl + WL_XK), D, 0, nullptr, 1.f, 0, 0, scr, r, lane); continue; } r -= IT_SQ;
        if (r < IT_SQ) { tr_item(a.in[I_WXV] + (size_t)l * D * D, D, (bf16_t*)(wl + WL_XV), D, 0, nullptr, 1.f, 0, 0, scr, r, lane); continue; } r -= IT_SQ;
        { tr_item(a.in[I_WXO] + (size_t)l * D * D, D, (bf16_t*)(wl + WL_XO), D, 0, nullptr, 1.f, 0, 0, scr, r, lane); }
    }
    for (long idx = gt; idx < (long)NLAYER * 256 * 1024; idx += NGT) {
        const int l = (int)(idx >> 18), k = (int)(idx >> 8) & 1023, n = (int)idx & 255, g = n >> 6, cc = n & 63, jp = cc >> 1, second = cc & 1;
        const int mult = (jp == 0 && second) ? 32 : jp; const bool use_cos = (second == 0) || (jp == 0);
        const float* w = a.in[I_WIN] + ((size_t)l * 1024 + k) * INC + g * 64; float acc = 0.f;
#pragma unroll 8
        for (int c = 0; c < 64; ++c) { const float fr = (float)((mult * c) & 63) * (1.f / 64.f); const float cv = __builtin_amdgcn_cosf(fr), sv = -__builtin_amdgcn_sinf(fr); acc += w[c] * (use_cos ? cv : sv); }
        ((bf16_t*)(ws + WS_W + (size_t)l * WL_SIZE + WL_IN))[(size_t)n * 1024 + k] = (bf16_t)f2bf(acc);
    }
    for (long idx = gt; idx < (long)NLAYER * 96 * 1024; idx += NGT) { const int l = (int)(idx / (96 * 1024)); const long r = idx % (96 * 1024);
        ((bf16_t*)(ws + WS_W + (size_t)l * WL_SIZE + WL_IN))[(size_t)INC * 1024 + r] = 0; }
    for (long idx = gt; idx < (long)NLAYER * 1024 * 384; idx += NGT) { const int l = (int)(idx / (1024 * 384)); const int r = (int)(idx % (1024 * 384)), row = r / 384, k = r % 384;
        const bool pad = (row < 512) ? (k >= 256 || (row & 127) >= 96) : (k < 256);
        if (pad) ((bf16_t*)(ws + WS_W + (size_t)l * WL_SIZE + WL_MLA))[r] = 0; }
    for (long idx = gt; idx < (long)NLAYER * 32 * 1024; idx += NGT) { const int l = (int)(idx >> 15), e = (int)(idx >> 10) & 31, k = (int)idx & 1023;
        const float w = a.in[I_WR][((size_t)l * 1024 + k) * 32 + e]; const unsigned hb = f2bf(w); const unsigned lb = f2bf(w - bf2f(hb));
        bf16_t* wr = (bf16_t*)(ws + WS_W + (size_t)l * WL_SIZE + WL_RT); wr[e * 1024 + k] = (bf16_t)hb; wr[32768 + e * 1024 + k] = (bf16_t)lb; }
    for (long idx = gt; idx < (long)NB * MEML * D / 4; idx += NGT) { const f32x4 v = *(const f32x4*)(a.in[I_MEM] + idx * 4); u32x2 w; w.x = pk2(v.x, v.y); w.y = pk2(v.z, v.w); *(u32x2*)((bf16_t*)(ws + WS_MEMB) + idx * 4) = w; }
    for (int m0 = gw; m0 < T; m0 += 4 * NGW) { R8 v[4][2];
#pragma unroll
        for (int q = 0; q < 4; ++q) { const float* xr = a.in[I_X] + (size_t)(m0 + q * NGW) * D;
#pragma unroll
            for (int j = 0; j < 2; ++j) { v[q][j].lo = *(const f32x4*)(xr + 512 * j + 8 * lane); v[q][j].hi = *(const f32x4*)(xr + 512 * j + 8 * lane + 4); } }
        ln_rows<4>(v, a.in[I_LNIN_G], a.in[I_LNIN_B], lane);
#pragma unroll
        for (int q = 0; q < 4; ++q) store_row_bf16((bf16_t*)(ws + WS_HB) + (size_t)(m0 + q * NGW) * D, v[q], lane); }
}

struct LayerCtx {
    int l; unsigned char* ws; unsigned char* wl;
    bf16_t *Z, *FC, *QG, *KG, *CQKV, *KR, *QKVM, *Y, *XQ, *PB, *XO, *XS, *ACT, *YS, *HB;
    float *YMIX, *RS; bf16_t* FB;
    int *RE, *RR, *DEST, *TOK; float* GATE; unsigned* cnt;
};
__device__ __forceinline__ LayerCtx make_ctx(const Args& a, int l) {
    LayerCtx c; c.l = l; c.ws = a.ws; c.wl = a.ws + WS_W + (size_t)l * WL_SIZE; unsigned char* r = a.ws + WS_R;
    c.Z = (bf16_t*)(r + R_Z); c.FC = (bf16_t*)(r + R_FC); c.QG = (bf16_t*)(r + R_QG); c.KG = (bf16_t*)(r + R_KG); c.CQKV = (bf16_t*)(r + R_CQKV); c.KR = (bf16_t*)(r + R_KR);
    c.QKVM = (bf16_t*)(r + R_QKVM); c.YMIX = (float*)(r + R_YMIX); c.Y = (bf16_t*)(r + R_Y);
    c.XQ = (bf16_t*)(r + R_XQ); c.RS = (float*)(a.ws + WS_F + 64 * MiB); c.PB = (bf16_t*)(r + R_PB); c.XO = (bf16_t*)(r + R_XO);
    c.XS = (bf16_t*)(r + R_XS); c.ACT = (bf16_t*)(r + R_ACT); c.YS = (bf16_t*)(r + R_XS);
    c.HB = (bf16_t*)(a.ws + WS_HB); c.FB = (bf16_t*)(a.ws + WS_F);
    c.RE = (int*)(a.ws + WS_ROUTE); c.RR = c.RE + T * 4; c.GATE = (float*)(c.RR + T * 4); c.DEST = (int*)(c.GATE + T * 4);
    c.cnt = (unsigned*)(a.ws + WS_CTL) + CW_CNT + MAXWG * 32 * l; c.TOK = (int*)(a.ws + WS_CTL) + CW_TOK;
    return c;
}
constexpr float L2_THETA = 13.287712379549449f;

__device__ __forceinline__ void conv_item(const int tid, const Args& a, const LayerCtx& c, int item, LAS unsigned char* lds) {
    const int lane = tid & 63, wave = tid >> 6;
    LAS float* U = (LAS float*)lds; LAS float* CO = (LAS float*)lds;
    const int t0 = item * 64, b = t0 >> 13, s0 = t0 & (SEQ - 1);
#pragma unroll
    for (int i = 0; i < 6; ++i) { const int idx = tid + NTHREADS * i, row = idx >> 5, c8 = (idx & 31) * 8, sq = s0 - 15 + row;
        if (row < 94) { f32x4 u0 = {0.f, 0.f, 0.f, 0.f}, u1 = {0.f, 0.f, 0.f, 0.f};
            if (sq >= 0 && sq < SEQ) { const bf16_t* z = c.Z + (size_t)(b * SEQ + sq) * ZC; const R8 av = unpack8(*(const u32x4*)(z + ZC_CA + c8)), gv = unpack8(*(const u32x4*)(z + ZC_CG + c8));
#pragma unroll
                for (int e = 0; e < 4; ++e) { u0[e] = av.lo[e] * sigmoidf_(gv.lo[e]); u1[e] = av.hi[e] * sigmoidf_(gv.hi[e]); } }
            *(LAS f32x4*)(U + row * 256 + c8) = u0; *(LAS f32x4*)(U + row * 256 + c8 + 4) = u1; } }
    __syncthreads();
    { const int ch = tid & 255, half = tid >> 8; const float* dw = a.in[I_DWW] + (size_t)c.l * 31 * 256 + ch; const float bias = a.in[I_DWB][c.l * 256 + ch];
      float wv[31], win[62];
#pragma unroll
      for (int w = 0; w < 31; ++w) wv[w] = dw[w * 256];
#pragma unroll
      for (int r = 0; r < 62; ++r) win[r] = U[(half * 32 + r) * 256 + ch];
      __syncthreads();
#pragma unroll
      for (int o = 0; o < 32; ++o) { float acc = bias;
#pragma unroll
          for (int w = 0; w < 31; ++w) acc += win[o + w] * wv[w];
          CO[(half * 32 + o) * 256 + ch] = acc; } }
    __syncthreads();
    { const float* cg = a.in[I_CLG] + c.l * 256; const float* cb = a.in[I_CLB] + c.l * 256;
      const f32x4 gg = *(const f32x4*)(cg + 4 * lane), bb = *(const f32x4*)(cb + 4 * lane);
#pragma unroll
      for (int q0 = 0; q0 < 8; q0 += 4) { f32x4 x[4]; float mean[4], var[4];
#pragma unroll
          for (int q = 0; q < 4; ++q) { x[q] = *(const LAS f32x4*)(CO + (wave * 8 + q0 + q) * 256 + 4 * lane); mean[q] = (x[q].x + x[q].y) + (x[q].z + x[q].w); }
#pragma unroll
          for (int q = 0; q < 4; ++q) mean[q] = wave_sum(mean[q]);
#pragma unroll
          for (int q = 0; q < 4; ++q) { x[q] = x[q] - mean[q] * (1.f / 256.f); var[q] = (x[q].x * x[q].x + x[q].y * x[q].y) + (x[q].z * x[q].z + x[q].w * x[q].w); }
#pragma unroll
          for (int q = 0; q < 4; ++q) var[q] = wave_sum(var[q]);
#pragma unroll
          for (int q = 0; q < 4; ++q) { const float rstd = __builtin_amdgcn_rsqf(var[q] * (1.f / 256.f) + LN_EPS); f32x4 y = x[q] * rstd * gg + bb;
#pragma unroll
              for (int e = 0; e < 4; ++e) y[e] = y[e] * sigmoidf_(y[e]);
              u32x2 w; w.x = pk2(y.x, y.y); w.y = pk2(y.z, y.w); *(u32x2*)(c.FC + (size_t)(t0 + wave * 8 + q0 + q) * 512 + 256 + 4 * lane) = w; } } }
    __syncthreads();
}

struct QkRaw { u32x2 q; unsigned k; u32x2 cq; unsigned ckv; unsigned kr; };
__device__ __forceinline__ QkRaw qkprep_load(const LayerCtx& c, int t, int lane) { const bf16_t* z = c.Z + (size_t)t * ZC; QkRaw r;
    r.q = *(const u32x2*)(z + ZC_Q + 4 * lane); r.k = *(const unsigned*)(z + ZC_K + 2 * lane); r.cq = *(const u32x2*)(z + ZC_CQ + 4 * lane); r.ckv = *(const unsigned*)(z + ZC_CKV + 2 * lane);
    r.kr = (lane < 16) ? *(const unsigned*)(z + ZC_KR + 2 * lane) : 0u; return r; }
__device__ __forceinline__ void qkprep_row(const Args& a, const LayerCtx& c, int t, int lane, const QkRaw& raw) {
    const int s = t & (SEQ - 1); const float prow = (float)(s >> 6), pcol = (float)(s & 63);
    {
        const u32x2 w = raw.q; float x0 = bflo(w.x), x1 = bfhi(w.x), x2 = bflo(w.y), x3 = bfhi(w.y);
        float ss = (x0 * x0 + x1 * x1) + (x2 * x2 + x3 * x3);
        ss = rsum<1>(ss); ss = rsum<2>(ss); ss = rsum<4>(ss); ss = rsum<8>(ss);
        const float rstd = __builtin_amdgcn_rsqf(ss * (1.f / 64.f) + RMS_EPS);
        const int p = 4 * (lane & 15), half = p >> 5, i0 = (p & 31) >> 1; const float* qg = a.in[I_QG] + c.l * 64 + half * 32;
        x0 *= rstd * qg[i0]; x1 *= rstd * qg[16 + i0]; x2 *= rstd * qg[i0 + 1]; x3 *= rstd * qg[16 + i0 + 1];
        const float pos = half ? pcol : prow;
        rope2(x0, x1, pos * __builtin_amdgcn_exp2f(-(float)i0 * (L2_THETA / 16.f))); rope2(x2, x3, pos * __builtin_amdgcn_exp2f(-(float)(i0 + 1) * (L2_THETA / 16.f)));
        u32x2 o; o.x = pk2(x0 * QSCALE_G, x1 * QSCALE_G); o.y = pk2(x2 * QSCALE_G, x3 * QSCALE_G); *(u32x2*)(c.QG + (size_t)t * 256 + 4 * lane) = o;
    }
    {
        const unsigned w = raw.k; float x0 = bflo(w), x1 = bfhi(w);
        float ss = x0 * x0 + x1 * x1;
        ss = rsum<1>(ss); ss = rsum<2>(ss); ss = rsum<4>(ss); ss = rsum<8>(ss); ss = rsum<16>(ss);
        const float rstd = __builtin_amdgcn_rsqf(ss * (1.f / 64.f) + RMS_EPS);
        const int p = (2 * lane) & 63, half = p >> 5, i0 = (p & 31) >> 1; const float* kg = a.in[I_KG] + c.l * 64 + half * 32;
        x0 *= rstd * kg[i0]; x1 *= rstd * kg[16 + i0];
        rope2(x0, x1, (half ? pcol : prow) * __builtin_amdgcn_exp2f(-(float)i0 * (L2_THETA / 16.f)));
        *(unsigned*)(c.KG + (size_t)t * 128 + 2 * lane) = pk2(x0, x1);
    }
    {
        const u32x2 w = raw.cq; const float x0 = bflo(w.x), x1 = bfhi(w.x), x2 = bflo(w.y), x3 = bfhi(w.y);
        const float rstd = __builtin_amdgcn_rsqf(wave_sum((x0 * x0 + x1 * x1) + (x2 * x2 + x3 * x3)) * (1.f / 256.f) + RMS_EPS);
        u32x2 o; o.x = pk2(x0 * rstd, x1 * rstd); o.y = pk2(x2 * rstd, x3 * rstd); *(u32x2*)(c.CQKV + (size_t)t * 384 + 4 * lane) = o;
    }
    {
        const unsigned w = raw.ckv; const float x0 = bflo(w), x1 = bfhi(w);
        const float rstd = __builtin_amdgcn_rsqf(wave_sum(x0 * x0 + x1 * x1) * (1.f / 128.f) + RMS_EPS);
        *(unsigned*)(c.CQKV + (size_t)t * 384 + 256 + 2 * lane) = pk2(x0 * rstd, x1 * rstd);
    }
    if (lane < 16) {
        const unsigned w = raw.kr; float x0 = bflo(w), x1 = bfhi(w);
        const int half = lane >> 3, i0 = lane & 7;
        rope2(x0, x1, (half ? pcol : prow) * __builtin_amdgcn_exp2f(-(float)i0 * (L2_THETA / 8.f)));
        *(unsigned*)(c.KR + (size_t)t * 32 + 2 * lane) = pk2(x0, x1);
    }
}

__device__ __forceinline__ void dft_table(const int tid, LAS unsigned char* lds) {
    LAS f32x2* tw = (LAS f32x2*)lds;
    for (int m = tid; m < SEQ; m += NTHREADS) { const float x = (float)m * (1.f / 4096.f); tw[m] = (f32x2){cospif(x), sinpif(x)}; }
    __syncthreads();
}
__device__ __forceinline__ void dft_naive_unit(const int tid, const LayerCtx& c, int unit, LAS unsigned char* lds) {
    const LAS f32x2* tw = (const LAS f32x2*)lds;
    const int kk = tid >> 7, pair = tid & 127, g = pair >> 5, jp = pair & 31;
    const int b = unit >> 11, k = ((unit & 2047) << 2) + kk;
    const bf16_t* zp = c.Z + (size_t)b * SEQ * ZC + g * 64 + 2 * jp;
    float acc0 = 0.f, acc1 = 0.f; int idx = 0;
    for (int s = 0; s < SEQ; ++s) { const unsigned w = *(const unsigned*)(zp + (size_t)s * ZC); const f32x2 cs = tw[idx]; idx = (idx + k) & (SEQ - 1);
        acc0 += bflo(w) * cs.x; acc1 += bfhi(w) * (jp == 0 ? cs.x : cs.y); }
    bf16_t* o = c.FC + (size_t)(b * SEQ + k) * 512 + g * 64;
    if (jp == 0) { o[0] = (bf16_t)f2bf(acc0); o[32] = (bf16_t)f2bf(acc1); }
    else { o[jp] = (bf16_t)f2bf(acc0 + acc1); o[64 - jp] = (bf16_t)f2bf(acc0 - acc1); }
}

namespace fft {
constexpr int L_XI = 16384, L_FI = 32768, L_CS = 65536;
__device__ __forceinline__ float cosrev(float x) { return __builtin_amdgcn_cosf(x); }
__device__ __forceinline__ float sinrev(float x) { return __builtin_amdgcn_sinf(x); }
__device__ __forceinline__ void build_table(const int tid, LAS unsigned char* lds) {
#pragma unroll 1
    for (int e = tid; e < 4096; e += NTHREADS) { const int lane = e & 63, cs = (e >> 6) & 1, ks = (e >> 7) & 7, nb = e >> 10; const int k1 = 32 * nb + (lane & 31), h = lane >> 5;
        unsigned w[4];
#pragma unroll
        for (int j = 0; j < 4; ++j) { const int m0 = ((16 * ks + 8 * h + 2 * j) * k1) & 127, m1 = ((16 * ks + 8 * h + 2 * j + 1) * k1) & 127; const float f0 = (float)m0 * (1.f / 128.f), f1 = (float)m1 * (1.f / 128.f);
            w[j] = cs ? pk2(sinrev(f0), sinrev(f1)) : pk2(cosrev(f0), cosrev(f1)); }
        *(LAS u32x4*)(lds + L_CS + e * 16) = (u32x4){w[0], w[1], w[2], w[3]}; }
}
struct F64Frags { bf16x8 c[2][2], s[2][2]; };
__device__ __forceinline__ void build_f64(const int tid, F64Frags& F) {
    const int wid = tid >> 6, lane = tid & 63, r32 = lane & 31, hi = lane >> 5, k2 = 32 * (wid >> 2) + r32;
#pragma unroll
    for (int mb = 0; mb < 2; ++mb)
#pragma unroll
        for (int st = 0; st < 2; ++st) { unsigned wc[4], wsn[4];
#pragma unroll
            for (int jj = 0; jj < 4; ++jj) { const int j0 = 2 * jj, j1 = 2 * jj + 1;
                const int sa = 32 * mb + 16 * st + 8 * (j0 >> 2) + 4 * hi + (j0 & 3), sb = 32 * mb + 16 * st + 8 * (j1 >> 2) + 4 * hi + (j1 & 3);
                const float fa = (float)((sa * k2) & 63) * (1.f / 64.f), fb = (float)((sb * k2) & 63) * (1.f / 64.f);
                wc[jj] = pk2(cosrev(fa), cosrev(fb)); wsn[jj] = pk2(sinrev(fa), sinrev(fb)); }
            F.c[mb][st] = __builtin_bit_cast(bf16x8, (u32x4){wc[0], wc[1], wc[2], wc[3]}); F.s[mb][st] = __builtin_bit_cast(bf16x8, (u32x4){wsn[0], wsn[1], wsn[2], wsn[3]}); }
}
__device__ __forceinline__ bf16x8 negbf(bf16x8 x) { u32x4 w = __builtin_bit_cast(u32x4, x); w ^= 0x80008000u; return __builtin_bit_cast(bf16x8, w); }
__device__ __forceinline__ void unit(const int tid, const LayerCtx& c, const int u, LAS unsigned char* lds, const F64Frags& F) {
    const int wid = tid >> 6, lane = tid & 63, r32 = lane & 31, hi = lane >> 5, nb = wid & 3, kb = wid >> 2;
    const int b = u >> 7, g = (u >> 5) & 3, jp = u & 31;
    const bf16_t* zp = c.Z + (size_t)b * SEQ * ZC + g * 64 + 2 * jp;
#pragma unroll 4
    for (int i = 0; i < 16; ++i) { const int sx = tid + NTHREADS * i, s2 = sx & 63, s1 = sx >> 6; const unsigned w = *(const unsigned*)(zp + (size_t)sx * ZC);
        const int off = s2 * 256 + ((((s1 >> 3) ^ (s2 & 15))) << 4) + (s1 & 7) * 2;
        *(LAS unsigned short*)(lds + off) = (unsigned short)(w & 0xffffu); *(LAS unsigned short*)(lds + L_XI + off) = (unsigned short)(w >> 16); }
    __syncthreads();
    f32x16 GR[2], GI[2];
#pragma unroll
    for (int mb = 0; mb < 2; ++mb) { GR[mb] = f32x16{}; GI[mb] = f32x16{}; }
#pragma unroll
    for (int ks = 0; ks < 8; ++ks) {
        const bf16x8 cf = *(const LAS bf16x8*)(lds + L_CS + ((nb * 8 + ks) * 2 + 0) * 1024 + lane * 16), sf = *(const LAS bf16x8*)(lds + L_CS + ((nb * 8 + ks) * 2 + 1) * 1024 + lane * 16);
#pragma unroll
        for (int mb = 0; mb < 2; ++mb) { const int row = 32 * mb + r32, off = row * 256 + (((2 * ks + hi) ^ (row & 15)) << 4);
            const bf16x8 xr = *(const LAS bf16x8*)(lds + off), xi = *(const LAS bf16x8*)(lds + L_XI + off); const bf16x8 nxr = negbf(xr);
            GR[mb] = __builtin_amdgcn_mfma_f32_32x32x16_bf16(xr, cf, GR[mb], 0, 0, 0); GR[mb] = __builtin_amdgcn_mfma_f32_32x32x16_bf16(xi, sf, GR[mb], 0, 0, 0);
            GI[mb] = __builtin_amdgcn_mfma_f32_32x32x16_bf16(xi, cf, GI[mb], 0, 0, 0); GI[mb] = __builtin_amdgcn_mfma_f32_32x32x16_bf16(nxr, sf, GI[mb], 0, 0, 0); }
    }
    const int k1 = 32 * nb + r32;
    bf16x8 ar[2][2], ai[2][2];
#pragma unroll
    for (int mb = 0; mb < 2; ++mb) {
#pragma unroll
        for (int r = 0; r < 16; ++r) { const int s2v = 32 * mb + (r & 3) + 8 * (r >> 2) + 4 * hi; const float fr = (float)((s2v * k1) & (SEQ - 1)) * (1.f / 8192.f);
            const float tc = cosrev(fr), ts = sinrev(fr), gr = GR[mb][r], gi = GI[mb][r]; GR[mb][r] = gr * tc + gi * ts; GI[mb][r] = gi * tc - gr * ts; }
#pragma unroll
        for (int st = 0; st < 2; ++st) {
            const u32x4 wr = {pk2(GR[mb][8 * st], GR[mb][8 * st + 1]), pk2(GR[mb][8 * st + 2], GR[mb][8 * st + 3]), pk2(GR[mb][8 * st + 4], GR[mb][8 * st + 5]), pk2(GR[mb][8 * st + 6], GR[mb][8 * st + 7])};
            const u32x4 wi = {pk2(GI[mb][8 * st], GI[mb][8 * st + 1]), pk2(GI[mb][8 * st + 2], GI[mb][8 * st + 3]), pk2(GI[mb][8 * st + 4], GI[mb][8 * st + 5]), pk2(GI[mb][8 * st + 6], GI[mb][8 * st + 7])};
            ar[mb][st] = __builtin_bit_cast(bf16x8, wr); ai[mb][st] = __builtin_bit_cast(bf16x8, wi); }
    }
    __syncthreads();
    f32x16 ZR = f32x16{}, ZI = f32x16{};
#pragma unroll
    for (int mb = 0; mb < 2; ++mb)
#pragma unroll
        for (int st = 0; st < 2; ++st) { const bf16x8 nar = negbf(ar[mb][st]);
            ZR = __builtin_amdgcn_mfma_f32_32x32x16_bf16(ar[mb][st], F.c[mb][st], ZR, 0, 0, 0); ZR = __builtin_amdgcn_mfma_f32_32x32x16_bf16(ai[mb][st], F.s[mb][st], ZR, 0, 0, 0);
            ZI = __builtin_amdgcn_mfma_f32_32x32x16_bf16(ai[mb][st], F.c[mb][st], ZI, 0, 0, 0); ZI = __builtin_amdgcn_mfma_f32_32x32x16_bf16(nar, F.s[mb][st], ZI, 0, 0, 0); }
    { const int k2 = 32 * kb + r32;
#pragma unroll
      for (int q = 0; q < 4; ++q) { const int kk = k2 * 128 + 32 * nb + 8 * q + 4 * hi;
          *(LAS f32x4*)(lds + kk * 4) = (f32x4){ZR[4 * q], ZR[4 * q + 1], ZR[4 * q + 2], ZR[4 * q + 3]}; *(LAS f32x4*)(lds + L_FI + kk * 4) = (f32x4){ZI[4 * q], ZI[4 * q + 1], ZI[4 * q + 2], ZI[4 * q + 3]}; } }
    __syncthreads();
    bf16_t* op = c.FC + (size_t)b * SEQ * 512 + g * 64 + 2 * jp;
#pragma unroll 4
    for (int i = 0; i < 16; ++i) { const int k = tid + NTHREADS * i, kr = (SEQ - k) & (SEQ - 1);
        const float a0 = *(const LAS float*)(lds + k * 4), a1 = *(const LAS float*)(lds + kr * 4); float y0 = a0, y1 = a1;
        if (jp == 0) { const float b0 = *(const LAS float*)(lds + L_FI + k * 4), b1 = *(const LAS float*)(lds + L_FI + kr * 4); y0 = 0.5f * (a0 + a1); y1 = 0.5f * (b0 + b1); }
        *(unsigned*)(op + (size_t)k * 512) = pk2(y0, y1); }
    __syncthreads();
}
}

struct AttnSrc { const bf16_t* Q; int qp; const bf16_t* K; int kp; const bf16_t* K2; int k2p; const bf16_t* V; int vp; float* O; int op; };
template <int DK>
__device__ __forceinline__ void attn_naive_unit(const int tid, const AttnSrc& A, int q0) {
    const int row = q0 + tid;
    unsigned q[DK / 2]; float o[64];
#pragma unroll
    for (int i = 0; i < DK / 8; ++i) { const u32x4 w = *(const u32x4*)(A.Q + (size_t)row * A.qp + 8 * i); q[4 * i] = w.x; q[4 * i + 1] = w.y; q[4 * i + 2] = w.z; q[4 * i + 3] = w.w; }
    if constexpr (DK > 64) {
        const int sq = row & (SEQ - 1); const float prow = (float)(sq >> 6), pcol = (float)(sq & 63);
#pragma unroll
        for (int pr = 0; pr < 16; ++pr) { float x0 = bflo(q[32 + pr]), x1 = bfhi(q[32 + pr]);
            rope2(x0, x1, (pr < 8 ? prow : pcol) * __builtin_amdgcn_exp2f(-(float)(pr & 7) * (13.287712379549449f / 8.f))); q[32 + pr] = pk2(x0, x1); }
    }
#pragma unroll
    for (int d = 0; d < 64; ++d) o[d] = 0.f;
    float m = -1e30f, l = 0.f;
#pragma unroll 1
    for (int key = 0; key < SEQ; ++key) {
        float sc = 0.f;
#pragma unroll
        for (int i = 0; i < DK / 2; ++i) asm volatile("" : "+v"(q[i]));
#pragma unroll
        for (int i = 0; i < 8; ++i) { const u32x4 w = *(const u32x4*)(A.K + (size_t)key * A.kp + 8 * i);
            sc += bflo(q[4 * i]) * bflo(w.x) + bfhi(q[4 * i]) * bfhi(w.x) + bflo(q[4 * i + 1]) * bflo(w.y) + bfhi(q[4 * i + 1]) * bfhi(w.y)
                + bflo(q[4 * i + 2]) * bflo(w.z) + bfhi(q[4 * i + 2]) * bfhi(w.z) + bflo(q[4 * i + 3]) * bflo(w.w) + bfhi(q[4 * i + 3]) * bfhi(w.w); }
        if constexpr (DK > 64) {
#pragma unroll
            for (int i = 8; i < DK / 8; ++i) { const u32x4 w = *(const u32x4*)(A.K2 + (size_t)key * A.k2p + 8 * (i - 8));
                sc += bflo(q[4 * i]) * bflo(w.x) + bfhi(q[4 * i]) * bfhi(w.x) + bflo(q[4 * i + 1]) * bflo(w.y) + bfhi(q[4 * i + 1]) * bfhi(w.y)
                    + bflo(q[4 * i + 2]) * bflo(w.z) + bfhi(q[4 * i + 2]) * bfhi(w.z) + bflo(q[4 * i + 3]) * bflo(w.w) + bfhi(q[4 * i + 3]) * bfhi(w.w); }
        }
        if (sc > m) { const float f = __builtin_amdgcn_exp2f(m - sc); l *= f;
#pragma unroll
            for (int d = 0; d < 64; ++d) o[d] *= f;
            m = sc; }
        const float p = __builtin_amdgcn_exp2f(sc - m); l += p;
#pragma unroll
        for (int i = 0; i < 8; ++i) { const u32x4 w = *(const u32x4*)(A.V + (size_t)key * A.vp + 8 * i);
            o[8 * i] += p * bflo(w.x); o[8 * i + 1] += p * bfhi(w.x); o[8 * i + 2] += p * bflo(w.y); o[8 * i + 3] += p * bfhi(w.y); o[8 * i + 4] += p * bflo(w.z); o[8 * i + 5] += p * bfhi(w.z); o[8 * i + 6] += p * bflo(w.w); o[8 * i + 7] += p * bfhi(w.w); }
    }
    const float rl = 1.f / l; float* op = A.O + (size_t)row * A.op;
#pragma unroll
    for (int i = 0; i < 16; ++i) *(f32x4*)(op + 4 * i) = (f32x4){o[4 * i] * rl, o[4 * i + 1] * rl, o[4 * i + 2] * rl, o[4 * i + 3] * rl};
}
__device__ __forceinline__ AttnSrc gqa_src(unsigned char* ws, int b, int h) {
    AttnSrc A; const size_t r0 = (size_t)b * SEQ; unsigned char* r = ws + WS_R;
    A.Q = (const bf16_t*)(r + R_QG) + r0 * 256 + h * 64; A.qp = 256; A.K = (const bf16_t*)(r + R_KG) + r0 * 128 + (h >> 1) * 64; A.kp = 128; A.K2 = nullptr; A.k2p = 0;
    A.V = (const bf16_t*)(r + R_Z) + r0 * ZC + ZC_V + (h >> 1) * 64; A.vp = ZC; A.O = (float*)(r + R_YMIX) + r0 * 1024 + 512 + h * 64; A.op = 1024; return A;
}
__device__ __forceinline__ AttnSrc mla_src(unsigned char* ws, int b, int h) {
    AttnSrc A; const size_t r0 = (size_t)b * SEQ; unsigned char* r = ws + WS_R; const bf16_t* qkvm = (const bf16_t*)(r + R_QKVM);
    A.Q = qkvm + r0 * 1024 + h * 128; A.qp = 1024; A.K = qkvm + r0 * 1024 + 512 + h * 128; A.kp = 1024; A.K2 = (const bf16_t*)(r + R_KR) + r0 * 32; A.k2p = 32;
    A.V = qkvm + r0 * 1024 + 512 + h * 128 + 64; A.vp = 1024; A.O = (float*)(r + R_YMIX) + r0 * 1024 + 768 + h * 64; A.op = 1024; return A;
}

namespace att {
using s16x4 = __attribute__((ext_vector_type(4))) short;
constexpr float ATT_THR = 8.f;
#define ATT_SBAR() __builtin_amdgcn_sched_barrier(0)
__device__ __forceinline__ int crow(int r, int hi) { return (r & 3) + 8 * (r >> 2) + 4 * hi; }
__device__ __forceinline__ unsigned cvtpk(float lo, float hi) { unsigned r; asm volatile("v_cvt_pk_bf16_f32 %0, %1, %2" : "=v"(r) : "v"(lo), "v"(hi)); return r; }
template <int KROW> __device__ __forceinline__ int kswz(int row, int colB) { return (KROW == 128) ? row * 128 + (colB ^ (((row >> 1) & 7) << 4)) : row * 256 + (colB ^ ((row & 15) << 4)); }
__device__ __forceinline__ void partialSM(f32x16& p0, f32x16& p1, float& m_reg, f32x16& negm, float& alpha, const bool first) {
    float pa = fmaxf(fmaxf(p0[0], p0[1]), p0[2]), pb = fmaxf(fmaxf(p1[0], p1[1]), p1[2]);
#pragma unroll
    for (int r = 3; r < 15; r += 2) { pa = fmaxf(fmaxf(pa, p0[r]), p0[r + 1]); pb = fmaxf(fmaxf(pb, p1[r]), p1[r + 1]); }
    float pmax = fmaxf(fmaxf(pa, pb), fmaxf(p0[15], p1[15]));
    { auto rr = __builtin_amdgcn_permlane32_swap(__float_as_uint(pmax), __float_as_uint(pmax), false, false); pmax = fmaxf(__uint_as_float(rr[0]), __uint_as_float(rr[1])); }
    alpha = 1.f;
    if (first || !__all(pmax <= ATT_THR)) {
        const float delta = first ? pmax : fmaxf(pmax, 0.f);
        m_reg += delta; alpha = first ? 1.f : __builtin_amdgcn_exp2f(-delta);
#pragma unroll
        for (int r = 0; r < 16; ++r) { p0[r] -= delta; p1[r] -= delta; negm[r] = -m_reg; }
    }
#pragma unroll
    for (int r = 0; r < 16; ++r) p0[r] = __builtin_amdgcn_exp2f(p0[r]);
}
__device__ __forceinline__ void finishSM(f32x16& p0, f32x16& p1, bf16x8& pa0, bf16x8& pa1, bf16x8& pa2, bf16x8& pa3) {
#pragma unroll
    for (int r = 0; r < 16; ++r) p1[r] = __builtin_amdgcn_exp2f(p1[r]);
#define ATT_PK4(P, BASE, OUT) do { unsigned a0 = cvtpk(P[BASE + 0], P[BASE + 1]), a1 = cvtpk(P[BASE + 2], P[BASE + 3]);   \
    unsigned b0 = cvtpk(P[BASE + 4], P[BASE + 5]), b1 = cvtpk(P[BASE + 6], P[BASE + 7]);                              \
    auto r0 = __builtin_amdgcn_permlane32_swap(a0, b0, false, false); auto r1 = __builtin_amdgcn_permlane32_swap(a1, b1, false, false); \
    u32x4 w = {r0[0], r1[0], r0[1], r1[1]}; OUT = __builtin_bit_cast(bf16x8, w); } while (0)
    ATT_PK4(p0, 0, pa0); ATT_PK4(p0, 8, pa1); ATT_PK4(p1, 0, pa2); ATT_PK4(p1, 8, pa3);
#undef ATT_PK4
}
template <int DK, int KROW>
__device__ __forceinline__ void qkt(f32x16& p0, f32x16& p1, const LAS unsigned char* Ks, const bf16x8* qr, const f32x16& negm, int r32, int hi) {
#pragma unroll
    for (int d0 = 0; d0 < DK / 16; ++d0) { const int cb = (d0 * 16 + hi * 8) * 2;
        const bf16x8 b0 = *(const LAS bf16x8*)(Ks + kswz<KROW>(r32, cb));
        const bf16x8 b1 = *(const LAS bf16x8*)(Ks + kswz<KROW>(32 + r32, cb));
        if (d0 == 0) { p0 = __builtin_amdgcn_mfma_f32_32x32x16_bf16(b0, qr[0], negm, 0, 0, 0); p1 = __builtin_amdgcn_mfma_f32_32x32x16_bf16(b1, qr[0], negm, 0, 0, 0); }
        else { p0 = __builtin_amdgcn_mfma_f32_32x32x16_bf16(b0, qr[d0], p0, 0, 0, 0); p1 = __builtin_amdgcn_mfma_f32_32x32x16_bf16(b1, qr[d0], p1, 0, 0, 0); } }
}
__device__ __forceinline__ int v_st(int k, int c) { const int kk = (k & ~0xC) | ((k & 4) << 1) | ((k & 8) >> 1); return ((kk >> 3) * 2 + (c >> 5)) * 512 + ((kk & 7) * 32 + (c & 31)) * 2; }
__device__ __forceinline__ int v_rd_base(int lane) { return ((lane & 3) << 3) | (((lane >> 2) & 3) << 6) | (((lane >> 4) & 1) << 5) | (((lane >> 5) & 1) << 8); }
constexpr int v_rd_off(int d0, int ks, int half) { return d0 * 512 + ks * 2048 + half * 1024; }
template <int OFF> __device__ __forceinline__ s16x4 tr_read(int vb) { s16x4 r; asm volatile("ds_read_b64_tr_b16 %0, %1 offset:%2" : "=&v"(r) : "v"(vb), "i"(OFF) : "memory"); return r; }
template <int KS> __device__ __forceinline__ void pv_half(f32x16* o, int vb, bf16x8 paA, bf16x8 paB) {
    const s16x4 a0 = tr_read<v_rd_off(0, KS, 0)>(vb), b0 = tr_read<v_rd_off(0, KS, 1)>(vb), c0 = tr_read<v_rd_off(1, KS, 0)>(vb), d0 = tr_read<v_rd_off(1, KS, 1)>(vb);
    const s16x4 a1 = tr_read<v_rd_off(0, KS + 1, 0)>(vb), b1 = tr_read<v_rd_off(0, KS + 1, 1)>(vb), c1 = tr_read<v_rd_off(1, KS + 1, 0)>(vb), d1 = tr_read<v_rd_off(1, KS + 1, 1)>(vb);
    const bf16x8 ones = {0x3F80, 0x3F80, 0x3F80, 0x3F80, 0x3F80, 0x3F80, 0x3F80, 0x3F80};
    asm volatile("s_waitcnt lgkmcnt(0)" ::: "memory"); ATT_SBAR();
#define ATT_PK(L, H) (bf16x8){L[0], L[1], L[2], L[3], H[0], H[1], H[2], H[3]}
    o[0] = __builtin_amdgcn_mfma_f32_32x32x16_bf16(paA, ATT_PK(a0, b0), o[0], 0, 0, 0); o[1] = __builtin_amdgcn_mfma_f32_32x32x16_bf16(paA, ATT_PK(c0, d0), o[1], 0, 0, 0); o[2] = __builtin_amdgcn_mfma_f32_32x32x16_bf16(paA, ones, o[2], 0, 0, 0);
    o[0] = __builtin_amdgcn_mfma_f32_32x32x16_bf16(paB, ATT_PK(a1, b1), o[0], 0, 0, 0); o[1] = __builtin_amdgcn_mfma_f32_32x32x16_bf16(paB, ATT_PK(c1, d1), o[1], 0, 0, 0); o[2] = __builtin_amdgcn_mfma_f32_32x32x16_bf16(paB, ones, o[2], 0, 0, 0);
#undef ATT_PK
}
__device__ __forceinline__ void pv_d0(f32x16* o, int vb, bf16x8 pa0, bf16x8 pa1, bf16x8 pa2, bf16x8 pa3) { pv_half<0>(o, vb, pa0, pa1); pv_half<2>(o, vb, pa2, pa3); }

#define ATT_WAITBAR(N) asm volatile("s_waitcnt vmcnt(" #N ") lgkmcnt(0)\n\ts_barrier" ::: "memory")
template <int DK>
__device__ __forceinline__ void unit(const int tid, const AttnSrc& A, const int q0, LAS unsigned char* lds) {
    constexpr int QP = (DK == 64) ? 256 : 1024, KP = (DK == 64) ? 128 : 1024, K2P = 32, VP = (DK == 64) ? ZC : 1024, OP = 1024;
    constexpr int KROW = (DK == 64) ? 128 : 256, SHM_K = 64 * KROW, SHM_V = 64 * 64 * 2, ND = DK / 16, NT = SEQ / 64, NKI = SHM_K / 8192;
    const int wid = __builtin_amdgcn_readfirstlane(tid >> 6), lane = tid & 63, r32 = lane & 31, hi = lane >> 5;
    LAS unsigned char* V_lds = lds; LAS unsigned char* K_lds = lds + 3 * SHM_V;
    LAS float* al_l = (LAS float*)(lds + 3 * SHM_V + 3 * SHM_K) + wid * 32;
    float m_reg = 0.f; f32x16 o[3] = {}; f32x16 negm = f32x16{}; bf16x8 qr[ND];
    const int qrow = q0 + wid * 32 + r32;
    const bf16_t* Qw = A.Q + (size_t)qrow * QP + hi * 8;
#pragma unroll
    for (int d0 = 0; d0 < ND; ++d0) qr[d0] = *(const bf16x8*)(Qw + d0 * 16);
    if constexpr (DK > 64) {
        const int sq = qrow & (SEQ - 1); const float prow = (float)(sq >> 6), pcol = (float)(sq & 63);
#pragma unroll
        for (int d0 = 4; d0 < 6; ++d0) { u32x4 w = __builtin_bit_cast(u32x4, qr[d0]); const float pos = (d0 == 4) ? prow : pcol;
#pragma unroll
            for (int j = 0; j < 4; ++j) { float x0 = bflo(w[j]), x1 = bfhi(w[j]); rope2(x0, x1, pos * __builtin_amdgcn_exp2f(-(float)(4 * hi + j) * (13.287712379549449f / 8.f))); w[j] = pk2i(x0, x1); }
            qr[d0] = __builtin_bit_cast(bf16x8, w); }
    }
    const bf16_t* Vsrc; const bf16_t* Ksrc[NKI]; int kstepE[NKI];
    { const int kk = 8 * wid + ((lane & 31) >> 2), kv = (kk & ~0xC) | ((kk & 4) << 1) | ((kk & 8) >> 1); Vsrc = A.V + (size_t)kv * VP + 32 * (lane >> 5) + 8 * (lane & 3); }
#pragma unroll
    for (int i = 0; i < NKI; ++i) {
        if constexpr (DK == 64) { const int row = 8 * wid + (lane >> 3), chunk = (lane & 7) ^ ((row >> 1) & 7); Ksrc[i] = A.K + (size_t)row * KP + chunk * 8; kstepE[i] = KP; }
        else { const int row = 4 * (i * 8 + wid) + (lane >> 4), chunk = (lane & 15) ^ (row & 15);
            if (chunk >= 8 && chunk < 12) { Ksrc[i] = A.K2 + (size_t)row * K2P + (chunk - 8) * 8; kstepE[i] = K2P; }
            else { Ksrc[i] = A.K + (size_t)row * KP + (chunk < 8 ? chunk : 0) * 8; kstepE[i] = KP; } }
    }
    const unsigned ldsw = (unsigned)wid * 1024u;
#define ATT_DMA_V(t, slot) __builtin_amdgcn_global_load_lds((const unsigned*)(Vsrc + (size_t)(t) * 64 * VP), (LAS unsigned*)(V_lds + (slot) * SHM_V + ldsw), 16, 0, 0)
#define ATT_DMA_K(t, slot) do { _Pragma("unroll") for (int i_ = 0; i_ < NKI; ++i_) \
        __builtin_amdgcn_global_load_lds((const unsigned*)(Ksrc[i_] + (size_t)(t) * 64 * kstepE[i_]), (LAS unsigned*)(K_lds + (slot) * SHM_K + i_ * 8192 + ldsw), 16, 0, 0); } while (0)
    const int vb0 = (int)(uintptr_t)V_lds + v_rd_base(lane);
#define ATT_RESC(a) do { if (__any((a) < 1.f)) { if (hi == 0) al_l[r32] = (a); asm volatile("s_waitcnt lgkmcnt(0)" ::: "memory"); \
    _Pragma("unroll") for (int d = 0; d < 3; ++d) _Pragma("unroll") for (int r = 0; r < 16; ++r) o[d][r] *= al_l[crow(r, hi)]; } } while (0)
    f32x16 pA0, pA1, pB0, pB1; float alA, alB; bf16x8 pa0, pa1, pa2, pa3;
    ATT_DMA_K(0, 0); ATT_DMA_V(0, 0); ATT_DMA_K(1, 1);
    ATT_WAITBAR(0);
    ATT_DMA_K(2, 2); ATT_DMA_V(1, 1);
    qkt<DK, KROW>(pA0, pA1, K_lds, qr, negm, r32, hi); partialSM(pA0, pA1, m_reg, negm, alA, true);
    if constexpr (NKI == 1) ATT_WAITBAR(2); else ATT_WAITBAR(3);
#define ATT_STEP(PC0, PC1, PP0, PP1, ALC, j, SK, SV) do { \
        const bool hk_ = (j) + 2 < NT, hv_ = (j) + 1 < NT; \
        if (hk_) ATT_DMA_K((j) + 2, ((SK) + 2) % 3); if (hv_) ATT_DMA_V((j) + 1, ((SV) + 2) % 3); \
        ATT_SBAR(); qkt<DK, KROW>(PC0, PC1, K_lds + (SK) * SHM_K, qr, negm, r32, hi); \
        finishSM(PP0, PP1, pa0, pa1, pa2, pa3); ATT_SBAR(); \
        pv_d0(o, vb0 + (SV) * SHM_V, pa0, pa1, pa2, pa3); partialSM(PC0, PC1, m_reg, negm, ALC, false); \
        if (hk_) { if constexpr (NKI == 1) ATT_WAITBAR(2); else ATT_WAITBAR(3); } else if (hv_) ATT_WAITBAR(1); else ATT_WAITBAR(0); \
        ATT_RESC(ALC); } while (0)
    static_assert((NT - 2) % 6 == 0, "steps 1 .. NT-2 are a whole number of 6-step periods");
#pragma unroll 1
    for (int j = 1; j + 1 < NT; j += 6) {
        ATT_STEP(pB0, pB1, pA0, pA1, alB, j,     1, 0);
        ATT_STEP(pA0, pA1, pB0, pB1, alA, j + 1, 2, 1);
        ATT_STEP(pB0, pB1, pA0, pA1, alB, j + 2, 0, 2);
        ATT_STEP(pA0, pA1, pB0, pB1, alA, j + 3, 1, 0);
        ATT_STEP(pB0, pB1, pA0, pA1, alB, j + 4, 2, 1);
        ATT_STEP(pA0, pA1, pB0, pB1, alA, j + 5, 0, 2);
    }
    ATT_STEP(pB0, pB1, pA0, pA1, alB, NT - 1, (NT - 1) % 3, (NT - 2) % 3);
    finishSM(pB0, pB1, pa0, pa1, pa2, pa3); ATT_SBAR();
    pv_d0(o, vb0 + ((NT - 1) % 3) * SHM_V, pa0, pa1, pa2, pa3);
    float rli[16];
#pragma unroll
    for (int r = 0; r < 16; ++r) rli[r] = __builtin_amdgcn_rcpf(o[2][r]);
    float* Ow = A.O + (size_t)(q0 + wid * 32) * OP;
#pragma unroll
    for (int r = 0; r < 16; ++r) { const int orow = crow(r, hi);
#pragma unroll
        for (int d0 = 0; d0 < 2; ++d0) Ow[(size_t)orow * OP + d0 * 32 + r32] = o[d0][r] * rli[r]; }
    ATT_WAITBAR(0);
#undef ATT_DMA_V
#undef ATT_DMA_K
#undef ATT_RESC
#undef ATT_STEP
}
#undef ATT_WAITBAR
#undef ATT_SBAR
}

__device__ __forceinline__ void grpnorm_rows4(const LayerCtx& c, int t0, int tstride, int lane) {
    R8 v[4][2]; float ss[4][2];
#pragma unroll
    for (int q = 0; q < 4; ++q) { const float* x = c.YMIX + (size_t)(t0 + q * tstride) * 1024;
#pragma unroll
        for (int j = 0; j < 2; ++j) { v[q][j].lo = *(const f32x4*)(x + 512 * j + 8 * lane); v[q][j].hi = *(const f32x4*)(x + 512 * j + 8 * lane + 4); ss[q][j] = hsq8(v[q][j]); } }
#pragma unroll
    for (int q = 0; q < 4; ++q)
#pragma unroll
        for (int j = 0; j < 2; ++j) { float x = ss[q][j]; x = rsum<1>(x); x = rsum<2>(x); x = rsum<4>(x); x = rsum<8>(x); ss[q][j] = rsum<16>(x); }
#pragma unroll
    for (int q = 0; q < 4; ++q) {
#pragma unroll
        for (int j = 0; j < 2; ++j) { const float r = __builtin_amdgcn_rsqf(ss[q][j] * (1.f / 256.f) + RMS_EPS); v[q][j].lo = v[q][j].lo * r; v[q][j].hi = v[q][j].hi * r; }
        store_row_bf16(c.Y + (size_t)(t0 + q * tstride) * 1024, v[q], lane); }
}
template <int NR>
__device__ __forceinline__ void resln_load(const LayerCtx& c, int t0, int tstride, int lane, u32x4 (&hw)[NR][2], u32x4 (&fw)[NR][2]) {
#pragma unroll
    for (int q = 0; q < NR; ++q) { const bf16_t* hr = c.HB + (size_t)(t0 + q * tstride) * D; const bf16_t* fr = c.FB + (size_t)(t0 + q * tstride) * D;
#pragma unroll
        for (int j = 0; j < 2; ++j) { hw[q][j] = *(const u32x4*)(hr + 512 * j + 8 * lane); fw[q][j] = *(const u32x4*)(fr + 512 * j + 8 * lane); } }
}
template <int NR>
__device__ __forceinline__ void resln_finish(const LayerCtx& c, int t0, int tstride, const float* g, const float* b, int lane, const u32x4 (&hw)[NR][2], const u32x4 (&fw)[NR][2], R8 (&v)[NR][2]) {
#pragma unroll
    for (int q = 0; q < NR; ++q)
#pragma unroll
        for (int j = 0; j < 2; ++j) { const R8 h = unpack8(hw[q][j]), f = unpack8(fw[q][j]); v[q][j].lo = h.lo * DN_ALPHA + f.lo; v[q][j].hi = h.hi * DN_ALPHA + f.hi; }
    ln_rows<NR>(v, g, b, lane);
#pragma unroll
    for (int q = 0; q < NR; ++q) store_row_bf16(c.HB + (size_t)(t0 + q * tstride) * D, v[q], lane);
}
template <int NR>
__device__ __forceinline__ void resln_rows(const LayerCtx& c, int t0, int tstride, const float* g, const float* b, int lane, R8 (&v)[NR][2]) {
    u32x4 hw[NR][2], fw[NR][2];
    resln_load<NR>(c, t0, tstride, lane, hw, fw);
    resln_finish<NR>(c, t0, tstride, g, b, lane, hw, fw, v);
}
constexpr int RT_LO = 65536, RT_LOGT = 40960;
__device__ __forceinline__ void ln2_router_group(const int tid, const Args& a, const LayerCtx& c, const int grp, const int grp_next, LAS unsigned char* lds, const bf16x8 (&bh)[8], const bf16x8 (&bl)[8], LAS unsigned* lcnt, u32x4 (&hw)[4][2], u32x4 (&fw)[4][2]) {
    const int wid = tid >> 6, lane = tid & 63, r32 = lane & 31, hi = lane >> 5;
    { R8 v[4][2];
      resln_finish<4>(c, grp * 32 + wid * 4, 1, a.in[I_LN2G] + c.l * D, a.in[I_LN2B] + c.l * D, lane, hw, fw, v);
#pragma unroll
      for (int q = 0; q < 4; ++q) { const int row = wid * 4 + q;
#pragma unroll
          for (int j = 0; j < 2; ++j) { const int chunk = 64 * j + lane; const int off = row * 2048 + ((chunk ^ (row & 15)) << 4);
              const R8 x = v[q][j]; const unsigned h0 = f2bf(x.lo.x), h1 = f2bf(x.lo.y), h2 = f2bf(x.lo.z), h3 = f2bf(x.lo.w), h4 = f2bf(x.hi.x), h5 = f2bf(x.hi.y), h6 = f2bf(x.hi.z), h7 = f2bf(x.hi.w);
              const u32x4 wh = {h0 | (h1 << 16), h2 | (h3 << 16), h4 | (h5 << 16), h6 | (h7 << 16)};
              const u32x4 wl = {pk2(x.lo.x - bf2f(h0), x.lo.y - bf2f(h1)), pk2(x.lo.z - bf2f(h2), x.lo.w - bf2f(h3)), pk2(x.hi.x - bf2f(h4), x.hi.y - bf2f(h5)), pk2(x.hi.z - bf2f(h6), x.hi.w - bf2f(h7))};
              *(LAS u32x4*)(lds + off) = wh; *(LAS u32x4*)(lds + RT_LO + off) = wl; } } }
    resln_load<4>(c, (grp_next < T / 32 ? grp_next : grp) * 32 + wid * 4, 1, lane, hw, fw);
    __syncthreads();
    f32x16 acc = f32x16{};
#pragma unroll
    for (int ks = 0; ks < 8; ++ks) { const int chunk = 16 * wid + 2 * ks + hi; const int off = r32 * 2048 + ((chunk ^ (r32 & 15)) << 4);
        const bf16x8 ah = *(const LAS bf16x8*)(lds + off), al = *(const LAS bf16x8*)(lds + RT_LO + off);
        acc = __builtin_amdgcn_mfma_f32_32x32x16_bf16(ah, bh[ks], acc, 0, 0, 0); acc = __builtin_amdgcn_mfma_f32_32x32x16_bf16(ah, bl[ks], acc, 0, 0, 0); acc = __builtin_amdgcn_mfma_f32_32x32x16_bf16(al, bh[ks], acc, 0, 0, 0); }
    __syncthreads();
    { LAS float* red = (LAS float*)lds;
#pragma unroll
      for (int r = 0; r < 16; ++r) { const int tok = (r & 3) + 8 * (r >> 2) + 4 * hi; red[(wid * 32 + tok) * 33 + r32] = acc[r]; } }
    __syncthreads();
    { const LAS float* red = (const LAS float*)lds; LAS float* logt = (LAS float*)(lds + RT_LOGT); const float* br = a.in[I_BR] + c.l * 32;
#pragma unroll
      for (int i = 0; i < 2; ++i) { const int idx = tid + NTHREADS * i, tok = idx >> 5, e = idx & 31; float sres = br[e];
#pragma unroll
          for (int w = 0; w < 8; ++w) sres += red[(w * 32 + tok) * 33 + e];
          logt[tok * 33 + e] = sres; } }
    __syncthreads();
    { const LAS float* logt = (const LAS float*)(lds + RT_LOGT);
#pragma unroll 1
      for (int q = 0; q < 4; ++q) { const int tok = wid * 4 + q, t = grp * 32 + tok;
          float mine = (lane < 32) ? logt[tok * 33 + lane] : -3.0e38f;
          float tv[4]; int ti[4];
#pragma unroll
          for (int k = 0; k < 4; ++k) { const float best = wave_max(mine); const unsigned long long mk = __ballot(mine == best); const int bi = __ffsll((long long)mk) - 1;
              tv[k] = best; ti[k] = bi; if (lane == bi) mine = -3.0e38f; }
          const float e1 = __expf(tv[1] - tv[0]), e2 = __expf(tv[2] - tv[0]), e3 = __expf(tv[3] - tv[0]); const float rs = 1.f / (1.f + e1 + e2 + e3);
          if (lane < 4) { const int e = lane == 0 ? ti[0] : lane == 1 ? ti[1] : lane == 2 ? ti[2] : ti[3]; const float gt = (lane == 0 ? 1.f : lane == 1 ? e1 : lane == 2 ? e2 : e3) * rs;
              const unsigned rank = __hip_atomic_fetch_add(lcnt + e, 1u, __ATOMIC_RELAXED, __HIP_MEMORY_SCOPE_WORKGROUP);
              c.RE[t * 4 + lane] = e; c.RR[t * 4 + lane] = (int)rank; c.GATE[t * 4 + lane] = gt; } } }
    __syncthreads();
}
constexpr int TBL_OFF = 131072, TBL_PSTART = TBL_OFF + 2304, TBL_NBLK = TBL_PSTART + 256, TBL_WBASE = TBL_NBLK + 64, TBL_CNT = TBL_WBASE + 128, TBL_PART = TBL_OFF + 4096, TBL_LCNT = TBL_OFF + 8192;
__device__ __forceinline__ void moe_tables(const int tid, const int bid, const LayerCtx& c, LAS unsigned char* lds) {
    LAS int* blk_e = (LAS int*)(lds + TBL_OFF); LAS int* pstart = (LAS int*)(lds + TBL_PSTART); LAS int* nblk = (LAS int*)(lds + TBL_NBLK); LAS int* wbase = (LAS int*)(lds + TBL_WBASE);
    LAS int* cntL = (LAS int*)(lds + TBL_CNT); LAS int* part = (LAS int*)(lds + TBL_PART);
    { const int e = tid & 31, pr = tid >> 5; int tot = 0, pf = 0;
#pragma unroll 4
      for (int w = pr * 16; w < pr * 16 + 16; ++w) { const int v = (int)__hip_atomic_load(c.cnt + w * 32 + e, RLX_AGENT); tot += v; pf += (w < bid) ? v : 0; }
      part[pr * 32 + e] = tot; part[512 + pr * 32 + e] = pf; }
    __syncthreads();
    if (tid < 32) { int tot = 0, pf = 0;
#pragma unroll 4
        for (int pr = 0; pr < 16; ++pr) { tot += part[pr * 32 + tid]; pf += part[512 + pr * 32 + tid]; }
        cntL[tid] = tot; wbase[tid] = pf; }
    __syncthreads();
    if (tid < 32) { int pos = 0;
#pragma unroll 1
        for (int e = 0; e < tid; ++e) pos += (cntL[e] + 255) >> 8;
        pstart[tid] = pos * 256; wbase[tid] += pos * 256;
        if (tid == 31) nblk[0] = pos + ((cntL[31] + 255) >> 8); }
    __syncthreads();
#pragma unroll 1
    for (int rb = tid; rb < MOE_MAXBLK; rb += NTHREADS) { int e = 0;
#pragma unroll 1
        for (int q = 1; q < NE; ++q) e += (pstart[q] <= rb * 256) ? 1 : 0;
        blk_e[rb] = e; }
    __syncthreads();
}
__device__ __forceinline__ void gather_rows2(const LayerCtx& c, int t0, int lane, const LAS int* wbase) {
    u32x4 hv[2][2]; int dest[2][4];
#pragma unroll
    for (int q = 0; q < 2; ++q) { const int t = t0 + q;
        hv[q][0] = *(const u32x4*)(c.HB + (size_t)t * D + 8 * lane); hv[q][1] = *(const u32x4*)(c.HB + (size_t)t * D + 512 + 8 * lane);
        const u32x4 e4 = *(const u32x4*)(c.RE + t * 4), r4 = *(const u32x4*)(c.RR + t * 4);
#pragma unroll
        for (int k = 0; k < 4; ++k) dest[q][k] = wbase[e4[k]] + (int)r4[k]; }
#pragma unroll
    for (int q = 0; q < 2; ++q) { const int t = t0 + q;
#pragma unroll
        for (int k = 0; k < 4; ++k) { *(u32x4*)(c.XS + (size_t)dest[q][k] * D + 8 * lane) = hv[q][0]; *(u32x4*)(c.XS + (size_t)dest[q][k] * D + 512 + 8 * lane) = hv[q][1]; }
        if (lane == 0) *(u32x4*)(c.DEST + t * 4) = (u32x4){(unsigned)dest[q][0], (unsigned)dest[q][1], (unsigned)dest[q][2], (unsigned)dest[q][3]}; }
}
__device__ __forceinline__ void combine_rows2(const Args& a, const LayerCtx& c, int t0, int tstride, int lane, float* out2) {
    u32x4 d4[2]; f32x4 g4[2]; u32x4 hw[2][2], yw[2][4][2];
#pragma unroll
    for (int q = 0; q < 2; ++q) { const int t = t0 + q * tstride; d4[q] = *(const u32x4*)(c.DEST + t * 4); g4[q] = *(const f32x4*)(c.GATE + t * 4);
        hw[q][0] = *(const u32x4*)(c.HB + (size_t)t * D + 8 * lane); hw[q][1] = *(const u32x4*)(c.HB + (size_t)t * D + 512 + 8 * lane); }
#pragma unroll
    for (int q = 0; q < 2; ++q)
#pragma unroll
        for (int k = 0; k < 4; ++k) { const bf16_t* y = c.YS + (size_t)d4[q][k] * D; yw[q][k][0] = *(const u32x4*)(y + 8 * lane); yw[q][k][1] = *(const u32x4*)(y + 512 + 8 * lane); }
    R8 v[2][2];
#pragma unroll
    for (int q = 0; q < 2; ++q)
#pragma unroll
        for (int j = 0; j < 2; ++j) { const R8 h = unpack8(hw[q][j]); v[q][j].lo = h.lo * DN_ALPHA; v[q][j].hi = h.hi * DN_ALPHA;
#pragma unroll
            for (int k = 0; k < 4; ++k) { const R8 y = unpack8(yw[q][k][j]); v[q][j].lo += y.lo * g4[q][k]; v[q][j].hi += y.hi * g4[q][k]; } }
    ln_rows<2>(v, a.in[I_LN3G] + c.l * D, a.in[I_LN3B] + c.l * D, lane);
#pragma unroll
    for (int q = 0; q < 2; ++q) { const int t = t0 + q * tstride; store_row_bf16(c.HB + (size_t)t * D, v[q], lane); if (out2) store_row_f32(out2 + (size_t)t * D, v[q], lane); }
}
constexpr int NPH_LAYER = 17, NPH_PRE = 3, NPHASES = NPH_PRE + NLAYER * NPH_LAYER;
#ifndef USE_PG8
#define USE_PG8 1
#endif
#if USE_PG8
#define GEMM_CALL(PAIR, g, S, E) do { int tid_ = tid; asm volatile("" : "+v"(tid_)); pg8::gemm_phase<PAIR, false>(tid_, lds, g, S, E); } while (0)
#define GEMM_CALL_GATHER(PAIR, g, S, E) do { int tid_ = tid; asm volatile("" : "+v"(tid_)); pg8::gemm_phase<PAIR, true>(tid_, lds, g, S, E); } while (0)
#else
#define GEMM_CALL(PAIR, g, S, E) sgemm_phase<PAIR>(tid, g, S, E)
#endif

__global__ void __launch_bounds__(NTHREADS, 2) fwd(Args a) {
    extern __shared__ __attribute__((aligned(16))) unsigned char lds_raw[];
    LAS unsigned char* lds = (LAS unsigned char*)lds_raw;
    volatile LAS unsigned* MISC = (volatile LAS unsigned*)(lds + MISC_OFF);
    const int G = gridDim.x, NGW = G * NWAVES;
    const int wave_s = __builtin_amdgcn_readfirstlane((int)threadIdx.x >> 6);
#define HW_TID() (wave_s * 64 + hw_lane())
    if (threadIdx.x < 64) MISC[threadIdx.x] = 0u;
    __syncthreads();
    unsigned* ctl = (unsigned*)(a.ws + WS_CTL);
    XcdBarrier bar; bar.bar = ctl + CW_BAR; bar.x = 0; bar.st = nullptr;
    if (N_LAUNCH_MODE == 1) bar = xcd_barrier_post(ctl + CW_BAR, MISC + 8, (int)threadIdx.x);
    const int lo = a.lo, hi = a.hi;
#define PH_TID int tid = HW_TID(); asm volatile("" : "+v"(tid)); int bid = blockIdx.x; asm volatile("" : "+s"(bid)); const __attribute__((address_space(4))) Args* ap_ = (const __attribute__((address_space(4))) Args*)__builtin_amdgcn_kernarg_segment_ptr(); asm volatile("" : "+s"(ap_)); const Args& a = *(const Args*)ap_; const int lane = tid & 63, wave = tid >> 6, gw = bid * NWAVES + wave; (void)lane; (void)gw
#define PH_BEGIN int lv = l; asm volatile("" : "+s"(lv)); PH_TID; const LayerCtx c = make_ctx(a, lv)
#define IN(k) (lo <= (k) && (k) < hi)
#define SEAM(k) do { if (N_LAUNCH_MODE == 1 && IN(k) && IN((k) + 1)) xcd_barrier(bar, HW_TID()); } while (0)

    if (IN(0)) { PH_TID; phase_pre0(tid, bid, a, lds); } SEAM(0);
    if (IN(1)) { PH_TID;
        GemmDesc g{(const bf16_t*)a.ws, (const bf16_t*)a.ws, 1024, 1024, 1024}; PreOrder S{G, bid}; EpiPre E{a.ws};
        GEMM_CALL(false, g, S, E);
    } SEAM(1);
    if (IN(2)) { PH_TID;
        GemmDesc g{(const bf16_t*)a.ws, (const bf16_t*)a.ws, 1024, 1024, 256}; Pre2Order S{G, bid}; EpiPre2 E{a.ws};
        GEMM_CALL(false, g, S, E);
    } SEAM(2);

    for (int l = 0; l < NLAYER; ++l) {
        const int pb = NPH_PRE + NPH_LAYER * l;
        if (IN(pb + 0)) { PH_BEGIN;
            GemmDesc g{c.HB, (const bf16_t*)(c.wl + WL_IN), 1024, 1024, 1024}; TileOrder S; S.init(T / 256, ZC / 256, G, bid, 0, 1024, 1024);
            EpiBf16 E{c.Z, ZC, nullptr}; GEMM_CALL(false, g, S, E);
        } SEAM(pb + 0);
        if (IN(pb + 1)) { PH_BEGIN;
            { fft::build_table(tid, lds); fft::F64Frags FF; fft::build_f64(tid, FF); __syncthreads();
              for (int u = bid; u < 512; u += G) fft::unit(tid, c, u, lds, FF); }
            __syncthreads();
            for (int it = bid; it < T / 64; it += G) conv_item(tid, a, c, it, lds);
            for (int t = gw; t < T; t += 4 * NGW) { QkRaw raw[4];
#pragma unroll
                for (int q = 0; q < 4; ++q) raw[q] = qkprep_load(c, t + q * NGW, lane);
#pragma unroll
                for (int q = 0; q < 4; ++q) qkprep_row(a, c, t + q * NGW, lane, raw[q]); }
        } SEAM(pb + 1);
        if (IN(pb + 2)) { PH_BEGIN;
            { GemmDesc g{c.CQKV, (const bf16_t*)(c.wl + WL_MLA), 384, 384, 384}; TileOrder S; S.init(T / 256, 4, G, bid, 0, 384, 384);
              EpiBf16 E{c.QKVM, 1024, nullptr}; GEMM_CALL(false, g, S, E); }
            { GemmDesc g{c.FC, (const bf16_t*)(c.wl + WL_FC), 512, 256, 256}; TileOrder S; S.init(T / 256, 2, G, bid, 1, 512, 256);
              EpiF32 E{c.YMIX, 1024, a.in[I_BF] + lv * 256, a.in[I_BPW] + lv * 256}; GEMM_CALL(false, g, S, E); }
        } SEAM(pb + 2);
        if (IN(pb + 3)) { PH_BEGIN;
            for (int U = bid; U < 1024; U += G) { const int x = U & 511, b = x >> 7, h = (x >> 5) & 3, qb = x & 31;
                if (lv == 0 && (U >> 8) == ((bid >> 3) & 3)) { int tw = tid; asm volatile("" : "+v"(tw)); moe_weight_items(tw, bid, a, lds); __syncthreads(); }
                unsigned char* wsb = a.ws; asm volatile("" : "+s"(wsb));
                int tu = tid; asm volatile("" : "+v"(tu));
                if (U < 512) { const AttnSrc A = gqa_src(wsb, b, h); att::unit<64>(tu, A, qb * 256, lds); }
                else         { const AttnSrc A = mla_src(wsb, b, h); att::unit<96>(tu, A, qb * 256, lds); } }
        } SEAM(pb + 3);
        if (IN(pb + 4)) { PH_BEGIN; for (int t = gw; t < T; t += 4 * NGW) grpnorm_rows4(c, t, NGW, lane); } SEAM(pb + 4);
        if (IN(pb + 5)) { PH_BEGIN;
            GemmDesc g{c.Y, (const bf16_t*)(c.wl + WL_O), 1024, 1024, 1024}; TileOrder S; S.init(T / 256, 4, G, bid, 0, 1024, 1024);
            EpiBf16 E{c.FB, 1024, nullptr}; GEMM_CALL(false, g, S, E);
        } SEAM(pb + 5);
        if (IN(pb + 6)) { PH_BEGIN; for (int t = gw; t < T; t += 4 * NGW) { R8 v[4][2]; resln_rows<4>(c, t, NGW, a.in[I_LN1G] + lv * D, a.in[I_LN1B] + lv * D, lane, v); } } SEAM(pb + 6);
        if (IN(pb + 7)) { PH_BEGIN;
            GemmDesc g{c.HB, (const bf16_t*)(a.ws + WS_MT + (size_t)((lv * 2 + 0) * 4) * 2 * MiB), 1024, 1024, 1024}; TileOrder S; S.init(T / 256, 4, G, bid, 4, 1024, 1024);
            EpiXSN E{c.PB, lds}; GEMM_CALL(false, g, S, E);
        } SEAM(pb + 10);
        if (IN(pb + 11)) { PH_BEGIN;
            GemmDesc g{c.PB, (const bf16_t*)(a.ws + WS_MT + (size_t)((lv * 2 + 1) * 4) * 2 * MiB), 1024, 1024, 1024}; TileOrder S; S.init(T / 256, 4, G, bid, 4, 1024, 1024);
            EpiBf16 E{c.FB, 1024, nullptr}; GEMM_CALL(false, g, S, E);
        } SEAM(pb + 11);
        if (IN(pb + 12)) { PH_BEGIN; LAS unsigned* lcnt = (LAS unsigned*)(lds + TBL_LCNT);
            if (tid < 32) lcnt[tid] = 0u;
            bf16x8 bh[8], bl[8];
            { const bf16_t* wr = (const bf16_t*)(c.wl + WL_RT) + (size_t)(lane & 31) * 1024 + 128 * wave + 8 * (lane >> 5);
#pragma unroll
              for (int ks = 0; ks < 8; ++ks) { bh[ks] = *(const bf16x8*)(wr + 16 * ks); bl[ks] = *(const bf16x8*)(wr + 32768 + 16 * ks); } }
            __syncthreads();
            { u32x4 hw[4][2], fw[4][2]; static_assert(MAXWG <= T / 32, "every workgroup has a first group"); resln_load<4>(c, bid * 32 + wave * 4, 1, lane, hw, fw);
              for (int grp = bid; grp < T / 32; grp += G) ln2_router_group(tid, a, c, grp, grp + G, lds, bh, bl, lcnt, hw, fw); }
            __syncthreads();
            if (tid < 32) __hip_atomic_store(c.cnt + bid * 32 + tid, lcnt[tid], RLX_AGENT);
        } SEAM(pb + 12);
        if (IN(pb + 13)) { PH_BEGIN; moe_tables(tid, bid, c, lds); const LAS int* wbase = (const LAS int*)(lds + TBL_WBASE);
            { const int gi = tid >> 7, pr = tid & 127; const int grp = bid + G * gi;
              if (grp < T / 32) { const int t = grp * 32 + (pr >> 2), k = pr & 3; const int dest = wbase[c.RE[t * 4 + k]] + c.RR[t * 4 + k]; c.TOK[dest] = t; c.DEST[t * 4 + k] = dest; } }
        } SEAM(pb + 13);
        if (IN(pb + 14)) { PH_BEGIN;
            const int nblk = *(const LAS int*)(lds + TBL_NBLK);
            GemmDesc g{c.HB, (const bf16_t*)(c.wl + WL_GU), 1024, 1024, 1024, c.TOK}; MoeOrder S{(const LAS int*)(lds + TBL_OFF), nblk, 8, G, bid};
            EpiGU E{c.ACT, a.in[I_BGU] + (size_t)lv * NE * 2048, lds}; GEMM_CALL_GATHER(true, g, S, E);
        } SEAM(pb + 14);
        if (IN(pb + 15)) { PH_BEGIN;
            const int nblk = *(const LAS int*)(lds + TBL_NBLK);
            GemmDesc g{c.ACT, (const bf16_t*)(c.wl + WL_DN), 1024, 1024, 1024}; MoeOrder S{(const LAS int*)(lds + TBL_OFF), nblk, 4, G, bid};
            EpiDown E{c.YS, a.in[I_BDN] + (size_t)lv * NE * 1024, lds}; GEMM_CALL(false, g, S, E);
        } SEAM(pb + 15);
        if (IN(pb + 16)) { PH_BEGIN; for (int t = gw; t < T; t += 2 * NGW) combine_rows2(a, c, t, NGW, lane, (lv == NLAYER - 1) ? a.out : nullptr); } SEAM(pb + 16);
    }
#undef IN
#undef SEAM
}

extern "C" void kernel_launch(void* const* d_in, const int* in_sizes, int n_in, void* d_out, int out_size, void* d_ws, size_t ws_size, hipStream_t stream) {
    static int grid = 0;
    if (grid == 0) {
        if (n_in != 37 || in_sizes[0] != T * D || out_size != T * D || ws_size < WS_END) {
            fprintf(stderr, "kernel_launch: unexpected shapes: n_in %d in0 %d out %d ws %zu (need %zu)\n", n_in, n_in > 0 ? in_sizes[0] : -1, out_size, ws_size, (size_t)WS_END); grid = -1; return; }
        int dev = 0, cus = 0;
        if (hipGetDevice(&dev) != hipSuccess || hipDeviceGetAttribute(&cus, hipDeviceAttributeMultiprocessorCount, dev) != hipSuccess) { grid = -1; return; }
        if (hipFuncSetAttribute((const void*)fwd, hipFuncAttributeMaxDynamicSharedMemorySize, LDS_BYTES) != hipSuccess) { fprintf(stderr, "kernel_launch: hipFuncSetAttribute failed\n"); grid = -1; return; }
        int per_cu = 0;
        if (hipOccupancyMaxActiveBlocksPerMultiprocessor(&per_cu, (const void*)fwd, NTHREADS, LDS_BYTES) != hipSuccess || per_cu < 1) fprintf(stderr, "kernel_launch: occupancy query reports %d\n", per_cu);
        (void)hipGetLastError();
        grid = MAXWG;
        if (cus < MAXWG) fprintf(stderr, "kernel_launch: only %d CUs: the 256-workgroup persistent grid cannot be resident; the grid barrier will time out\n", cus);
    }
    if (grid < 0) return;
    (void)hipMemsetAsync((char*)d_ws + WS_CTL, 0, CTL_ZERO_BYTES, stream);
    Args a{};
    for (int i = 0; i < 37; ++i) a.in[i] = (const float*)d_in[i];
    a.out = (float*)d_out; a.ws = (unsigned char*)d_ws; a.pad0 = 0; a.pad1 = 0;
    if (N_LAUNCH_MODE == 1) { a.lo = 0; a.hi = NPHASES; hipLaunchKernelGGL(fwd, dim3(grid), dim3(NTHREADS), LDS_BYTES, stream, a); }
    else for (int p = 0; p < NPHASES; ++p) { a.lo = p; a.hi = p + 1; hipLaunchKernelGGL(fwd, dim3(grid), dim3(NTHREADS), LDS_BYTES, stream, a); }
    const hipError_t le = hipPeekAtLastError();
    if (le != hipSuccess) fprintf(stderr, "kernel_launch: launch failed: %s\n", hipGetErrorName(le));
}
```

```cpp
#include <hip/hip_runtime.h>
#include <cstdio>
#include <cstdint>

#ifndef N_LAUNCH_MODE
#define N_LAUNCH_MODE 1
#endif

#define LAS __attribute__((address_space(3)))
#define GAS __attribute__((address_space(1)))
typedef unsigned short bf16_t;
typedef short bf16x8 __attribute__((ext_vector_type(8)));
typedef float f32x4 __attribute__((ext_vector_type(4)));
typedef float f32x2 __attribute__((ext_vector_type(2)));
typedef float f32x16 __attribute__((ext_vector_type(16)));
typedef unsigned u32x4 __attribute__((ext_vector_type(4)));
typedef unsigned u32x2 __attribute__((ext_vector_type(2)));
typedef GAS unsigned gu32;
#define RLX_AGENT __ATOMIC_RELAXED, __HIP_MEMORY_SCOPE_AGENT
#define LDS_WAIT() asm volatile("s_waitcnt lgkmcnt(0)" ::: "memory")
#define VM_WAIT() asm volatile("s_waitcnt vmcnt(0)" ::: "memory")

constexpr int NB = 4, SEQ = 8192, T = NB * SEQ, D = 1024, MEML = 256, NE = 32, TOPK = 4, NLAYER = 2;
constexpr int ZC = 1792;
constexpr int ZC_CA = 256, ZC_CG = 512, ZC_Q = 768, ZC_K = 1024, ZC_V = 1152, ZC_CQ = 1280, ZC_CKV = 1536, ZC_KR = 1664;
constexpr int INC = 1696;
constexpr float LOG2E = 1.4426950408889634f;
constexpr float DN_ALPHA = 1.4142135623730951f;
constexpr float LN_EPS = 1e-5f, RMS_EPS = 1e-6f;
constexpr float QSCALE_G = 0.125f * LOG2E;
constexpr float QSCALE_M = 0.10206207261596575f * LOG2E;
constexpr float QSCALE_X = 0.0625f * LOG2E;
constexpr int MOE_MAXBLK = T * TOPK / 256 + NE;
constexpr int MOE_ROWS = MOE_MAXBLK * 256;

constexpr size_t MiB = 1u << 20;
constexpr size_t WS_CTL = 0, CTL_ZERO_BYTES = 1 * MiB;
constexpr size_t WS_W = 1 * MiB, WL_SIZE = 208 * MiB;
constexpr size_t WL_IN = 0, WL_MLA = 4 * MiB, WL_FC = 5 * MiB, WL_RT = 5 * MiB + 512 * 1024, WL_O = 6 * MiB, WL_XQ = 8 * MiB, WL_XK = 10 * MiB, WL_XV = 12 * MiB,
                 WL_XO = 14 * MiB, WL_GU = 16 * MiB, WL_DN = 144 * MiB;
constexpr size_t WS_MEMB = 418 * MiB, WS_KX = 420 * MiB, WS_VXT = 424 * MiB;
constexpr size_t WS_ROUTE = 428 * MiB;
constexpr size_t WS_H = 430 * MiB, WS_HB = 558 * MiB, WS_F = 622 * MiB, WS_R = 750 * MiB;
constexpr size_t R_Z = 0, R_FC = 112 * MiB, R_QG = 144 * MiB, R_KG = 160 * MiB, R_CQKV = 168 * MiB, R_KR = 192 * MiB, R_QKVM = 194 * MiB, R_YMIX = 258 * MiB, R_Y = 386 * MiB;
constexpr size_t R_XQ = 0, R_SC = 64 * MiB, R_PB = 192 * MiB, R_XO = 256 * MiB;
constexpr size_t R_XS = 0, R_ACT = 272 * MiB;
constexpr size_t WS_MT = 430 * MiB;
constexpr size_t WS_END = WS_R + 544 * MiB;
constexpr int CW_TMO = 0, CW_CODE = 1, CW_BAR = 4096, CW_CNT = 16384, MAXWG = 256, CW_TOK = 65536;

constexpr int NTHREADS = 512, NWAVES = 8;
constexpr int LDS_BYTES = 147456;
constexpr int MISC_OFF = 147456 - 256;

__device__ __forceinline__ unsigned f2bf(float f) { unsigned u = __builtin_bit_cast(unsigned, f); return (u + 0x7fffu + ((u >> 16) & 1u)) >> 16; }
__device__ __forceinline__ unsigned pk2i(float lo, float hi) { return f2bf(lo) | (f2bf(hi) << 16); }
typedef __bf16 hwbf2 __attribute__((ext_vector_type(2))); typedef float hwf2 __attribute__((ext_vector_type(2)));
__device__ __forceinline__ unsigned pk2(float lo, float hi) { const hwf2 v = {lo, hi}; return __builtin_bit_cast(unsigned, __builtin_convertvector(v, hwbf2)); }
__device__ __forceinline__ float bf2f(unsigned b) { return __builtin_bit_cast(float, b << 16); }
__device__ __forceinline__ float bflo(unsigned w) { return __builtin_bit_cast(float, w << 16); }
__device__ __forceinline__ float bfhi(unsigned w) { return __builtin_bit_cast(float, w & 0xffff0000u); }
template <int CTRL> __device__ __forceinline__ float dppf(float v) { return __builtin_bit_cast(float, __builtin_amdgcn_update_dpp(0, __builtin_bit_cast(int, v), CTRL, 0xF, 0xF, true)); }
template <int O, bool MAX> __device__ __forceinline__ float rstep(float v) {
    float o;
    if constexpr (O == 1) o = dppf<0xB1>(v); else if constexpr (O == 2) o = dppf<0x4E>(v); else if constexpr (O == 4) o = dppf<0x141>(v); else if constexpr (O == 8) o = dppf<0x140>(v);
    else { const unsigned u = __builtin_bit_cast(unsigned, v);
        if constexpr (O == 16) { auto r = __builtin_amdgcn_permlane16_swap(u, u, false, false); v = __builtin_bit_cast(float, (unsigned)r[0]); o = __builtin_bit_cast(float, (unsigned)r[1]); }
        else { auto r = __builtin_amdgcn_permlane32_swap(u, u, false, false); v = __builtin_bit_cast(float, (unsigned)r[0]); o = __builtin_bit_cast(float, (unsigned)r[1]); } }
    return MAX ? fmaxf(v, o) : v + o;
}
template <int O> __device__ __forceinline__ float rsum(float v) { return rstep<O, false>(v); }
__device__ __forceinline__ float wave_sum(float v) { v = rsum<1>(v); v = rsum<2>(v); v = rsum<4>(v); v = rsum<8>(v); v = rsum<16>(v); return rsum<32>(v); }
__device__ __forceinline__ float wave_max(float v) { v = rstep<1, true>(v); v = rstep<2, true>(v); v = rstep<4, true>(v); v = rstep<8, true>(v); v = rstep<16, true>(v); return rstep<32, true>(v); }
__device__ __forceinline__ f32x4 ldbf4(const bf16_t* p) { const u32x2 w = *(const u32x2*)p; return (f32x4){bflo(w.x), bfhi(w.x), bflo(w.y), bfhi(w.y)}; }
__device__ __forceinline__ float sigmoidf_(float x) { return __builtin_amdgcn_rcpf(1.f + __expf(-x)); }

#define XB_TMO      128
#define XB_XCNT(j)  (256  + 64 * (j))
#define XB_XSUB(j)  (1280 + 64 * (j))
#define XB_XGEN(j)  (2304 + 64 * (j))
#define XB_TOP      3328
#define XB_TOPGEN   3392
#define XCD_BAR_WORDS 3456
#define XB_SPIN_CAP (1u << 22)
__device__ __forceinline__ unsigned xb_ld(unsigned* p)              { return __hip_atomic_load(p, __ATOMIC_RELAXED, __HIP_MEMORY_SCOPE_AGENT); }
__device__ __forceinline__ unsigned xb_add(unsigned* p, unsigned v) { return __hip_atomic_fetch_add(p, v, __ATOMIC_RELAXED, __HIP_MEMORY_SCOPE_AGENT); }
__device__ __forceinline__ unsigned xb_xcc_id() { return (unsigned)__builtin_amdgcn_s_getreg((3 << 11) | 20) & 0xFu; }
#define XB_SPIN(cond, bar) do { unsigned _sp = 0; while (cond) { __builtin_amdgcn_s_sleep(1); \
    if ((++_sp & 255u) == 0u) { if (xb_ld(&(bar)[XB_TMO])) break; if (_sp > XB_SPIN_CAP) { atomicAdd(&(bar)[XB_TMO], 1u); break; } } } } while (0)
struct XcdBarrier { unsigned* bar; unsigned x; volatile LAS unsigned* st; };
__device__ __forceinline__ XcdBarrier xcd_barrier_post(unsigned* bar, volatile LAS unsigned* st, int tid) {
    XcdBarrier b; b.bar = bar; b.x = xb_xcc_id(); b.st = st;
    if (tid == 0) (void)xb_add(&bar[XB_XCNT(b.x)], 1u);
    return b;
}
__device__ __forceinline__ void xcd_barrier_complete(unsigned* bar, unsigned x, unsigned& nloc, unsigned& nx) {
    const unsigned G = gridDim.x * gridDim.y * gridDim.z;
    unsigned sum, cnt, mine, sp = 0u;
    for (;;) {
        sum = 0u; cnt = 0u; mine = 0u;
#pragma unroll
        for (unsigned j = 0; j < 16; ++j) { const unsigned c = xb_ld(&bar[XB_XCNT(j)]); sum += c; cnt += (c > 0u) ? 1u : 0u; mine = (j == x) ? c : mine; }
        if (sum == G) break;
        __builtin_amdgcn_s_sleep(1);
        if ((++sp & 255u) == 0u) { if (xb_ld(&bar[XB_TMO])) break; if (sp > XB_SPIN_CAP) { atomicAdd(&bar[XB_TMO], 1u); break; } }
    }
    nloc = mine > 0u ? mine : 1u; nx = cnt > 0u ? cnt : 1u;
}
__device__ __forceinline__ void xcd_barrier(const XcdBarrier& b, int tid) {
    asm volatile("s_waitcnt vmcnt(0)" ::: "memory");
    __syncthreads();
    if (tid == 0) {
        unsigned* bar = b.bar;
        __builtin_amdgcn_s_waitcnt(0);
        unsigned nloc = b.st[0], nx = b.st[1];
        if (nloc == 0u) { xcd_barrier_complete(bar, b.x, nloc, nx); b.st[0] = nloc; b.st[1] = nx; }
        const unsigned old = xb_add(&bar[XB_XSUB(b.x)], 1u);
        const unsigned gen = old / nloc;
        if (old + 1u == (gen + 1u) * nloc) {
            __builtin_amdgcn_fence(__ATOMIC_RELEASE, "agent");
            asm volatile("s_waitcnt vmcnt(0)" ::: "memory");
            const unsigned og = xb_add(&bar[XB_TOP], 1u);
            const unsigned tg = og / nx;
            if (og + 1u == (tg + 1u) * nx) xb_add(&bar[XB_TOPGEN], 1u);
            else XB_SPIN(xb_ld(&bar[XB_TOPGEN]) == tg, bar);
            __builtin_amdgcn_fence(__ATOMIC_ACQUIRE, "agent");
            xb_add(&bar[XB_XGEN(b.x)], 1u);
            asm volatile("s_waitcnt vmcnt(0)" ::: "memory");
        } else {
            XB_SPIN(xb_ld(&bar[XB_XGEN(b.x)]) == gen, bar);
            __builtin_amdgcn_fence(__ATOMIC_ACQUIRE, "agent");
            asm volatile("s_waitcnt vmcnt(0)" ::: "memory");
        }
    }
    __syncthreads();
}

__device__ __forceinline__ int hw_lane() { int l; asm volatile("v_mbcnt_lo_u32_b32 %0, -1, 0\n\tv_mbcnt_hi_u32_b32 %0, -1, %0" : "=v"(l)); return l; }
constexpr int XSN_PART_OFF = 141312;
constexpr int EPI_BIAS_OFF = 143360;
struct Unit { int pm, pn, z; long aoff, boff; };
struct GemmDesc { const bf16_t* A; const bf16_t* Bt; int lda, ldb, K; const int* tok = nullptr; };

struct TileOrder {
    int nM, nN, nwg, G, c, mode, lda, ldb;
    __device__ __forceinline__ void init(int nM_, int nN_, int G_, int c_, int mode_, int lda_, int ldb_) { nM = nM_; nN = nN_; nwg = nM * nN; G = G_; c = c_; mode = mode_; lda = lda_; ldb = ldb_; }
    __device__ __forceinline__ bool next(int i, Unit& u) const {
        const long L = (long)i * G + c; if (L >= nwg) return false;
        int wgid = (int)L; { const int q = nwg / 8, r = nwg % 8, xcd = wgid % 8, off = wgid / 8; wgid = (xcd < r ? xcd * (q + 1) : r * (q + 1) + (xcd - r) * q) + off; }
        const int nig = 8 * nN, gid = wgid / nig, fm = gid * 8, gsz = (nM - fm) < 8 ? (nM - fm) : 8;
        u.pm = fm + ((wgid % nig) % gsz); u.pn = (wgid % nig) / gsz; u.z = 0;
        const long ar = (long)u.pm * 256 * lda;
        if (mode == 0)      { u.aoff = ar;                u.boff = (long)u.pn * 256 * ldb; }
        else if (mode == 1) { u.aoff = ar + u.pn * 256;   u.boff = (long)u.pn * 256 * ldb; }
        else if (mode == 2) { u.aoff = ar + u.pn * 256;   u.boff = (long)((u.pm >> 5) * 256) * ldb + u.pn * 256; }
        else if (mode == 3) { u.aoff = ar + u.pn * 256;   u.boff = (long)(u.pn * 256) * ldb + (u.pm >> 5) * 256; }
        else                { u.aoff = ar;                u.boff = (long)(u.pm >> 5) * 1048576 + (long)u.pn * 256 * ldb; }
        return true;
    }
};
struct PreOrder {
    int G, c;
    __device__ __forceinline__ bool next(int i, Unit& u) const {
        const int L = i * G + c; if (L >= 64) return false;
        const int which = L >> 4, t16 = L & 15, l = which >> 1, isv = which & 1;
        u.pm = t16 >> 2; u.pn = t16 & 3; u.z = which;
        const long memb = (long)(WS_MEMB / 2), wk = (long)((WS_W + l * WL_SIZE + WL_XK) / 2), wv = (long)((WS_W + l * WL_SIZE + WL_XV) / 2);
        const long ao = memb, bo = isv ? wv : wk;
        u.aoff = ao + (long)u.pm * 256 * 1024; u.boff = bo + (long)u.pn * 256 * 1024; return true;
    }
};
struct Pre2Order {
    int G, c;
    __device__ __forceinline__ bool next(int i, Unit& u) const {
        const int L = i * G + c; if (L >= 256) return false;
        const int l = L >> 7, which = (L >> 6) & 1, b = (L >> 4) & 3, h = (L >> 2) & 3, j = L & 3;
        const long kx = (long)((WS_KX + (size_t)l * 2 * MiB) / 2), vx = (long)((WS_VXT + (size_t)l * 2 * MiB) / 2), wq = (long)((WS_W + l * WL_SIZE + WL_XQ) / 2), wo = (long)((WS_W + l * WL_SIZE + WL_XO) / 2);
        u.z = (l * 2 + which) * 4 + b;
        if (which == 0) { u.pm = h; u.pn = j; u.aoff = kx + (long)(b * 256) * 1024 + h * 256; u.boff = wq + (long)(j * 256) * 1024 + h * 256; }
        else            { u.pm = j; u.pn = h; u.aoff = wo + (long)(j * 256) * 1024 + h * 256; u.boff = vx + (long)(b * 256) * 1024 + h * 256; }
        return true;
    }
};
struct MoeOrder {
    const LAS int* blk_e; int nblk, nN, G, c;
    __device__ __forceinline__ bool next(int i, Unit& u) const {
        const int x = c & 7, v = c >> 3, per = G >> 3; const long ul = (long)i * per + v; const int rb = x + 8 * (int)(ul / nN), pn = (int)(ul % nN); if (rb >= nblk) return false;
        const int e = blk_e[rb]; u.pm = rb; u.pn = pn; u.z = e;
        u.aoff = (long)rb * 256 * 1024; u.boff = ((long)e * nN * 256 + (long)pn * 256) * 1024; return true;
    }
};

__device__ __forceinline__ u32x4 pk8(const f32x4 a, const f32x4 b) { return (u32x4){pk2(a.x, a.y), pk2(a.z, a.w), pk2(b.x, b.y), pk2(b.z, b.w)}; }
struct EpiBf16 { static constexpr bool TILE = true; static constexpr int NST = 16; static constexpr int NPRE = 0; bf16_t* O; int ldo; const float* bias;
    __device__ __forceinline__ void tile(const f32x4 (&acc)[2][2][4][2], const Unit& u, int wr, int wc, int fr, int fq) const {
        const int col0 = u.pn * 256 + wc * 32 + 8 * fq; f32x4 b[2][2];
#pragma unroll
        for (int bj = 0; bj < 2; ++bj) { b[bj][0] = bias ? *(const f32x4*)(bias + col0 + bj * 128) : (f32x4){0.f, 0.f, 0.f, 0.f}; b[bj][1] = bias ? *(const f32x4*)(bias + col0 + bj * 128 + 4) : (f32x4){0.f, 0.f, 0.f, 0.f}; }
        if (bias) asm volatile("s_waitcnt vmcnt(0)" ::: "memory");
#pragma unroll
        for (int ai = 0; ai < 2; ++ai)
#pragma unroll
            for (int m = 0; m < 4; ++m) { bf16_t* rowp = O + (size_t)(u.pm * 256 + ai * 128 + wr * 64 + m * 16 + fr) * ldo + col0;
#pragma unroll
                for (int bj = 0; bj < 2; ++bj) *(u32x4*)(rowp + bj * 128) = pk8(acc[ai][bj][m][0] + b[bj][0], acc[ai][bj][m][1] + b[bj][1]); }
    }
    __device__ __forceinline__ void st4(const Unit&, int grow, int gcol, f32x4 v) const {
        if (bias) { const f32x4 b = *(const f32x4*)(bias + gcol); v += b; }
        u32x2 w; w.x = pk2(v.x, v.y); w.y = pk2(v.z, v.w); *(u32x2*)(O + (size_t)grow * ldo + gcol) = w; } };
struct EpiF32 { static constexpr bool TILE = false; static constexpr int NST = 0; static constexpr int NPRE = 0; float* O; int ldo; const float* bias0; const float* bias1;
    __device__ __forceinline__ void st4(const Unit&, int grow, int gcol, f32x4 v) const {
        if (bias0) { const f32x4 b = (gcol < 256) ? *(const f32x4*)(bias0 + gcol) : *(const f32x4*)(bias1 + gcol - 256); v += b; }
        *(f32x4*)(O + (size_t)grow * ldo + gcol) = v; } };
struct EpiFCN { static constexpr bool TILE = true; static constexpr int NST = 16; static constexpr int NPRE = 0; bf16_t* Y; const float* bias0; const float* bias1; LAS unsigned char* lds;
    __device__ __forceinline__ void tile(const f32x4 (&acc)[2][2][4][2], const Unit& u, int wr, int wc, int fr_, int fq_) const {
        int fr = fr_, fq = fq_; asm volatile("" : "+v"(fr), "+v"(fq));
        LAS float* part = (LAS float*)(lds + XSN_PART_OFF);
        const float* bp = (u.pn == 0 ? bias0 : bias1) + wc * 32 + 8 * fq; f32x4 b[2][2];
#pragma unroll
        for (int bj = 0; bj < 2; ++bj) { b[bj][0] = *(const f32x4*)(bp + bj * 128); b[bj][1] = *(const f32x4*)(bp + bj * 128 + 4); }
        asm volatile("s_waitcnt vmcnt(0)" ::: "memory");
#pragma unroll
        for (int ai = 0; ai < 2; ++ai)
#pragma unroll
            for (int m = 0; m < 4; ++m) { float ss = 0.f;
#pragma unroll
                for (int bj = 0; bj < 2; ++bj)
#pragma unroll
                    for (int n = 0; n < 2; ++n) { const f32x4 x = acc[ai][bj][m][n] + b[bj][n]; ss += (x.x * x.x + x.y * x.y) + (x.z * x.z + x.w * x.w); }
                ss = rsum<16>(ss); ss = rsum<32>(ss);
                if (fq == 0) part[(ai * 128 + wr * 64 + m * 16 + fr) * 4 + wc] = ss;
                __builtin_amdgcn_sched_barrier(0); }
        asm volatile("s_waitcnt lgkmcnt(0)\n\ts_barrier" ::: "memory");
        asm volatile("" : "+v"(b[0][0]), "+v"(b[0][1]), "+v"(b[1][0]), "+v"(b[1][1]));
#pragma unroll
        for (int ai = 0; ai < 2; ++ai)
#pragma unroll
            for (int m = 0; m < 4; ++m) { const int lrow = ai * 128 + wr * 64 + m * 16 + fr; const f32x4 t = *(const LAS f32x4*)(part + lrow * 4); const float r = __builtin_amdgcn_rsqf(((t.x + t.y) + (t.z + t.w)) * (1.f / 256.f) + RMS_EPS);
#pragma unroll
                for (int bj = 0; bj < 2; ++bj) *(u32x4*)(Y + (size_t)(u.pm * 256 + lrow) * 1024 + u.pn * 256 + bj * 128 + wc * 32 + 8 * fq) = pk8((acc[ai][bj][m][0] + b[bj][0]) * r, (acc[ai][bj][m][1] + b[bj][1]) * r);
                __builtin_amdgcn_sched_barrier(0); }
    } };
struct EpiPre { static constexpr bool TILE = false; static constexpr int NST = 0; static constexpr int NPRE = 0; unsigned char* ws;
    __device__ __forceinline__ void st4(const Unit& u, int grow, int gcol, f32x4 v) const {
        bf16_t* O = (bf16_t*)(ws + ((u.z & 1) ? WS_VXT : WS_KX) + (size_t)(u.z >> 1) * 2 * MiB);
        u32x2 w; w.x = pk2(v.x, v.y); w.y = pk2(v.z, v.w); *(u32x2*)(O + (size_t)grow * 1024 + gcol) = w; } };
struct EpiPre2 { static constexpr bool TILE = false; static constexpr int NST = 0; static constexpr int NPRE = 0; unsigned char* ws;
    __device__ __forceinline__ void st4(const Unit& u, int grow, int gcol, f32x4 v) const {
        bf16_t* O = (bf16_t*)(ws + WS_MT + (size_t)u.z * 2 * MiB);
        u32x2 w; w.x = pk2(v.x, v.y); w.y = pk2(v.z, v.w); *(u32x2*)(O + (size_t)grow * 1024 + gcol) = w; } };
__device__ __forceinline__ void rope2(float& x1, float& x2, float ang) { const float c = __cosf(ang), s = __sinf(ang); const float a = x1 * c - x2 * s, b = x2 * c + x1 * s; x1 = a; x2 = b; }
struct EpiGU { static constexpr bool TILE = true; static constexpr int NST = 8; static constexpr int NPRE = 1; bf16_t* O; const float* bgu; LAS unsigned char* lds;
    __device__ __forceinline__ void prefetch(const Unit& u, int wid, int lane) const {
        const float* b = bgu + (size_t)u.z * 2048 + (lane >> 5) * 1024 + u.pn * 128 + (wid & 3) * 32 + (lane & 31);
        __builtin_amdgcn_global_load_lds((const unsigned*)b, (LAS unsigned*)(lds + EPI_BIAS_OFF + wid * 256), 4, 0, 0); }
    __device__ __forceinline__ void tile(const f32x4 (&acc)[2][2][4][2], const Unit& u, int wr, int wc, int fr, int fq) const {
        const int acol = u.pn * 128 + wc * 32 + 8 * fq; const LAS float* b = (const LAS float*)(lds + EPI_BIAS_OFF + (wr * 4 + wc) * 256) + 8 * fq;
        const f32x4 bg0 = *(const LAS f32x4*)b, bg1 = *(const LAS f32x4*)(b + 4); f32x4 bu0 = *(const LAS f32x4*)(b + 32), bu1 = *(const LAS f32x4*)(b + 36);
        bu0 += 1.f; bu1 += 1.f;
#define GU_PAIR(G, U, BG, BU, I) ({ hwf2 g_ = hwf2{G[I], G[I + 1]} + hwf2{BG[I], BG[I + 1]}, u_ = hwf2{U[I], U[I + 1]} + hwf2{BU[I], BU[I + 1]};   \
            g_.x = fminf(g_.x, 7.f); g_.y = fminf(g_.y, 7.f); u_.x = __builtin_amdgcn_fmed3f(u_.x, -6.f, 8.f); u_.y = __builtin_amdgcn_fmed3f(u_.y, -6.f, 8.f);          \
            hwf2 e_ = g_ * -2.45546696f; e_.x = __builtin_amdgcn_exp2f(e_.x); e_.y = __builtin_amdgcn_exp2f(e_.y); e_ = e_ + 1.f;                                       \
            e_.x = __builtin_amdgcn_rcpf(e_.x); e_.y = __builtin_amdgcn_rcpf(e_.y); const hwf2 a_ = (g_ * u_) * e_; pk2(a_.x, a_.y); })
#pragma unroll
        for (int ai = 0; ai < 2; ++ai)
#pragma unroll
            for (int m = 0; m < 4; ++m) { const f32x4 g0 = acc[ai][0][m][0], g1 = acc[ai][0][m][1], u0 = acc[ai][1][m][0], u1 = acc[ai][1][m][1];
                u32x4 o; o.x = GU_PAIR(g0, u0, bg0, bu0, 0); o.y = GU_PAIR(g0, u0, bg0, bu0, 2); o.z = GU_PAIR(g1, u1, bg1, bu1, 0); o.w = GU_PAIR(g1, u1, bg1, bu1, 2);
                *(u32x4*)(O + (size_t)(u.pm * 256 + ai * 128 + wr * 64 + m * 16 + fr) * 1024 + acol) = o;
                __builtin_amdgcn_sched_barrier(0); }
#undef GU_PAIR
    }
    __device__ __forceinline__ void st4x2(const Unit& u, int grow, int acol, f32x4 g, f32x4 up) const {
        const float* b = bgu + (size_t)u.z * 2048; const f32x4 bg = *(const f32x4*)(b + acol), bu = *(const f32x4*)(b + 1024 + acol);
        g += bg; up += bu; f32x4 a;
#pragma unroll
        for (int i = 0; i < 4; ++i) { const float gg = fminf(g[i], 7.f), uu = fminf(fmaxf(up[i], -7.f), 7.f); a[i] = (uu + 1.f) * (gg * sigmoidf_(1.702f * gg)); }
        u32x2 w; w.x = pk2(a.x, a.y); w.y = pk2(a.z, a.w); *(u32x2*)(O + (size_t)grow * 1024 + acol) = w; } };
struct EpiDown { static constexpr bool TILE = true; static constexpr int NST = 16; static constexpr int NPRE = 1; bf16_t* O; const float* bdn; LAS unsigned char* lds;
    __device__ __forceinline__ void prefetch(const Unit& u, int wid, int lane) const {
        const float* b = bdn + (size_t)u.z * 1024 + u.pn * 256 + (lane >> 5) * 128 + (wid & 3) * 32 + (lane & 31);
        __builtin_amdgcn_global_load_lds((const unsigned*)b, (LAS unsigned*)(lds + EPI_BIAS_OFF + wid * 256), 4, 0, 0); }
    __device__ __forceinline__ void tile(const f32x4 (&acc)[2][2][4][2], const Unit& u, int wr, int wc, int fr, int fq) const {
        const int col0 = u.pn * 256 + wc * 32 + 8 * fq; const LAS float* bl = (const LAS float*)(lds + EPI_BIAS_OFF + (wr * 4 + wc) * 256) + 8 * fq; f32x4 b[2][2];
#pragma unroll
        for (int bj = 0; bj < 2; ++bj) { b[bj][0] = *(const LAS f32x4*)(bl + 32 * bj); b[bj][1] = *(const LAS f32x4*)(bl + 32 * bj + 4); }
#pragma unroll
        for (int ai = 0; ai < 2; ++ai)
#pragma unroll
            for (int m = 0; m < 4; ++m) { bf16_t* rowp = O + (size_t)(u.pm * 256 + ai * 128 + wr * 64 + m * 16 + fr) * 1024 + col0;
#pragma unroll
                for (int bj = 0; bj < 2; ++bj) *(u32x4*)(rowp + bj * 128) = pk8(acc[ai][bj][m][0] + b[bj][0], acc[ai][bj][m][1] + b[bj][1]); }
    }
    __device__ __forceinline__ void st4(const Unit& u, int grow, int gcol, f32x4 v) const {
        const f32x4 b = *(const f32x4*)(bdn + (size_t)u.z * 1024 + gcol); v += b;
        u32x2 w; w.x = pk2(v.x, v.y); w.y = pk2(v.z, v.w); *(u32x2*)(O + (size_t)grow * 1024 + gcol) = w; } };

struct EpiXS { static constexpr bool TILE = true; static constexpr int NST = 16; static constexpr int NPRE = 0; bf16_t* P; float* RS;
    __device__ __forceinline__ void tile(const f32x4 (&acc)[2][2][4][2], const Unit& u, int wr, int wc, int fr, int fq) const {
#pragma unroll
        for (int ai = 0; ai < 2; ++ai)
#pragma unroll
            for (int m = 0; m < 4; ++m) { const int grow = u.pm * 256 + ai * 128 + wr * 64 + m * 16 + fr; float rs = 0.f;
#pragma unroll
                for (int bj = 0; bj < 2; ++bj) { f32x4 p0, p1;
#pragma unroll
                    for (int i = 0; i < 4; ++i) { p0[i] = __builtin_amdgcn_exp2f(fminf(acc[ai][bj][m][0][i], 100.f)); p1[i] = __builtin_amdgcn_exp2f(fminf(acc[ai][bj][m][1][i], 100.f)); }
                    rs += ((p0.x + p0.y) + (p0.z + p0.w)) + ((p1.x + p1.y) + (p1.z + p1.w));
                    u32x4 w; w.x = pk2(p0.x, p0.y); w.y = pk2(p0.z, p0.w); w.z = pk2(p1.x, p1.y); w.w = pk2(p1.z, p1.w);
                    *(u32x4*)(P + (size_t)grow * 1024 + u.pn * 256 + bj * 128 + wc * 32 + 8 * fq) = w; }
                rs = rsum<16>(rs); rs = rsum<32>(rs);
                if (fq == 0) RS[((size_t)grow * 4 + u.pn) * 4 + wc] = rs;
                __builtin_amdgcn_sched_barrier(0); }
    } };
struct EpiXSN { static constexpr bool TILE = true; static constexpr int NST = 16; static constexpr int NPRE = 0; bf16_t* P; LAS unsigned char* lds;
    __device__ __forceinline__ void tile(const f32x4 (&acc)[2][2][4][2], const Unit& u, int wr, int wc, int fr_, int fq_) const {
        int fr = fr_, fq = fq_; asm volatile("" : "+v"(fr), "+v"(fq));
        LAS float* part = (LAS float*)(lds + XSN_PART_OFF);
#pragma unroll
        for (int ai = 0; ai < 2; ++ai)
#pragma unroll
            for (int m = 0; m < 4; ++m) { float rs = 0.f;
#pragma unroll
                for (int bj = 0; bj < 2; ++bj)
#pragma unroll
                    for (int n = 0; n < 2; ++n) { f32x4 q;
#pragma unroll
                        for (int i = 0; i < 4; ++i) q[i] = __builtin_amdgcn_exp2f(fminf(acc[ai][bj][m][n][i], 100.f));
                        rs += (q.x + q.y) + (q.z + q.w); }
                rs = rsum<16>(rs); rs = rsum<32>(rs);
                if (fq == 0) part[(ai * 128 + wr * 64 + m * 16 + fr) * 4 + wc] = rs;
                __builtin_amdgcn_sched_barrier(0); }
        asm volatile("s_waitcnt lgkmcnt(0)\n\ts_barrier" ::: "memory");
        float cap = 100.f; asm volatile("" : "+v"(cap));
#pragma unroll
        for (int ai = 0; ai < 2; ++ai)
#pragma unroll
            for (int m = 0; m < 4; ++m) { const int lrow = ai * 128 + wr * 64 + m * 16 + fr; const f32x4 t = *(const LAS f32x4*)(part + lrow * 4); const float r = __builtin_amdgcn_rcpf((t.x + t.y) + (t.z + t.w));
#pragma unroll
                for (int bj = 0; bj < 2; ++bj) { f32x4 q0, q1;
#pragma unroll
                    for (int i = 0; i < 4; ++i) { q0[i] = __builtin_amdgcn_exp2f(fminf(acc[ai][bj][m][0][i], cap)) * r; q1[i] = __builtin_amdgcn_exp2f(fminf(acc[ai][bj][m][1][i], cap)) * r; }
                    *(u32x4*)(P + (size_t)(u.pm * 256 + lrow) * 1024 + u.pn * 256 + bj * 128 + wc * 32 + 8 * fq) = pk8(q0, q1); }
                __builtin_amdgcn_sched_barrier(0); }
    } };
struct EpiXO { static constexpr bool TILE = true; static constexpr int NST = 16; static constexpr int NPRE = 0; bf16_t* O; const float* RS;
    __device__ __forceinline__ void tile(const f32x4 (&acc)[2][2][4][2], const Unit& u, int wr, int wc, int fr, int fq) const {
        const int col0 = u.pn * 256 + wc * 32 + 8 * fq; float rr[2][4];
#pragma unroll
        for (int ai = 0; ai < 2; ++ai)
#pragma unroll
            for (int m = 0; m < 4; ++m) { const int grow = u.pm * 256 + ai * 128 + wr * 64 + m * 16 + fr; const f32x4 q = *(const f32x4*)(RS + ((size_t)grow * 4 + u.pn) * 4); rr[ai][m] = __builtin_amdgcn_rcpf((q.x + q.y) + (q.z + q.w)); }
        asm volatile("s_waitcnt vmcnt(0)" ::: "memory");
#pragma unroll
        for (int ai = 0; ai < 2; ++ai)
#pragma unroll
            for (int m = 0; m < 4; ++m) { const int grow = u.pm * 256 + ai * 128 + wr * 64 + m * 16 + fr; const float r = rr[ai][m];
#pragma unroll
                for (int bj = 0; bj < 2; ++bj) *(u32x4*)(O + (size_t)grow * 1024 + col0 + bj * 128) = pk8(acc[ai][bj][m][0] * r, acc[ai][bj][m][1] * r); }
    }
    __device__ __forceinline__ void st4(const Unit&, int grow, int gcol, f32x4 v) const {
        const f32x4 q = *(const f32x4*)(RS + ((size_t)grow * 4 + (gcol >> 8)) * 4); const float r = __builtin_amdgcn_rcpf((q.x + q.y) + (q.z + q.w)); v = v * r;
        u32x2 w; w.x = pk2(v.x, v.y); w.y = pk2(v.z, v.w); *(u32x2*)(O + (size_t)grow * 1024 + gcol) = w; } };

template <bool PAIR, class Sched, class Epi>
__device__ __forceinline__ void sgemm_phase(const int tid, const GemmDesc g, const Sched& S, const Epi& E) {
    const int wid = tid >> 6, lane = tid & 63, r32 = lane & 31, hi = lane >> 5;
    Unit u;
    for (int i = 0; S.next(i, u); ++i) {
        const int grow = u.pm * 256 + wid * 32 + r32;
        const bf16_t* Ap = g.A + u.aoff + (long)(wid * 32 + r32) * g.lda + hi * 8;
        const bf16_t* Bp = g.Bt + u.boff + (long)r32 * g.ldb + hi * 8;
#pragma unroll 1
        for (int pass = 0; pass < 2; ++pass) {
            int cbs[4];
#pragma unroll
            for (int j = 0; j < 4; ++j) cbs[j] = PAIR ? ((j & 1) + 2 * pass + 4 * (j >> 1)) : (4 * pass + j);
            f32x16 acc[4];
#pragma unroll
            for (int j = 0; j < 4; ++j) acc[j] = f32x16{};
#pragma unroll 2
            for (int k0 = 0; k0 < g.K; k0 += 16) {
                const bf16x8 a = *(const bf16x8*)(Ap + k0);
#pragma unroll
                for (int j = 0; j < 4; ++j) { const bf16x8 b = *(const bf16x8*)(Bp + (long)cbs[j] * 32 * g.ldb + k0); acc[j] = __builtin_amdgcn_mfma_f32_32x32x16_bf16(b, a, acc[j], 0, 0, 0); }
            }
            if constexpr (PAIR) {
#pragma unroll
                for (int j = 0; j < 2; ++j)
#pragma unroll
                    for (int q = 0; q < 4; ++q) { const f32x4 gv = {acc[j][4 * q], acc[j][4 * q + 1], acc[j][4 * q + 2], acc[j][4 * q + 3]};
                        const f32x4 uv = {acc[j + 2][4 * q], acc[j + 2][4 * q + 1], acc[j + 2][4 * q + 2], acc[j + 2][4 * q + 3]};
                        E.st4x2(u, grow, u.pn * 128 + cbs[j] * 32 + 8 * q + 4 * hi, gv, uv); }
            } else {
#pragma unroll
                for (int j = 0; j < 4; ++j)
#pragma unroll
                    for (int q = 0; q < 4; ++q) { const f32x4 v = {acc[j][4 * q], acc[j][4 * q + 1], acc[j][4 * q + 2], acc[j][4 * q + 3]};
                        E.st4(u, grow, u.pn * 256 + cbs[j] * 32 + 8 * q + 4 * hi, v); }
            }
        }
    }
}

namespace pg8 {
constexpr int BK = 64, HALF = 128, HTB = HALF * BK * 2, STAGE_BYTES = 8 * HTB;
__device__ __forceinline__ int lds_byte(int r, int c) { const int st = (r >> 4) * 2 + (c >> 5), rr = r & 15, cc = c & 31, ob = rr * 64 + cc * 2; return st * 1024 + (ob ^ (((ob >> 9) & 1) << 5)); }
__device__ __forceinline__ void stage_rc(int b, int& R, int& C) { const int st = b / 1024, sb = b % 1024, swz = sb ^ (((sb >> 9) & 1) << 5); R = (st >> 1) * 16 + swz / 64; C = (st & 1) * 32 + (swz % 64) / 2; }
__device__ __forceinline__ int perm32(int rho) { const int n = rho >> 4, i = rho & 15; return 8 * (i >> 2) + 4 * n + (i & 3); }
template <bool PAIR, class Epi>
__device__ __forceinline__ void run_epi(const Epi& E, const f32x4 (&acc)[2][2][4][2], const Unit& u, int wr, int wc, int fr, int fq) {
    if constexpr (Epi::TILE) { E.tile(acc, u, wr, wc, fr, fq); return; } else {
#pragma unroll
    for (int ai = 0; ai < 2; ++ai)
#pragma unroll
        for (int m = 0; m < 4; ++m) { const int grow = u.pm * 256 + ai * HALF + wr * 64 + m * 16 + fr;
            if constexpr (PAIR) {
#pragma unroll
                for (int n = 0; n < 2; ++n) E.st4x2(u, grow, u.pn * 128 + wc * 32 + 8 * fq + 4 * n, acc[ai][0][m][n], acc[ai][1][m][n]);
            } else {
#pragma unroll
                for (int bj = 0; bj < 2; ++bj)
#pragma unroll
                    for (int n = 0; n < 2; ++n) E.st4(u, grow, u.pn * 256 + bj * HALF + wc * 32 + 8 * fq + 4 * n, acc[ai][bj][m][n]);
            }
            __builtin_amdgcn_sched_barrier(0); }
    }
}
template <bool PAIR, bool GATH, class Sched, class Epi>
__device__ __forceinline__ void gemm_phase(const int tid, LAS unsigned char* lds, const GemmDesc g, const Sched& S, const Epi& E) {
    const int wid = __builtin_amdgcn_readfirstlane(tid >> 6), lane = tid & 63, wr = wid >> 2, wc = wid & 3, fr = lane & 15, fq = lane >> 4;
    const int K = g.K, nt = K / BK;
    unsigned voffA[2], voffB[2]; int RA[2], CA[2];
#define PG8_VOFFS() do { const int t_ = wid * 64 + hw_lane(); _Pragma("unroll") for (int i = 0; i < 2; ++i) { int R, C; stage_rc(t_ * 16 + i * 8192, R, C); const int Rb = (R & ~31) + perm32(R & 31); RA[i] = R; CA[i] = C * 2; \
        voffA[i] = (unsigned)(R * g.lda + C) * 2u; voffB[i] = (unsigned)(Rb * g.ldb + C) * 2u; } } while (0)
    PG8_VOFFS();
    unsigned cvA[2][2], nvA[2][2];
#define PG8_GVOFF(U, V) do { if constexpr (GATH) { _Pragma("unroll") for (int h_ = 0; h_ < 2; ++h_) _Pragma("unroll") for (int i_ = 0; i_ < 2; ++i_) \
        V[h_][i_] = (unsigned)g.tok[(U).pm * 256 + h_ * HALF + RA[i_]] * (unsigned)(g.lda * 2) + (unsigned)CA[i_]; } } while (0)
    const size_t kstep = (size_t)(BK * 2);
    const size_t hstepA = (size_t)HALF * g.lda * 2, hstepB = (size_t)HALF * g.ldb * 2;
    const unsigned ldsw = (unsigned)wid * 1024u;
    const int aoff = lds_byte(wr * 64 + fr, fq * 8), boff = lds_byte(wc * 32 + fr, fq * 8);
#define PG8_SA(b, h) (((b) * 2 + (h)) * HTB)
#define PG8_SB(b, h) ((4 + (b) * 2 + (h)) * HTB)
#define PG8_STAGE(bufoff, gbase, voff) do { _Pragma("unroll") for (int _i = 0; _i < 2; ++_i) \
        __builtin_amdgcn_global_load_lds((const unsigned*)((const char*)(gbase) + (voff)[_i]), (LAS unsigned*)(lds + (bufoff) + ldsw + _i * 8192), 16, 0, 0); } while (0)
#define PG8_STA(b, h, base, V) do { if constexpr (GATH) PG8_STAGE(PG8_SA(b, h), base, V[h]); else PG8_STAGE(PG8_SA(b, h), (base) + (h) * hstepA, voffA); } while (0)
#define PG8_LDA(dst, b, h) do { _Pragma("unroll") for (int m = 0; m < 4; ++m) _Pragma("unroll") for (int k = 0; k < 2; ++k) dst[m][k] = *(const LAS bf16x8*)(lds + PG8_SA(b, h) + aoff + m * 2048 + k * 1024); } while (0)
#define PG8_LDB(dst, b, h) do { _Pragma("unroll") for (int n = 0; n < 2; ++n) _Pragma("unroll") for (int k = 0; k < 2; ++k) dst[n][k] = *(const LAS bf16x8*)(lds + PG8_SB(b, h) + boff + n * 2048 + k * 1024); } while (0)
#define PG8_MMA(ai, bj, At, Bt) do { __builtin_amdgcn_s_setprio(1); _Pragma("unroll") for (int m = 0; m < 4; ++m) _Pragma("unroll") for (int n = 0; n < 2; ++n) _Pragma("unroll") for (int k = 0; k < 2; ++k) \
        acc[ai][bj][m][n] = __builtin_amdgcn_mfma_f32_16x16x32_bf16(Bt[n][k], At[m][k], acc[ai][bj][m][n], 0, 0, 0); __builtin_amdgcn_s_setprio(0); } while (0)
#define PG8_WAIT_V(n) asm volatile("s_waitcnt vmcnt(" #n ")" ::: "memory")
#define PG8_WAIT_VN(n) asm volatile("s_waitcnt vmcnt(%0)" :: "n"(n) : "memory")
#define PG8_WAIT_L(n) asm volatile("s_waitcnt lgkmcnt(" #n ")" ::: "memory")
#define PG8_BAR __builtin_amdgcn_s_barrier()
#define PG8_SCHED __builtin_amdgcn_sched_barrier(0)
    Unit cur, nxt; int ui = 0;
    if (!S.next(0, cur)) return;
    bool has_next = S.next(1, nxt);
    f32x4 acc[2][2][4][2];
    float zf = 0.f; asm volatile("" : "+v"(zf)); const f32x4 Z4 = {zf, zf, zf, zf};
#pragma unroll
    for (int a = 0; a < 2; ++a)
#pragma unroll
        for (int b = 0; b < 2; ++b)
#pragma unroll
            for (int m = 0; m < 4; ++m)
#pragma unroll
                for (int n = 0; n < 2; ++n) acc[a][b][m][n] = Z4;
    bf16x8 At[4][2], B0[2][2], B1[2][2];
    const char* cA = (const char*)g.A + (GATH ? (size_t)0 : (size_t)cur.aoff * 2); const char* cB = (const char*)g.Bt + (size_t)cur.boff * 2;
    const char* nA = (has_next && !GATH) ? (const char*)g.A + (size_t)nxt.aoff * 2 : cA; const char* nB = has_next ? (const char*)g.Bt + (size_t)nxt.boff * 2 : cB;
    PG8_GVOFF(cur, cvA);
    if constexpr (GATH) { if (has_next) PG8_GVOFF(nxt, nvA); else { _Pragma("unroll") for (int h_ = 0; h_ < 2; ++h_) _Pragma("unroll") for (int i_ = 0; i_ < 2; ++i_) nvA[h_][i_] = cvA[h_][i_]; } }
    PG8_STAGE(PG8_SB(0, 0), cB, voffB); PG8_STAGE(PG8_SB(0, 1), cB + hstepB, voffB); PG8_STA(0, 0, cA, cvA); PG8_STA(0, 1, cA, cvA);
    PG8_STAGE(PG8_SB(1, 0), cB + kstep, voffB); PG8_STA(1, 0, cA + kstep, cvA); PG8_STAGE(PG8_SB(1, 1), cB + hstepB + kstep, voffB); PG8_STA(1, 1, cA + kstep, cvA);
    PG8_WAIT_V(0);
    if (wr == 1) PG8_BAR;
    PG8_BAR;
    constexpr int WX = 8 + Epi::NST + Epi::NPRE;
#define PG8_WAIT_X() do { if constexpr (WX == 8) PG8_WAIT_V(8); else { if (fst) PG8_WAIT_VN(WX); else PG8_WAIT_V(8); } } while (0)
    for (;;) {
        int fst = 1; asm volatile("" : "+s"(fst));
#pragma unroll 1
        for (int t = 0; t < nt; t += 2) {
            const bool last = (t == nt - 2);
            const char* a1 = cA + (size_t)(t + 1) * kstep;
            const char* a2 = last ? nA : cA + (size_t)(t + 2) * kstep; const char* b2 = last ? nB : cB + (size_t)(t + 2) * kstep;
            const char* a3 = a2 + kstep; const char* b3 = b2 + kstep;
            unsigned sv[2][2];
            if constexpr (GATH) { _Pragma("unroll") for (int h_ = 0; h_ < 2; ++h_) _Pragma("unroll") for (int i_ = 0; i_ < 2; ++i_) sv[h_][i_] = last ? nvA[h_][i_] : cvA[h_][i_]; }
            PG8_LDB(B0, 0, 0); PG8_LDB(B1, 0, 1); PG8_SCHED; PG8_LDA(At, 0, 0); if (!fst) PG8_STA(1, 1, a1, cvA); else { if constexpr (Epi::NPRE == 1) E.prefetch(cur, wid, lane); }
            PG8_WAIT_X(); PG8_WAIT_L(0); PG8_BAR; PG8_MMA(0, 0, At, B0); PG8_MMA(0, 1, At, B1); PG8_BAR; PG8_SCHED;
            PG8_LDA(At, 0, 1); PG8_STAGE(PG8_SB(0, 0), b2, voffB); PG8_STAGE(PG8_SB(0, 1), b2 + hstepB, voffB); PG8_STA(0, 0, a2, sv);
            PG8_WAIT_X(); PG8_WAIT_L(0); PG8_BAR; PG8_MMA(1, 0, At, B0); PG8_MMA(1, 1, At, B1); PG8_BAR; PG8_SCHED;
            PG8_LDB(B0, 1, 0); PG8_LDB(B1, 1, 1); PG8_SCHED; PG8_LDA(At, 1, 0); PG8_STA(0, 1, a2, sv);
            PG8_WAIT_X(); PG8_WAIT_L(0); PG8_BAR; PG8_MMA(0, 0, At, B0); PG8_MMA(0, 1, At, B1); PG8_BAR; PG8_SCHED;
            PG8_LDA(At, 1, 1); PG8_STAGE(PG8_SB(1, 0), b3, voffB); PG8_STAGE(PG8_SB(1, 1), b3 + hstepB, voffB); PG8_STA(1, 0, a3, sv);
            PG8_WAIT_V(8); PG8_WAIT_L(0); PG8_BAR; PG8_MMA(1, 0, At, B0); PG8_MMA(1, 1, At, B1); PG8_BAR; PG8_SCHED;
            fst = 0;
        }
        if (wr == 0) PG8_BAR;
        PG8_STA(1, 1, nA + kstep, nvA);
        Unit nn; const bool has_nn = has_next && S.next(ui + 2, nn);
        unsigned n2vA[2][2];
        if constexpr (GATH) { if (has_nn) PG8_GVOFF(nn, n2vA); else { _Pragma("unroll") for (int h_ = 0; h_ < 2; ++h_) _Pragma("unroll") for (int i_ = 0; i_ < 2; ++i_) n2vA[h_][i_] = nvA[h_][i_]; } }
        { const int le_ = hw_lane(); run_epi<PAIR>(E, acc, cur, wr, wc, le_ & 15, le_ >> 4); }
        if (!has_next) break;
#pragma unroll
        for (int a = 0; a < 2; ++a)
#pragma unroll
            for (int b = 0; b < 2; ++b)
#pragma unroll
                for (int m = 0; m < 4; ++m)
#pragma unroll
                    for (int n = 0; n < 2; ++n) acc[a][b][m][n] = Z4;
        PG8_VOFFS();
        cur = nxt; cA = nA; cB = nB; ++ui;
        if constexpr (GATH) { _Pragma("unroll") for (int h_ = 0; h_ < 2; ++h_) _Pragma("unroll") for (int i_ = 0; i_ < 2; ++i_) { cvA[h_][i_] = nvA[h_][i_]; nvA[h_][i_] = n2vA[h_][i_]; } }
        has_next = has_nn;
        if (has_nn) { nxt = nn; if constexpr (!GATH) nA = (const char*)g.A + (size_t)nn.aoff * 2; nB = (const char*)g.Bt + (size_t)nn.boff * 2; }
        if (wr == 1) PG8_BAR;
    }
#undef PG8_WAIT_X
#undef PG8_VOFFS
    PG8_WAIT_V(0);
    PG8_BAR;
#undef PG8_SA
#undef PG8_SB
#undef PG8_STAGE
#undef PG8_LDA
#undef PG8_STA
#undef PG8_GVOFF
#undef PG8_LDB
#undef PG8_MMA
#undef PG8_WAIT_V
#undef PG8_WAIT_VN
#undef PG8_WAIT_L
#undef PG8_BAR
#undef PG8_SCHED
}
}

struct Args { const float* in[37]; float* out; unsigned char* ws; int lo, hi, pad0, pad1; };
enum { I_X = 0, I_MEM, I_LNIN_G, I_LNIN_B, I_WIN, I_WF, I_BF, I_DWW, I_DWB, I_CLG, I_CLB, I_WPW, I_BPW, I_QG, I_KG, I_MQG, I_WUQ, I_MKG, I_WUKV, I_GRPG, I_WO, I_LN1G, I_LN1B,
       I_WXQ, I_WXK, I_WXV, I_WXO, I_LN2G, I_LN2B, I_WR, I_BR, I_WGU, I_BGU, I_WDN, I_BDN, I_LN3G, I_LN3B };

__device__ __forceinline__ int rope_perm16(int d) { const int half = d >> 4, dd = d & 15; return half * 16 + ((dd < 8) ? 2 * dd : 2 * (dd - 8) + 1); }
__device__ __forceinline__ int rope_perm32(int d) { const int half = d >> 5, dd = d & 31; return half * 32 + ((dd < 16) ? 2 * dd : 2 * (dd - 16) + 1); }
__device__ __forceinline__ int map_row(int mode, int n) {
    switch (mode) {
    case 1: if (n < 256) return -1; if (n < 768) return n; if (n < 1152) { const int m = n - 768; return 768 + (m & ~63) + rope_perm32(m & 63); } if (n < 1664) return n; return 1664 + rope_perm16(n - 1664);
    case 2: { const int h = n / 96, p = n % 96; return h * 128 + (p < 64 ? p : 64 + rope_perm16(p - 64)); }
    case 3: return 512 + n;
    case 4: { const int half = n >> 10, m = n & 1023; return (m >> 7) * 256 + half * 128 + (m & 127); }
    default: return n;
    }
}
__device__ __forceinline__ void cp_item(const float* __restrict__ W, bf16_t* dst, float scale, int item, int lane) {
    const int r0 = (item >> 4) * 64 + (lane >> 4), c0 = (item & 15) * 64 + (lane & 15) * 4;
#pragma unroll
    for (int i = 0; i < 16; ++i) { const f32x4 v = *(const f32x4*)(W + (size_t)(r0 + 4 * i) * 1024 + c0) * scale; u32x2 w; w.x = pk2(v.x, v.y); w.y = pk2(v.z, v.w); *(u32x2*)(dst + (size_t)(r0 + 4 * i) * 1024 + c0) = w; }
}
__device__ __forceinline__ int fnet_j(int cc) { const int jp = cc >> 1, second = cc & 1; return jp == 0 ? (second ? 32 : 0) : (second ? 64 - jp : jp); }
__device__ __forceinline__ void tr_item(const float* __restrict__ W, int N, bf16_t* dst, int ldd, int koff, const float* kgain, float scale, int mode, int rowbase, LAS float* scr, int item, int lane, int kperm = 0) {
    const int nblk = (N + 63) >> 6, kb = item / nblk, nb = item - kb * nblk, k0 = kb * 64, n0 = nb * 64;
    const int nq = (lane & 15) * 4, kq = lane >> 4;
    const bool ok = (n0 + nq) < N;
    f32x4 v[16];
#pragma unroll
    for (int i = 0; i < 16; ++i) { const int kk = 4 * i + kq; const int ksrc = kperm ? (((k0 + kk) & ~63) + fnet_j((k0 + kk) & 63)) : (k0 + kk); v[i] = ok ? *(const f32x4*)(W + (size_t)ksrc * N + n0 + nq) : (f32x4){0.f, 0.f, 0.f, 0.f}; }
#pragma unroll
    for (int i = 0; i < 16; ++i) { const int kk = 4 * i + kq; const float gs = (kgain ? kgain[k0 + kk] : 1.f) * scale;
        scr[kk * 65 + nq + 0] = v[i].x * gs; scr[kk * 65 + nq + 1] = v[i].y * gs; scr[kk * 65 + nq + 2] = v[i].z * gs; scr[kk * 65 + nq + 3] = v[i].w * gs; }
    LDS_WAIT(); asm volatile("" ::: "memory");
    const int c = lane & 7;
#pragma unroll
    for (int j = 0; j < 8; ++j) { const int n = (lane >> 3) + 8 * j;
        if (n0 + n < N) { const int row = map_row(mode, n0 + n);
            if (row >= 0) { const LAS float* s = scr + (8 * c) * 65 + n;
                u32x4 o; o.x = pk2(s[0 * 65], s[1 * 65]); o.y = pk2(s[2 * 65], s[3 * 65]); o.z = pk2(s[4 * 65], s[5 * 65]); o.w = pk2(s[6 * 65], s[7 * 65]);
                *(u32x4*)(dst + (size_t)(rowbase + row) * ldd + koff + k0 + 8 * c) = o; } } }
    LDS_WAIT(); asm volatile("" ::: "memory");
}
constexpr int IT_IN = 16 * 27, IT_UQ = 4 * 6, IT_UKV = 2 * 8, IT_F = 16, IT_SQ = 256, IT_GU = 32 * 512, IT_DN = 32 * 256;
constexpr int IT_SMALL = IT_IN + IT_UQ + IT_UKV + 2 * IT_F + 5 * IT_SQ, IT_MOE = IT_GU + IT_DN;

struct R8 { f32x4 lo, hi; };
__device__ __forceinline__ R8 unpack8(const u32x4 w) { R8 r; r.lo = (f32x4){bflo(w.x), bfhi(w.x), bflo(w.y), bfhi(w.y)}; r.hi = (f32x4){bflo(w.z), bfhi(w.z), bflo(w.w), bfhi(w.w)}; return r; }
__device__ __forceinline__ u32x4 pack8(const R8& r) { return (u32x4){pk2(r.lo.x, r.lo.y), pk2(r.lo.z, r.lo.w), pk2(r.hi.x, r.hi.y), pk2(r.hi.z, r.hi.w)}; }
__device__ __forceinline__ float hsum8(const R8& r) { return ((r.lo.x + r.lo.y) + (r.lo.z + r.lo.w)) + ((r.hi.x + r.hi.y) + (r.hi.z + r.hi.w)); }
__device__ __forceinline__ float hsq8(const R8& r) { return ((r.lo.x * r.lo.x + r.lo.y * r.lo.y) + (r.lo.z * r.lo.z + r.lo.w * r.lo.w)) + ((r.hi.x * r.hi.x + r.hi.y * r.hi.y) + (r.hi.z * r.hi.z + r.hi.w * r.hi.w)); }
template <int NR>
__device__ __forceinline__ void ln_rows(R8 (&v)[NR][2], const float* g, const float* b, int lane) {
    float mean[NR], rstd[NR];
#pragma unroll
    for (int q = 0; q < NR; ++q) mean[q] = hsum8(v[q][0]) + hsum8(v[q][1]);
#pragma unroll
    for (int q = 0; q < NR; ++q) mean[q] = rsum<2>(rsum<1>(mean[q]));
#pragma unroll
    for (int q = 0; q < NR; ++q) mean[q] = rsum<8>(rsum<4>(mean[q]));
#pragma unroll
    for (int q = 0; q < NR; ++q) mean[q] = rsum<32>(rsum<16>(mean[q]));
#pragma unroll
    for (int q = 0; q < NR; ++q) { mean[q] *= (1.f / D);
#pragma unroll
        for (int j = 0; j < 2; ++j) { v[q][j].lo = v[q][j].lo - mean[q]; v[q][j].hi = v[q][j].hi - mean[q]; }
        rstd[q] = hsq8(v[q][0]) + hsq8(v[q][1]); }
#pragma unroll
    for (int q = 0; q < NR; ++q) rstd[q] = rsum<2>(rsum<1>(rstd[q]));
#pragma unroll
    for (int q = 0; q < NR; ++q) rstd[q] = rsum<8>(rsum<4>(rstd[q]));
#pragma unroll
    for (int q = 0; q < NR; ++q) rstd[q] = rsum<32>(rsum<16>(rstd[q]));
#pragma unroll
    for (int j = 0; j < 2; ++j) { const f32x4 g0 = *(const f32x4*)(g + 512 * j + 8 * lane), g1 = *(const f32x4*)(g + 512 * j + 8 * lane + 4), b0 = *(const f32x4*)(b + 512 * j + 8 * lane), b1 = *(const f32x4*)(b + 512 * j + 8 * lane + 4);
#pragma unroll
        for (int q = 0; q < NR; ++q) { const float r = __builtin_amdgcn_rsqf(rstd[q] * (1.f / D) + LN_EPS); v[q][j].lo = v[q][j].lo * r * g0 + b0; v[q][j].hi = v[q][j].hi * r * g1 + b1; } }
}
__device__ __forceinline__ void store_row_bf16(bf16_t* row, const R8 (&v)[2], int lane) {
#pragma unroll
    for (int j = 0; j < 2; ++j) *(u32x4*)(row + 512 * j + 8 * lane) = pack8(v[j]);
}
__device__ __forceinline__ void store_row_f32(float* row, const R8 (&v)[2], int lane) {
#pragma unroll
    for (int j = 0; j < 2; ++j) { *(f32x4*)(row + 512 * j + 8 * lane) = v[j].lo; *(f32x4*)(row + 512 * j + 8 * lane + 4) = v[j].hi; }
}

struct MoeWItem { const float* W; bf16_t* dst; int N, mode, rowbase, k0, n0; };
__device__ __forceinline__ MoeWItem moe_w_item(const Args& a, int it) {
    MoeWItem m; const int l = it / IT_MOE; int r = it - l * IT_MOE; unsigned char* wl = a.ws + WS_W + (size_t)l * WL_SIZE; int item;
    if (r < IT_GU) { const int e = r >> 9; m.W = a.in[I_WGU] + ((size_t)l * NE + e) * 1024 * 2048; m.N = 2048; m.dst = (bf16_t*)(wl + WL_GU); m.mode = 4; m.rowbase = e * 2048; item = r & 511; }
    else { r -= IT_GU; const int e = r >> 8; m.W = a.in[I_WDN] + ((size_t)l * NE + e) * 1024 * 1024; m.N = 1024; m.dst = (bf16_t*)(wl + WL_DN); m.mode = 0; m.rowbase = e * 1024; item = r & 255; }
    const int nblk = m.N >> 6, kb = item / nblk, nb = item - kb * nblk; m.k0 = kb * 64; m.n0 = nb * 64; return m;
}
__device__ __forceinline__ void moe_w_load(const MoeWItem& m, int lane, f32x4 (&v)[16]) {
    const float* src = m.W + (size_t)(m.k0 + 2 * (lane >> 4)) * m.N + m.n0 + (lane & 15) * 4;
#pragma unroll
    for (int i = 0; i < 8; ++i) { v[2 * i] = __builtin_nontemporal_load((const f32x4*)(src + (size_t)(8 * i) * m.N)); v[2 * i + 1] = __builtin_nontemporal_load((const f32x4*)(src + (size_t)(8 * i + 1) * m.N)); }
}
__device__ __forceinline__ void moe_w_finish(const MoeWItem& m, int lane, const f32x4 (&v)[16], LAS float* scr) {
    const int l = lane & 15, kq = lane >> 4; LAS unsigned* sw = (LAS unsigned*)scr;
#pragma unroll
    for (int i = 0; i < 8; ++i) { LAS unsigned* w = sw + (4 * l) * 32 + 4 * (i ^ (l & 7)) + kq;
        w[0] = pk2(v[2 * i].x, v[2 * i + 1].x); w[32] = pk2(v[2 * i].y, v[2 * i + 1].y); w[64] = pk2(v[2 * i].z, v[2 * i + 1].z); w[96] = pk2(v[2 * i].w, v[2 * i + 1].w); }
    LDS_WAIT(); asm volatile("" ::: "memory");
    const int c = lane & 7;
#pragma unroll
    for (int j = 0; j < 8; ++j) { const int n = (lane >> 3) + 8 * j; const int row = map_row(m.mode, m.n0 + n);
        const u32x4 o = *(const LAS u32x4*)(sw + n * 32 + 4 * (c ^ ((n >> 2) & 7)));
        *(u32x4*)(m.dst + (size_t)(m.rowbase + row) * 1024 + m.k0 + 8 * c) = o; }
    LDS_WAIT(); asm volatile("" ::: "memory");
}
__device__ __forceinline__ void moe_weight_items(const int tid, const int bid, const Args& a, LAS unsigned char* lds) {
    const int lane = tid & 63, wave = tid >> 6;
    const int gw = bid * NWAVES + wave, NGW = gridDim.x * NWAVES;
    LAS float* scr = (LAS float*)(lds + wave * 16640);
    static_assert((NLAYER * IT_MOE) % (256 * NWAVES * 2) == 0, "every wave converts an even number of tiles");
    f32x4 va[16], vb[16];
    MoeWItem ma = moe_w_item(a, gw), mb; moe_w_load(ma, lane, va);
#pragma unroll 1
    for (int it = gw; it < NLAYER * IT_MOE; it += 2 * NGW) {
        mb = moe_w_item(a, it + NGW); moe_w_load(mb, lane, vb);
        moe_w_finish(ma, lane, va, scr);
        if (it + 2 * NGW < NLAYER * IT_MOE) { ma = moe_w_item(a, it + 2 * NGW); moe_w_load(ma, lane, va); }
        moe_w_finish(mb, lane, vb, scr);
    }
}
__device__ __forceinline__ void phase_pre0(const int tid, const int bid, const Args& a, LAS unsigned char* lds) {
    const int lane = tid & 63, wave = tid >> 6;
    const int gw = bid * NWAVES + wave, NGW = gridDim.x * NWAVES;
    const long gt = (long)bid * NTHREADS + tid, NGT = (long)gridDim.x * NTHREADS;
    unsigned char* ws = a.ws;
    LAS float* scr = (LAS float*)(lds + wave * 16640);
    for (int it = gw; it < NLAYER * IT_SMALL; it += NGW) {
        const int l = it / IT_SMALL; int r = it - l * IT_SMALL;
        unsigned char* wl = ws + WS_W + (size_t)l * WL_SIZE;
        if (r < IT_IN) { tr_item(a.in[I_WIN] + (size_t)l * 1024 * INC, INC, (bf16_t*)(wl + WL_IN), 1024, 0, nullptr, 1.f, 1, 0, scr, r, lane); continue; } r -= IT_IN;
        if (r < IT_UQ) { tr_item(a.in[I_WUQ] + (size_t)l * 256 * 384, 384, (bf16_t*)(wl + WL_MLA), 384, 0, a.in[I_MQG] + l * 256, QSCALE_M, 2, 0, scr, r, lane); continue; } r -= IT_UQ;
        if (r < IT_UKV) { tr_item(a.in[I_WUKV] + (size_t)l * 128 * 512, 512, (bf16_t*)(wl + WL_MLA), 384, 256, a.in[I_MKG] + l * 128, 1.f, 3, 0, scr, r, lane); continue; } r -= IT_UKV;
        if (r < IT_F) { tr_item(a.in[I_WF] + (size_t)l * 65536, 256, (bf16_t*)(wl + WL_FC), 256, 0, nullptr, 1.f, 0, 0, scr, r, lane, 1); continue; } r -= IT_F;
        if (r < IT_F) { tr_item(a.in[I_WPW] + (size_t)l * 65536, 256, (bf16_t*)(wl + WL_FC), 256, 0, nullptr, 1.f, 0, 256, scr, r, lane); continue; } r -= IT_F;
        if (r < IT_SQ) { tr_item(a.in[I_WO] + (size_t)l * D * D, D, (bf16_t*)(wl + WL_O), D, 0, a.in[I_GRPG] + l * 1024, 1.f, 0, 0, scr, r, lane); continue; } r -= IT_SQ;
        if (r < IT_SQ) { cp_item(a.in[I_WXQ] + (size_t)l * D * D, (bf16_t*)(wl + WL_XQ), QSCALE_X, r, lane); continue; } r -= IT_SQ;
        if (r < IT_SQ) { tr_item(a.in[I_WXK] + (size_t)l * D * D, D, (bf16_t*)(wl + WL_XK), D, 0, nullptr, 1.f, 0, 0, scr, r, lane); continue; } r -= IT_SQ;
        if (r < IT_SQ) { tr_item(a.in[I_WXV] + (size_t)l * D * D, D, (bf16_t*)(wl + WL_XV), D, 0, nullptr, 1.f, 0, 0, scr, r, lane); continue; } r -= IT_SQ;
        { tr_item(a.in[I_WXO] + (size_t)l * D * D, D, (bf16_t*)(wl + WL_XO), D, 0, nullptr, 1.f, 0, 0, scr, r, lane); }
    }
    for (long idx = gt; idx < (long)NLAYER * 256 * 1024; idx += NGT) {
        const int l = (int)(idx >> 18), k = (int)(idx >> 8) & 1023, n = (int)idx & 255, g = n >> 6, cc = n & 63, jp = cc >> 1, second = cc & 1;
        const int mult = (jp == 0 && second) ? 32 : jp; const bool use_cos = (second == 0) || (jp == 0);
        const float* w = a.in[I_WIN] + ((size_t)l * 1024 + k) * INC + g * 64; float acc = 0.f;
#pragma unroll 8
        for (int c = 0; c < 64; ++c) { const float fr = (float)((mult * c) & 63) * (1.f / 64.f); const float cv = __builtin_amdgcn_cosf(fr), sv = -__builtin_amdgcn_sinf(fr); acc += w[c] * (use_cos ? cv : sv); }
        ((bf16_t*)(ws + WS_W + (size_t)l * WL_SIZE + WL_IN))[(size_t)n * 1024 + k] = (bf16_t)f2bf(acc);
    }
    for (long idx = gt; idx < (long)NLAYER * 96 * 1024; idx += NGT) { const int l = (int)(idx / (96 * 1024)); const long r = idx % (96 * 1024);
        ((bf16_t*)(ws + WS_W + (size_t)l * WL_SIZE + WL_IN))[(size_t)INC * 1024 + r] = 0; }
    for (long idx = gt; idx < (long)NLAYER * 1024 * 384; idx += NGT) { const int l = (int)(idx / (1024 * 384)); const int r = (int)(idx % (1024 * 384)), row = r / 384, k = r % 384;
        const bool pad = (row < 512) ? (k >= 256 || (row & 127) >= 96) : (k < 256);
        if (pad) ((bf16_t*)(ws + WS_W + (size_t)l * WL_SIZE + WL_MLA))[r] = 0; }
    for (long idx = gt; idx < (long)NLAYER * 32 * 1024; idx += NGT) { const int l = (int)(idx >> 15), e = (int)(idx >> 10) & 31, k = (int)idx & 1023;
        const float w = a.in[I_WR][((size_t)l * 1024 + k) * 32 + e]; const unsigned hb = f2bf(w); const unsigned lb = f2bf(w - bf2f(hb));
        bf16_t* wr = (bf16_t*)(ws + WS_W + (size_t)l * WL_SIZE + WL_RT); wr[e * 1024 + k] = (bf16_t)hb; wr[32768 + e * 1024 + k] = (bf16_t)lb; }
    for (long idx = gt; idx < (long)NB * MEML * D / 4; idx += NGT) { const f32x4 v = *(const f32x4*)(a.in[I_MEM] + idx * 4); u32x2 w; w.x = pk2(v.x, v.y); w.y = pk2(v.z, v.w); *(u32x2*)((bf16_t*)(ws + WS_MEMB) + idx * 4) = w; }
    for (int m0 = gw; m0 < T; m0 += 4 * NGW) { R8 v[4][2];
#pragma unroll
        for (int q = 0; q < 4; ++q) { const float* xr = a.in[I_X] + (size_t)(m0 + q * NGW) * D;
#pragma unroll
            for (int j = 0; j < 2; ++j) { v[q][j].lo = *(const f32x4*)(xr + 512 * j + 8 * lane); v[q][j].hi = *(const f32x4*)(xr + 512 * j + 8 * lane + 4); } }
        ln_rows<4>(v, a.in[I_LNIN_G], a.in[I_LNIN_B], lane);
#pragma unroll
        for (int q = 0; q < 4; ++q) store_row_bf16((bf16_t*)(ws + WS_HB) + (size_t)(m0 + q * NGW) * D, v[q], lane); }
}

struct LayerCtx {
    int l; unsigned char* ws; unsigned char* wl;
    bf16_t *Z, *FC, *QG, *KG, *CQKV, *KR, *QKVM, *Y, *XQ, *PB, *XO, *XS, *ACT, *YS, *HB;
    float *YMIX, *RS; bf16_t* FB;
    int *RE, *RR, *DEST, *TOK; float* GATE; unsigned* cnt;
};
__device__ __forceinline__ LayerCtx make_ctx(const Args& a, int l) {
    LayerCtx c; c.l = l; c.ws = a.ws; c.wl = a.ws + WS_W + (size_t)l * WL_SIZE; unsigned char* r = a.ws + WS_R;
    c.Z = (bf16_t*)(r + R_Z); c.FC = (bf16_t*)(r + R_FC); c.QG = (bf16_t*)(r + R_QG); c.KG = (bf16_t*)(r + R_KG); c.CQKV = (bf16_t*)(r + R_CQKV); c.KR = (bf16_t*)(r + R_KR);
    c.QKVM = (bf16_t*)(r + R_QKVM); c.YMIX = (float*)(r + R_YMIX); c.Y = (bf16_t*)(r + R_Y);
    c.XQ = (bf16_t*)(r + R_XQ); c.RS = (float*)(a.ws + WS_F + 64 * MiB); c.PB = (bf16_t*)(r + R_PB); c.XO = (bf16_t*)(r + R_XO);
    c.XS = (bf16_t*)(r + R_XS); c.ACT = (bf16_t*)(r + R_ACT); c.YS = (bf16_t*)(r + R_XS);
    c.HB = (bf16_t*)(a.ws + WS_HB); c.FB = (bf16_t*)(a.ws + WS_F);
    c.RE = (int*)(a.ws + WS_ROUTE); c.RR = c.RE + T * 4; c.GATE = (float*)(c.RR + T * 4); c.DEST = (int*)(c.GATE + T * 4);
    c.cnt = (unsigned*)(a.ws + WS_CTL) + CW_CNT + MAXWG * 32 * l; c.TOK = (int*)(a.ws + WS_CTL) + CW_TOK;
    return c;
}
constexpr float L2_THETA = 13.287712379549449f;

__device__ __forceinline__ void conv_item(const int tid, const Args& a, const LayerCtx& c, int item, LAS unsigned char* lds) {
    const int lane = tid & 63, wave = tid >> 6;
    LAS float* U = (LAS float*)lds; LAS float* CO = (LAS float*)lds;
    const int t0 = item * 64, b = t0 >> 13, s0 = t0 & (SEQ - 1);
#pragma unroll
    for (int i = 0; i < 6; ++i) { const int idx = tid + NTHREADS * i, row = idx >> 5, c8 = (idx & 31) * 8, sq = s0 - 15 + row;
        if (row < 94) { f32x4 u0 = {0.f, 0.f, 0.f, 0.f}, u1 = {0.f, 0.f, 0.f, 0.f};
            if (sq >= 0 && sq < SEQ) { const bf16_t* z = c.Z + (size_t)(b * SEQ + sq) * ZC; const R8 av = unpack8(*(const u32x4*)(z + ZC_CA + c8)), gv = unpack8(*(const u32x4*)(z + ZC_CG + c8));
#pragma unroll
                for (int e = 0; e < 4; ++e) { u0[e] = av.lo[e] * sigmoidf_(gv.lo[e]); u1[e] = av.hi[e] * sigmoidf_(gv.hi[e]); } }
            *(LAS f32x4*)(U + row * 256 + c8) = u0; *(LAS f32x4*)(U + row * 256 + c8 + 4) = u1; } }
    __syncthreads();
    { const int ch = tid & 255, half = tid >> 8; const float* dw = a.in[I_DWW] + (size_t)c.l * 31 * 256 + ch; const float bias = a.in[I_DWB][c.l * 256 + ch];
      float wv[31], win[62];
#pragma unroll
      for (int w = 0; w < 31; ++w) wv[w] = dw[w * 256];
#pragma unroll
      for (int r = 0; r < 62; ++r) win[r] = U[(half * 32 + r) * 256 + ch];
      __syncthreads();
#pragma unroll
      for (int o = 0; o < 32; ++o) { float acc = bias;
#pragma unroll
          for (int w = 0; w < 31; ++w) acc += win[o + w] * wv[w];
          CO[(half * 32 + o) * 256 + ch] = acc; } }
    __syncthreads();
    { const float* cg = a.in[I_CLG] + c.l * 256; const float* cb = a.in[I_CLB] + c.l * 256;
      const f32x4 gg = *(const f32x4*)(cg + 4 * lane), bb = *(const f32x4*)(cb + 4 * lane);
#pragma unroll
      for (int q0 = 0; q0 < 8; q0 += 4) { f32x4 x[4]; float mean[4], var[4];
#pragma unroll
          for (int q = 0; q < 4; ++q) { x[q] = *(const LAS f32x4*)(CO + (wave * 8 + q0 + q) * 256 + 4 * lane); mean[q] = (x[q].x + x[q].y) + (x[q].z + x[q].w); }
#pragma unroll
          for (int q = 0; q < 4; ++q) mean[q] = wave_sum(mean[q]);
#pragma unroll
          for (int q = 0; q < 4; ++q) { x[q] = x[q] - mean[q] * (1.f / 256.f); var[q] = (x[q].x * x[q].x + x[q].y * x[q].y) + (x[q].z * x[q].z + x[q].w * x[q].w); }
#pragma unroll
          for (int q = 0; q < 4; ++q) var[q] = wave_sum(var[q]);
#pragma unroll
          for (int q = 0; q < 4; ++q) { const float rstd = __builtin_amdgcn_rsqf(var[q] * (1.f / 256.f) + LN_EPS); f32x4 y = x[q] * rstd * gg + bb;
#pragma unroll
              for (int e = 0; e < 4; ++e) y[e] = y[e] * sigmoidf_(y[e]);
              u32x2 w; w.x = pk2(y.x, y.y); w.y = pk2(y.z, y.w); *(u32x2*)(c.FC + (size_t)(t0 + wave * 8 + q0 + q) * 512 + 256 + 4 * lane) = w; } } }
    __syncthreads();
}

struct QkRaw { u32x2 q; unsigned k; u32x2 cq; unsigned ckv; unsigned kr; };
__device__ __forceinline__ QkRaw qkprep_load(const LayerCtx& c, int t, int lane) { const bf16_t* z = c.Z + (size_t)t * ZC; QkRaw r;
    r.q = *(const u32x2*)(z + ZC_Q + 4 * lane); r.k = *(const unsigned*)(z + ZC_K + 2 * lane); r.cq = *(const u32x2*)(z + ZC_CQ + 4 * lane); r.ckv = *(const unsigned*)(z + ZC_CKV + 2 * lane);
    r.kr = (lane < 16) ? *(const unsigned*)(z + ZC_KR + 2 * lane) : 0u; return r; }
__device__ __forceinline__ void qkprep_row(const Args& a, const LayerCtx& c, int t, int lane, const QkRaw& raw) {
    const int s = t & (SEQ - 1); const float prow = (float)(s >> 6), pcol = (float)(s & 63);
    {
        const u32x2 w = raw.q; float x0 = bflo(w.x), x1 = bfhi(w.x), x2 = bflo(w.y), x3 = bfhi(w.y);
        float ss = (x0 * x0 + x1 * x1) + (x2 * x2 + x3 * x3);
        ss = rsum<1>(ss); ss = rsum<2>(ss); ss = rsum<4>(ss); ss = rsum<8>(ss);
        const float rstd = __builtin_amdgcn_rsqf(ss * (1.f / 64.f) + RMS_EPS);
        const int p = 4 * (lane & 15), half = p >> 5, i0 = (p & 31) >> 1; const float* qg = a.in[I_QG] + c.l * 64 + half * 32;
        x0 *= rstd * qg[i0]; x1 *= rstd * qg[16 + i0]; x2 *= rstd * qg[i0 + 1]; x3 *= rstd * qg[16 + i0 + 1];
        const float pos = half ? pcol : prow;
        rope2(x0, x1, pos * __builtin_amdgcn_exp2f(-(float)i0 * (L2_THETA / 16.f))); rope2(x2, x3, pos * __builtin_amdgcn_exp2f(-(float)(i0 + 1) * (L2_THETA / 16.f)));
        u32x2 o; o.x = pk2(x0 * QSCALE_G, x1 * QSCALE_G); o.y = pk2(x2 * QSCALE_G, x3 * QSCALE_G); *(u32x2*)(c.QG + (size_t)t * 256 + 4 * lane) = o;
    }
    {
        const unsigned w = raw.k; float x0 = bflo(w), x1 = bfhi(w);
        float ss = x0 * x0 + x1 * x1;
        ss = rsum<1>(ss); ss = rsum<2>(ss); ss = rsum<4>(ss); ss = rsum<8>(ss); ss = rsum<16>(ss);
        const float rstd = __builtin_amdgcn_rsqf(ss * (1.f / 64.f) + RMS_EPS);
        const int p = (2 * lane) & 63, half = p >> 5, i0 = (p & 31) >> 1; const float* kg = a.in[I_KG] + c.l * 64 + half * 32;
        x0 *= rstd * kg[i0]; x1 *= rstd * kg[16 + i0];
        rope2(x0, x1, (half ? pcol : prow) * __builtin_amdgcn_exp2f(-(float)i0 * (L2_THETA / 16.f)));
        *(unsigned*)(c.KG + (size_t)t * 128 + 2 * lane) = pk2(x0, x1);
    }
    {
        const u32x2 w = raw.cq; const float x0 = bflo(w.x), x1 = bfhi(w.x), x2 = bflo(w.y), x3 = bfhi(w.y);
        const float rstd = __builtin_amdgcn_rsqf(wave_sum((x0 * x0 + x1 * x1) + (x2 * x2 + x3 * x3)) * (1.f / 256.f) + RMS_EPS);
        u32x2 o; o.x = pk2(x0 * rstd, x1 * rstd); o.y = pk2(x2 * rstd, x3 * rstd); *(u32x2*)(c.CQKV + (size_t)t * 384 + 4 * lane) = o;
    }
    {
        const unsigned w = raw.ckv; const float x0 = bflo(w), x1 = bfhi(w);
        const float rstd = __builtin_amdgcn_rsqf(wave_sum(x0 * x0 + x1 * x1) * (1.f / 128.f) + RMS_EPS);
        *(unsigned*)(c.CQKV + (size_t)t * 384 + 256 + 2 * lane) = pk2(x0 * rstd, x1 * rstd);
    }
    if (lane < 16) {
        const unsigned w = raw.kr; float x0 = bflo(w), x1 = bfhi(w);
        const int half = lane >> 3, i0 = lane & 7;
        rope2(x0, x1, (half ? pcol : prow) * __builtin_amdgcn_exp2f(-(float)i0 * (L2_THETA / 8.f)));
        *(unsigned*)(c.KR + (size_t)t * 32 + 2 * lane) = pk2(x0, x1);
    }
}

__device__ __forceinline__ void dft_table(const int tid, LAS unsigned char* lds) {
    LAS f32x2* tw = (LAS f32x2*)lds;
    for (int m = tid; m < SEQ; m += NTHREADS) { const float x = (float)m * (1.f / 4096.f); tw[m] = (f32x2){cospif(x), sinpif(x)}; }
    __syncthreads();
}
__device__ __forceinline__ void dft_naive_unit(const int tid, const LayerCtx& c, int unit, LAS unsigned char* lds) {
    const LAS f32x2* tw = (const LAS f32x2*)lds;
    const int kk = tid >> 7, pair = tid & 127, g = pair >> 5, jp = pair & 31;
    const int b = unit >> 11, k = ((unit & 2047) << 2) + kk;
    const bf16_t* zp = c.Z + (size_t)b * SEQ * ZC + g * 64 + 2 * jp;
    float acc0 = 0.f, acc1 = 0.f; int idx = 0;
    for (int s = 0; s < SEQ; ++s) { const unsigned w = *(const unsigned*)(zp + (size_t)s * ZC); const f32x2 cs = tw[idx]; idx = (idx + k) & (SEQ - 1);
        acc0 += bflo(w) * cs.x; acc1 += bfhi(w) * (jp == 0 ? cs.x : cs.y); }
    bf16_t* o = c.FC + (size_t)(b * SEQ + k) * 512 + g * 64;
    if (jp == 0) { o[0] = (bf16_t)f2bf(acc0); o[32] = (bf16_t)f2bf(acc1); }
    else { o[jp] = (bf16_t)f2bf(acc0 + acc1); o[64 - jp] = (bf16_t)f2bf(acc0 - acc1); }
}

namespace fft {
constexpr int L_XI = 16384, L_FI = 32768, L_CS = 65536;
__device__ __forceinline__ float cosrev(float x) { return __builtin_amdgcn_cosf(x); }
__device__ __forceinline__ float sinrev(float x) { return __builtin_amdgcn_sinf(x); }
__device__ __forceinline__ void build_table(const int tid, LAS unsigned char* lds) {
#pragma unroll 1
    for (int e = tid; e < 4096; e += NTHREADS) { const int lane = e & 63, cs = (e >> 6) & 1, ks = (e >> 7) & 7, nb = e >> 10; const int k1 = 32 * nb + (lane & 31), h = lane >> 5;
        unsigned w[4];
#pragma unroll
        for (int j = 0; j < 4; ++j) { const int m0 = ((16 * ks + 8 * h + 2 * j) * k1) & 127, m1 = ((16 * ks + 8 * h + 2 * j + 1) * k1) & 127; const float f0 = (float)m0 * (1.f / 128.f), f1 = (float)m1 * (1.f / 128.f);
            w[j] = cs ? pk2(sinrev(f0), sinrev(f1)) : pk2(cosrev(f0), cosrev(f1)); }
        *(LAS u32x4*)(lds + L_CS + e * 16) = (u32x4){w[0], w[1], w[2], w[3]}; }
}
struct F64Frags { bf16x8 c[2][2], s[2][2]; };
__device__ __forceinline__ void build_f64(const int tid, F64Frags& F) {
    const int wid = tid >> 6, lane = tid & 63, r32 = lane & 31, hi = lane >> 5, k2 = 32 * (wid >> 2) + r32;
#pragma unroll
    for (int mb = 0; mb < 2; ++mb)
#pragma unroll
        for (int st = 0; st < 2; ++st) { unsigned wc[4], wsn[4];
#pragma unroll
            for (int jj = 0; jj < 4; ++jj) { const int j0 = 2 * jj, j1 = 2 * jj + 1;
                const int sa = 32 * mb + 16 * st + 8 * (j0 >> 2) + 4 * hi + (j0 & 3), sb = 32 * mb + 16 * st + 8 * (j1 >> 2) + 4 * hi + (j1 & 3);
                const float fa = (float)((sa * k2) & 63) * (1.f / 64.f), fb = (float)((sb * k2) & 63) * (1.f / 64.f);
                wc[jj] = pk2(cosrev(fa), cosrev(fb)); wsn[jj] = pk2(sinrev(fa), sinrev(fb)); }
            F.c[mb][st] = __builtin_bit_cast(bf16x8, (u32x4){wc[0], wc[1], wc[2], wc[3]}); F.s[mb][st] = __builtin_bit_cast(bf16x8, (u32x4){wsn[0], wsn[1], wsn[2], wsn[3]}); }
}
__device__ __forceinline__ bf16x8 negbf(bf16x8 x) { u32x4 w = __builtin_bit_cast(u32x4, x); w ^= 0x80008000u; return __builtin_bit_cast(bf16x8, w); }
__device__ __forceinline__ void unit(const int tid, const LayerCtx& c, const int u, LAS unsigned char* lds, const F64Frags& F) {
    const int wid = tid >> 6, lane = tid & 63, r32 = lane & 31, hi = lane >> 5, nb = wid & 3, kb = wid >> 2;
    const int b = u >> 7, g = (u >> 5) & 3, jp = u & 31;
    const bf16_t* zp = c.Z + (size_t)b * SEQ * ZC + g * 64 + 2 * jp;
#pragma unroll 4
    for (int i = 0; i < 16; ++i) { const int sx = tid + NTHREADS * i, s2 = sx & 63, s1 = sx >> 6; const unsigned w = *(const unsigned*)(zp + (size_t)sx * ZC);
        const int off = s2 * 256 + ((((s1 >> 3) ^ (s2 & 15))) << 4) + (s1 & 7) * 2;
        *(LAS unsigned short*)(lds + off) = (unsigned short)(w & 0xffffu); *(LAS unsigned short*)(lds + L_XI + off) = (unsigned short)(w >> 16); }
    __syncthreads();
    f32x16 GR[2], GI[2];
#pragma unroll
    for (int mb = 0; mb < 2; ++mb) { GR[mb] = f32x16{}; GI[mb] = f32x16{}; }
#pragma unroll
    for (int ks = 0; ks < 8; ++ks) {
        const bf16x8 cf = *(const LAS bf16x8*)(lds + L_CS + ((nb * 8 + ks) * 2 + 0) * 1024 + lane * 16), sf = *(const LAS bf16x8*)(lds + L_CS + ((nb * 8 + ks) * 2 + 1) * 1024 + lane * 16);
#pragma unroll
        for (int mb = 0; mb < 2; ++mb) { const int row = 32 * mb + r32, off = row * 256 + (((2 * ks + hi) ^ (row & 15)) << 4);
            const bf16x8 xr = *(const LAS bf16x8*)(lds + off), xi = *(const LAS bf16x8*)(lds + L_XI + off); const bf16x8 nxr = negbf(xr);
            GR[mb] = __builtin_amdgcn_mfma_f32_32x32x16_bf16(xr, cf, GR[mb], 0, 0, 0); GR[mb] = __builtin_amdgcn_mfma_f32_32x32x16_bf16(xi, sf, GR[mb], 0, 0, 0);
            GI[mb] = __builtin_amdgcn_mfma_f32_32x32x16_bf16(xi, cf, GI[mb], 0, 0, 0); GI[mb] = __builtin_amdgcn_mfma_f32_32x32x16_bf16(nxr, sf, GI[mb], 0, 0, 0); }
    }
    const int k1 = 32 * nb + r32;
    bf16x8 ar[2][2], ai[2][2];
#pragma unroll
    for (int mb = 0; mb < 2; ++mb) {
#pragma unroll
        for (int r = 0; r < 16; ++r) { const int s2v = 32 * mb + (r & 3) + 8 * (r >> 2) + 4 * hi; const float fr = (float)((s2v * k1) & (SEQ - 1)) * (1.f / 8192.f);
            const float tc = cosrev(fr), ts = sinrev(fr), gr = GR[mb][r], gi = GI[mb][r]; GR[mb][r] = gr * tc + gi * ts; GI[mb][r] = gi * tc - gr * ts; }
#pragma unroll
        for (int st = 0; st < 2; ++st) {
            const u32x4 wr = {pk2(GR[mb][8 * st], GR[mb][8 * st + 1]), pk2(GR[mb][8 * st + 2], GR[mb][8 * st + 3]), pk2(GR[mb][8 * st + 4], GR[mb][8 * st + 5]), pk2(GR[mb][8 * st + 6], GR[mb][8 * st + 7])};
            const u32x4 wi = {pk2(GI[mb][8 * st], GI[mb][8 * st + 1]), pk2(GI[mb][8 * st + 2], GI[mb][8 * st + 3]), pk2(GI[mb][8 * st + 4], GI[mb][8 * st + 5]), pk2(GI[mb][8 * st + 6], GI[mb][8 * st + 7])};
            ar[mb][st] = __builtin_bit_cast(bf16x8, wr); ai[mb][st] = __builtin_bit_cast(bf16x8, wi); }
    }
    __syncthreads();
    f32x16 ZR = f32x16{}, ZI = f32x16{};
#pragma unroll
    for (int mb = 0; mb < 2; ++mb)
#pragma unroll
        for (int st = 0; st < 2; ++st) { const bf16x8 nar = negbf(ar[mb][st]);
            ZR = __builtin_amdgcn_mfma_f32_32x32x16_bf16(ar[mb][st], F.c[mb][st], ZR, 0, 0, 0); ZR = __builtin_amdgcn_mfma_f32_32x32x16_bf16(ai[mb][st], F.s[mb][st], ZR, 0, 0, 0);
            ZI = __builtin_amdgcn_mfma_f32_32x32x16_bf16(ai[mb][st], F.c[mb][st], ZI, 0, 0, 0); ZI = __builtin_amdgcn_mfma_f32_32x32x16_bf16(nar, F.s[mb][st], ZI, 0, 0, 0); }
    { const int k2 = 32 * kb + r32;
#pragma unroll
      for (int q = 0; q < 4; ++q) { const int kk = k2 * 128 + 32 * nb + 8 * q + 4 * hi;
          *(LAS f32x4*)(lds + kk * 4) = (f32x4){ZR[4 * q], ZR[4 * q + 1], ZR[4 * q + 2], ZR[4 * q + 3]}; *(LAS f32x4*)(lds + L_FI + kk * 4) = (f32x4){ZI[4 * q], ZI[4 * q + 1], ZI[4 * q + 2], ZI[4 * q + 3]}; } }
    __syncthreads();
    bf16_t* op = c.FC + (size_t)b * SEQ * 512 + g * 64 + 2 * jp;
#pragma unroll 4
    for (int i = 0; i < 16; ++i) { const int k = tid + NTHREADS * i, kr = (SEQ - k) & (SEQ - 1);
        const float a0 = *(const LAS float*)(lds + k * 4), a1 = *(const LAS float*)(lds + kr * 4); float y0 = a0, y1 = a1;
        if (jp == 0) { const float b0 = *(const LAS float*)(lds + L_FI + k * 4), b1 = *(const LAS float*)(lds + L_FI + kr * 4); y0 = 0.5f * (a0 + a1); y1 = 0.5f * (b0 + b1); }
        *(unsigned*)(op + (size_t)k * 512) = pk2(y0, y1); }
    __syncthreads();
}
}

struct AttnSrc { const bf16_t* Q; int qp; const bf16_t* K; int kp; const bf16_t* K2; int k2p; const bf16_t* V; int vp; bf16_t* O; int op; };
__device__ __forceinline__ AttnSrc gqa_src(unsigned char* ws, int b, int h) {
    AttnSrc A; const size_t r0 = (size_t)b * SEQ; unsigned char* r = ws + WS_R;
    A.Q = (const bf16_t*)(r + R_QG) + r0 * 256 + h * 64; A.qp = 256; A.K = (const bf16_t*)(r + R_KG) + r0 * 128 + (h >> 1) * 64; A.kp = 128; A.K2 = nullptr; A.k2p = 0;
    A.V = (const bf16_t*)(r + R_Z) + r0 * ZC + ZC_V + (h >> 1) * 64; A.vp = ZC; A.O = (bf16_t*)(r + R_YMIX) + r0 * 512 + h * 64; A.op = 512; return A;
}
__device__ __forceinline__ AttnSrc mla_src(unsigned char* ws, int b, int h) {
    AttnSrc A; const size_t r0 = (size_t)b * SEQ; unsigned char* r = ws + WS_R; const bf16_t* qkvm = (const bf16_t*)(r + R_QKVM);
    A.Q = qkvm + r0 * 1024 + h * 128; A.qp = 1024; A.K = qkvm + r0 * 1024 + 512 + h * 128; A.kp = 1024; A.K2 = (const bf16_t*)(r + R_KR) + r0 * 32; A.k2p = 32;
    A.V = qkvm + r0 * 1024 + 512 + h * 128 + 64; A.vp = 1024; A.O = (bf16_t*)(r + R_YMIX) + r0 * 512 + 256 + h * 64; A.op = 512; return A;
}

namespace att {
using s16x4 = __attribute__((ext_vector_type(4))) short;
constexpr float ATT_THR = 8.f;
#define ATT_SBAR() __builtin_amdgcn_sched_barrier(0)
__device__ __forceinline__ int crow(int r, int hi) { return (r & 3) + 8 * (r >> 2) + 4 * hi; }
__device__ __forceinline__ unsigned cvtpk(float lo, float hi) { unsigned r; asm volatile("v_cvt_pk_bf16_f32 %0, %1, %2" : "=v"(r) : "v"(lo), "v"(hi)); return r; }
template <int KROW> __device__ __forceinline__ int kswz(int row, int colB) { return (KROW == 128) ? row * 128 + (colB ^ (((row >> 1) & 7) << 4)) : row * 256 + (colB ^ ((row & 15) << 4)); }
__device__ __forceinline__ void partialSM(f32x16& p0, f32x16& p1, float& m_reg, f32x16& negm, float& alpha, const bool first) {
    float pa = fmaxf(fmaxf(p0[0], p0[1]), p0[2]), pb = fmaxf(fmaxf(p1[0], p1[1]), p1[2]);
#pragma unroll
    for (int r = 3; r < 15; r += 2) { pa = fmaxf(fmaxf(pa, p0[r]), p0[r + 1]); pb = fmaxf(fmaxf(pb, p1[r]), p1[r + 1]); }
    float pmax = fmaxf(fmaxf(pa, pb), fmaxf(p0[15], p1[15]));
    { auto rr = __builtin_amdgcn_permlane32_swap(__float_as_uint(pmax), __float_as_uint(pmax), false, false); pmax = fmaxf(__uint_as_float(rr[0]), __uint_as_float(rr[1])); }
    alpha = 1.f;
    if (first || !__all(pmax <= ATT_THR)) {
        const float delta = first ? pmax : fmaxf(pmax, 0.f);
        m_reg += delta; alpha = first ? 1.f : __builtin_amdgcn_exp2f(-delta);
#pragma unroll
        for (int r = 0; r < 16; ++r) { p0[r] -= delta; p1[r] -= delta; negm[r] = -m_reg; }
    }
#pragma unroll
    for (int r = 0; r < 16; ++r) p0[r] = __builtin_amdgcn_exp2f(p0[r]);
}
__device__ __forceinline__ void finishSM(f32x16& p0, f32x16& p1, bf16x8& pa0, bf16x8& pa1, bf16x8& pa2, bf16x8& pa3) {
#pragma unroll
    for (int r = 0; r < 16; ++r) p1[r] = __builtin_amdgcn_exp2f(p1[r]);
#define ATT_PK4(P, BASE, OUT) do { unsigned a0 = cvtpk(P[BASE + 0], P[BASE + 1]), a1 = cvtpk(P[BASE + 2], P[BASE + 3]);   \
    unsigned b0 = cvtpk(P[BASE + 4], P[BASE + 5]), b1 = cvtpk(P[BASE + 6], P[BASE + 7]);                              \
    auto r0 = __builtin_amdgcn_permlane32_swap(a0, b0, false, false); auto r1 = __builtin_amdgcn_permlane32_swap(a1, b1, false, false); \
    u32x4 w = {r0[0], r1[0], r0[1], r1[1]}; OUT = __builtin_bit_cast(bf16x8, w); } while (0)
    ATT_PK4(p0, 0, pa0); ATT_PK4(p0, 8, pa1); ATT_PK4(p1, 0, pa2); ATT_PK4(p1, 8, pa3);
#undef ATT_PK4
}
template <int DK, int KROW>
__device__ __forceinline__ void qkt(f32x16& p0, f32x16& p1, const LAS unsigned char* Ks, const bf16x8* qr, const f32x16& negm, int r32, int hi) {
#pragma unroll
    for (int d0 = 0; d0 < DK / 16; ++d0) { const int cb = (d0 * 16 + hi * 8) * 2;
        const bf16x8 b0 = *(const LAS bf16x8*)(Ks + kswz<KROW>(r32, cb));
        const bf16x8 b1 = *(const LAS bf16x8*)(Ks + kswz<KROW>(32 + r32, cb));
        if (d0 == 0) { p0 = __builtin_amdgcn_mfma_f32_32x32x16_bf16(b0, qr[0], negm, 0, 0, 0); p1 = __builtin_amdgcn_mfma_f32_32x32x16_bf16(b1, qr[0], negm, 0, 0, 0); }
        else { p0 = __builtin_amdgcn_mfma_f32_32x32x16_bf16(b0, qr[d0], p0, 0, 0, 0); p1 = __builtin_amdgcn_mfma_f32_32x32x16_bf16(b1, qr[d0], p1, 0, 0, 0); } }
}
__device__ __forceinline__ int v_st(int k, int c) { const int kk = (k & ~0xC) | ((k & 4) << 1) | ((k & 8) >> 1); return ((kk >> 3) * 2 + (c >> 5)) * 512 + ((kk & 7) * 32 + (c & 31)) * 2; }
__device__ __forceinline__ int v_rd_base(int lane) { return ((lane & 3) << 3) | (((lane >> 2) & 3) << 6) | (((lane >> 4) & 1) << 5) | (((lane >> 5) & 1) << 8); }
constexpr int v_rd_off(int d0, int ks, int half) { return d0 * 512 + ks * 2048 + half * 1024; }
template <int OFF> __device__ __forceinline__ s16x4 tr_read(int vb) { s16x4 r; asm volatile("ds_read_b64_tr_b16 %0, %1 offset:%2" : "=&v"(r) : "v"(vb), "i"(OFF) : "memory"); return r; }
template <int KS> __device__ __forceinline__ void pv_half(f32x16* o, int vb, bf16x8 paA, bf16x8 paB) {
    const s16x4 a0 = tr_read<v_rd_off(0, KS, 0)>(vb), b0 = tr_read<v_rd_off(0, KS, 1)>(vb), c0 = tr_read<v_rd_off(1, KS, 0)>(vb), d0 = tr_read<v_rd_off(1, KS, 1)>(vb);
    const s16x4 a1 = tr_read<v_rd_off(0, KS + 1, 0)>(vb), b1 = tr_read<v_rd_off(0, KS + 1, 1)>(vb), c1 = tr_read<v_rd_off(1, KS + 1, 0)>(vb), d1 = tr_read<v_rd_off(1, KS + 1, 1)>(vb);
    const bf16x8 ones = {0x3F80, 0x3F80, 0x3F80, 0x3F80, 0x3F80, 0x3F80, 0x3F80, 0x3F80};
    asm volatile("s_waitcnt lgkmcnt(0)" ::: "memory"); ATT_SBAR();
#define ATT_PK(L, H) (bf16x8){L[0], L[1], L[2], L[3], H[0], H[1], H[2], H[3]}
    o[0] = __builtin_amdgcn_mfma_f32_32x32x16_bf16(paA, ATT_PK(a0, b0), o[0], 0, 0, 0); o[1] = __builtin_amdgcn_mfma_f32_32x32x16_bf16(paA, ATT_PK(c0, d0), o[1], 0, 0, 0); o[2] = __builtin_amdgcn_mfma_f32_32x32x16_bf16(paA, ones, o[2], 0, 0, 0);
    o[0] = __builtin_amdgcn_mfma_f32_32x32x16_bf16(paB, ATT_PK(a1, b1), o[0], 0, 0, 0); o[1] = __builtin_amdgcn_mfma_f32_32x32x16_bf16(paB, ATT_PK(c1, d1), o[1], 0, 0, 0); o[2] = __builtin_amdgcn_mfma_f32_32x32x16_bf16(paB, ones, o[2], 0, 0, 0);
#undef ATT_PK
}
__device__ __forceinline__ void pv_d0(f32x16* o, int vb, bf16x8 pa0, bf16x8 pa1, bf16x8 pa2, bf16x8 pa3) { pv_half<0>(o, vb, pa0, pa1); pv_half<2>(o, vb, pa2, pa3); }

#define ATT_WAITBAR(N) asm volatile("s_waitcnt vmcnt(" #N ") lgkmcnt(0)\n\ts_barrier" ::: "memory")
template <int DK>
__device__ __forceinline__ void unit(const int tid, const AttnSrc& A, const int q0, LAS unsigned char* lds) {
    constexpr int QP = (DK == 64) ? 256 : 1024, KP = (DK == 64) ? 128 : 1024, K2P = 32, VP = (DK == 64) ? ZC : 1024, OP = 512;
    constexpr int KROW = (DK == 64) ? 128 : 256, SHM_K = 64 * KROW, SHM_V = 64 * 64 * 2, ND = DK / 16, NT = SEQ / 64, NKI = SHM_K / 8192;
    const int wid = __builtin_amdgcn_readfirstlane(tid >> 6), lane = tid & 63, r32 = lane & 31, hi = lane >> 5;
    LAS unsigned char* V_lds = lds; LAS unsigned char* K_lds = lds + 3 * SHM_V;
    LAS float* al_l = (LAS float*)(lds + 3 * SHM_V + 3 * SHM_K) + wid * 32;
    float m_reg = 0.f; f32x16 o[3] = {}; f32x16 negm = f32x16{}; bf16x8 qr[ND];
    const int qrow = q0 + wid * 32 + r32;
    const bf16_t* Qw = A.Q + (size_t)qrow * QP + hi * 8;
#pragma unroll
    for (int d0 = 0; d0 < ND; ++d0) qr[d0] = *(const bf16x8*)(Qw + d0 * 16);
    if constexpr (DK > 64) {
        const int sq = qrow & (SEQ - 1); const float prow = (float)(sq >> 6), pcol = (float)(sq & 63);
#pragma unroll
        for (int d0 = 4; d0 < 6; ++d0) { u32x4 w = __builtin_bit_cast(u32x4, qr[d0]); const float pos = (d0 == 4) ? prow : pcol;
#pragma unroll
            for (int j = 0; j < 4; ++j) { float x0 = bflo(w[j]), x1 = bfhi(w[j]); rope2(x0, x1, pos * __builtin_amdgcn_exp2f(-(float)(4 * hi + j) * (13.287712379549449f / 8.f))); w[j] = pk2i(x0, x1); }
            qr[d0] = __builtin_bit_cast(bf16x8, w); }
    }
    const bf16_t* Vsrc; const bf16_t* Ksrc[NKI]; int kstepE[NKI];
    { const int kk = 8 * wid + ((lane & 31) >> 2), kv = (kk & ~0xC) | ((kk & 4) << 1) | ((kk & 8) >> 1); Vsrc = A.V + (size_t)kv * VP + 32 * (lane >> 5) + 8 * (lane & 3); }
#pragma unroll
    for (int i = 0; i < NKI; ++i) {
        if constexpr (DK == 64) { const int row = 8 * wid + (lane >> 3), chunk = (lane & 7) ^ ((row >> 1) & 7); Ksrc[i] = A.K + (size_t)row * KP + chunk * 8; kstepE[i] = KP; }
        else { const int row = 4 * (i * 8 + wid) + (lane >> 4), chunk = (lane & 15) ^ (row & 15);
            if (chunk >= 8 && chunk < 12) { Ksrc[i] = A.K2 + (size_t)row * K2P + (chunk - 8) * 8; kstepE[i] = K2P; }
            else { Ksrc[i] = A.K + (size_t)row * KP + (chunk < 8 ? chunk : 0) * 8; kstepE[i] = KP; } }
    }
    const unsigned ldsw = (unsigned)wid * 1024u;
#define ATT_DMA_V(t, slot) __builtin_amdgcn_global_load_lds((const unsigned*)(Vsrc + (size_t)(t) * 64 * VP), (LAS unsigned*)(V_lds + (slot) * SHM_V + ldsw), 16, 0, 0)
#define ATT_DMA_K(t, slot) do { _Pragma("unroll") for (int i_ = 0; i_ < NKI; ++i_) \
        __builtin_amdgcn_global_load_lds((const unsigned*)(Ksrc[i_] + (size_t)(t) * 64 * kstepE[i_]), (LAS unsigned*)(K_lds + (slot) * SHM_K + i_ * 8192 + ldsw), 16, 0, 0); } while (0)
    const int vb0 = (int)(uintptr_t)V_lds + v_rd_base(lane);
#define ATT_RESC(a) do { if (__any((a) < 1.f)) { if (hi == 0) al_l[r32] = (a); asm volatile("s_waitcnt lgkmcnt(0)" ::: "memory"); \
    _Pragma("unroll") for (int d = 0; d < 3; ++d) _Pragma("unroll") for (int r = 0; r < 16; ++r) o[d][r] *= al_l[crow(r, hi)]; } } while (0)
    f32x16 pA0, pA1, pB0, pB1; float alA, alB; bf16x8 pa0, pa1, pa2, pa3;
    ATT_DMA_K(0, 0); ATT_DMA_V(0, 0); ATT_DMA_K(1, 1);
    ATT_WAITBAR(0);
    ATT_DMA_K(2, 2); ATT_DMA_V(1, 1);
    qkt<DK, KROW>(pA0, pA1, K_lds, qr, negm, r32, hi); partialSM(pA0, pA1, m_reg, negm, alA, true);
    if constexpr (NKI == 1) ATT_WAITBAR(2); else ATT_WAITBAR(3);
#define ATT_STEP(PC0, PC1, PP0, PP1, ALC, j, SK, SV) do { \
        const bool hk_ = (j) + 2 < NT, hv_ = (j) + 1 < NT; \
        if (hk_) ATT_DMA_K((j) + 2, ((SK) + 2) % 3); if (hv_) ATT_DMA_V((j) + 1, ((SV) + 2) % 3); \
        ATT_SBAR(); qkt<DK, KROW>(PC0, PC1, K_lds + (SK) * SHM_K, qr, negm, r32, hi); \
        finishSM(PP0, PP1, pa0, pa1, pa2, pa3); ATT_SBAR(); \
        pv_d0(o, vb0 + (SV) * SHM_V, pa0, pa1, pa2, pa3); partialSM(PC0, PC1, m_reg, negm, ALC, false); \
        if (hk_) { if constexpr (NKI == 1) ATT_WAITBAR(2); else ATT_WAITBAR(3); } else if (hv_) ATT_WAITBAR(1); else ATT_WAITBAR(0); \
        ATT_RESC(ALC); } while (0)
    static_assert((NT - 2) % 6 == 0, "steps 1 .. NT-2 are a whole number of 6-step periods");
#pragma unroll 1
    for (int j = 1; j + 1 < NT; j += 6) {
        ATT_STEP(pB0, pB1, pA0, pA1, alB, j,     1, 0);
        ATT_STEP(pA0, pA1, pB0, pB1, alA, j + 1, 2, 1);
        ATT_STEP(pB0, pB1, pA0, pA1, alB, j + 2, 0, 2);
        ATT_STEP(pA0, pA1, pB0, pB1, alA, j + 3, 1, 0);
        ATT_STEP(pB0, pB1, pA0, pA1, alB, j + 4, 2, 1);
        ATT_STEP(pA0, pA1, pB0, pB1, alA, j + 5, 0, 2);
    }
    ATT_STEP(pB0, pB1, pA0, pA1, alB, NT - 1, (NT - 1) % 3, (NT - 2) % 3);
    finishSM(pB0, pB1, pa0, pa1, pa2, pa3); ATT_SBAR();
    pv_d0(o, vb0 + ((NT - 1) % 3) * SHM_V, pa0, pa1, pa2, pa3);
    float rli[16];
#pragma unroll
    for (int r = 0; r < 16; ++r) rli[r] = __builtin_amdgcn_rcpf(o[2][r]);
    bf16_t* Ow = A.O + (size_t)(q0 + wid * 32) * OP + ((lane & 1) ? 32 + r32 - 1 : r32);
#pragma unroll
    for (int r = 0; r < 16; ++r) { const float a0 = o[0][r] * rli[r], a1 = o[1][r] * rli[r];
        const float got = dppf<0xB1>((lane & 1) ? a0 : a1);
        *(unsigned*)(Ow + (size_t)crow(r, hi) * OP) = (lane & 1) ? pk2(got, a1) : pk2(a0, got); }
    ATT_WAITBAR(0);
#undef ATT_DMA_V
#undef ATT_DMA_K
#undef ATT_RESC
#undef ATT_STEP
}
#undef ATT_WAITBAR
#undef ATT_SBAR
}

__device__ __forceinline__ void grpnorm_hi_rows8(const LayerCtx& c, int t0, int tstride, int lane) {
    R8 v[8]; float ss[8];
#pragma unroll
    for (int q = 0; q < 8; ++q) { v[q] = unpack8(*(const u32x4*)((const bf16_t*)c.YMIX + (size_t)(t0 + q * tstride) * 512 + 8 * lane)); ss[q] = hsq8(v[q]); }
#pragma unroll
    for (int q = 0; q < 8; ++q) { float x = ss[q]; x = rsum<1>(x); x = rsum<2>(x); x = rsum<4>(x); x = rsum<8>(x); ss[q] = rsum<16>(x); }
#pragma unroll
    for (int q = 0; q < 8; ++q) { const float r = __builtin_amdgcn_rsqf(ss[q] * (1.f / 256.f) + RMS_EPS);
        *(u32x4*)(c.Y + (size_t)(t0 + q * tstride) * 1024 + 512 + 8 * lane) = pk8(v[q].lo * r, v[q].hi * r); }
}
template <int NR>
__device__ __forceinline__ void resln_load(const LayerCtx& c, int t0, int tstride, int lane, u32x4 (&hw)[NR][2], u32x4 (&fw)[NR][2]) {
#pragma unroll
    for (int q = 0; q < NR; ++q) { const bf16_t* hr = c.HB + (size_t)(t0 + q * tstride) * D; const bf16_t* fr = c.FB + (size_t)(t0 + q * tstride) * D;
#pragma unroll
        for (int j = 0; j < 2; ++j) { hw[q][j] = *(const u32x4*)(hr + 512 * j + 8 * lane); fw[q][j] = *(const u32x4*)(fr + 512 * j + 8 * lane); } }
}
template <int NR>
__device__ __forceinline__ void resln_finish(const LayerCtx& c, int t0, int tstride, const float* g, const float* b, int lane, const u32x4 (&hw)[NR][2], const u32x4 (&fw)[NR][2], R8 (&v)[NR][2]) {
#pragma unroll
    for (int q = 0; q < NR; ++q)
#pragma unroll
        for (int j = 0; j < 2; ++j) { const R8 h = unpack8(hw[q][j]), f = unpack8(fw[q][j]); v[q][j].lo = h.lo * DN_ALPHA + f.lo; v[q][j].hi = h.hi * DN_ALPHA + f.hi; }
    ln_rows<NR>(v, g, b, lane);
#pragma unroll
    for (int q = 0; q < NR; ++q) store_row_bf16(c.HB + (size_t)(t0 + q * tstride) * D, v[q], lane);
}
template <int NR>
__device__ __forceinline__ void resln_rows(const LayerCtx& c, int t0, int tstride, const float* g, const float* b, int lane, R8 (&v)[NR][2]) {
    u32x4 hw[NR][2], fw[NR][2];
    resln_load<NR>(c, t0, tstride, lane, hw, fw);
    resln_finish<NR>(c, t0, tstride, g, b, lane, hw, fw, v);
}
constexpr int RT_LO = 65536, RT_LOGT = 40960;
__device__ __forceinline__ void ln2_router_group(const int tid, const Args& a, const LayerCtx& c, const int grp, const int grp_next, LAS unsigned char* lds, const bf16x8 (&bh)[8], const bf16x8 (&bl)[8], LAS unsigned* lcnt, u32x4 (&hw)[4][2], u32x4 (&fw)[4][2]) {
    const int wid = tid >> 6, lane = tid & 63, r32 = lane & 31, hi = lane >> 5;
    { R8 v[4][2];
      resln_finish<4>(c, grp * 32 + wid * 4, 1, a.in[I_LN2G] + c.l * D, a.in[I_LN2B] + c.l * D, lane, hw, fw, v);
#pragma unroll
      for (int q = 0; q < 4; ++q) { const int row = wid * 4 + q;
#pragma unroll
          for (int j = 0; j < 2; ++j) { const int chunk = 64 * j + lane; const int off = row * 2048 + ((chunk ^ (row & 15)) << 4);
              const R8 x = v[q][j]; const unsigned h0 = f2bf(x.lo.x), h1 = f2bf(x.lo.y), h2 = f2bf(x.lo.z), h3 = f2bf(x.lo.w), h4 = f2bf(x.hi.x), h5 = f2bf(x.hi.y), h6 = f2bf(x.hi.z), h7 = f2bf(x.hi.w);
              const u32x4 wh = {h0 | (h1 << 16), h2 | (h3 << 16), h4 | (h5 << 16), h6 | (h7 << 16)};
              const u32x4 wl = {pk2(x.lo.x - bf2f(h0), x.lo.y - bf2f(h1)), pk2(x.lo.z - bf2f(h2), x.lo.w - bf2f(h3)), pk2(x.hi.x - bf2f(h4), x.hi.y - bf2f(h5)), pk2(x.hi.z - bf2f(h6), x.hi.w - bf2f(h7))};
              *(LAS u32x4*)(lds + off) = wh; *(LAS u32x4*)(lds + RT_LO + off) = wl; } } }
    resln_load<4>(c, (grp_next < T / 32 ? grp_next : grp) * 32 + wid * 4, 1, lane, hw, fw);
    __syncthreads();
    f32x16 acc = f32x16{};
#pragma unroll
    for (int ks = 0; ks < 8; ++ks) { const int chunk = 16 * wid + 2 * ks + hi; const int off = r32 * 2048 + ((chunk ^ (r32 & 15)) << 4);
        const bf16x8 ah = *(const LAS bf16x8*)(lds + off), al = *(const LAS bf16x8*)(lds + RT_LO + off);
        acc = __builtin_amdgcn_mfma_f32_32x32x16_bf16(ah, bh[ks], acc, 0, 0, 0); acc = __builtin_amdgcn_mfma_f32_32x32x16_bf16(ah, bl[ks], acc, 0, 0, 0); acc = __builtin_amdgcn_mfma_f32_32x32x16_bf16(al, bh[ks], acc, 0, 0, 0); }
    __syncthreads();
    { LAS float* red = (LAS float*)lds;
#pragma unroll
      for (int r = 0; r < 16; ++r) { const int tok = (r & 3) + 8 * (r >> 2) + 4 * hi; red[(wid * 32 + tok) * 33 + r32] = acc[r]; } }
    __syncthreads();
    { const LAS float* red = (const LAS float*)lds; LAS float* logt = (LAS float*)(lds + RT_LOGT); const float* br = a.in[I_BR] + c.l * 32;
#pragma unroll
      for (int i = 0; i < 2; ++i) { const int idx = tid + NTHREADS * i, tok = idx >> 5, e = idx & 31; float sres = br[e];
#pragma unroll
          for (int w = 0; w < 8; ++w) sres += red[(w * 32 + tok) * 33 + e];
          logt[tok * 33 + e] = sres; } }
    __syncthreads();
    { const LAS float* logt = (const LAS float*)(lds + RT_LOGT);
#pragma unroll 1
      for (int q = 0; q < 4; ++q) { const int tok = wid * 4 + q, t = grp * 32 + tok;
          float mine = (lane < 32) ? logt[tok * 33 + lane] : -3.0e38f;
          float tv[4]; int ti[4];
#pragma unroll
          for (int k = 0; k < 4; ++k) { const float best = wave_max(mine); const unsigned long long mk = __ballot(mine == best); const int bi = __ffsll((long long)mk) - 1;
              tv[k] = best; ti[k] = bi; if (lane == bi) mine = -3.0e38f; }
          const float e1 = __expf(tv[1] - tv[0]), e2 = __expf(tv[2] - tv[0]), e3 = __expf(tv[3] - tv[0]); const float rs = 1.f / (1.f + e1 + e2 + e3);
          if (lane < 4) { const int e = lane == 0 ? ti[0] : lane == 1 ? ti[1] : lane == 2 ? ti[2] : ti[3]; const float gt = (lane == 0 ? 1.f : lane == 1 ? e1 : lane == 2 ? e2 : e3) * rs;
              const unsigned rank = __hip_atomic_fetch_add(lcnt + e, 1u, __ATOMIC_RELAXED, __HIP_MEMORY_SCOPE_WORKGROUP);
              c.RE[t * 4 + lane] = e; c.RR[t * 4 + lane] = (int)rank; c.GATE[t * 4 + lane] = gt; } } }
    __syncthreads();
}
constexpr int TBL_OFF = 131072, TBL_PSTART = TBL_OFF + 2304, TBL_NBLK = TBL_PSTART + 256, TBL_WBASE = TBL_NBLK + 64, TBL_CNT = TBL_WBASE + 128, TBL_PART = TBL_OFF + 4096, TBL_LCNT = TBL_OFF + 8192;
__device__ __forceinline__ void moe_tables(const int tid, const int bid, const LayerCtx& c, LAS unsigned char* lds) {
    LAS int* blk_e = (LAS int*)(lds + TBL_OFF); LAS int* pstart = (LAS int*)(lds + TBL_PSTART); LAS int* nblk = (LAS int*)(lds + TBL_NBLK); LAS int* wbase = (LAS int*)(lds + TBL_WBASE);
    LAS int* cntL = (LAS int*)(lds + TBL_CNT); LAS int* part = (LAS int*)(lds + TBL_PART);
    { const int e = tid & 31, pr = tid >> 5; int tot = 0, pf = 0;
#pragma unroll 4
      for (int w = pr * 16; w < pr * 16 + 16; ++w) { const int v = (int)__hip_atomic_load(c.cnt + w * 32 + e, RLX_AGENT); tot += v; pf += (w < bid) ? v : 0; }
      part[pr * 32 + e] = tot; part[512 + pr * 32 + e] = pf; }
    __syncthreads();
    if (tid < 32) { int tot = 0, pf = 0;
#pragma unroll 4
        for (int pr = 0; pr < 16; ++pr) { tot += part[pr * 32 + tid]; pf += part[512 + pr * 32 + tid]; }
        cntL[tid] = tot; wbase[tid] = pf; }
    __syncthreads();
    if (tid < 32) { int pos = 0;
#pragma unroll 1
        for (int e = 0; e < tid; ++e) pos += (cntL[e] + 255) >> 8;
        pstart[tid] = pos * 256; wbase[tid] += pos * 256;
        if (tid == 31) nblk[0] = pos + ((cntL[31] + 255) >> 8); }
    __syncthreads();
#pragma unroll 1
    for (int rb = tid; rb < MOE_MAXBLK; rb += NTHREADS) { int e = 0;
#pragma unroll 1
        for (int q = 1; q < NE; ++q) e += (pstart[q] <= rb * 256) ? 1 : 0;
        blk_e[rb] = e; }
    __syncthreads();
}
__device__ __forceinline__ void gather_rows2(const LayerCtx& c, int t0, int lane, const LAS int* wbase) {
    u32x4 hv[2][2]; int dest[2][4];
#pragma unroll
    for (int q = 0; q < 2; ++q) { const int t = t0 + q;
        hv[q][0] = *(const u32x4*)(c.HB + (size_t)t * D + 8 * lane); hv[q][1] = *(const u32x4*)(c.HB + (size_t)t * D + 512 + 8 * lane);
        const u32x4 e4 = *(const u32x4*)(c.RE + t * 4), r4 = *(const u32x4*)(c.RR + t * 4);
#pragma unroll
        for (int k = 0; k < 4; ++k) dest[q][k] = wbase[e4[k]] + (int)r4[k]; }
#pragma unroll
    for (int q = 0; q < 2; ++q) { const int t = t0 + q;
#pragma unroll
        for (int k = 0; k < 4; ++k) { *(u32x4*)(c.XS + (size_t)dest[q][k] * D + 8 * lane) = hv[q][0]; *(u32x4*)(c.XS + (size_t)dest[q][k] * D + 512 + 8 * lane) = hv[q][1]; }
        if (lane == 0) *(u32x4*)(c.DEST + t * 4) = (u32x4){(unsigned)dest[q][0], (unsigned)dest[q][1], (unsigned)dest[q][2], (unsigned)dest[q][3]}; }
}
__device__ __forceinline__ void combine_rows2(const Args& a, const LayerCtx& c, int t0, int tstride, int lane, float* out2) {
    u32x4 d4[2]; f32x4 g4[2]; u32x4 hw[2][2], yw[2][4][2];
#pragma unroll
    for (int q = 0; q < 2; ++q) { const int t = t0 + q * tstride; d4[q] = *(const u32x4*)(c.DEST + t * 4); g4[q] = *(const f32x4*)(c.GATE + t * 4);
        hw[q][0] = *(const u32x4*)(c.HB + (size_t)t * D + 8 * lane); hw[q][1] = *(const u32x4*)(c.HB + (size_t)t * D + 512 + 8 * lane); }
#pragma unroll
    for (int q = 0; q < 2; ++q)
#pragma unroll
        for (int k = 0; k < 4; ++k) { const bf16_t* y = c.YS + (size_t)d4[q][k] * D; yw[q][k][0] = *(const u32x4*)(y + 8 * lane); yw[q][k][1] = *(const u32x4*)(y + 512 + 8 * lane); }
    R8 v[2][2];
#pragma unroll
    for (int q = 0; q < 2; ++q)
#pragma unroll
        for (int j = 0; j < 2; ++j) { const R8 h = unpack8(hw[q][j]); v[q][j].lo = h.lo * DN_ALPHA; v[q][j].hi = h.hi * DN_ALPHA;
#pragma unroll
            for (int k = 0; k < 4; ++k) { const R8 y = unpack8(yw[q][k][j]); v[q][j].lo += y.lo * g4[q][k]; v[q][j].hi += y.hi * g4[q][k]; } }
    ln_rows<2>(v, a.in[I_LN3G] + c.l * D, a.in[I_LN3B] + c.l * D, lane);
#pragma unroll
    for (int q = 0; q < 2; ++q) { const int t = t0 + q * tstride; store_row_bf16(c.HB + (size_t)t * D, v[q], lane); if (out2) store_row_f32(out2 + (size_t)t * D, v[q], lane); }
}
constexpr int NPH_LAYER = 17, NPH_PRE = 3, NPHASES = NPH_PRE + NLAYER * NPH_LAYER;
#ifndef USE_PG8
#define USE_PG8 1
#endif
#if USE_PG8
#define GEMM_CALL(PAIR, g, S, E) do { int tid_ = tid; asm volatile("" : "+v"(tid_)); pg8::gemm_phase<PAIR, false>(tid_, lds, g, S, E); } while (0)
#define GEMM_CALL_GATHER(PAIR, g, S, E) do { int tid_ = tid; asm volatile("" : "+v"(tid_)); pg8::gemm_phase<PAIR, true>(tid_, lds, g, S, E); } while (0)
#else
#define GEMM_CALL(PAIR, g, S, E) sgemm_phase<PAIR>(tid, g, S, E)
#endif

__global__ void __launch_bounds__(NTHREADS, 2) fwd(Args a) {
    extern __shared__ __attribute__((aligned(16))) unsigned char lds_raw[];
    LAS unsigned char* lds = (LAS unsigned char*)lds_raw;
    volatile LAS unsigned* MISC = (volatile LAS unsigned*)(lds + MISC_OFF);
    const int G = gridDim.x, NGW = G * NWAVES;
    const int wave_s = __builtin_amdgcn_readfirstlane((int)threadIdx.x >> 6);
#define HW_TID() (wave_s * 64 + hw_lane())
    if (threadIdx.x < 64) MISC[threadIdx.x] = 0u;
    __syncthreads();
    unsigned* ctl = (unsigned*)(a.ws + WS_CTL);
    XcdBarrier bar; bar.bar = ctl + CW_BAR; bar.x = 0; bar.st = nullptr;
    if (N_LAUNCH_MODE == 1) bar = xcd_barrier_post(ctl + CW_BAR, MISC + 8, (int)threadIdx.x);
    const int lo = a.lo, hi = a.hi;
#define PH_TID int tid = HW_TID(); asm volatile("" : "+v"(tid)); int bid = blockIdx.x; asm volatile("" : "+s"(bid)); const __attribute__((address_space(4))) Args* ap_ = (const __attribute__((address_space(4))) Args*)__builtin_amdgcn_kernarg_segment_ptr(); asm volatile("" : "+s"(ap_)); const Args& a = *(const Args*)ap_; const int lane = tid & 63, wave = tid >> 6, gw = bid * NWAVES + wave; (void)lane; (void)gw
#define PH_BEGIN int lv = l; asm volatile("" : "+s"(lv)); PH_TID; const LayerCtx c = make_ctx(a, lv)
#define IN(k) (lo <= (k) && (k) < hi)
#define SEAM(k) do { if (N_LAUNCH_MODE == 1 && IN(k) && IN((k) + 1)) xcd_barrier(bar, HW_TID()); } while (0)

    if (IN(0)) { PH_TID; phase_pre0(tid, bid, a, lds); } SEAM(0);
    if (IN(1)) { PH_TID;
        GemmDesc g{(const bf16_t*)a.ws, (const bf16_t*)a.ws, 1024, 1024, 1024}; PreOrder S{G, bid}; EpiPre E{a.ws};
        GEMM_CALL(false, g, S, E);
    } SEAM(1);
    if (IN(2)) { PH_TID;
        GemmDesc g{(const bf16_t*)a.ws, (const bf16_t*)a.ws, 1024, 1024, 256}; Pre2Order S{G, bid}; EpiPre2 E{a.ws};
        GEMM_CALL(false, g, S, E);
    } SEAM(2);

    for (int l = 0; l < NLAYER; ++l) {
        const int pb = NPH_PRE + NPH_LAYER * l;
        if (IN(pb + 0)) { PH_BEGIN;
            GemmDesc g{c.HB, (const bf16_t*)(c.wl + WL_IN), 1024, 1024, 1024}; TileOrder S; S.init(T / 256, ZC / 256, G, bid, 0, 1024, 1024);
            EpiBf16 E{c.Z, ZC, nullptr}; GEMM_CALL(false, g, S, E);
        } SEAM(pb + 0);
        if (IN(pb + 1)) { PH_BEGIN;
            { fft::build_table(tid, lds); fft::F64Frags FF; fft::build_f64(tid, FF); __syncthreads();
              for (int u = bid; u < 512; u += G) fft::unit(tid, c, u, lds, FF); }
            __syncthreads();
            for (int it = bid; it < T / 64; it += G) conv_item(tid, a, c, it, lds);
            for (int t = gw; t < T; t += 4 * NGW) { QkRaw raw[4];
#pragma unroll
                for (int q = 0; q < 4; ++q) raw[q] = qkprep_load(c, t + q * NGW, lane);
#pragma unroll
                for (int q = 0; q < 4; ++q) qkprep_row(a, c, t + q * NGW, lane, raw[q]); }
        } SEAM(pb + 1);
        if (IN(pb + 2)) { PH_BEGIN;
            { GemmDesc g{c.CQKV, (const bf16_t*)(c.wl + WL_MLA), 384, 384, 384}; TileOrder S; S.init(T / 256, 4, G, bid, 0, 384, 384);
              EpiBf16 E{c.QKVM, 1024, nullptr}; GEMM_CALL(false, g, S, E); }
            { GemmDesc g{c.FC, (const bf16_t*)(c.wl + WL_FC), 512, 256, 256}; TileOrder S; S.init(T / 256, 2, G, bid, 1, 512, 256);
              EpiFCN E{c.Y, a.in[I_BF] + lv * 256, a.in[I_BPW] + lv * 256, lds}; GEMM_CALL(false, g, S, E); }
        } SEAM(pb + 2);
        if (IN(pb + 3)) { PH_BEGIN;
            for (int U = bid; U < 1024; U += G) { const int x = U & 511, b = x >> 7, h = (x >> 5) & 3, qb = x & 31;
                if (lv == 0 && (U >> 8) == ((bid >> 3) & 3)) { int tw = tid; asm volatile("" : "+v"(tw)); moe_weight_items(tw, bid, a, lds); __syncthreads(); }
                unsigned char* wsb = a.ws; asm volatile("" : "+s"(wsb));
                int tu = tid; asm volatile("" : "+v"(tu));
                if (U < 512) { const AttnSrc A = gqa_src(wsb, b, h); att::unit<64>(tu, A, qb * 256, lds); }
                else         { const AttnSrc A = mla_src(wsb, b, h); att::unit<96>(tu, A, qb * 256, lds); } }
        } SEAM(pb + 3);
        if (IN(pb + 4)) { PH_BEGIN; for (int t = gw; t < T; t += 8 * NGW) grpnorm_hi_rows8(c, t, NGW, lane); } SEAM(pb + 4);
        if (IN(pb + 5)) { PH_BEGIN;
            GemmDesc g{c.Y, (const bf16_t*)(c.wl + WL_O), 1024, 1024, 1024}; TileOrder S; S.init(T / 256, 4, G, bid, 0, 1024, 1024);
            EpiBf16 E{c.FB, 1024, nullptr}; GEMM_CALL(false, g, S, E);
        } SEAM(pb + 5);
        if (IN(pb + 6)) { PH_BEGIN; for (int t = gw; t < T; t += 4 * NGW) { R8 v[4][2]; resln_rows<4>(c, t, NGW, a.in[I_LN1G] + lv * D, a.in[I_LN1B] + lv * D, lane, v); } } SEAM(pb + 6);
        if (IN(pb + 7)) { PH_BEGIN;
            GemmDesc g{c.HB, (const bf16_t*)(a.ws + WS_MT + (size_t)((lv * 2 + 0) * 4) * 2 * MiB), 1024, 1024, 1024}; TileOrder S; S.init(T / 256, 4, G, bid, 4, 1024, 1024);
            EpiXSN E{c.PB, lds}; GEMM_CALL(false, g, S, E);
        } SEAM(pb + 10);
        if (IN(pb + 11)) { PH_BEGIN;
            GemmDesc g{c.PB, (const bf16_t*)(a.ws + WS_MT + (size_t)((lv * 2 + 1) * 4) * 2 * MiB), 1024, 1024, 1024}; TileOrder S; S.init(T / 256, 4, G, bid, 4, 1024, 1024);
            EpiBf16 E{c.FB, 1024, nullptr}; GEMM_CALL(false, g, S, E);
        } SEAM(pb + 11);
        if (IN(pb + 12)) { PH_BEGIN; LAS unsigned* lcnt = (LAS unsigned*)(lds + TBL_LCNT);
            if (tid < 32) lcnt[tid] = 0u;
            bf16x8 bh[8], bl[8];
            { const bf16_t* wr = (const bf16_t*)(c.wl + WL_RT) + (size_t)(lane & 31) * 1024 + 128 * wave + 8 * (lane >> 5);
#pragma unroll
              for (int ks = 0; ks < 8; ++ks) { bh[ks] = *(const bf16x8*)(wr + 16 * ks); bl[ks] = *(const bf16x8*)(wr + 32768 + 16 * ks); } }
            __syncthreads();
            { u32x4 hw[4][2], fw[4][2]; static_assert(MAXWG <= T / 32, "every workgroup has a first group"); resln_load<4>(c, bid * 32 + wave * 4, 1, lane, hw, fw);
              for (int grp = bid; grp < T / 32; grp += G) ln2_router_group(tid, a, c, grp, grp + G, lds, bh, bl, lcnt, hw, fw); }
            __syncthreads();
            if (tid < 32) __hip_atomic_store(c.cnt + bid * 32 + tid, lcnt[tid], RLX_AGENT);
        } SEAM(pb + 12);
        if (IN(pb + 13)) { PH_BEGIN; moe_tables(tid, bid, c, lds); const LAS int* wbase = (const LAS int*)(lds + TBL_WBASE);
            { const int gi = tid >> 7, pr = tid & 127; const int grp = bid + G * gi;
              if (grp < T / 32) { const int t = grp * 32 + (pr >> 2), k = pr & 3; const int dest = wbase[c.RE[t * 4 + k]] + c.RR[t * 4 + k]; c.TOK[dest] = t; c.DEST[t * 4 + k] = dest; } }
        } SEAM(pb + 13);
        if (IN(pb + 14)) { PH_BEGIN;
            const int nblk = *(const LAS int*)(lds + TBL_NBLK);
            GemmDesc g{c.HB, (const bf16_t*)(c.wl + WL_GU), 1024, 1024, 1024, c.TOK}; MoeOrder S{(const LAS int*)(lds + TBL_OFF), nblk, 8, G, bid};
            EpiGU E{c.ACT, a.in[I_BGU] + (size_t)lv * NE * 2048, lds}; GEMM_CALL_GATHER(true, g, S, E);
        } SEAM(pb + 14);
        if (IN(pb + 15)) { PH_BEGIN;
            const int nblk = *(const LAS int*)(lds + TBL_NBLK);
            GemmDesc g{c.ACT, (const bf16_t*)(c.wl + WL_DN), 1024, 1024, 1024}; MoeOrder S{(const LAS int*)(lds + TBL_OFF), nblk, 4, G, bid};
            EpiDown E{c.YS, a.in[I_BDN] + (size_t)lv * NE * 1024, lds}; GEMM_CALL(false, g, S, E);
        } SEAM(pb + 15);
        if (IN(pb + 16)) { PH_BEGIN; for (int t = gw; t < T; t += 2 * NGW) combine_rows2(a, c, t, NGW, lane, (lv == NLAYER - 1) ? a.out : nullptr); } SEAM(pb + 16);
    }
#undef IN
#undef SEAM
}

extern "C" void kernel_launch(void* const* d_in, const int* in_sizes, int n_in, void* d_out, int out_size, void* d_ws, size_t ws_size, hipStream_t stream) {
    static int grid = 0;
    if (grid == 0) {
        if (n_in != 37 || in_sizes[0] != T * D || out_size != T * D || ws_size < WS_END) {
            fprintf(stderr, "kernel_launch: unexpected shapes: n_in %d in0 %d out %d ws %zu (need %zu)\n", n_in, n_in > 0 ? in_sizes[0] : -1, out_size, ws_size, (size_t)WS_END); grid = -1; return; }
        int dev = 0, cus = 0;
        if (hipGetDevice(&dev) != hipSuccess || hipDeviceGetAttribute(&cus, hipDeviceAttributeMultiprocessorCount, dev) != hipSuccess) { grid = -1; return; }
        if (hipFuncSetAttribute((const void*)fwd, hipFuncAttributeMaxDynamicSharedMemorySize, LDS_BYTES) != hipSuccess) { fprintf(stderr, "kernel_launch: hipFuncSetAttribute failed\n"); grid = -1; return; }
        int per_cu = 0;
        if (hipOccupancyMaxActiveBlocksPerMultiprocessor(&per_cu, (const void*)fwd, NTHREADS, LDS_BYTES) != hipSuccess || per_cu < 1) fprintf(stderr, "kernel_launch: occupancy query reports %d\n", per_cu);
        (void)hipGetLastError();
        grid = MAXWG;
        if (cus < MAXWG) fprintf(stderr, "kernel_launch: only %d CUs: the 256-workgroup persistent grid cannot be resident; the grid barrier will time out\n", cus);
    }
    if (grid < 0) return;
    (void)hipMemsetAsync((char*)d_ws + WS_CTL, 0, CTL_ZERO_BYTES, stream);
    Args a{};
    for (int i = 0; i < 37; ++i) a.in[i] = (const float*)d_in[i];
    a.out = (float*)d_out; a.ws = (unsigned char*)d_ws; a.pad0 = 0; a.pad1 = 0;
    if (N_LAUNCH_MODE == 1) { a.lo = 0; a.hi = NPHASES; hipLaunchKernelGGL(fwd, dim3(grid), dim3(NTHREADS), LDS_BYTES, stream, a); }
    else for (int p = 0; p < NPHASES; ++p) { a.lo = p; a.hi = p + 1; hipLaunchKernelGGL(fwd, dim3(grid), dim3(NTHREADS), LDS_BYTES, stream, a); }
    const hipError_t le = hipPeekAtLastError();
    if (le != hipSuccess) fprintf(stderr, "kernel_launch: launch failed: %s\n", hipGetErrorName(le));
}
```

```cpp
#include <hip/hip_runtime.h>
#include <cstdio>
#include <cstdint>

#ifndef N_LAUNCH_MODE
#define N_LAUNCH_MODE 1
#endif

#define LAS __attribute__((address_space(3)))
#define GAS __attribute__((address_space(1)))
typedef unsigned short bf16_t;
typedef short bf16x8 __attribute__((ext_vector_type(8)));
typedef float f32x4 __attribute__((ext_vector_type(4)));
typedef float f32x2 __attribute__((ext_vector_type(2)));
typedef float f32x16 __attribute__((ext_vector_type(16)));
typedef unsigned u32x4 __attribute__((ext_vector_type(4)));
typedef unsigned u32x2 __attribute__((ext_vector_type(2)));
typedef GAS unsigned gu32;
#define RLX_AGENT __ATOMIC_RELAXED, __HIP_MEMORY_SCOPE_AGENT
#define LDS_WAIT() asm volatile("s_waitcnt lgkmcnt(0)" ::: "memory")
#define VM_WAIT() asm volatile("s_waitcnt vmcnt(0)" ::: "memory")

constexpr int NB = 4, SEQ = 8192, T = NB * SEQ, D = 1024, MEML = 256, NE = 32, TOPK = 4, NLAYER = 2;
constexpr int ZC = 1792;
constexpr int ZC_CA = 256, ZC_CG = 512, ZC_Q = 768, ZC_K = 1024, ZC_V = 1152, ZC_CQ = 1280, ZC_CKV = 1536, ZC_KR = 1664;
constexpr int INC = 1696;
constexpr float LOG2E = 1.4426950408889634f;
constexpr float DN_ALPHA = 1.4142135623730951f;
constexpr float LN_EPS = 1e-5f, RMS_EPS = 1e-6f;
constexpr float QSCALE_G = 0.125f * LOG2E;
constexpr float QSCALE_M = 0.10206207261596575f * LOG2E;
constexpr float QSCALE_X = 0.0625f * LOG2E;
constexpr int MOE_MAXBLK = T * TOPK / 256 + NE;
constexpr int MOE_ROWS = MOE_MAXBLK * 256;

constexpr size_t MiB = 1u << 20;
constexpr size_t WS_CTL = 0, CTL_ZERO_BYTES = 1 * MiB;
constexpr size_t WS_W = 1 * MiB, WL_SIZE = 208 * MiB;
constexpr size_t WL_IN = 0, WL_MLA = 4 * MiB, WL_FC = 5 * MiB, WL_RT = 5 * MiB + 512 * 1024, WL_O = 6 * MiB, WL_XQ = 8 * MiB, WL_XK = 10 * MiB, WL_XV = 12 * MiB,
                 WL_XO = 14 * MiB, WL_GU = 16 * MiB, WL_DN = 144 * MiB;
constexpr size_t WS_MEMB = 418 * MiB, WS_KX = 420 * MiB, WS_VXT = 424 * MiB;
constexpr size_t WS_ROUTE = 428 * MiB;
constexpr size_t WS_H = 430 * MiB, WS_HB = 558 * MiB, WS_F = 622 * MiB, WS_R = 750 * MiB;
constexpr size_t R_Z = 0, R_FC = 112 * MiB, R_QG = 144 * MiB, R_KG = 160 * MiB, R_CQKV = 168 * MiB, R_KR = 192 * MiB, R_QKVM = 194 * MiB, R_YMIX = 258 * MiB, R_Y = 386 * MiB;
constexpr size_t R_XQ = 0, R_SC = 64 * MiB, R_PB = 192 * MiB, R_XO = 256 * MiB;
constexpr size_t R_XS = 0, R_ACT = 272 * MiB;
constexpr size_t WS_MT = 430 * MiB;
constexpr size_t WS_END = WS_R + 544 * MiB;
constexpr int CW_TMO = 0, CW_CODE = 1, CW_BAR = 4096, CW_CNT = 16384, MAXWG = 256, CW_TOK = 65536;

constexpr int NTHREADS = 512, NWAVES = 8;
constexpr int LDS_BYTES = 147456;
constexpr int MISC_OFF = 147456 - 256;

__device__ __forceinline__ unsigned f2bf(float f) { unsigned u = __builtin_bit_cast(unsigned, f); return (u + 0x7fffu + ((u >> 16) & 1u)) >> 16; }
__device__ __forceinline__ unsigned pk2i(float lo, float hi) { return f2bf(lo) | (f2bf(hi) << 16); }
typedef __bf16 hwbf2 __attribute__((ext_vector_type(2))); typedef float hwf2 __attribute__((ext_vector_type(2)));
__device__ __forceinline__ unsigned pk2(float lo, float hi) { const hwf2 v = {lo, hi}; return __builtin_bit_cast(unsigned, __builtin_convertvector(v, hwbf2)); }
__device__ __forceinline__ float bf2f(unsigned b) { return __builtin_bit_cast(float, b << 16); }
__device__ __forceinline__ float bflo(unsigned w) { return __builtin_bit_cast(float, w << 16); }
__device__ __forceinline__ float bfhi(unsigned w) { return __builtin_bit_cast(float, w & 0xffff0000u); }
template <int CTRL> __device__ __forceinline__ float dppf(float v) { return __builtin_bit_cast(float, __builtin_amdgcn_update_dpp(0, __builtin_bit_cast(int, v), CTRL, 0xF, 0xF, true)); }
template <int O, bool MAX> __device__ __forceinline__ float rstep(float v) {
    float o;
    if constexpr (O == 1) o = dppf<0xB1>(v); else if constexpr (O == 2) o = dppf<0x4E>(v); else if constexpr (O == 4) o = dppf<0x141>(v); else if constexpr (O == 8) o = dppf<0x140>(v);
    else { const unsigned u = __builtin_bit_cast(unsigned, v);
        if constexpr (O == 16) { auto r = __builtin_amdgcn_permlane16_swap(u, u, false, false); v = __builtin_bit_cast(float, (unsigned)r[0]); o = __builtin_bit_cast(float, (unsigned)r[1]); }
        else { auto r = __builtin_amdgcn_permlane32_swap(u, u, false, false); v = __builtin_bit_cast(float, (unsigned)r[0]); o = __builtin_bit_cast(float, (unsigned)r[1]); } }
    return MAX ? fmaxf(v, o) : v + o;
}
template <int O> __device__ __forceinline__ float rsum(float v) { return rstep<O, false>(v); }
__device__ __forceinline__ float wave_sum(float v) { v = rsum<1>(v); v = rsum<2>(v); v = rsum<4>(v); v = rsum<8>(v); v = rsum<16>(v); return rsum<32>(v); }
__device__ __forceinline__ float wave_max(float v) { v = rstep<1, true>(v); v = rstep<2, true>(v); v = rstep<4, true>(v); v = rstep<8, true>(v); v = rstep<16, true>(v); return rstep<32, true>(v); }
__device__ __forceinline__ f32x4 ldbf4(const bf16_t* p) { const u32x2 w = *(const u32x2*)p; return (f32x4){bflo(w.x), bfhi(w.x), bflo(w.y), bfhi(w.y)}; }
__device__ __forceinline__ float sigmoidf_(float x) { return __builtin_amdgcn_rcpf(1.f + __expf(-x)); }

#define XB_TMO      128
#define XB_XCNT(j)  (256  + 64 * (j))
#define XB_XSUB(j)  (1280 + 64 * (j))
#define XB_XGEN(j)  (2304 + 64 * (j))
#define XB_TOP      3328
#define XB_TOPGEN   3392
#define XCD_BAR_WORDS 3456
#define XB_SPIN_CAP (1u << 22)
__device__ __forceinline__ unsigned xb_ld(unsigned* p)              { return __hip_atomic_load(p, __ATOMIC_RELAXED, __HIP_MEMORY_SCOPE_AGENT); }
__device__ __forceinline__ unsigned xb_add(unsigned* p, unsigned v) { return __hip_atomic_fetch_add(p, v, __ATOMIC_RELAXED, __HIP_MEMORY_SCOPE_AGENT); }
__device__ __forceinline__ unsigned xb_xcc_id() { return (unsigned)__builtin_amdgcn_s_getreg((3 << 11) | 20) & 0xFu; }
#define XB_SPIN(cond, bar) do { unsigned _sp = 0; while (cond) { __builtin_amdgcn_s_sleep(1); \
    if ((++_sp & 255u) == 0u) { if (xb_ld(&(bar)[XB_TMO])) break; if (_sp > XB_SPIN_CAP) { atomicAdd(&(bar)[XB_TMO], 1u); break; } } } } while (0)
struct XcdBarrier { unsigned* bar; unsigned x; volatile LAS unsigned* st; };
__device__ __forceinline__ XcdBarrier xcd_barrier_post(unsigned* bar, volatile LAS unsigned* st, int tid) {
    XcdBarrier b; b.bar = bar; b.x = xb_xcc_id(); b.st = st;
    if (tid == 0) (void)xb_add(&bar[XB_XCNT(b.x)], 1u);
    return b;
}
__device__ __forceinline__ void xcd_barrier_complete(unsigned* bar, unsigned x, unsigned& nloc, unsigned& nx) {
    const unsigned G = gridDim.x * gridDim.y * gridDim.z;
    unsigned sum, cnt, mine, sp = 0u;
    for (;;) {
        sum = 0u; cnt = 0u; mine = 0u;
#pragma unroll
        for (unsigned j = 0; j < 16; ++j) { const unsigned c = xb_ld(&bar[XB_XCNT(j)]); sum += c; cnt += (c > 0u) ? 1u : 0u; mine = (j == x) ? c : mine; }
        if (sum == G) break;
        __builtin_amdgcn_s_sleep(1);
        if ((++sp & 255u) == 0u) { if (xb_ld(&bar[XB_TMO])) break; if (sp > XB_SPIN_CAP) { atomicAdd(&bar[XB_TMO], 1u); break; } }
    }
    nloc = mine > 0u ? mine : 1u; nx = cnt > 0u ? cnt : 1u;
}
__device__ __forceinline__ void xcd_barrier(const XcdBarrier& b, int tid) {
    asm volatile("s_waitcnt vmcnt(0)" ::: "memory");
    __syncthreads();
    if (tid == 0) {
        unsigned* bar = b.bar;
        __builtin_amdgcn_s_waitcnt(0);
        unsigned nloc = b.st[0], nx = b.st[1];
        if (nloc == 0u) { xcd_barrier_complete(bar, b.x, nloc, nx); b.st[0] = nloc; b.st[1] = nx; }
        const unsigned old = xb_add(&bar[XB_XSUB(b.x)], 1u);
        const unsigned gen = old / nloc;
        if (old + 1u == (gen + 1u) * nloc) {
            __builtin_amdgcn_fence(__ATOMIC_RELEASE, "agent");
            asm volatile("s_waitcnt vmcnt(0)" ::: "memory");
            const unsigned og = xb_add(&bar[XB_TOP], 1u);
            const unsigned tg = og / nx;
            if (og + 1u == (tg + 1u) * nx) xb_add(&bar[XB_TOPGEN], 1u);
            else XB_SPIN(xb_ld(&bar[XB_TOPGEN]) == tg, bar);
            __builtin_amdgcn_fence(__ATOMIC_ACQUIRE, "agent");
            xb_add(&bar[XB_XGEN(b.x)], 1u);
            asm volatile("s_waitcnt vmcnt(0)" ::: "memory");
        } else {
            XB_SPIN(xb_ld(&bar[XB_XGEN(b.x)]) == gen, bar);
            __builtin_amdgcn_fence(__ATOMIC_ACQUIRE, "agent");
            asm volatile("s_waitcnt vmcnt(0)" ::: "memory");
        }
    }
    __syncthreads();
}

__device__ __forceinline__ int hw_lane() { int l; asm volatile("v_mbcnt_lo_u32_b32 %0, -1, 0\n\tv_mbcnt_hi_u32_b32 %0, -1, %0" : "=v"(l)); return l; }
constexpr int XSN_PART_OFF = 141312;
constexpr int EPI_BIAS_OFF = 143360;
struct Unit { int pm, pn, z; long aoff, boff; };
struct GemmDesc { const bf16_t* A; const bf16_t* Bt; int lda, ldb, K; const int* tok = nullptr; };

struct TileOrder {
    int nM, nN, nwg, G, c, mode, lda, ldb;
    __device__ __forceinline__ void init(int nM_, int nN_, int G_, int c_, int mode_, int lda_, int ldb_) { nM = nM_; nN = nN_; nwg = nM * nN; G = G_; c = c_; mode = mode_; lda = lda_; ldb = ldb_; }
    __device__ __forceinline__ bool next(int i, Unit& u) const {
        const long L = (long)i * G + c; if (L >= nwg) return false;
        int wgid = (int)L; { const int q = nwg / 8, r = nwg % 8, xcd = wgid % 8, off = wgid / 8; wgid = (xcd < r ? xcd * (q + 1) : r * (q + 1) + (xcd - r) * q) + off; }
        const int nig = 8 * nN, gid = wgid / nig, fm = gid * 8, gsz = (nM - fm) < 8 ? (nM - fm) : 8;
        u.pm = fm + ((wgid % nig) % gsz); u.pn = (wgid % nig) / gsz; u.z = 0;
        const long ar = (long)u.pm * 256 * lda;
        if (mode == 0)      { u.aoff = ar;                u.boff = (long)u.pn * 256 * ldb; }
        else if (mode == 1) { u.aoff = ar + u.pn * 256;   u.boff = (long)u.pn * 256 * ldb; }
        else if (mode == 2) { u.aoff = ar + u.pn * 256;   u.boff = (long)((u.pm >> 5) * 256) * ldb + u.pn * 256; }
        else if (mode == 3) { u.aoff = ar + u.pn * 256;   u.boff = (long)(u.pn * 256) * ldb + (u.pm >> 5) * 256; }
        else                { u.aoff = ar;                u.boff = (long)(u.pm >> 5) * 1048576 + (long)u.pn * 256 * ldb; }
        return true;
    }
};
struct PreOrder {
    int G, c;
    __device__ __forceinline__ bool next(int i, Unit& u) const {
        const int L = i * G + c; if (L >= 64) return false;
        const int which = L >> 4, t16 = L & 15, l = which >> 1, isv = which & 1;
        u.pm = t16 >> 2; u.pn = t16 & 3; u.z = which;
        const long memb = (long)(WS_MEMB / 2), wk = (long)((WS_W + l * WL_SIZE + WL_XK) / 2), wv = (long)((WS_W + l * WL_SIZE + WL_XV) / 2);
        const long ao = memb, bo = isv ? wv : wk;
        u.aoff = ao + (long)u.pm * 256 * 1024; u.boff = bo + (long)u.pn * 256 * 1024; return true;
    }
};
struct Pre2Order {
    int G, c;
    __device__ __forceinline__ bool next(int i, Unit& u) const {
        const int L = i * G + c; if (L >= 256) return false;
        const int l = L >> 7, which = (L >> 6) & 1, b = (L >> 4) & 3, h = (L >> 2) & 3, j = L & 3;
        const long kx = (long)((WS_KX + (size_t)l * 2 * MiB) / 2), vx = (long)((WS_VXT + (size_t)l * 2 * MiB) / 2), wq = (long)((WS_W + l * WL_SIZE + WL_XQ) / 2), wo = (long)((WS_W + l * WL_SIZE + WL_XO) / 2);
        u.z = (l * 2 + which) * 4 + b;
        if (which == 0) { u.pm = h; u.pn = j; u.aoff = kx + (long)(b * 256) * 1024 + h * 256; u.boff = wq + (long)(j * 256) * 1024 + h * 256; }
        else            { u.pm = j; u.pn = h; u.aoff = wo + (long)(j * 256) * 1024 + h * 256; u.boff = vx + (long)(b * 256) * 1024 + h * 256; }
        return true;
    }
};
struct MoeOrder {
    const LAS int* blk_e; int nblk, nN, G, c;
    __device__ __forceinline__ bool next(int i, Unit& u) const {
        const int x = c & 7, v = c >> 3, per = G >> 3; const long ul = (long)i * per + v; const int rb = x + 8 * (int)(ul / nN), pn = (int)(ul % nN); if (rb >= nblk) return false;
        const int e = blk_e[rb]; u.pm = rb; u.pn = pn; u.z = e;
        u.aoff = (long)rb * 256 * 1024; u.boff = ((long)e * nN * 256 + (long)pn * 256) * 1024; return true;
    }
};

__device__ __forceinline__ u32x4 pk8(const f32x4 a, const f32x4 b) { return (u32x4){pk2(a.x, a.y), pk2(a.z, a.w), pk2(b.x, b.y), pk2(b.z, b.w)}; }
struct EpiBf16 { static constexpr bool TILE = true; static constexpr int NST = 16; static constexpr int NPRE = 0; bf16_t* O; int ldo; const float* bias;
    __device__ __forceinline__ void tile(const f32x4 (&acc)[2][2][4][2], const Unit& u, int wr, int wc, int fr, int fq) const {
        const int col0 = u.pn * 256 + wc * 32 + 8 * fq; f32x4 b[2][2];
#pragma unroll
        for (int bj = 0; bj < 2; ++bj) { b[bj][0] = bias ? *(const f32x4*)(bias + col0 + bj * 128) : (f32x4){0.f, 0.f, 0.f, 0.f}; b[bj][1] = bias ? *(const f32x4*)(bias + col0 + bj * 128 + 4) : (f32x4){0.f, 0.f, 0.f, 0.f}; }
        if (bias) asm volatile("s_waitcnt vmcnt(0)" ::: "memory");
#pragma unroll
        for (int ai = 0; ai < 2; ++ai)
#pragma unroll
            for (int m = 0; m < 4; ++m) { bf16_t* rowp = O + (size_t)(u.pm * 256 + ai * 128 + wr * 64 + m * 16 + fr) * ldo + col0;
#pragma unroll
                for (int bj = 0; bj < 2; ++bj) *(u32x4*)(rowp + bj * 128) = pk8(acc[ai][bj][m][0] + b[bj][0], acc[ai][bj][m][1] + b[bj][1]); }
    }
    __device__ __forceinline__ void st4(const Unit&, int grow, int gcol, f32x4 v) const {
        if (bias) { const f32x4 b = *(const f32x4*)(bias + gcol); v += b; }
        u32x2 w; w.x = pk2(v.x, v.y); w.y = pk2(v.z, v.w); *(u32x2*)(O + (size_t)grow * ldo + gcol) = w; } };
struct EpiF32 { static constexpr bool TILE = false; static constexpr int NST = 0; static constexpr int NPRE = 0; float* O; int ldo; const float* bias0; const float* bias1;
    __device__ __forceinline__ void st4(const Unit&, int grow, int gcol, f32x4 v) const {
        if (bias0) { const f32x4 b = (gcol < 256) ? *(const f32x4*)(bias0 + gcol) : *(const f32x4*)(bias1 + gcol - 256); v += b; }
        *(f32x4*)(O + (size_t)grow * ldo + gcol) = v; } };
struct EpiFCN { static constexpr bool TILE = true; static constexpr int NST = 16; static constexpr int NPRE = 0; bf16_t* Y; const float* bias0; const float* bias1; LAS unsigned char* lds;
    __device__ __forceinline__ void tile(const f32x4 (&acc)[2][2][4][2], const Unit& u, int wr, int wc, int fr_, int fq_) const {
        int fr = fr_, fq = fq_; asm volatile("" : "+v"(fr), "+v"(fq));
        LAS float* part = (LAS float*)(lds + XSN_PART_OFF);
        const float* bp = (u.pn == 0 ? bias0 : bias1) + wc * 32 + 8 * fq; f32x4 b[2][2];
#pragma unroll
        for (int bj = 0; bj < 2; ++bj) { b[bj][0] = *(const f32x4*)(bp + bj * 128); b[bj][1] = *(const f32x4*)(bp + bj * 128 + 4); }
        asm volatile("s_waitcnt vmcnt(0)" ::: "memory");
#pragma unroll
        for (int ai = 0; ai < 2; ++ai)
#pragma unroll
            for (int m = 0; m < 4; ++m) { float ss = 0.f;
#pragma unroll
                for (int bj = 0; bj < 2; ++bj)
#pragma unroll
                    for (int n = 0; n < 2; ++n) { const f32x4 x = acc[ai][bj][m][n] + b[bj][n]; ss += (x.x * x.x + x.y * x.y) + (x.z * x.z + x.w * x.w); }
                ss = rsum<16>(ss); ss = rsum<32>(ss);
                if (fq == 0) part[(ai * 128 + wr * 64 + m * 16 + fr) * 4 + wc] = ss;
                __builtin_amdgcn_sched_barrier(0); }
        asm volatile("s_waitcnt lgkmcnt(0)\n\ts_barrier" ::: "memory");
        asm volatile("" : "+v"(b[0][0]), "+v"(b[0][1]), "+v"(b[1][0]), "+v"(b[1][1]));
#pragma unroll
        for (int ai = 0; ai < 2; ++ai)
#pragma unroll
            for (int m = 0; m < 4; ++m) { const int lrow = ai * 128 + wr * 64 + m * 16 + fr; const f32x4 t = *(const LAS f32x4*)(part + lrow * 4); const float r = __builtin_amdgcn_rsqf(((t.x + t.y) + (t.z + t.w)) * (1.f / 256.f) + RMS_EPS);
#pragma unroll
                for (int bj = 0; bj < 2; ++bj) *(u32x4*)(Y + (size_t)(u.pm * 256 + lrow) * 1024 + u.pn * 256 + bj * 128 + wc * 32 + 8 * fq) = pk8((acc[ai][bj][m][0] + b[bj][0]) * r, (acc[ai][bj][m][1] + b[bj][1]) * r);
                __builtin_amdgcn_sched_barrier(0); }
    } };
struct EpiPre { static constexpr bool TILE = false; static constexpr int NST = 0; static constexpr int NPRE = 0; unsigned char* ws;
    __device__ __forceinline__ void st4(const Unit& u, int grow, int gcol, f32x4 v) const {
        bf16_t* O = (bf16_t*)(ws + ((u.z & 1) ? WS_VXT : WS_KX) + (size_t)(u.z >> 1) * 2 * MiB);
        u32x2 w; w.x = pk2(v.x, v.y); w.y = pk2(v.z, v.w); *(u32x2*)(O + (size_t)grow * 1024 + gcol) = w; } };
struct EpiPre2 { static constexpr bool TILE = false; static constexpr int NST = 0; static constexpr int NPRE = 0; unsigned char* ws;
    __device__ __forceinline__ void st4(const Unit& u, int grow, int gcol, f32x4 v) const {
        bf16_t* O = (bf16_t*)(ws + WS_MT + (size_t)u.z * 2 * MiB);
        u32x2 w; w.x = pk2(v.x, v.y); w.y = pk2(v.z, v.w); *(u32x2*)(O + (size_t)grow * 1024 + gcol) = w; } };
__device__ __forceinline__ void rope2(float& x1, float& x2, float ang) { const float c = __cosf(ang), s = __sinf(ang); const float a = x1 * c - x2 * s, b = x2 * c + x1 * s; x1 = a; x2 = b; }
struct EpiGU { static constexpr bool TILE = true; static constexpr int NST = 8; static constexpr int NPRE = 1; bf16_t* O; const float* bgu; LAS unsigned char* lds;
    __device__ __forceinline__ void prefetch(const Unit& u, int wid, int lane) const {
        const float* b = bgu + (size_t)u.z * 2048 + (lane >> 5) * 1024 + u.pn * 128 + (wid & 3) * 32 + (lane & 31);
        __builtin_amdgcn_global_load_lds((const unsigned*)b, (LAS unsigned*)(lds + EPI_BIAS_OFF + wid * 256), 4, 0, 0); }
    __device__ __forceinline__ void tile(const f32x4 (&acc)[2][2][4][2], const Unit& u, int wr, int wc, int fr, int fq) const {
        const int acol = u.pn * 128 + wc * 32 + 8 * fq; const LAS float* b = (const LAS float*)(lds + EPI_BIAS_OFF + (wr * 4 + wc) * 256) + 8 * fq;
        const f32x4 bg0 = *(const LAS f32x4*)b, bg1 = *(const LAS f32x4*)(b + 4); f32x4 bu0 = *(const LAS f32x4*)(b + 32), bu1 = *(const LAS f32x4*)(b + 36);
        bu0 += 1.f; bu1 += 1.f;
#define GU_PAIR(G, U, BG, BU, I) ({ hwf2 g_ = hwf2{G[I], G[I + 1]} + hwf2{BG[I], BG[I + 1]}, u_ = hwf2{U[I], U[I + 1]} + hwf2{BU[I], BU[I + 1]};   \
            g_.x = fminf(g_.x, 7.f); g_.y = fminf(g_.y, 7.f); u_.x = __builtin_amdgcn_fmed3f(u_.x, -6.f, 8.f); u_.y = __builtin_amdgcn_fmed3f(u_.y, -6.f, 8.f);          \
            hwf2 e_ = g_ * -2.45546696f; e_.x = __builtin_amdgcn_exp2f(e_.x); e_.y = __builtin_amdgcn_exp2f(e_.y); e_ = e_ + 1.f;                                       \
            e_.x = __builtin_amdgcn_rcpf(e_.x); e_.y = __builtin_amdgcn_rcpf(e_.y); const hwf2 a_ = (g_ * u_) * e_; pk2(a_.x, a_.y); })
#pragma unroll
        for (int ai = 0; ai < 2; ++ai)
#pragma unroll
            for (int m = 0; m < 4; ++m) { const f32x4 g0 = acc[ai][0][m][0], g1 = acc[ai][0][m][1], u0 = acc[ai][1][m][0], u1 = acc[ai][1][m][1];
                u32x4 o; o.x = GU_PAIR(g0, u0, bg0, bu0, 0); o.y = GU_PAIR(g0, u0, bg0, bu0, 2); o.z = GU_PAIR(g1, u1, bg1, bu1, 0); o.w = GU_PAIR(g1, u1, bg1, bu1, 2);
                *(u32x4*)(O + (size_t)(u.pm * 256 + ai * 128 + wr * 64 + m * 16 + fr) * 1024 + acol) = o;
                __builtin_amdgcn_sched_barrier(0); }
#undef GU_PAIR
    }
    __device__ __forceinline__ void st4x2(const Unit& u, int grow, int acol, f32x4 g, f32x4 up) const {
        const float* b = bgu + (size_t)u.z * 2048; const f32x4 bg = *(const f32x4*)(b + acol), bu = *(const f32x4*)(b + 1024 + acol);
        g += bg; up += bu; f32x4 a;
#pragma unroll
        for (int i = 0; i < 4; ++i) { const float gg = fminf(g[i], 7.f), uu = fminf(fmaxf(up[i], -7.f), 7.f); a[i] = (uu + 1.f) * (gg * sigmoidf_(1.702f * gg)); }
        u32x2 w; w.x = pk2(a.x, a.y); w.y = pk2(a.z, a.w); *(u32x2*)(O + (size_t)grow * 1024 + acol) = w; } };
struct EpiDown { static constexpr bool TILE = true; static constexpr int NST = 16; static constexpr int NPRE = 1; bf16_t* O; const float* bdn; LAS unsigned char* lds;
    __device__ __forceinline__ void prefetch(const Unit& u, int wid, int lane) const {
        const float* b = bdn + (size_t)u.z * 1024 + u.pn * 256 + (lane >> 5) * 128 + (wid & 3) * 32 + (lane & 31);
        __builtin_amdgcn_global_load_lds((const unsigned*)b, (LAS unsigned*)(lds + EPI_BIAS_OFF + wid * 256), 4, 0, 0); }
    __device__ __forceinline__ void tile(const f32x4 (&acc)[2][2][4][2], const Unit& u, int wr, int wc, int fr, int fq) const {
        const int col0 = u.pn * 256 + wc * 32 + 8 * fq; const LAS float* bl = (const LAS float*)(lds + EPI_BIAS_OFF + (wr * 4 + wc) * 256) + 8 * fq; f32x4 b[2][2];
#pragma unroll
        for (int bj = 0; bj < 2; ++bj) { b[bj][0] = *(const LAS f32x4*)(bl + 32 * bj); b[bj][1] = *(const LAS f32x4*)(bl + 32 * bj + 4); }
#pragma unroll
        for (int ai = 0; ai < 2; ++ai)
#pragma unroll
            for (int m = 0; m < 4; ++m) { bf16_t* rowp = O + (size_t)(u.pm * 256 + ai * 128 + wr * 64 + m * 16 + fr) * 1024 + col0;
#pragma unroll
                for (int bj = 0; bj < 2; ++bj) *(u32x4*)(rowp + bj * 128) = pk8(acc[ai][bj][m][0] + b[bj][0], acc[ai][bj][m][1] + b[bj][1]); }
    }
    __device__ __forceinline__ void st4(const Unit& u, int grow, int gcol, f32x4 v) const {
        const f32x4 b = *(const f32x4*)(bdn + (size_t)u.z * 1024 + gcol); v += b;
        u32x2 w; w.x = pk2(v.x, v.y); w.y = pk2(v.z, v.w); *(u32x2*)(O + (size_t)grow * 1024 + gcol) = w; } };

struct EpiXS { static constexpr bool TILE = true; static constexpr int NST = 16; static constexpr int NPRE = 0; bf16_t* P; float* RS;
    __device__ __forceinline__ void tile(const f32x4 (&acc)[2][2][4][2], const Unit& u, int wr, int wc, int fr, int fq) const {
#pragma unroll
        for (int ai = 0; ai < 2; ++ai)
#pragma unroll
            for (int m = 0; m < 4; ++m) { const int grow = u.pm * 256 + ai * 128 + wr * 64 + m * 16 + fr; float rs = 0.f;
#pragma unroll
                for (int bj = 0; bj < 2; ++bj) { f32x4 p0, p1;
#pragma unroll
                    for (int i = 0; i < 4; ++i) { p0[i] = __builtin_amdgcn_exp2f(fminf(acc[ai][bj][m][0][i], 100.f)); p1[i] = __builtin_amdgcn_exp2f(fminf(acc[ai][bj][m][1][i], 100.f)); }
                    rs += ((p0.x + p0.y) + (p0.z + p0.w)) + ((p1.x + p1.y) + (p1.z + p1.w));
                    u32x4 w; w.x = pk2(p0.x, p0.y); w.y = pk2(p0.z, p0.w); w.z = pk2(p1.x, p1.y); w.w = pk2(p1.z, p1.w);
                    *(u32x4*)(P + (size_t)grow * 1024 + u.pn * 256 + bj * 128 + wc * 32 + 8 * fq) = w; }
                rs = rsum<16>(rs); rs = rsum<32>(rs);
                if (fq == 0) RS[((size_t)grow * 4 + u.pn) * 4 + wc] = rs;
                __builtin_amdgcn_sched_barrier(0); }
    } };
struct EpiXSN { static constexpr bool TILE = true; static constexpr int NST = 16; static constexpr int NPRE = 0; bf16_t* P; LAS unsigned char* lds;
    __device__ __forceinline__ void tile(const f32x4 (&acc)[2][2][4][2], const Unit& u, int wr, int wc, int fr_, int fq_) const {
        int fr = fr_, fq = fq_; asm volatile("" : "+v"(fr), "+v"(fq));
        LAS float* part = (LAS float*)(lds + XSN_PART_OFF);
#pragma unroll
        for (int ai = 0; ai < 2; ++ai)
#pragma unroll
            for (int m = 0; m < 4; ++m) { float rs = 0.f;
#pragma unroll
                for (int bj = 0; bj < 2; ++bj)
#pragma unroll
                    for (int n = 0; n < 2; ++n) { f32x4 q;
#pragma unroll
                        for (int i = 0; i < 4; ++i) q[i] = __builtin_amdgcn_exp2f(fminf(acc[ai][bj][m][n][i], 100.f));
                        rs += (q.x + q.y) + (q.z + q.w); }
                rs = rsum<16>(rs); rs = rsum<32>(rs);
                if (fq == 0) part[(ai * 128 + wr * 64 + m * 16 + fr) * 4 + wc] = rs;
                __builtin_amdgcn_sched_barrier(0); }
        asm volatile("s_waitcnt lgkmcnt(0)\n\ts_barrier" ::: "memory");
        float cap = 100.f; asm volatile("" : "+v"(cap));
#pragma unroll
        for (int ai = 0; ai < 2; ++ai)
#pragma unroll
            for (int m = 0; m < 4; ++m) { const int lrow = ai * 128 + wr * 64 + m * 16 + fr; const f32x4 t = *(const LAS f32x4*)(part + lrow * 4); const float r = __builtin_amdgcn_rcpf((t.x + t.y) + (t.z + t.w));
#pragma unroll
                for (int bj = 0; bj < 2; ++bj) { f32x4 q0, q1;
#pragma unroll
                    for (int i = 0; i < 4; ++i) { q0[i] = __builtin_amdgcn_exp2f(fminf(acc[ai][bj][m][0][i], cap)) * r; q1[i] = __builtin_amdgcn_exp2f(fminf(acc[ai][bj][m][1][i], cap)) * r; }
                    *(u32x4*)(P + (size_t)(u.pm * 256 + lrow) * 1024 + u.pn * 256 + bj * 128 + wc * 32 + 8 * fq) = pk8(q0, q1); }
                __builtin_amdgcn_sched_barrier(0); }
    } };
struct EpiXO { static constexpr bool TILE = true; static constexpr int NST = 16; static constexpr int NPRE = 0; bf16_t* O; const float* RS;
    __device__ __forceinline__ void tile(const f32x4 (&acc)[2][2][4][2], const Unit& u, int wr, int wc, int fr, int fq) const {
        const int col0 = u.pn * 256 + wc * 32 + 8 * fq; float rr[2][4];
#pragma unroll
        for (int ai = 0; ai < 2; ++ai)
#pragma unroll
            for (int m = 0; m < 4; ++m) { const int grow = u.pm * 256 + ai * 128 + wr * 64 + m * 16 + fr; const f32x4 q = *(const f32x4*)(RS + ((size_t)grow * 4 + u.pn) * 4); rr[ai][m] = __builtin_amdgcn_rcpf((q.x + q.y) + (q.z + q.w)); }
        asm volatile("s_waitcnt vmcnt(0)" ::: "memory");
#pragma unroll
        for (int ai = 0; ai < 2; ++ai)
#pragma unroll
            for (int m = 0; m < 4; ++m) { const int grow = u.pm * 256 + ai * 128 + wr * 64 + m * 16 + fr; const float r = rr[ai][m];
#pragma unroll
                for (int bj = 0; bj < 2; ++bj) *(u32x4*)(O + (size_t)grow * 1024 + col0 + bj * 128) = pk8(acc[ai][bj][m][0] * r, acc[ai][bj][m][1] * r); }
    }
    __device__ __forceinline__ void st4(const Unit&, int grow, int gcol, f32x4 v) const {
        const f32x4 q = *(const f32x4*)(RS + ((size_t)grow * 4 + (gcol >> 8)) * 4); const float r = __builtin_amdgcn_rcpf((q.x + q.y) + (q.z + q.w)); v = v * r;
        u32x2 w; w.x = pk2(v.x, v.y); w.y = pk2(v.z, v.w); *(u32x2*)(O + (size_t)grow * 1024 + gcol) = w; } };

template <bool PAIR, class Sched, class Epi>
__device__ __forceinline__ void sgemm_phase(const int tid, const GemmDesc g, const Sched& S, const Epi& E) {
    const int wid = tid >> 6, lane = tid & 63, r32 = lane & 31, hi = lane >> 5;
    Unit u;
    for (int i = 0; S.next(i, u); ++i) {
        const int grow = u.pm * 256 + wid * 32 + r32;
        const bf16_t* Ap = g.A + u.aoff + (long)(wid * 32 + r32) * g.lda + hi * 8;
        const bf16_t* Bp = g.Bt + u.boff + (long)r32 * g.ldb + hi * 8;
#pragma unroll 1
        for (int pass = 0; pass < 2; ++pass) {
            int cbs[4];
#pragma unroll
            for (int j = 0; j < 4; ++j) cbs[j] = PAIR ? ((j & 1) + 2 * pass + 4 * (j >> 1)) : (4 * pass + j);
            f32x16 acc[4];
#pragma unroll
            for (int j = 0; j < 4; ++j) acc[j] = f32x16{};
#pragma unroll 2
            for (int k0 = 0; k0 < g.K; k0 += 16) {
                const bf16x8 a = *(const bf16x8*)(Ap + k0);
#pragma unroll
                for (int j = 0; j < 4; ++j) { const bf16x8 b = *(const bf16x8*)(Bp + (long)cbs[j] * 32 * g.ldb + k0); acc[j] = __builtin_amdgcn_mfma_f32_32x32x16_bf16(b, a, acc[j], 0, 0, 0); }
            }
            if constexpr (PAIR) {
#pragma unroll
                for (int j = 0; j < 2; ++j)
#pragma unroll
                    for (int q = 0; q < 4; ++q) { const f32x4 gv = {acc[j][4 * q], acc[j][4 * q + 1], acc[j][4 * q + 2], acc[j][4 * q + 3]};
                        const f32x4 uv = {acc[j + 2][4 * q], acc[j + 2][4 * q + 1], acc[j + 2][4 * q + 2], acc[j + 2][4 * q + 3]};
                        E.st4x2(u, grow, u.pn * 128 + cbs[j] * 32 + 8 * q + 4 * hi, gv, uv); }
            } else {
#pragma unroll
                for (int j = 0; j < 4; ++j)
#pragma unroll
                    for (int q = 0; q < 4; ++q) { const f32x4 v = {acc[j][4 * q], acc[j][4 * q + 1], acc[j][4 * q + 2], acc[j][4 * q + 3]};
                        E.st4(u, grow, u.pn * 256 + cbs[j] * 32 + 8 * q + 4 * hi, v); }
            }
        }
    }
}

namespace pg8 {
constexpr int BK = 64, HALF = 128, HTB = HALF * BK * 2, STAGE_BYTES = 8 * HTB;
__device__ __forceinline__ int lds_byte(int r, int c) { const int st = (r >> 4) * 2 + (c >> 5), rr = r & 15, cc = c & 31, ob = rr * 64 + cc * 2; return st * 1024 + (ob ^ (((ob >> 9) & 1) << 5)); }
__device__ __forceinline__ void stage_rc(int b, int& R, int& C) { const int st = b / 1024, sb = b % 1024, swz = sb ^ (((sb >> 9) & 1) << 5); R = (st >> 1) * 16 + swz / 64; C = (st & 1) * 32 + (swz % 64) / 2; }
__device__ __forceinline__ int perm32(int rho) { const int n = rho >> 4, i = rho & 15; return 8 * (i >> 2) + 4 * n + (i & 3); }
template <bool PAIR, class Epi>
__device__ __forceinline__ void run_epi(const Epi& E, const f32x4 (&acc)[2][2][4][2], const Unit& u, int wr, int wc, int fr, int fq) {
    if constexpr (Epi::TILE) { E.tile(acc, u, wr, wc, fr, fq); return; } else {
#pragma unroll
    for (int ai = 0; ai < 2; ++ai)
#pragma unroll
        for (int m = 0; m < 4; ++m) { const int grow = u.pm * 256 + ai * HALF + wr * 64 + m * 16 + fr;
            if constexpr (PAIR) {
#pragma unroll
                for (int n = 0; n < 2; ++n) E.st4x2(u, grow, u.pn * 128 + wc * 32 + 8 * fq + 4 * n, acc[ai][0][m][n], acc[ai][1][m][n]);
            } else {
#pragma unroll
                for (int bj = 0; bj < 2; ++bj)
#pragma unroll
                    for (int n = 0; n < 2; ++n) E.st4(u, grow, u.pn * 256 + bj * HALF + wc * 32 + 8 * fq + 4 * n, acc[ai][bj][m][n]);
            }
            __builtin_amdgcn_sched_barrier(0); }
    }
}
template <bool PAIR, bool GATH, class Sched, class Epi>
__device__ __forceinline__ void gemm_phase(const int tid, LAS unsigned char* lds, const GemmDesc g, const Sched& S, const Epi& E) {
    const int wid = __builtin_amdgcn_readfirstlane(tid >> 6), lane = tid & 63, wr = wid >> 2, wc = wid & 3, fr = lane & 15, fq = lane >> 4;
    const int K = g.K, nt = K / BK;
    unsigned voffA[2], voffB[2]; int RA[2], CA[2];
#define PG8_VOFFS() do { const int t_ = wid * 64 + hw_lane(); _Pragma("unroll") for (int i = 0; i < 2; ++i) { int R, C; stage_rc(t_ * 16 + i * 8192, R, C); const int Rb = (R & ~31) + perm32(R & 31); RA[i] = R; CA[i] = C * 2; \
        voffA[i] = (unsigned)(R * g.lda + C) * 2u; voffB[i] = (unsigned)(Rb * g.ldb + C) * 2u; } } while (0)
    PG8_VOFFS();
    unsigned cvA[2][2], nvA[2][2];
#define PG8_GVOFF(U, V) do { if constexpr (GATH) { _Pragma("unroll") for (int h_ = 0; h_ < 2; ++h_) _Pragma("unroll") for (int i_ = 0; i_ < 2; ++i_) \
        V[h_][i_] = (unsigned)g.tok[(U).pm * 256 + h_ * HALF + RA[i_]] * (unsigned)(g.lda * 2) + (unsigned)CA[i_]; } } while (0)
    const size_t kstep = (size_t)(BK * 2);
    const size_t hstepA = (size_t)HALF * g.lda * 2, hstepB = (size_t)HALF * g.ldb * 2;
    const unsigned ldsw = (unsigned)wid * 1024u;
    const int aoff = lds_byte(wr * 64 + fr, fq * 8), boff = lds_byte(wc * 32 + fr, fq * 8);
#define PG8_SA(b, h) (((b) * 2 + (h)) * HTB)
#define PG8_SB(b, h) ((4 + (b) * 2 + (h)) * HTB)
#define PG8_STAGE(bufoff, gbase, voff) do { _Pragma("unroll") for (int _i = 0; _i < 2; ++_i) \
        __builtin_amdgcn_global_load_lds((const unsigned*)((const char*)(gbase) + (voff)[_i]), (LAS unsigned*)(lds + (bufoff) + ldsw + _i * 8192), 16, 0, 0); } while (0)
#define PG8_STA(b, h, base, V) do { if constexpr (GATH) PG8_STAGE(PG8_SA(b, h), base, V[h]); else PG8_STAGE(PG8_SA(b, h), (base) + (h) * hstepA, voffA); } while (0)
#define PG8_LDA(dst, b, h) do { _Pragma("unroll") for (int m = 0; m < 4; ++m) _Pragma("unroll") for (int k = 0; k < 2; ++k) dst[m][k] = *(const LAS bf16x8*)(lds + PG8_SA(b, h) + aoff + m * 2048 + k * 1024); } while (0)
#define PG8_LDB(dst, b, h) do { _Pragma("unroll") for (int n = 0; n < 2; ++n) _Pragma("unroll") for (int k = 0; k < 2; ++k) dst[n][k] = *(const LAS bf16x8*)(lds + PG8_SB(b, h) + boff + n * 2048 + k * 1024); } while (0)
#define PG8_MMA(ai, bj, At, Bt) do { __builtin_amdgcn_s_setprio(1); _Pragma("unroll") for (int m = 0; m < 4; ++m) _Pragma("unroll") for (int n = 0; n < 2; ++n) _Pragma("unroll") for (int k = 0; k < 2; ++k) \
        acc[ai][bj][m][n] = __builtin_amdgcn_mfma_f32_16x16x32_bf16(Bt[n][k], At[m][k], acc[ai][bj][m][n], 0, 0, 0); __builtin_amdgcn_s_setprio(0); } while (0)
#define PG8_WAIT_V(n) asm volatile("s_waitcnt vmcnt(" #n ")" ::: "memory")
#define PG8_WAIT_VN(n) asm volatile("s_waitcnt vmcnt(%0)" :: "n"(n) : "memory")
#define PG8_WAIT_L(n) asm volatile("s_waitcnt lgkmcnt(" #n ")" ::: "memory")
#define PG8_BAR __builtin_amdgcn_s_barrier()
#define PG8_SCHED __builtin_amdgcn_sched_barrier(0)
    Unit cur, nxt; int ui = 0;
    if (!S.next(0, cur)) return;
    bool has_next = S.next(1, nxt);
    f32x4 acc[2][2][4][2];
    float zf = 0.f; asm volatile("" : "+v"(zf)); const f32x4 Z4 = {zf, zf, zf, zf};
#pragma unroll
    for (int a = 0; a < 2; ++a)
#pragma unroll
        for (int b = 0; b < 2; ++b)
#pragma unroll
            for (int m = 0; m < 4; ++m)
#pragma unroll
                for (int n = 0; n < 2; ++n) acc[a][b][m][n] = Z4;
    bf16x8 At[4][2], B0[2][2], B1[2][2];
    const char* cA = (const char*)g.A + (GATH ? (size_t)0 : (size_t)cur.aoff * 2); const char* cB = (const char*)g.Bt + (size_t)cur.boff * 2;
    const char* nA = (has_next && !GATH) ? (const char*)g.A + (size_t)nxt.aoff * 2 : cA; const char* nB = has_next ? (const char*)g.Bt + (size_t)nxt.boff * 2 : cB;
    PG8_GVOFF(cur, cvA);
    if constexpr (GATH) { if (has_next) PG8_GVOFF(nxt, nvA); else { _Pragma("unroll") for (int h_ = 0; h_ < 2; ++h_) _Pragma("unroll") for (int i_ = 0; i_ < 2; ++i_) nvA[h_][i_] = cvA[h_][i_]; } }
    PG8_STAGE(PG8_SB(0, 0), cB, voffB); PG8_STAGE(PG8_SB(0, 1), cB + hstepB, voffB); PG8_STA(0, 0, cA, cvA); PG8_STA(0, 1, cA, cvA);
    PG8_STAGE(PG8_SB(1, 0), cB + kstep, voffB); PG8_STA(1, 0, cA + kstep, cvA); PG8_STAGE(PG8_SB(1, 1), cB + hstepB + kstep, voffB); PG8_STA(1, 1, cA + kstep, cvA);
    PG8_WAIT_V(0);
    if (wr == 1) PG8_BAR;
    PG8_BAR;
    constexpr int WX = 8 + Epi::NST + Epi::NPRE;
#define PG8_WAIT_X() do { if constexpr (WX == 8) PG8_WAIT_V(8); else { if (fst) PG8_WAIT_VN(WX); else PG8_WAIT_V(8); } } while (0)
    for (;;) {
        int fst = 1; asm volatile("" : "+s"(fst));
#pragma unroll 1
        for (int t = 0; t < nt; t += 2) {
            const bool last = (t == nt - 2);
            const char* a1 = cA + (size_t)(t + 1) * kstep;
            const char* a2 = last ? nA : cA + (size_t)(t + 2) * kstep; const char* b2 = last ? nB : cB + (size_t)(t + 2) * kstep;
            const char* a3 = a2 + kstep; const char* b3 = b2 + kstep;
            unsigned sv[2][2];
            if constexpr (GATH) { _Pragma("unroll") for (int h_ = 0; h_ < 2; ++h_) _Pragma("unroll") for (int i_ = 0; i_ < 2; ++i_) sv[h_][i_] = last ? nvA[h_][i_] : cvA[h_][i_]; }
            PG8_LDB(B0, 0, 0); PG8_LDB(B1, 0, 1); PG8_SCHED; PG8_LDA(At, 0, 0); if (!fst) PG8_STA(1, 1, a1, cvA); else { if constexpr (Epi::NPRE == 1) E.prefetch(cur, wid, lane); }
            PG8_WAIT_X(); PG8_WAIT_L(0); PG8_BAR; PG8_MMA(0, 0, At, B0); PG8_MMA(0, 1, At, B1); PG8_BAR; PG8_SCHED;
            PG8_LDA(At, 0, 1); PG8_STAGE(PG8_SB(0, 0), b2, voffB); PG8_STAGE(PG8_SB(0, 1), b2 + hstepB, voffB); PG8_STA(0, 0, a2, sv);
            PG8_WAIT_X(); PG8_WAIT_L(0); PG8_BAR; PG8_MMA(1, 0, At, B0); PG8_MMA(1, 1, At, B1); PG8_BAR; PG8_SCHED;
            PG8_LDB(B0, 1, 0); PG8_LDB(B1, 1, 1); PG8_SCHED; PG8_LDA(At, 1, 0); PG8_STA(0, 1, a2, sv);
            PG8_WAIT_X(); PG8_WAIT_L(0); PG8_BAR; PG8_MMA(0, 0, At, B0); PG8_MMA(0, 1, At, B1); PG8_BAR; PG8_SCHED;
            PG8_LDA(At, 1, 1); PG8_STAGE(PG8_SB(1, 0), b3, voffB); PG8_STAGE(PG8_SB(1, 1), b3 + hstepB, voffB); PG8_STA(1, 0, a3, sv);
            PG8_WAIT_V(8); PG8_WAIT_L(0); PG8_BAR; PG8_MMA(1, 0, At, B0); PG8_MMA(1, 1, At, B1); PG8_BAR; PG8_SCHED;
            fst = 0;
        }
        if (wr == 0) PG8_BAR;
        PG8_STA(1, 1, nA + kstep, nvA);
        Unit nn; const bool has_nn = has_next && S.next(ui + 2, nn);
        unsigned n2vA[2][2];
        if constexpr (GATH) { if (has_nn) PG8_GVOFF(nn, n2vA); else { _Pragma("unroll") for (int h_ = 0; h_ < 2; ++h_) _Pragma("unroll") for (int i_ = 0; i_ < 2; ++i_) n2vA[h_][i_] = nvA[h_][i_]; } }
        { const int le_ = hw_lane(); run_epi<PAIR>(E, acc, cur, wr, wc, le_ & 15, le_ >> 4); }
        if (!has_next) break;
#pragma unroll
        for (int a = 0; a < 2; ++a)
#pragma unroll
            for (int b = 0; b < 2; ++b)
#pragma unroll
                for (int m = 0; m < 4; ++m)
#pragma unroll
                    for (int n = 0; n < 2; ++n) acc[a][b][m][n] = Z4;
        PG8_VOFFS();
        cur = nxt; cA = nA; cB = nB; ++ui;
        if constexpr (GATH) { _Pragma("unroll") for (int h_ = 0; h_ < 2; ++h_) _Pragma("unroll") for (int i_ = 0; i_ < 2; ++i_) { cvA[h_][i_] = nvA[h_][i_]; nvA[h_][i_] = n2vA[h_][i_]; } }
        has_next = has_nn;
        if (has_nn) { nxt = nn; if constexpr (!GATH) nA = (const char*)g.A + (size_t)nn.aoff * 2; nB = (const char*)g.Bt + (size_t)nn.boff * 2; }
        if (wr == 1) PG8_BAR;
    }
#undef PG8_WAIT_X
#undef PG8_VOFFS
    PG8_WAIT_V(0);
    PG8_BAR;
#undef PG8_SA
#undef PG8_SB
#undef PG8_STAGE
#undef PG8_LDA
#undef PG8_STA
#undef PG8_GVOFF
#undef PG8_LDB
#undef PG8_MMA
#undef PG8_WAIT_V
#undef PG8_WAIT_VN
#undef PG8_WAIT_L
#undef PG8_BAR
#undef PG8_SCHED
}
}

struct Args { const float* in[37]; float* out; unsigned char* ws; int lo, hi, pad0, pad1; };
enum { I_X = 0, I_MEM, I_LNIN_G, I_LNIN_B, I_WIN, I_WF, I_BF, I_DWW, I_DWB, I_CLG, I_CLB, I_WPW, I_BPW, I_QG, I_KG, I_MQG, I_WUQ, I_MKG, I_WUKV, I_GRPG, I_WO, I_LN1G, I_LN1B,
       I_WXQ, I_WXK, I_WXV, I_WXO, I_LN2G, I_LN2B, I_WR, I_BR, I_WGU, I_BGU, I_WDN, I_BDN, I_LN3G, I_LN3B };

__device__ __forceinline__ int rope_perm16(int d) { const int half = d >> 4, dd = d & 15; return half * 16 + ((dd < 8) ? 2 * dd : 2 * (dd - 8) + 1); }
__device__ __forceinline__ int rope_perm32(int d) { const int half = d >> 5, dd = d & 31; return half * 32 + ((dd < 16) ? 2 * dd : 2 * (dd - 16) + 1); }
__device__ __forceinline__ int map_row(int mode, int n) {
    switch (mode) {
    case 1: if (n < 256) return -1; if (n < 768) return n; if (n < 1152) { const int m = n - 768; return 768 + (m & ~63) + rope_perm32(m & 63); } if (n < 1664) return n; return 1664 + rope_perm16(n - 1664);
    case 2: { const int h = n / 96, p = n % 96; return h * 128 + (p < 64 ? p : 64 + rope_perm16(p - 64)); }
    case 3: return 512 + n;
    case 4: { const int half = n >> 10, m = n & 1023; return (m >> 7) * 256 + half * 128 + (m & 127); }
    default: return n;
    }
}
__device__ __forceinline__ void cp_item(const float* __restrict__ W, bf16_t* dst, float scale, int item, int lane) {
    const int r0 = (item >> 4) * 64 + (lane >> 4), c0 = (item & 15) * 64 + (lane & 15) * 4;
#pragma unroll
    for (int i = 0; i < 16; ++i) { const f32x4 v = *(const f32x4*)(W + (size_t)(r0 + 4 * i) * 1024 + c0) * scale; u32x2 w; w.x = pk2(v.x, v.y); w.y = pk2(v.z, v.w); *(u32x2*)(dst + (size_t)(r0 + 4 * i) * 1024 + c0) = w; }
}
__device__ __forceinline__ int fnet_j(int cc) { const int jp = cc >> 1, second = cc & 1; return jp == 0 ? (second ? 32 : 0) : (second ? 64 - jp : jp); }
__device__ __forceinline__ void tr_item(const float* __restrict__ W, int N, bf16_t* dst, int ldd, int koff, const float* kgain, float scale, int mode, int rowbase, LAS float* scr, int item, int lane, int kperm = 0) {
    const int nblk = (N + 63) >> 6, kb = item / nblk, nb = item - kb * nblk, k0 = kb * 64, n0 = nb * 64;
    const int nq = (lane & 15) * 4, kq = lane >> 4;
    const bool ok = (n0 + nq) < N;
    f32x4 v[16];
#pragma unroll
    for (int i = 0; i < 16; ++i) { const int kk = 4 * i + kq; const int ksrc = kperm ? (((k0 + kk) & ~63) + fnet_j((k0 + kk) & 63)) : (k0 + kk); v[i] = ok ? *(const f32x4*)(W + (size_t)ksrc * N + n0 + nq) : (f32x4){0.f, 0.f, 0.f, 0.f}; }
#pragma unroll
    for (int i = 0; i < 16; ++i) { const int kk = 4 * i + kq; const float gs = (kgain ? kgain[k0 + kk] : 1.f) * scale;
        scr[kk * 65 + nq + 0] = v[i].x * gs; scr[kk * 65 + nq + 1] = v[i].y * gs; scr[kk * 65 + nq + 2] = v[i].z * gs; scr[kk * 65 + nq + 3] = v[i].w * gs; }
    LDS_WAIT(); asm volatile("" ::: "memory");
    const int c = lane & 7;
#pragma unroll
    for (int j = 0; j < 8; ++j) { const int n = (lane >> 3) + 8 * j;
        if (n0 + n < N) { const int row = map_row(mode, n0 + n);
            if (row >= 0) { const LAS float* s = scr + (8 * c) * 65 + n;
                u32x4 o; o.x = pk2(s[0 * 65], s[1 * 65]); o.y = pk2(s[2 * 65], s[3 * 65]); o.z = pk2(s[4 * 65], s[5 * 65]); o.w = pk2(s[6 * 65], s[7 * 65]);
                *(u32x4*)(dst + (size_t)(rowbase + row) * ldd + koff + k0 + 8 * c) = o; } } }
    LDS_WAIT(); asm volatile("" ::: "memory");
}
constexpr int IT_IN = 16 * 27, IT_UQ = 4 * 6, IT_UKV = 2 * 8, IT_F = 16, IT_SQ = 256, IT_GU = 32 * 512, IT_DN = 32 * 256;
constexpr int IT_SMALL = IT_IN + IT_UQ + IT_UKV + 2 * IT_F + 5 * IT_SQ, IT_MOE = IT_GU + IT_DN;

struct R8 { f32x4 lo, hi; };
__device__ __forceinline__ R8 unpack8(const u32x4 w) { R8 r; r.lo = (f32x4){bflo(w.x), bfhi(w.x), bflo(w.y), bfhi(w.y)}; r.hi = (f32x4){bflo(w.z), bfhi(w.z), bflo(w.w), bfhi(w.w)}; return r; }
__device__ __forceinline__ u32x4 pack8(const R8& r) { return (u32x4){pk2(r.lo.x, r.lo.y), pk2(r.lo.z, r.lo.w), pk2(r.hi.x, r.hi.y), pk2(r.hi.z, r.hi.w)}; }
__device__ __forceinline__ float hsum8(const R8& r) { return ((r.lo.x + r.lo.y) + (r.lo.z + r.lo.w)) + ((r.hi.x + r.hi.y) + (r.hi.z + r.hi.w)); }
__device__ __forceinline__ float hsq8(const R8& r) { return ((r.lo.x * r.lo.x + r.lo.y * r.lo.y) + (r.lo.z * r.lo.z + r.lo.w * r.lo.w)) + ((r.hi.x * r.hi.x + r.hi.y * r.hi.y) + (r.hi.z * r.hi.z + r.hi.w * r.hi.w)); }
template <int NR>
__device__ __forceinline__ void ln_rows(R8 (&v)[NR][2], const float* g, const float* b, int lane) {
    float mean[NR], rstd[NR];
#pragma unroll
    for (int q = 0; q < NR; ++q) mean[q] = hsum8(v[q][0]) + hsum8(v[q][1]);
#pragma unroll
    for (int q = 0; q < NR; ++q) mean[q] = rsum<2>(rsum<1>(mean[q]));
#pragma unroll
    for (int q = 0; q < NR; ++q) mean[q] = rsum<8>(rsum<4>(mean[q]));
#pragma unroll
    for (int q = 0; q < NR; ++q) mean[q] = rsum<32>(rsum<16>(mean[q]));
#pragma unroll
    for (int q = 0; q < NR; ++q) { mean[q] *= (1.f / D);
#pragma unroll
        for (int j = 0; j < 2; ++j) { v[q][j].lo = v[q][j].lo - mean[q]; v[q][j].hi = v[q][j].hi - mean[q]; }
        rstd[q] = hsq8(v[q][0]) + hsq8(v[q][1]); }
#pragma unroll
    for (int q = 0; q < NR; ++q) rstd[q] = rsum<2>(rsum<1>(rstd[q]));
#pragma unroll
    for (int q = 0; q < NR; ++q) rstd[q] = rsum<8>(rsum<4>(rstd[q]));
#pragma unroll
    for (int q = 0; q < NR; ++q) rstd[q] = rsum<32>(rsum<16>(rstd[q]));
#pragma unroll
    for (int j = 0; j < 2; ++j) { const f32x4 g0 = *(const f32x4*)(g + 512 * j + 8 * lane), g1 = *(const f32x4*)(g + 512 * j + 8 * lane + 4), b0 = *(const f32x4*)(b + 512 * j + 8 * lane), b1 = *(const f32x4*)(b + 512 * j + 8 * lane + 4);
#pragma unroll
        for (int q = 0; q < NR; ++q) { const float r = __builtin_amdgcn_rsqf(rstd[q] * (1.f / D) + LN_EPS); v[q][j].lo = v[q][j].lo * r * g0 + b0; v[q][j].hi = v[q][j].hi * r * g1 + b1; } }
}
__device__ __forceinline__ void store_row_bf16(bf16_t* row, const R8 (&v)[2], int lane) {
#pragma unroll
    for (int j = 0; j < 2; ++j) *(u32x4*)(row + 512 * j + 8 * lane) = pack8(v[j]);
}
__device__ __forceinline__ void store_row_f32(float* row, const R8 (&v)[2], int lane) {
#pragma unroll
    for (int j = 0; j < 2; ++j) { *(f32x4*)(row + 512 * j + 8 * lane) = v[j].lo; *(f32x4*)(row + 512 * j + 8 * lane + 4) = v[j].hi; }
}

struct MoeWItem { const float* W; bf16_t* dst; int N, mode, rowbase, k0, n0; };
__device__ __forceinline__ MoeWItem moe_w_item(const Args& a, int it) {
    MoeWItem m; const int l = it / IT_MOE; int r = it - l * IT_MOE; unsigned char* wl = a.ws + WS_W + (size_t)l * WL_SIZE; int item;
    if (r < IT_GU) { const int e = r >> 9; m.W = a.in[I_WGU] + ((size_t)l * NE + e) * 1024 * 2048; m.N = 2048; m.dst = (bf16_t*)(wl + WL_GU); m.mode = 4; m.rowbase = e * 2048; item = r & 511; }
    else { r -= IT_GU; const int e = r >> 8; m.W = a.in[I_WDN] + ((size_t)l * NE + e) * 1024 * 1024; m.N = 1024; m.dst = (bf16_t*)(wl + WL_DN); m.mode = 0; m.rowbase = e * 1024; item = r & 255; }
    const int nblk = m.N >> 6, kb = item / nblk, nb = item - kb * nblk; m.k0 = kb * 64; m.n0 = nb * 64; return m;
}
__device__ __forceinline__ void moe_w_load(const MoeWItem& m, int lane, f32x4 (&v)[16]) {
    const float* src = m.W + (size_t)(m.k0 + 2 * (lane >> 4)) * m.N + m.n0 + (lane & 15) * 4;
#pragma unroll
    for (int i = 0; i < 8; ++i) { v[2 * i] = __builtin_nontemporal_load((const f32x4*)(src + (size_t)(8 * i) * m.N)); v[2 * i + 1] = __builtin_nontemporal_load((const f32x4*)(src + (size_t)(8 * i + 1) * m.N)); }
}
__device__ __forceinline__ void moe_w_finish(const MoeWItem& m, int lane, const f32x4 (&v)[16], LAS float* scr) {
    const int l = lane & 15, kq = lane >> 4; LAS unsigned* sw = (LAS unsigned*)scr;
#pragma unroll
    for (int i = 0; i < 8; ++i) { LAS unsigned* w = sw + (4 * l) * 32 + 4 * (i ^ (l & 7)) + kq;
        w[0] = pk2(v[2 * i].x, v[2 * i + 1].x); w[32] = pk2(v[2 * i].y, v[2 * i + 1].y); w[64] = pk2(v[2 * i].z, v[2 * i + 1].z); w[96] = pk2(v[2 * i].w, v[2 * i + 1].w); }
    LDS_WAIT(); asm volatile("" ::: "memory");
    const int c = lane & 7;
#pragma unroll
    for (int j = 0; j < 8; ++j) { const int n = (lane >> 3) + 8 * j; const int row = map_row(m.mode, m.n0 + n);
        const u32x4 o = *(const LAS u32x4*)(sw + n * 32 + 4 * (c ^ ((n >> 2) & 7)));
        *(u32x4*)(m.dst + (size_t)(m.rowbase + row) * 1024 + m.k0 + 8 * c) = o; }
    LDS_WAIT(); asm volatile("" ::: "memory");
}
__device__ __forceinline__ void moe_weight_items(const int tid, const int bid, const Args& a, LAS unsigned char* lds) {
    const int lane = tid & 63, wave = tid >> 6;
    const int gw = bid * NWAVES + wave, NGW = gridDim.x * NWAVES;
    LAS float* scr = (LAS float*)(lds + wave * 16640);
    static_assert((NLAYER * IT_MOE) % (256 * NWAVES * 2) == 0, "every wave converts an even number of tiles");
    f32x4 va[16], vb[16];
    MoeWItem ma = moe_w_item(a, gw), mb; moe_w_load(ma, lane, va);
#pragma unroll 1
    for (int it = gw; it < NLAYER * IT_MOE; it += 2 * NGW) {
        mb = moe_w_item(a, it + NGW); moe_w_load(mb, lane, vb);
        moe_w_finish(ma, lane, va, scr);
        if (it + 2 * NGW < NLAYER * IT_MOE) { ma = moe_w_item(a, it + 2 * NGW); moe_w_load(ma, lane, va); }
        moe_w_finish(mb, lane, vb, scr);
    }
}
__device__ __forceinline__ void phase_pre0(const int tid, const int bid, const Args& a, LAS unsigned char* lds) {
    const int lane = tid & 63, wave = tid >> 6;
    const int gw = bid * NWAVES + wave, NGW = gridDim.x * NWAVES;
    const long gt = (long)bid * NTHREADS + tid, NGT = (long)gridDim.x * NTHREADS;
    unsigned char* ws = a.ws;
    LAS float* scr = (LAS float*)(lds + wave * 16640);
    for (int it = gw; it < NLAYER * IT_SMALL; it += NGW) {
        const int l = it / IT_SMALL; int r = it - l * IT_SMALL;
        unsigned char* wl = ws + WS_W + (size_t)l * WL_SIZE;
        if (r < IT_IN) { tr_item(a.in[I_WIN] + (size_t)l * 1024 * INC, INC, (bf16_t*)(wl + WL_IN), 1024, 0, nullptr, 1.f, 1, 0, scr, r, lane); continue; } r -= IT_IN;
        if (r < IT_UQ) { tr_item(a.in[I_WUQ] + (size_t)l * 256 * 384, 384, (bf16_t*)(wl + WL_MLA), 384, 0, a.in[I_MQG] + l * 256, QSCALE_M, 2, 0, scr, r, lane); continue; } r -= IT_UQ;
        if (r < IT_UKV) { tr_item(a.in[I_WUKV] + (size_t)l * 128 * 512, 512, (bf16_t*)(wl + WL_MLA), 384, 256, a.in[I_MKG] + l * 128, 1.f, 3, 0, scr, r, lane); continue; } r -= IT_UKV;
        if (r < IT_F) { tr_item(a.in[I_WF] + (size_t)l * 65536, 256, (bf16_t*)(wl + WL_FC), 256, 0, nullptr, 1.f, 0, 0, scr, r, lane, 1); continue; } r -= IT_F;
        if (r < IT_F) { tr_item(a.in[I_WPW] + (size_t)l * 65536, 256, (bf16_t*)(wl + WL_FC), 256, 0, nullptr, 1.f, 0, 256, scr, r, lane); continue; } r -= IT_F;
        if (r < IT_SQ) { tr_item(a.in[I_WO] + (size_t)l * D * D, D, (bf16_t*)(wl + WL_O), D, 0, a.in[I_GRPG] + l * 1024, 1.f, 0, 0, scr, r, lane); continue; } r -= IT_SQ;
        if (r < IT_SQ) { cp_item(a.in[I_WXQ] + (size_t)l * D * D, (bf16_t*)(wl + WL_XQ), QSCALE_X, r, lane); continue; } r -= IT_SQ;
        if (r < IT_SQ) { tr_item(a.in[I_WXK] + (size_t)l * D * D, D, (bf16_t*)(wl + WL_XK), D, 0, nullptr, 1.f, 0, 0, scr, r, lane); continue; } r -= IT_SQ;
        if (r < IT_SQ) { tr_item(a.in[I_WXV] + (size_t)l * D * D, D, (bf16_t*)(wl + WL_XV), D, 0, nullptr, 1.f, 0, 0, scr, r, lane); continue; } r -= IT_SQ;
        { tr_item(a.in[I_WXO] + (size_t)l * D * D, D, (bf16_t*)(wl + WL_XO), D, 0, nullptr, 1.f, 0, 0, scr, r, lane); }
    }
    for (long idx = gt; idx < (long)NLAYER * 256 * 1024; idx += NGT) {
        const int l = (int)(idx >> 18), k = (int)(idx >> 8) & 1023, n = (int)idx & 255, g = n >> 6, cc = n & 63, jp = cc >> 1, second = cc & 1;
        const int mult = (jp == 0 && second) ? 32 : jp; const bool use_cos = (second == 0) || (jp == 0);
        const float* w = a.in[I_WIN] + ((size_t)l * 1024 + k) * INC + g * 64; float acc = 0.f;
#pragma unroll 8
        for (int c = 0; c < 64; ++c) { const float fr = (float)((mult * c) & 63) * (1.f / 64.f); const float cv = __builtin_amdgcn_cosf(fr), sv = -__builtin_amdgcn_sinf(fr); acc += w[c] * (use_cos ? cv : sv); }
        ((bf16_t*)(ws + WS_W + (size_t)l * WL_SIZE + WL_IN))[(size_t)n * 1024 + k] = (bf16_t)f2bf(acc);
    }
    for (long idx = gt; idx < (long)NLAYER * 96 * 1024; idx += NGT) { const int l = (int)(idx / (96 * 1024)); const long r = idx % (96 * 1024);
        ((bf16_t*)(ws + WS_W + (size_t)l * WL_SIZE + WL_IN))[(size_t)INC * 1024 + r] = 0; }
    for (long idx = gt; idx < (long)NLAYER * 1024 * 384; idx += NGT) { const int l = (int)(idx / (1024 * 384)); const int r = (int)(idx % (1024 * 384)), row = r / 384, k = r % 384;
        const bool pad = (row < 512) ? (k >= 256 || (row & 127) >= 96) : (k < 256);
        if (pad) ((bf16_t*)(ws + WS_W + (size_t)l * WL_SIZE + WL_MLA))[r] = 0; }
    for (long idx = gt; idx < (long)NLAYER * 32 * 1024; idx += NGT) { const int l = (int)(idx >> 15), e = (int)(idx >> 10) & 31, k = (int)idx & 1023;
        const float w = a.in[I_WR][((size_t)l * 1024 + k) * 32 + e]; const unsigned hb = f2bf(w); const unsigned lb = f2bf(w - bf2f(hb));
        bf16_t* wr = (bf16_t*)(ws + WS_W + (size_t)l * WL_SIZE + WL_RT); wr[e * 1024 + k] = (bf16_t)hb; wr[32768 + e * 1024 + k] = (bf16_t)lb; }
    for (long idx = gt; idx < (long)NB * MEML * D / 4; idx += NGT) { const f32x4 v = *(const f32x4*)(a.in[I_MEM] + idx * 4); u32x2 w; w.x = pk2(v.x, v.y); w.y = pk2(v.z, v.w); *(u32x2*)((bf16_t*)(ws + WS_MEMB) + idx * 4) = w; }
    for (int m0 = gw; m0 < T; m0 += 4 * NGW) { R8 v[4][2];
#pragma unroll
        for (int q = 0; q < 4; ++q) { const float* xr = a.in[I_X] + (size_t)(m0 + q * NGW) * D;
#pragma unroll
            for (int j = 0; j < 2; ++j) { v[q][j].lo = *(const f32x4*)(xr + 512 * j + 8 * lane); v[q][j].hi = *(const f32x4*)(xr + 512 * j + 8 * lane + 4); } }
        ln_rows<4>(v, a.in[I_LNIN_G], a.in[I_LNIN_B], lane);
#pragma unroll
        for (int q = 0; q < 4; ++q) store_row_bf16((bf16_t*)(ws + WS_HB) + (size_t)(m0 + q * NGW) * D, v[q], lane); }
}

struct LayerCtx {
    int l; unsigned char* ws; unsigned char* wl;
    bf16_t *Z, *FC, *QG, *KG, *CQKV, *KR, *QKVM, *Y, *XQ, *PB, *XO, *XS, *ACT, *YS, *HB;
    float *YMIX, *RS; bf16_t* FB;
    int *RE, *RR, *DEST, *TOK; float* GATE; unsigned* cnt;
};
__device__ __forceinline__ LayerCtx make_ctx(const Args& a, int l) {
    LayerCtx c; c.l = l; c.ws = a.ws; c.wl = a.ws + WS_W + (size_t)l * WL_SIZE; unsigned char* r = a.ws + WS_R;
    c.Z = (bf16_t*)(r + R_Z); c.FC = (bf16_t*)(r + R_FC); c.QG = (bf16_t*)(r + R_QG); c.KG = (bf16_t*)(r + R_KG); c.CQKV = (bf16_t*)(r + R_CQKV); c.KR = (bf16_t*)(r + R_KR);
    c.QKVM = (bf16_t*)(r + R_QKVM); c.YMIX = (float*)(r + R_YMIX); c.Y = (bf16_t*)(r + R_Y);
    c.XQ = (bf16_t*)(r + R_XQ); c.RS = (float*)(a.ws + WS_F + 64 * MiB); c.PB = (bf16_t*)(r + R_PB); c.XO = (bf16_t*)(r + R_XO);
    c.XS = (bf16_t*)(r + R_XS); c.ACT = (bf16_t*)(r + R_ACT); c.YS = (bf16_t*)(r + R_XS);
    c.HB = (bf16_t*)(a.ws + WS_HB); c.FB = (bf16_t*)(a.ws + WS_F);
    c.RE = (int*)(a.ws + WS_ROUTE); c.RR = c.RE + T * 4; c.GATE = (float*)(c.RR + T * 4); c.DEST = (int*)(c.GATE + T * 4);
    c.cnt = (unsigned*)(a.ws + WS_CTL) + CW_CNT + MAXWG * 32 * l; c.TOK = (int*)(a.ws + WS_CTL) + CW_TOK;
    return c;
}
constexpr float L2_THETA = 13.287712379549449f;

__device__ __forceinline__ void conv_item(const int tid, const Args& a, const LayerCtx& c, int item, LAS unsigned char* lds) {
    const int lane = tid & 63, wave = tid >> 6;
    LAS float* U = (LAS float*)lds; LAS float* CO = (LAS float*)lds;
    const int t0 = item * 64, b = t0 >> 13, s0 = t0 & (SEQ - 1);
#pragma unroll
    for (int i = 0; i < 6; ++i) { const int idx = tid + NTHREADS * i, row = idx >> 5, c8 = (idx & 31) * 8, sq = s0 - 15 + row;
        if (row < 94) { f32x4 u0 = {0.f, 0.f, 0.f, 0.f}, u1 = {0.f, 0.f, 0.f, 0.f};
            if (sq >= 0 && sq < SEQ) { const bf16_t* z = c.Z + (size_t)(b * SEQ + sq) * ZC; const R8 av = unpack8(*(const u32x4*)(z + ZC_CA + c8)), gv = unpack8(*(const u32x4*)(z + ZC_CG + c8));
#pragma unroll
                for (int e = 0; e < 4; ++e) { u0[e] = av.lo[e] * sigmoidf_(gv.lo[e]); u1[e] = av.hi[e] * sigmoidf_(gv.hi[e]); } }
            *(LAS f32x4*)(U + row * 256 + c8) = u0; *(LAS f32x4*)(U + row * 256 + c8 + 4) = u1; } }
    __syncthreads();
    { const int ch = tid & 255, half = tid >> 8; const float* dw = a.in[I_DWW] + (size_t)c.l * 31 * 256 + ch; const float bias = a.in[I_DWB][c.l * 256 + ch];
      float wv[31], win[62];
#pragma unroll
      for (int w = 0; w < 31; ++w) wv[w] = dw[w * 256];
#pragma unroll
      for (int r = 0; r < 62; ++r) win[r] = U[(half * 32 + r) * 256 + ch];
      __syncthreads();
#pragma unroll
      for (int o = 0; o < 32; ++o) { float acc = bias;
#pragma unroll
          for (int w = 0; w < 31; ++w) acc += win[o + w] * wv[w];
          CO[(half * 32 + o) * 256 + ch] = acc; } }
    __syncthreads();
    { const float* cg = a.in[I_CLG] + c.l * 256; const float* cb = a.in[I_CLB] + c.l * 256;
      const f32x4 gg = *(const f32x4*)(cg + 4 * lane), bb = *(const f32x4*)(cb + 4 * lane);
#pragma unroll
      for (int q0 = 0; q0 < 8; q0 += 4) { f32x4 x[4]; float mean[4], var[4];
#pragma unroll
          for (int q = 0; q < 4; ++q) { x[q] = *(const LAS f32x4*)(CO + (wave * 8 + q0 + q) * 256 + 4 * lane); mean[q] = (x[q].x + x[q].y) + (x[q].z + x[q].w); }
#pragma unroll
          for (int q = 0; q < 4; ++q) mean[q] = wave_sum(mean[q]);
#pragma unroll
          for (int q = 0; q < 4; ++q) { x[q] = x[q] - mean[q] * (1.f / 256.f); var[q] = (x[q].x * x[q].x + x[q].y * x[q].y) + (x[q].z * x[q].z + x[q].w * x[q].w); }
#pragma unroll
          for (int q = 0; q < 4; ++q) var[q] = wave_sum(var[q]);
#pragma unroll
          for (int q = 0; q < 4; ++q) { const float rstd = __builtin_amdgcn_rsqf(var[q] * (1.f / 256.f) + LN_EPS); f32x4 y = x[q] * rstd * gg + bb;
#pragma unroll
              for (int e = 0; e < 4; ++e) y[e] = y[e] * sigmoidf_(y[e]);
              u32x2 w; w.x = pk2(y.x, y.y); w.y = pk2(y.z, y.w); *(u32x2*)(c.FC + (size_t)(t0 + wave * 8 + q0 + q) * 512 + 256 + 4 * lane) = w; } } }
    __syncthreads();
}

struct QkRaw { u32x2 q; unsigned k; u32x2 cq; unsigned ckv; unsigned kr; };
struct QkConst { float qg0, qg1, qg2, qg3, kg0, kg1, fq0, fq1, fk, fr; };
__device__ __forceinline__ QkConst qkprep_const(const Args& a, const LayerCtx& c, int lane) { QkConst k;
    { const int p = 4 * (lane & 15), half = p >> 5, i0 = (p & 31) >> 1; const float* qg = a.in[I_QG] + c.l * 64 + half * 32;
      k.qg0 = qg[i0]; k.qg1 = qg[16 + i0]; k.qg2 = qg[i0 + 1]; k.qg3 = qg[16 + i0 + 1];
      k.fq0 = __builtin_amdgcn_exp2f(-(float)i0 * (L2_THETA / 16.f)); k.fq1 = __builtin_amdgcn_exp2f(-(float)(i0 + 1) * (L2_THETA / 16.f)); }
    { const int p = (2 * lane) & 63, half = p >> 5, i0 = (p & 31) >> 1; const float* kg = a.in[I_KG] + c.l * 64 + half * 32;
      k.kg0 = kg[i0]; k.kg1 = kg[16 + i0]; k.fk = __builtin_amdgcn_exp2f(-(float)i0 * (L2_THETA / 16.f)); }
    k.fr = __builtin_amdgcn_exp2f(-(float)(lane & 7) * (L2_THETA / 8.f)); return k; }
__device__ __forceinline__ QkRaw qkprep_load(const LayerCtx& c, int t, int lane) { const bf16_t* z = c.Z + (size_t)t * ZC; QkRaw r;
    r.q = *(const u32x2*)(z + ZC_Q + 4 * lane); r.k = *(const unsigned*)(z + ZC_K + 2 * lane); r.cq = *(const u32x2*)(z + ZC_CQ + 4 * lane); r.ckv = *(const unsigned*)(z + ZC_CKV + 2 * lane);
    r.kr = (lane < 16) ? *(const unsigned*)(z + ZC_KR + 2 * lane) : 0u; return r; }
__device__ __forceinline__ void qkprep_row(const LayerCtx& c, int t, int lane, const QkRaw& raw, const QkConst& kc) {
    const int s = t & (SEQ - 1); const float prow = (float)(s >> 6), pcol = (float)(s & 63);
    {
        const u32x2 w = raw.q; float x0 = bflo(w.x), x1 = bfhi(w.x), x2 = bflo(w.y), x3 = bfhi(w.y);
        float ss = (x0 * x0 + x1 * x1) + (x2 * x2 + x3 * x3);
        ss = rsum<1>(ss); ss = rsum<2>(ss); ss = rsum<4>(ss); ss = rsum<8>(ss);
        const float rstd = __builtin_amdgcn_rsqf(ss * (1.f / 64.f) + RMS_EPS);
        const int half = (lane & 15) >> 3;
        x0 *= rstd * kc.qg0; x1 *= rstd * kc.qg1; x2 *= rstd * kc.qg2; x3 *= rstd * kc.qg3;
        const float pos = half ? pcol : prow;
        rope2(x0, x1, pos * kc.fq0); rope2(x2, x3, pos * kc.fq1);
        u32x2 o; o.x = pk2(x0 * QSCALE_G, x1 * QSCALE_G); o.y = pk2(x2 * QSCALE_G, x3 * QSCALE_G); *(u32x2*)(c.QG + (size_t)t * 256 + 4 * lane) = o;
    }
    {
        const unsigned w = raw.k; float x0 = bflo(w), x1 = bfhi(w);
        float ss = x0 * x0 + x1 * x1;
        ss = rsum<1>(ss); ss = rsum<2>(ss); ss = rsum<4>(ss); ss = rsum<8>(ss); ss = rsum<16>(ss);
        const float rstd = __builtin_amdgcn_rsqf(ss * (1.f / 64.f) + RMS_EPS);
        const int half = (lane >> 4) & 1;
        x0 *= rstd * kc.kg0; x1 *= rstd * kc.kg1;
        rope2(x0, x1, (half ? pcol : prow) * kc.fk);
        *(unsigned*)(c.KG + (size_t)t * 128 + 2 * lane) = pk2(x0, x1);
    }
    {
        const u32x2 w = raw.cq; const float x0 = bflo(w.x), x1 = bfhi(w.x), x2 = bflo(w.y), x3 = bfhi(w.y);
        const float rstd = __builtin_amdgcn_rsqf(wave_sum((x0 * x0 + x1 * x1) + (x2 * x2 + x3 * x3)) * (1.f / 256.f) + RMS_EPS);
        u32x2 o; o.x = pk2(x0 * rstd, x1 * rstd); o.y = pk2(x2 * rstd, x3 * rstd); *(u32x2*)(c.CQKV + (size_t)t * 384 + 4 * lane) = o;
    }
    {
        const unsigned w = raw.ckv; const float x0 = bflo(w), x1 = bfhi(w);
        const float rstd = __builtin_amdgcn_rsqf(wave_sum(x0 * x0 + x1 * x1) * (1.f / 128.f) + RMS_EPS);
        *(unsigned*)(c.CQKV + (size_t)t * 384 + 256 + 2 * lane) = pk2(x0 * rstd, x1 * rstd);
    }
    if (lane < 16) {
        const unsigned w = raw.kr; float x0 = bflo(w), x1 = bfhi(w);
        const int half = lane >> 3;
        rope2(x0, x1, (half ? pcol : prow) * kc.fr);
        *(unsigned*)(c.KR + (size_t)t * 32 + 2 * lane) = pk2(x0, x1);
    }
}

__device__ __forceinline__ void dft_table(const int tid, LAS unsigned char* lds) {
    LAS f32x2* tw = (LAS f32x2*)lds;
    for (int m = tid; m < SEQ; m += NTHREADS) { const float x = (float)m * (1.f / 4096.f); tw[m] = (f32x2){cospif(x), sinpif(x)}; }
    __syncthreads();
}
__device__ __forceinline__ void dft_naive_unit(const int tid, const LayerCtx& c, int unit, LAS unsigned char* lds) {
    const LAS f32x2* tw = (const LAS f32x2*)lds;
    const int kk = tid >> 7, pair = tid & 127, g = pair >> 5, jp = pair & 31;
    const int b = unit >> 11, k = ((unit & 2047) << 2) + kk;
    const bf16_t* zp = c.Z + (size_t)b * SEQ * ZC + g * 64 + 2 * jp;
    float acc0 = 0.f, acc1 = 0.f; int idx = 0;
    for (int s = 0; s < SEQ; ++s) { const unsigned w = *(const unsigned*)(zp + (size_t)s * ZC); const f32x2 cs = tw[idx]; idx = (idx + k) & (SEQ - 1);
        acc0 += bflo(w) * cs.x; acc1 += bfhi(w) * (jp == 0 ? cs.x : cs.y); }
    bf16_t* o = c.FC + (size_t)(b * SEQ + k) * 512 + g * 64;
    if (jp == 0) { o[0] = (bf16_t)f2bf(acc0); o[32] = (bf16_t)f2bf(acc1); }
    else { o[jp] = (bf16_t)f2bf(acc0 + acc1); o[64 - jp] = (bf16_t)f2bf(acc0 - acc1); }
}

namespace fft {
constexpr int L_XI = 16384, L_FI = 32768, L_CS = 65536;
__device__ __forceinline__ float cosrev(float x) { return __builtin_amdgcn_cosf(x); }
__device__ __forceinline__ float sinrev(float x) { return __builtin_amdgcn_sinf(x); }
__device__ __forceinline__ void build_table(const int tid, LAS unsigned char* lds) {
#pragma unroll 1
    for (int e = tid; e < 4096; e += NTHREADS) { const int lane = e & 63, cs = (e >> 6) & 1, ks = (e >> 7) & 7, nb = e >> 10; const int k1 = 32 * nb + (lane & 31), h = lane >> 5;
        unsigned w[4];
#pragma unroll
        for (int j = 0; j < 4; ++j) { const int m0 = ((16 * ks + 8 * h + 2 * j) * k1) & 127, m1 = ((16 * ks + 8 * h + 2 * j + 1) * k1) & 127; const float f0 = (float)m0 * (1.f / 128.f), f1 = (float)m1 * (1.f / 128.f);
            w[j] = cs ? pk2(sinrev(f0), sinrev(f1)) : pk2(cosrev(f0), cosrev(f1)); }
        *(LAS u32x4*)(lds + L_CS + e * 16) = (u32x4){w[0], w[1], w[2], w[3]}; }
}
struct F64Frags { bf16x8 c[2][2], s[2][2]; };
__device__ __forceinline__ void build_f64(const int tid, F64Frags& F) {
    const int wid = tid >> 6, lane = tid & 63, r32 = lane & 31, hi = lane >> 5, k2 = 32 * (wid >> 2) + r32;
#pragma unroll
    for (int mb = 0; mb < 2; ++mb)
#pragma unroll
        for (int st = 0; st < 2; ++st) { unsigned wc[4], wsn[4];
#pragma unroll
            for (int jj = 0; jj < 4; ++jj) { const int j0 = 2 * jj, j1 = 2 * jj + 1;
                const int sa = 32 * mb + 16 * st + 8 * (j0 >> 2) + 4 * hi + (j0 & 3), sb = 32 * mb + 16 * st + 8 * (j1 >> 2) + 4 * hi + (j1 & 3);
                const float fa = (float)((sa * k2) & 63) * (1.f / 64.f), fb = (float)((sb * k2) & 63) * (1.f / 64.f);
                wc[jj] = pk2(cosrev(fa), cosrev(fb)); wsn[jj] = pk2(sinrev(fa), sinrev(fb)); }
            F.c[mb][st] = __builtin_bit_cast(bf16x8, (u32x4){wc[0], wc[1], wc[2], wc[3]}); F.s[mb][st] = __builtin_bit_cast(bf16x8, (u32x4){wsn[0], wsn[1], wsn[2], wsn[3]}); }
}
__device__ __forceinline__ bf16x8 negbf(bf16x8 x) { u32x4 w = __builtin_bit_cast(u32x4, x); w ^= 0x80008000u; return __builtin_bit_cast(bf16x8, w); }
__device__ __forceinline__ void unit(const int tid, const LayerCtx& c, const int u, LAS unsigned char* lds, const F64Frags& F) {
    const int wid = tid >> 6, lane = tid & 63, r32 = lane & 31, hi = lane >> 5, nb = wid & 3, kb = wid >> 2;
    const int b = u >> 7, g = (u >> 5) & 3, jp = u & 31;
    const bf16_t* zp = c.Z + (size_t)b * SEQ * ZC + g * 64 + 2 * jp;
#pragma unroll 4
    for (int i = 0; i < 16; ++i) { const int sx = tid + NTHREADS * i, s2 = sx & 63, s1 = sx >> 6; const unsigned w = *(const unsigned*)(zp + (size_t)sx * ZC);
        const int off = s2 * 256 + ((((s1 >> 3) ^ (s2 & 15))) << 4) + (s1 & 7) * 2;
        *(LAS unsigned short*)(lds + off) = (unsigned short)(w & 0xffffu); *(LAS unsigned short*)(lds + L_XI + off) = (unsigned short)(w >> 16); }
    __syncthreads();
    f32x16 GR[2], GI[2];
#pragma unroll
    for (int mb = 0; mb < 2; ++mb) { GR[mb] = f32x16{}; GI[mb] = f32x16{}; }
#pragma unroll
    for (int ks = 0; ks < 8; ++ks) {
        const bf16x8 cf = *(const LAS bf16x8*)(lds + L_CS + ((nb * 8 + ks) * 2 + 0) * 1024 + lane * 16), sf = *(const LAS bf16x8*)(lds + L_CS + ((nb * 8 + ks) * 2 + 1) * 1024 + lane * 16);
#pragma unroll
        for (int mb = 0; mb < 2; ++mb) { const int row = 32 * mb + r32, off = row * 256 + (((2 * ks + hi) ^ (row & 15)) << 4);
            const bf16x8 xr = *(const LAS bf16x8*)(lds + off), xi = *(const LAS bf16x8*)(lds + L_XI + off); const bf16x8 nxr = negbf(xr);
            GR[mb] = __builtin_amdgcn_mfma_f32_32x32x16_bf16(xr, cf, GR[mb], 0, 0, 0); GR[mb] = __builtin_amdgcn_mfma_f32_32x32x16_bf16(xi, sf, GR[mb], 0, 0, 0);
            GI[mb] = __builtin_amdgcn_mfma_f32_32x32x16_bf16(xi, cf, GI[mb], 0, 0, 0); GI[mb] = __builtin_amdgcn_mfma_f32_32x32x16_bf16(nxr, sf, GI[mb], 0, 0, 0); }
    }
    const int k1 = 32 * nb + r32;
    bf16x8 ar[2][2], ai[2][2];
#pragma unroll
    for (int mb = 0; mb < 2; ++mb) {
#pragma unroll
        for (int r = 0; r < 16; ++r) { const int s2v = 32 * mb + (r & 3) + 8 * (r >> 2) + 4 * hi; const float fr = (float)((s2v * k1) & (SEQ - 1)) * (1.f / 8192.f);
            const float tc = cosrev(fr), ts = sinrev(fr), gr = GR[mb][r], gi = GI[mb][r]; GR[mb][r] = gr * tc + gi * ts; GI[mb][r] = gi * tc - gr * ts; }
#pragma unroll
        for (int st = 0; st < 2; ++st) {
            const u32x4 wr = {pk2(GR[mb][8 * st], GR[mb][8 * st + 1]), pk2(GR[mb][8 * st + 2], GR[mb][8 * st + 3]), pk2(GR[mb][8 * st + 4], GR[mb][8 * st + 5]), pk2(GR[mb][8 * st + 6], GR[mb][8 * st + 7])};
            const u32x4 wi = {pk2(GI[mb][8 * st], GI[mb][8 * st + 1]), pk2(GI[mb][8 * st + 2], GI[mb][8 * st + 3]), pk2(GI[mb][8 * st + 4], GI[mb][8 * st + 5]), pk2(GI[mb][8 * st + 6], GI[mb][8 * st + 7])};
            ar[mb][st] = __builtin_bit_cast(bf16x8, wr); ai[mb][st] = __builtin_bit_cast(bf16x8, wi); }
    }
    __syncthreads();
    f32x16 ZR = f32x16{}, ZI = f32x16{};
#pragma unroll
    for (int mb = 0; mb < 2; ++mb)
#pragma unroll
        for (int st = 0; st < 2; ++st) { const bf16x8 nar = negbf(ar[mb][st]);
            ZR = __builtin_amdgcn_mfma_f32_32x32x16_bf16(ar[mb][st], F.c[mb][st], ZR, 0, 0, 0); ZR = __builtin_amdgcn_mfma_f32_32x32x16_bf16(ai[mb][st], F.s[mb][st], ZR, 0, 0, 0);
            ZI = __builtin_amdgcn_mfma_f32_32x32x16_bf16(ai[mb][st], F.c[mb][st], ZI, 0, 0, 0); ZI = __builtin_amdgcn_mfma_f32_32x32x16_bf16(nar, F.s[mb][st], ZI, 0, 0, 0); }
    { const int k2 = 32 * kb + r32;
#pragma unroll
      for (int q = 0; q < 4; ++q) { const int kk = k2 * 128 + 32 * nb + 8 * q + 4 * hi;
          *(LAS f32x4*)(lds + kk * 4) = (f32x4){ZR[4 * q], ZR[4 * q + 1], ZR[4 * q + 2], ZR[4 * q + 3]}; *(LAS f32x4*)(lds + L_FI + kk * 4) = (f32x4){ZI[4 * q], ZI[4 * q + 1], ZI[4 * q + 2], ZI[4 * q + 3]}; } }
    __syncthreads();
    bf16_t* op = c.FC + (size_t)b * SEQ * 512 + g * 64 + 2 * jp;
#pragma unroll 4
    for (int i = 0; i < 16; ++i) { const int k = tid + NTHREADS * i, kr = (SEQ - k) & (SEQ - 1);
        const float a0 = *(const LAS float*)(lds + k * 4), a1 = *(const LAS float*)(lds + kr * 4); float y0 = a0, y1 = a1;
        if (jp == 0) { const float b0 = *(const LAS float*)(lds + L_FI + k * 4), b1 = *(const LAS float*)(lds + L_FI + kr * 4); y0 = 0.5f * (a0 + a1); y1 = 0.5f * (b0 + b1); }
        *(unsigned*)(op + (size_t)k * 512) = pk2(y0, y1); }
    __syncthreads();
}
}

struct AttnSrc { const bf16_t* Q; int qp; const bf16_t* K; int kp; const bf16_t* K2; int k2p; const bf16_t* V; int vp; bf16_t* O; int op; };
__device__ __forceinline__ AttnSrc gqa_src(unsigned char* ws, int b, int h) {
    AttnSrc A; const size_t r0 = (size_t)b * SEQ; unsigned char* r = ws + WS_R;
    A.Q = (const bf16_t*)(r + R_QG) + r0 * 256 + h * 64; A.qp = 256; A.K = (const bf16_t*)(r + R_KG) + r0 * 128 + (h >> 1) * 64; A.kp = 128; A.K2 = nullptr; A.k2p = 0;
    A.V = (const bf16_t*)(r + R_Z) + r0 * ZC + ZC_V + (h >> 1) * 64; A.vp = ZC; A.O = (bf16_t*)(r + R_YMIX) + r0 * 512 + h * 64; A.op = 512; return A;
}
__device__ __forceinline__ AttnSrc mla_src(unsigned char* ws, int b, int h) {
    AttnSrc A; const size_t r0 = (size_t)b * SEQ; unsigned char* r = ws + WS_R; const bf16_t* qkvm = (const bf16_t*)(r + R_QKVM);
    A.Q = qkvm + r0 * 1024 + h * 128; A.qp = 1024; A.K = qkvm + r0 * 1024 + 512 + h * 128; A.kp = 1024; A.K2 = (const bf16_t*)(r + R_KR) + r0 * 32; A.k2p = 32;
    A.V = qkvm + r0 * 1024 + 512 + h * 128 + 64; A.vp = 1024; A.O = (bf16_t*)(r + R_YMIX) + r0 * 512 + 256 + h * 64; A.op = 512; return A;
}

namespace att {
using s16x4 = __attribute__((ext_vector_type(4))) short;
constexpr float ATT_THR = 8.f;
#define ATT_SBAR() __builtin_amdgcn_sched_barrier(0)
__device__ __forceinline__ int crow(int r, int hi) { return (r & 3) + 8 * (r >> 2) + 4 * hi; }
__device__ __forceinline__ unsigned cvtpk(float lo, float hi) { unsigned r; asm volatile("v_cvt_pk_bf16_f32 %0, %1, %2" : "=v"(r) : "v"(lo), "v"(hi)); return r; }
template <int KROW> __device__ __forceinline__ int kswz(int row, int colB) { return (KROW == 128) ? row * 128 + (colB ^ (((row >> 1) & 7) << 4)) : row * 256 + (colB ^ ((row & 15) << 4)); }
__device__ __forceinline__ void partialSM(f32x16& p0, f32x16& p1, float& m_reg, f32x16& negm, float& alpha, const bool first) {
    float pa = fmaxf(fmaxf(p0[0], p0[1]), p0[2]), pb = fmaxf(fmaxf(p1[0], p1[1]), p1[2]);
#pragma unroll
    for (int r = 3; r < 15; r += 2) { pa = fmaxf(fmaxf(pa, p0[r]), p0[r + 1]); pb = fmaxf(fmaxf(pb, p1[r]), p1[r + 1]); }
    float pmax = fmaxf(fmaxf(pa, pb), fmaxf(p0[15], p1[15]));
    { auto rr = __builtin_amdgcn_permlane32_swap(__float_as_uint(pmax), __float_as_uint(pmax), false, false); pmax = fmaxf(__uint_as_float(rr[0]), __uint_as_float(rr[1])); }
    alpha = 1.f;
    if (first || !__all(pmax <= ATT_THR)) {
        const float delta = first ? pmax : fmaxf(pmax, 0.f);
        m_reg += delta; alpha = first ? 1.f : __builtin_amdgcn_exp2f(-delta);
#pragma unroll
        for (int r = 0; r < 16; ++r) { p0[r] -= delta; p1[r] -= delta; negm[r] = -m_reg; }
    }
#pragma unroll
    for (int r = 0; r < 16; ++r) p0[r] = __builtin_amdgcn_exp2f(p0[r]);
}
__device__ __forceinline__ void finishSM(f32x16& p0, f32x16& p1, bf16x8& pa0, bf16x8& pa1, bf16x8& pa2, bf16x8& pa3) {
#pragma unroll
    for (int r = 0; r < 16; ++r) p1[r] = __builtin_amdgcn_exp2f(p1[r]);
#define ATT_PK4(P, BASE, OUT) do { unsigned a0 = cvtpk(P[BASE + 0], P[BASE + 1]), a1 = cvtpk(P[BASE + 2], P[BASE + 3]);   \
    unsigned b0 = cvtpk(P[BASE + 4], P[BASE + 5]), b1 = cvtpk(P[BASE + 6], P[BASE + 7]);                              \
    auto r0 = __builtin_amdgcn_permlane32_swap(a0, b0, false, false); auto r1 = __builtin_amdgcn_permlane32_swap(a1, b1, false, false); \
    u32x4 w = {r0[0], r1[0], r0[1], r1[1]}; OUT = __builtin_bit_cast(bf16x8, w); } while (0)
    ATT_PK4(p0, 0, pa0); ATT_PK4(p0, 8, pa1); ATT_PK4(p1, 0, pa2); ATT_PK4(p1, 8, pa3);
#undef ATT_PK4
}
template <int DK, int KROW>
__device__ __forceinline__ void qkt(f32x16& p0, f32x16& p1, const LAS unsigned char* Ks, const bf16x8* qr, const f32x16& negm, int r32, int hi) {
#pragma unroll
    for (int d0 = 0; d0 < DK / 16; ++d0) { const int cb = (d0 * 16 + hi * 8) * 2;
        const bf16x8 b0 = *(const LAS bf16x8*)(Ks + kswz<KROW>(r32, cb));
        const bf16x8 b1 = *(const LAS bf16x8*)(Ks + kswz<KROW>(32 + r32, cb));
        if (d0 == 0) { p0 = __builtin_amdgcn_mfma_f32_32x32x16_bf16(b0, qr[0], negm, 0, 0, 0); p1 = __builtin_amdgcn_mfma_f32_32x32x16_bf16(b1, qr[0], negm, 0, 0, 0); }
        else { p0 = __builtin_amdgcn_mfma_f32_32x32x16_bf16(b0, qr[d0], p0, 0, 0, 0); p1 = __builtin_amdgcn_mfma_f32_32x32x16_bf16(b1, qr[d0], p1, 0, 0, 0); } }
}
__device__ __forceinline__ int v_st(int k, int c) { const int kk = (k & ~0xC) | ((k & 4) << 1) | ((k & 8) >> 1); return ((kk >> 3) * 2 + (c >> 5)) * 512 + ((kk & 7) * 32 + (c & 31)) * 2; }
__device__ __forceinline__ int v_rd_base(int lane) { return ((lane & 3) << 3) | (((lane >> 2) & 3) << 6) | (((lane >> 4) & 1) << 5) | (((lane >> 5) & 1) << 8); }
constexpr int v_rd_off(int d0, int ks, int half) { return d0 * 512 + ks * 2048 + half * 1024; }
template <int OFF> __device__ __forceinline__ s16x4 tr_read(int vb) { s16x4 r; asm volatile("ds_read_b64_tr_b16 %0, %1 offset:%2" : "=&v"(r) : "v"(vb), "i"(OFF) : "memory"); return r; }
template <int KS> __device__ __forceinline__ void pv_half(f32x16* o, int vb, bf16x8 paA, bf16x8 paB) {
    const s16x4 a0 = tr_read<v_rd_off(0, KS, 0)>(vb), b0 = tr_read<v_rd_off(0, KS, 1)>(vb), c0 = tr_read<v_rd_off(1, KS, 0)>(vb), d0 = tr_read<v_rd_off(1, KS, 1)>(vb);
    const s16x4 a1 = tr_read<v_rd_off(0, KS + 1, 0)>(vb), b1 = tr_read<v_rd_off(0, KS + 1, 1)>(vb), c1 = tr_read<v_rd_off(1, KS + 1, 0)>(vb), d1 = tr_read<v_rd_off(1, KS + 1, 1)>(vb);
    const bf16x8 ones = {0x3F80, 0x3F80, 0x3F80, 0x3F80, 0x3F80, 0x3F80, 0x3F80, 0x3F80};
    asm volatile("s_waitcnt lgkmcnt(0)" ::: "memory"); ATT_SBAR();
#define ATT_PK(L, H) (bf16x8){L[0], L[1], L[2], L[3], H[0], H[1], H[2], H[3]}
    o[0] = __builtin_amdgcn_mfma_f32_32x32x16_bf16(paA, ATT_PK(a0, b0), o[0], 0, 0, 0); o[1] = __builtin_amdgcn_mfma_f32_32x32x16_bf16(paA, ATT_PK(c0, d0), o[1], 0, 0, 0); o[2] = __builtin_amdgcn_mfma_f32_32x32x16_bf16(paA, ones, o[2], 0, 0, 0);
    o[0] = __builtin_amdgcn_mfma_f32_32x32x16_bf16(paB, ATT_PK(a1, b1), o[0], 0, 0, 0); o[1] = __builtin_amdgcn_mfma_f32_32x32x16_bf16(paB, ATT_PK(c1, d1), o[1], 0, 0, 0); o[2] = __builtin_amdgcn_mfma_f32_32x32x16_bf16(paB, ones, o[2], 0, 0, 0);
#undef ATT_PK
}
__device__ __forceinline__ void pv_d0(f32x16* o, int vb, bf16x8 pa0, bf16x8 pa1, bf16x8 pa2, bf16x8 pa3) { pv_half<0>(o, vb, pa0, pa1); pv_half<2>(o, vb, pa2, pa3); }

#define ATT_WAITBAR(N) asm volatile("s_waitcnt vmcnt(" #N ") lgkmcnt(0)\n\ts_barrier" ::: "memory")
template <int DK>
__device__ __forceinline__ void unit(const int tid, const AttnSrc& A, const int q0, LAS unsigned char* lds) {
    constexpr int QP = (DK == 64) ? 256 : 1024, KP = (DK == 64) ? 128 : 1024, K2P = 32, VP = (DK == 64) ? ZC : 1024, OP = 512;
    constexpr int KROW = (DK == 64) ? 128 : 256, SHM_K = 64 * KROW, SHM_V = 64 * 64 * 2, ND = DK / 16, NT = SEQ / 64, NKI = SHM_K / 8192;
    const int wid = __builtin_amdgcn_readfirstlane(tid >> 6), lane = tid & 63, r32 = lane & 31, hi = lane >> 5;
    LAS unsigned char* V_lds = lds; LAS unsigned char* K_lds = lds + 3 * SHM_V;
    LAS float* al_l = (LAS float*)(lds + 3 * SHM_V + 3 * SHM_K) + wid * 32;
    float m_reg = 0.f; f32x16 o[3] = {}; f32x16 negm = f32x16{}; bf16x8 qr[ND];
    const int qrow = q0 + wid * 32 + r32;
    const bf16_t* Qw = A.Q + (size_t)qrow * QP + hi * 8;
#pragma unroll
    for (int d0 = 0; d0 < ND; ++d0) qr[d0] = *(const bf16x8*)(Qw + d0 * 16);
    if constexpr (DK > 64) {
        const int sq = qrow & (SEQ - 1); const float prow = (float)(sq >> 6), pcol = (float)(sq & 63);
#pragma unroll
        for (int d0 = 4; d0 < 6; ++d0) { u32x4 w = __builtin_bit_cast(u32x4, qr[d0]); const float pos = (d0 == 4) ? prow : pcol;
#pragma unroll
            for (int j = 0; j < 4; ++j) { float x0 = bflo(w[j]), x1 = bfhi(w[j]); rope2(x0, x1, pos * __builtin_amdgcn_exp2f(-(float)(4 * hi + j) * (13.287712379549449f / 8.f))); w[j] = pk2i(x0, x1); }
            qr[d0] = __builtin_bit_cast(bf16x8, w); }
    }
    const bf16_t* Vsrc; const bf16_t* Ksrc[NKI]; int kstepE[NKI];
    { const int kk = 8 * wid + ((lane & 31) >> 2), kv = (kk & ~0xC) | ((kk & 4) << 1) | ((kk & 8) >> 1); Vsrc = A.V + (size_t)kv * VP + 32 * (lane >> 5) + 8 * (lane & 3); }
#pragma unroll
    for (int i = 0; i < NKI; ++i) {
        if constexpr (DK == 64) { const int row = 8 * wid + (lane >> 3), chunk = (lane & 7) ^ ((row >> 1) & 7); Ksrc[i] = A.K + (size_t)row * KP + chunk * 8; kstepE[i] = KP; }
        else { const int row = 4 * (i * 8 + wid) + (lane >> 4), chunk = (lane & 15) ^ (row & 15);
            if (chunk >= 8 && chunk < 12) { Ksrc[i] = A.K2 + (size_t)row * K2P + (chunk - 8) * 8; kstepE[i] = K2P; }
            else { Ksrc[i] = A.K + (size_t)row * KP + (chunk < 8 ? chunk : 0) * 8; kstepE[i] = KP; } }
    }
    const unsigned ldsw = (unsigned)wid * 1024u;
#define ATT_DMA_V(t, slot) __builtin_amdgcn_global_load_lds((const unsigned*)(Vsrc + (size_t)(t) * 64 * VP), (LAS unsigned*)(V_lds + (slot) * SHM_V + ldsw), 16, 0, 0)
#define ATT_DMA_K(t, slot) do { _Pragma("unroll") for (int i_ = 0; i_ < NKI; ++i_) \
        __builtin_amdgcn_global_load_lds((const unsigned*)(Ksrc[i_] + (size_t)(t) * 64 * kstepE[i_]), (LAS unsigned*)(K_lds + (slot) * SHM_K + i_ * 8192 + ldsw), 16, 0, 0); } while (0)
    const int vb0 = (int)(uintptr_t)V_lds + v_rd_base(lane);
#define ATT_RESC(a) do { if (__any((a) < 1.f)) { if (hi == 0) al_l[r32] = (a); asm volatile("s_waitcnt lgkmcnt(0)" ::: "memory"); \
    _Pragma("unroll") for (int d = 0; d < 3; ++d) _Pragma("unroll") for (int r = 0; r < 16; ++r) o[d][r] *= al_l[crow(r, hi)]; } } while (0)
    f32x16 pA0, pA1, pB0, pB1; float alA, alB; bf16x8 pa0, pa1, pa2, pa3;
    ATT_DMA_K(0, 0); ATT_DMA_V(0, 0); ATT_DMA_K(1, 1);
    ATT_WAITBAR(0);
    ATT_DMA_K(2, 2); ATT_DMA_V(1, 1);
    qkt<DK, KROW>(pA0, pA1, K_lds, qr, negm, r32, hi); partialSM(pA0, pA1, m_reg, negm, alA, true);
    if constexpr (NKI == 1) ATT_WAITBAR(2); else ATT_WAITBAR(3);
#define ATT_STEP(PC0, PC1, PP0, PP1, ALC, j, SK, SV) do { \
        const bool hk_ = (j) + 2 < NT, hv_ = (j) + 1 < NT; \
        if (hk_) ATT_DMA_K((j) + 2, ((SK) + 2) % 3); if (hv_) ATT_DMA_V((j) + 1, ((SV) + 2) % 3); \
        ATT_SBAR(); qkt<DK, KROW>(PC0, PC1, K_lds + (SK) * SHM_K, qr, negm, r32, hi); \
        finishSM(PP0, PP1, pa0, pa1, pa2, pa3); ATT_SBAR(); \
        pv_d0(o, vb0 + (SV) * SHM_V, pa0, pa1, pa2, pa3); partialSM(PC0, PC1, m_reg, negm, ALC, false); \
        if (hk_) { if constexpr (NKI == 1) ATT_WAITBAR(2); else ATT_WAITBAR(3); } else if (hv_) ATT_WAITBAR(1); else ATT_WAITBAR(0); \
        ATT_RESC(ALC); } while (0)
    static_assert((NT - 2) % 6 == 0, "steps 1 .. NT-2 are a whole number of 6-step periods");
#pragma unroll 1
    for (int j = 1; j + 1 < NT; j += 6) {
        ATT_STEP(pB0, pB1, pA0, pA1, alB, j,     1, 0);
        ATT_STEP(pA0, pA1, pB0, pB1, alA, j + 1, 2, 1);
        ATT_STEP(pB0, pB1, pA0, pA1, alB, j + 2, 0, 2);
        ATT_STEP(pA0, pA1, pB0, pB1, alA, j + 3, 1, 0);
        ATT_STEP(pB0, pB1, pA0, pA1, alB, j + 4, 2, 1);
        ATT_STEP(pA0, pA1, pB0, pB1, alA, j + 5, 0, 2);
    }
    ATT_STEP(pB0, pB1, pA0, pA1, alB, NT - 1, (NT - 1) % 3, (NT - 2) % 3);
    finishSM(pB0, pB1, pa0, pa1, pa2, pa3); ATT_SBAR();
    pv_d0(o, vb0 + ((NT - 1) % 3) * SHM_V, pa0, pa1, pa2, pa3);
    float rli[16];
#pragma unroll
    for (int r = 0; r < 16; ++r) rli[r] = __builtin_amdgcn_rcpf(o[2][r]);
    bf16_t* Ow = A.O + (size_t)(q0 + wid * 32) * OP + ((lane & 1) ? 32 + r32 - 1 : r32);
#pragma unroll
    for (int r = 0; r < 16; ++r) { const float a0 = o[0][r] * rli[r], a1 = o[1][r] * rli[r];
        const float got = dppf<0xB1>((lane & 1) ? a0 : a1);
        *(unsigned*)(Ow + (size_t)crow(r, hi) * OP) = (lane & 1) ? pk2(got, a1) : pk2(a0, got); }
    ATT_WAITBAR(0);
#undef ATT_DMA_V
#undef ATT_DMA_K
#undef ATT_RESC
#undef ATT_STEP
}
#undef ATT_WAITBAR
#undef ATT_SBAR
}

__device__ __forceinline__ void grpnorm_hi_rows8(const LayerCtx& c, int t0, int tstride, int lane) {
    R8 v[8]; float ss[8];
#pragma unroll
    for (int q = 0; q < 8; ++q) { v[q] = unpack8(*(const u32x4*)((const bf16_t*)c.YMIX + (size_t)(t0 + q * tstride) * 512 + 8 * lane)); ss[q] = hsq8(v[q]); }
#pragma unroll
    for (int q = 0; q < 8; ++q) { float x = ss[q]; x = rsum<1>(x); x = rsum<2>(x); x = rsum<4>(x); x = rsum<8>(x); ss[q] = rsum<16>(x); }
#pragma unroll
    for (int q = 0; q < 8; ++q) { const float r = __builtin_amdgcn_rsqf(ss[q] * (1.f / 256.f) + RMS_EPS);
        *(u32x4*)(c.Y + (size_t)(t0 + q * tstride) * 1024 + 512 + 8 * lane) = pk8(v[q].lo * r, v[q].hi * r); }
}
template <int NR>
__device__ __forceinline__ void resln_load(const LayerCtx& c, int t0, int tstride, int lane, u32x4 (&hw)[NR][2], u32x4 (&fw)[NR][2]) {
#pragma unroll
    for (int q = 0; q < NR; ++q) { const bf16_t* hr = c.HB + (size_t)(t0 + q * tstride) * D; const bf16_t* fr = c.FB + (size_t)(t0 + q * tstride) * D;
#pragma unroll
        for (int j = 0; j < 2; ++j) { hw[q][j] = *(const u32x4*)(hr + 512 * j + 8 * lane); fw[q][j] = *(const u32x4*)(fr + 512 * j + 8 * lane); } }
}
template <int NR>
__device__ __forceinline__ void resln_finish(const LayerCtx& c, int t0, int tstride, const float* g, const float* b, int lane, const u32x4 (&hw)[NR][2], const u32x4 (&fw)[NR][2], R8 (&v)[NR][2]) {
#pragma unroll
    for (int q = 0; q < NR; ++q)
#pragma unroll
        for (int j = 0; j < 2; ++j) { const R8 h = unpack8(hw[q][j]), f = unpack8(fw[q][j]); v[q][j].lo = h.lo * DN_ALPHA + f.lo; v[q][j].hi = h.hi * DN_ALPHA + f.hi; }
    ln_rows<NR>(v, g, b, lane);
#pragma unroll
    for (int q = 0; q < NR; ++q) store_row_bf16(c.HB + (size_t)(t0 + q * tstride) * D, v[q], lane);
}
template <int NR>
__device__ __forceinline__ void resln_rows(const LayerCtx& c, int t0, int tstride, const float* g, const float* b, int lane, R8 (&v)[NR][2]) {
    u32x4 hw[NR][2], fw[NR][2];
    resln_load<NR>(c, t0, tstride, lane, hw, fw);
    resln_finish<NR>(c, t0, tstride, g, b, lane, hw, fw, v);
}
constexpr int RT_LO = 65536, RT_LOGT = 40960;
__device__ __forceinline__ void ln2_router_group(const int tid, const Args& a, const LayerCtx& c, const int grp, const int grp_next, LAS unsigned char* lds, const bf16x8 (&bh)[8], const bf16x8 (&bl)[8], LAS unsigned* lcnt, u32x4 (&hw)[4][2], u32x4 (&fw)[4][2]) {
    const int wid = tid >> 6, lane = tid & 63, r32 = lane & 31, hi = lane >> 5;
    { R8 v[4][2];
      resln_finish<4>(c, grp * 32 + wid * 4, 1, a.in[I_LN2G] + c.l * D, a.in[I_LN2B] + c.l * D, lane, hw, fw, v);
#pragma unroll
      for (int q = 0; q < 4; ++q) { const int row = wid * 4 + q;
#pragma unroll
          for (int j = 0; j < 2; ++j) { const int chunk = 64 * j + lane; const int off = row * 2048 + ((chunk ^ (row & 15)) << 4);
              const R8 x = v[q][j]; const unsigned h0 = f2bf(x.lo.x), h1 = f2bf(x.lo.y), h2 = f2bf(x.lo.z), h3 = f2bf(x.lo.w), h4 = f2bf(x.hi.x), h5 = f2bf(x.hi.y), h6 = f2bf(x.hi.z), h7 = f2bf(x.hi.w);
              const u32x4 wh = {h0 | (h1 << 16), h2 | (h3 << 16), h4 | (h5 << 16), h6 | (h7 << 16)};
              const u32x4 wl = {pk2(x.lo.x - bf2f(h0), x.lo.y - bf2f(h1)), pk2(x.lo.z - bf2f(h2), x.lo.w - bf2f(h3)), pk2(x.hi.x - bf2f(h4), x.hi.y - bf2f(h5)), pk2(x.hi.z - bf2f(h6), x.hi.w - bf2f(h7))};
              *(LAS u32x4*)(lds + off) = wh; *(LAS u32x4*)(lds + RT_LO + off) = wl; } } }
    resln_load<4>(c, (grp_next < T / 32 ? grp_next : grp) * 32 + wid * 4, 1, lane, hw, fw);
    __syncthreads();
    f32x16 acc = f32x16{};
#pragma unroll
    for (int ks = 0; ks < 8; ++ks) { const int chunk = 16 * wid + 2 * ks + hi; const int off = r32 * 2048 + ((chunk ^ (r32 & 15)) << 4);
        const bf16x8 ah = *(const LAS bf16x8*)(lds + off), al = *(const LAS bf16x8*)(lds + RT_LO + off);
        acc = __builtin_amdgcn_mfma_f32_32x32x16_bf16(ah, bh[ks], acc, 0, 0, 0); acc = __builtin_amdgcn_mfma_f32_32x32x16_bf16(ah, bl[ks], acc, 0, 0, 0); acc = __builtin_amdgcn_mfma_f32_32x32x16_bf16(al, bh[ks], acc, 0, 0, 0); }
    __syncthreads();
    { LAS float* red = (LAS float*)lds;
#pragma unroll
      for (int r = 0; r < 16; ++r) { const int tok = (r & 3) + 8 * (r >> 2) + 4 * hi; red[(wid * 32 + tok) * 33 + r32] = acc[r]; } }
    __syncthreads();
    { const LAS float* red = (const LAS float*)lds; LAS float* logt = (LAS float*)(lds + RT_LOGT); const float* br = a.in[I_BR] + c.l * 32;
#pragma unroll
      for (int i = 0; i < 2; ++i) { const int idx = tid + NTHREADS * i, tok = idx >> 5, e = idx & 31; float sres = br[e];
#pragma unroll
          for (int w = 0; w < 8; ++w) sres += red[(w * 32 + tok) * 33 + e];
          logt[tok * 33 + e] = sres; } }
    __syncthreads();
    { const LAS float* logt = (const LAS float*)(lds + RT_LOGT);
#pragma unroll 1
      for (int q = 0; q < 4; ++q) { const int tok = wid * 4 + q, t = grp * 32 + tok;
          float mine = (lane < 32) ? logt[tok * 33 + lane] : -3.0e38f;
          float tv[4]; int ti[4];
#pragma unroll
          for (int k = 0; k < 4; ++k) { const float best = wave_max(mine); const unsigned long long mk = __ballot(mine == best); const int bi = __ffsll((long long)mk) - 1;
              tv[k] = best; ti[k] = bi; if (lane == bi) mine = -3.0e38f; }
          const float e1 = __expf(tv[1] - tv[0]), e2 = __expf(tv[2] - tv[0]), e3 = __expf(tv[3] - tv[0]); const float rs = 1.f / (1.f + e1 + e2 + e3);
          if (lane < 4) { const int e = lane == 0 ? ti[0] : lane == 1 ? ti[1] : lane == 2 ? ti[2] : ti[3]; const float gt = (lane == 0 ? 1.f : lane == 1 ? e1 : lane == 2 ? e2 : e3) * rs;
              const unsigned rank = __hip_atomic_fetch_add(lcnt + e, 1u, __ATOMIC_RELAXED, __HIP_MEMORY_SCOPE_WORKGROUP);
              c.RE[t * 4 + lane] = e; c.RR[t * 4 + lane] = (int)rank; c.GATE[t * 4 + lane] = gt; } } }
    __syncthreads();
}
constexpr int TBL_OFF = 131072, TBL_PSTART = TBL_OFF + 2304, TBL_NBLK = TBL_PSTART + 256, TBL_WBASE = TBL_NBLK + 64, TBL_CNT = TBL_WBASE + 128, TBL_PART = TBL_OFF + 4096, TBL_LCNT = TBL_OFF + 8192;
__device__ __forceinline__ void moe_tables(const int tid, const int bid, const LayerCtx& c, LAS unsigned char* lds) {
    LAS int* blk_e = (LAS int*)(lds + TBL_OFF); LAS int* pstart = (LAS int*)(lds + TBL_PSTART); LAS int* nblk = (LAS int*)(lds + TBL_NBLK); LAS int* wbase = (LAS int*)(lds + TBL_WBASE);
    LAS int* cntL = (LAS int*)(lds + TBL_CNT); LAS int* part = (LAS int*)(lds + TBL_PART);
    { const int e = tid & 31, pr = tid >> 5; int tot = 0, pf = 0;
#pragma unroll 4
      for (int w = pr * 16; w < pr * 16 + 16; ++w) { const int v = (int)__hip_atomic_load(c.cnt + w * 32 + e, RLX_AGENT); tot += v; pf += (w < bid) ? v : 0; }
      part[pr * 32 + e] = tot; part[512 + pr * 32 + e] = pf; }
    __syncthreads();
    if (tid < 32) { int tot = 0, pf = 0;
#pragma unroll 4
        for (int pr = 0; pr < 16; ++pr) { tot += part[pr * 32 + tid]; pf += part[512 + pr * 32 + tid]; }
        cntL[tid] = tot; wbase[tid] = pf; }
    __syncthreads();
    if (tid < 32) { int pos = 0;
#pragma unroll 1
        for (int e = 0; e < tid; ++e) pos += (cntL[e] + 255) >> 8;
        pstart[tid] = pos * 256; wbase[tid] += pos * 256;
        if (tid == 31) nblk[0] = pos + ((cntL[31] + 255) >> 8); }
    __syncthreads();
#pragma unroll 1
    for (int rb = tid; rb < MOE_MAXBLK; rb += NTHREADS) { int e = 0;
#pragma unroll 1
        for (int q = 1; q < NE; ++q) e += (pstart[q] <= rb * 256) ? 1 : 0;
        blk_e[rb] = e; }
    __syncthreads();
}
__device__ __forceinline__ void gather_rows2(const LayerCtx& c, int t0, int lane, const LAS int* wbase) {
    u32x4 hv[2][2]; int dest[2][4];
#pragma unroll
    for (int q = 0; q < 2; ++q) { const int t = t0 + q;
        hv[q][0] = *(const u32x4*)(c.HB + (size_t)t * D + 8 * lane); hv[q][1] = *(const u32x4*)(c.HB + (size_t)t * D + 512 + 8 * lane);
        const u32x4 e4 = *(const u32x4*)(c.RE + t * 4), r4 = *(const u32x4*)(c.RR + t * 4);
#pragma unroll
        for (int k = 0; k < 4; ++k) dest[q][k] = wbase[e4[k]] + (int)r4[k]; }
#pragma unroll
    for (int q = 0; q < 2; ++q) { const int t = t0 + q;
#pragma unroll
        for (int k = 0; k < 4; ++k) { *(u32x4*)(c.XS + (size_t)dest[q][k] * D + 8 * lane) = hv[q][0]; *(u32x4*)(c.XS + (size_t)dest[q][k] * D + 512 + 8 * lane) = hv[q][1]; }
        if (lane == 0) *(u32x4*)(c.DEST + t * 4) = (u32x4){(unsigned)dest[q][0], (unsigned)dest[q][1], (unsigned)dest[q][2], (unsigned)dest[q][3]}; }
}
__device__ __forceinline__ void combine_rows2(const Args& a, const LayerCtx& c, int t0, int tstride, int lane, float* out2) {
    u32x4 d4[2]; f32x4 g4[2]; u32x4 hw[2][2], yw[2][4][2];
#pragma unroll
    for (int q = 0; q < 2; ++q) { const int t = t0 + q * tstride; d4[q] = *(const u32x4*)(c.DEST + t * 4); g4[q] = *(const f32x4*)(c.GATE + t * 4);
        hw[q][0] = *(const u32x4*)(c.HB + (size_t)t * D + 8 * lane); hw[q][1] = *(const u32x4*)(c.HB + (size_t)t * D + 512 + 8 * lane); }
#pragma unroll
    for (int q = 0; q < 2; ++q)
#pragma unroll
        for (int k = 0; k < 4; ++k) { const bf16_t* y = c.YS + (size_t)d4[q][k] * D; yw[q][k][0] = *(const u32x4*)(y + 8 * lane); yw[q][k][1] = *(const u32x4*)(y + 512 + 8 * lane); }
    R8 v[2][2];
#pragma unroll
    for (int q = 0; q < 2; ++q)
#pragma unroll
        for (int j = 0; j < 2; ++j) { const R8 h = unpack8(hw[q][j]); v[q][j].lo = h.lo * DN_ALPHA; v[q][j].hi = h.hi * DN_ALPHA;
#pragma unroll
            for (int k = 0; k < 4; ++k) { const R8 y = unpack8(yw[q][k][j]); v[q][j].lo += y.lo * g4[q][k]; v[q][j].hi += y.hi * g4[q][k]; } }
    ln_rows<2>(v, a.in[I_LN3G] + c.l * D, a.in[I_LN3B] + c.l * D, lane);
#pragma unroll
    for (int q = 0; q < 2; ++q) { const int t = t0 + q * tstride; store_row_bf16(c.HB + (size_t)t * D, v[q], lane); if (out2) store_row_f32(out2 + (size_t)t * D, v[q], lane); }
}
constexpr int NPH_LAYER = 17, NPH_PRE = 3, NPHASES = NPH_PRE + NLAYER * NPH_LAYER;
#ifndef USE_PG8
#define USE_PG8 1
#endif
#if USE_PG8
#define GEMM_CALL(PAIR, g, S, E) do { int tid_ = tid; asm volatile("" : "+v"(tid_)); pg8::gemm_phase<PAIR, false>(tid_, lds, g, S, E); } while (0)
#define GEMM_CALL_GATHER(PAIR, g, S, E) do { int tid_ = tid; asm volatile("" : "+v"(tid_)); pg8::gemm_phase<PAIR, true>(tid_, lds, g, S, E); } while (0)
#else
#define GEMM_CALL(PAIR, g, S, E) sgemm_phase<PAIR>(tid, g, S, E)
#endif

__global__ void __launch_bounds__(NTHREADS, 2) fwd(Args a) {
    extern __shared__ __attribute__((aligned(16))) unsigned char lds_raw[];
    LAS unsigned char* lds = (LAS unsigned char*)lds_raw;
    volatile LAS unsigned* MISC = (volatile LAS unsigned*)(lds + MISC_OFF);
    const int G = gridDim.x, NGW = G * NWAVES;
    const int wave_s = __builtin_amdgcn_readfirstlane((int)threadIdx.x >> 6);
#define HW_TID() (wave_s * 64 + hw_lane())
    if (threadIdx.x < 64) MISC[threadIdx.x] = 0u;
    __syncthreads();
    unsigned* ctl = (unsigned*)(a.ws + WS_CTL);
    XcdBarrier bar; bar.bar = ctl + CW_BAR; bar.x = 0; bar.st = nullptr;
    if (N_LAUNCH_MODE == 1) bar = xcd_barrier_post(ctl + CW_BAR, MISC + 8, (int)threadIdx.x);
    const int lo = a.lo, hi = a.hi;
#define PH_TID int tid = HW_TID(); asm volatile("" : "+v"(tid)); int bid = blockIdx.x; asm volatile("" : "+s"(bid)); const __attribute__((address_space(4))) Args* ap_ = (const __attribute__((address_space(4))) Args*)__builtin_amdgcn_kernarg_segment_ptr(); asm volatile("" : "+s"(ap_)); const Args& a = *(const Args*)ap_; const int lane = tid & 63, wave = tid >> 6, gw = bid * NWAVES + wave; (void)lane; (void)gw
#define PH_BEGIN int lv = l; asm volatile("" : "+s"(lv)); PH_TID; const LayerCtx c = make_ctx(a, lv)
#define IN(k) (lo <= (k) && (k) < hi)
#define SEAM(k) do { if (N_LAUNCH_MODE == 1 && IN(k) && IN((k) + 1)) xcd_barrier(bar, HW_TID()); } while (0)

    if (IN(0)) { PH_TID; phase_pre0(tid, bid, a, lds); } SEAM(0);
    if (IN(1)) { PH_TID;
        GemmDesc g{(const bf16_t*)a.ws, (const bf16_t*)a.ws, 1024, 1024, 1024}; PreOrder S{G, bid}; EpiPre E{a.ws};
        GEMM_CALL(false, g, S, E);
    } SEAM(1);
    if (IN(2)) { PH_TID;
        GemmDesc g{(const bf16_t*)a.ws, (const bf16_t*)a.ws, 1024, 1024, 256}; Pre2Order S{G, bid}; EpiPre2 E{a.ws};
        GEMM_CALL(false, g, S, E);
    } SEAM(2);

    for (int l = 0; l < NLAYER; ++l) {
        const int pb = NPH_PRE + NPH_LAYER * l;
        if (IN(pb + 0)) { PH_BEGIN;
            GemmDesc g{c.HB, (const bf16_t*)(c.wl + WL_IN), 1024, 1024, 1024}; TileOrder S; S.init(T / 256, ZC / 256, G, bid, 0, 1024, 1024);
            EpiBf16 E{c.Z, ZC, nullptr}; GEMM_CALL(false, g, S, E);
        } SEAM(pb + 0);
        if (IN(pb + 1)) { PH_BEGIN;
            { fft::build_table(tid, lds); fft::F64Frags FF; fft::build_f64(tid, FF); __syncthreads();
              for (int u = bid; u < 512; u += G) fft::unit(tid, c, u, lds, FF); }
            __syncthreads();
            for (int it = bid; it < T / 64; it += G) conv_item(tid, a, c, it, lds);
            const QkConst kc = qkprep_const(a, c, lane);
            for (int t = gw; t < T; t += 4 * NGW) { QkRaw raw[4];
#pragma unroll
                for (int q = 0; q < 4; ++q) raw[q] = qkprep_load(c, t + q * NGW, lane);
#pragma unroll
                for (int q = 0; q < 4; ++q) qkprep_row(c, t + q * NGW, lane, raw[q], kc); }
        } SEAM(pb + 1);
        if (IN(pb + 2)) { PH_BEGIN;
            { GemmDesc g{c.CQKV, (const bf16_t*)(c.wl + WL_MLA), 384, 384, 384}; TileOrder S; S.init(T / 256, 4, G, bid, 0, 384, 384);
              EpiBf16 E{c.QKVM, 1024, nullptr}; GEMM_CALL(false, g, S, E); }
            { GemmDesc g{c.FC, (const bf16_t*)(c.wl + WL_FC), 512, 256, 256}; TileOrder S; S.init(T / 256, 2, G, bid, 1, 512, 256);
              EpiFCN E{c.Y, a.in[I_BF] + lv * 256, a.in[I_BPW] + lv * 256, lds}; GEMM_CALL(false, g, S, E); }
        } SEAM(pb + 2);
        if (IN(pb + 3)) { PH_BEGIN;
            for (int U = bid; U < 1024; U += G) { const int x = U & 511, b = x >> 7, h = (x >> 5) & 3, qb = x & 31;
                if (lv == 0 && (U >> 8) == ((bid >> 3) & 3)) { int tw = tid; asm volatile("" : "+v"(tw)); moe_weight_items(tw, bid, a, lds); __syncthreads(); }
                unsigned char* wsb = a.ws; asm volatile("" : "+s"(wsb));
                int tu = tid; asm volatile("" : "+v"(tu));
                if (U < 512) { const AttnSrc A = gqa_src(wsb, b, h); att::unit<64>(tu, A, qb * 256, lds); }
                else         { const AttnSrc A = mla_src(wsb, b, h); att::unit<96>(tu, A, qb * 256, lds); } }
        } SEAM(pb + 3);
        if (IN(pb + 4)) { PH_BEGIN; for (int t = gw; t < T; t += 8 * NGW) grpnorm_hi_rows8(c, t, NGW, lane); } SEAM(pb + 4);
        if (IN(pb + 5)) { PH_BEGIN;
            GemmDesc g{c.Y, (const bf16_t*)(c.wl + WL_O), 1024, 1024, 1024}; TileOrder S; S.init(T / 256, 4, G, bid, 0, 1024, 1024);
            EpiBf16 E{c.FB, 1024, nullptr}; GEMM_CALL(false, g, S, E);
        } SEAM(pb + 5);
        if (IN(pb + 6)) { PH_BEGIN; for (int t = gw; t < T; t += 4 * NGW) { R8 v[4][2]; resln_rows<4>(c, t, NGW, a.in[I_LN1G] + lv * D, a.in[I_LN1B] + lv * D, lane, v); } } SEAM(pb + 6);
        if (IN(pb + 7)) { PH_BEGIN;
            GemmDesc g{c.HB, (const bf16_t*)(a.ws + WS_MT + (size_t)((lv * 2 + 0) * 4) * 2 * MiB), 1024, 1024, 1024}; TileOrder S; S.init(T / 256, 4, G, bid, 4, 1024, 1024);
            EpiXSN E{c.PB, lds}; GEMM_CALL(false, g, S, E);
        } SEAM(pb + 10);
        if (IN(pb + 11)) { PH_BEGIN;
            GemmDesc g{c.PB, (const bf16_t*)(a.ws + WS_MT + (size_t)((lv * 2 + 1) * 4) * 2 * MiB), 1024, 1024, 1024}; TileOrder S; S.init(T / 256, 4, G, bid, 4, 1024, 1024);
            EpiBf16 E{c.FB, 1024, nullptr}; GEMM_CALL(false, g, S, E);
        } SEAM(pb + 11);
        if (IN(pb + 12)) { PH_BEGIN; LAS unsigned* lcnt = (LAS unsigned*)(lds + TBL_LCNT);
            if (tid < 32) lcnt[tid] = 0u;
            bf16x8 bh[8], bl[8];
            { const bf16_t* wr = (const bf16_t*)(c.wl + WL_RT) + (size_t)(lane & 31) * 1024 + 128 * wave + 8 * (lane >> 5);
#pragma unroll
              for (int ks = 0; ks < 8; ++ks) { bh[ks] = *(const bf16x8*)(wr + 16 * ks); bl[ks] = *(const bf16x8*)(wr + 32768 + 16 * ks); } }
            __syncthreads();
            { u32x4 hw[4][2], fw[4][2]; static_assert(MAXWG <= T / 32, "every workgroup has a first group"); resln_load<4>(c, bid * 32 + wave * 4, 1, lane, hw, fw);
              for (int grp = bid; grp < T / 32; grp += G) ln2_router_group(tid, a, c, grp, grp + G, lds, bh, bl, lcnt, hw, fw); }
            __syncthreads();
            if (tid < 32) __hip_atomic_store(c.cnt + bid * 32 + tid, lcnt[tid], RLX_AGENT);
        } SEAM(pb + 12);
        if (IN(pb + 13)) { PH_BEGIN; moe_tables(tid, bid, c, lds); const LAS int* wbase = (const LAS int*)(lds + TBL_WBASE);
            { const int gi = tid >> 7, pr = tid & 127; const int grp = bid + G * gi;
              if (grp < T / 32) { const int t = grp * 32 + (pr >> 2), k = pr & 3; const int dest = wbase[c.RE[t * 4 + k]] + c.RR[t * 4 + k]; c.TOK[dest] = t; c.DEST[t * 4 + k] = dest; } }
        } SEAM(pb + 13);
        if (IN(pb + 14)) { PH_BEGIN;
            const int nblk = *(const LAS int*)(lds + TBL_NBLK);
            GemmDesc g{c.HB, (const bf16_t*)(c.wl + WL_GU), 1024, 1024, 1024, c.TOK}; MoeOrder S{(const LAS int*)(lds + TBL_OFF), nblk, 8, G, bid};
            EpiGU E{c.ACT, a.in[I_BGU] + (size_t)lv * NE * 2048, lds}; GEMM_CALL_GATHER(true, g, S, E);
        } SEAM(pb + 14);
        if (IN(pb + 15)) { PH_BEGIN;
            const int nblk = *(const LAS int*)(lds + TBL_NBLK);
            GemmDesc g{c.ACT, (const bf16_t*)(c.wl + WL_DN), 1024, 1024, 1024}; MoeOrder S{(const LAS int*)(lds + TBL_OFF), nblk, 4, G, bid};
            EpiDown E{c.YS, a.in[I_BDN] + (size_t)lv * NE * 1024, lds}; GEMM_CALL(false, g, S, E);
        } SEAM(pb + 15);
        if (IN(pb + 16)) { PH_BEGIN; for (int t = gw; t < T; t += 2 * NGW) combine_rows2(a, c, t, NGW, lane, (lv == NLAYER - 1) ? a.out : nullptr); } SEAM(pb + 16);
    }
#undef IN
#undef SEAM
}

extern "C" void kernel_launch(void* const* d_in, const int* in_sizes, int n_in, void* d_out, int out_size, void* d_ws, size_t ws_size, hipStream_t stream) {
    static int grid = 0;
    if (grid == 0) {
        if (n_in != 37 || in_sizes[0] != T * D || out_size != T * D || ws_size < WS_END) {
            fprintf(stderr, "kernel_launch: unexpected shapes: n_in %d in0 %d out %d ws %zu (need %zu)\n", n_in, n_in > 0 ? in_sizes[0] : -1, out_size, ws_size, (size_t)WS_END); grid = -1; return; }
        int dev = 0, cus = 0;
        if (hipGetDevice(&dev) != hipSuccess || hipDeviceGetAttribute(&cus, hipDeviceAttributeMultiprocessorCount, dev) != hipSuccess) { grid = -1; return; }
        if (hipFuncSetAttribute((const void*)fwd, hipFuncAttributeMaxDynamicSharedMemorySize, LDS_BYTES) != hipSuccess) { fprintf(stderr, "kernel_launch: hipFuncSetAttribute failed\n"); grid = -1; return; }
        int per_cu = 0;
        if (hipOccupancyMaxActiveBlocksPerMultiprocessor(&per_cu, (const void*)fwd, NTHREADS, LDS_BYTES) != hipSuccess || per_cu < 1) fprintf(stderr, "kernel_launch: occupancy query reports %d\n", per_cu);
        (void)hipGetLastError();
        grid = MAXWG;
        if (cus < MAXWG) fprintf(stderr, "kernel_launch: only %d CUs: the 256-workgroup persistent grid cannot be resident; the grid barrier will time out\n", cus);
    }
    if (grid < 0) return;
    (void)hipMemsetAsync((char*)d_ws + WS_CTL, 0, CTL_ZERO_BYTES, stream);
    Args a{};
    for (int i = 0; i < 37; ++i) a.in[i] = (const float*)d_in[i];
    a.out = (float*)d_out; a.ws = (unsigned char*)d_ws; a.pad0 = 0; a.pad1 = 0;
    if (N_LAUNCH_MODE == 1) { a.lo = 0; a.hi = NPHASES; hipLaunchKernelGGL(fwd, dim3(grid), dim3(NTHREADS), LDS_BYTES, stream, a); }
    else for (int p = 0; p < NPHASES; ++p) { a.lo = p; a.hi = p + 1; hipLaunchKernelGGL(fwd, dim3(grid), dim3(NTHREADS), LDS_BYTES, stream, a); }
    const hipError_t le = hipPeekAtLastError();
    if (le != hipSuccess) fprintf(stderr, "kernel_launch: launch failed: %s\n", hipGetErrorName(le));
}
```

```cpp
#include <hip/hip_runtime.h>
#include <cstdio>
#include <cstdint>

#ifndef N_LAUNCH_MODE
#define N_LAUNCH_MODE 1
#endif

#define LAS __attribute__((address_space(3)))
#define GAS __attribute__((address_space(1)))
typedef unsigned short bf16_t;
typedef short bf16x8 __attribute__((ext_vector_type(8)));
typedef float f32x4 __attribute__((ext_vector_type(4)));
typedef float f32x2 __attribute__((ext_vector_type(2)));
typedef float f32x16 __attribute__((ext_vector_type(16)));
typedef unsigned u32x4 __attribute__((ext_vector_type(4)));
typedef unsigned u32x2 __attribute__((ext_vector_type(2)));
typedef GAS unsigned gu32;
#define RLX_AGENT __ATOMIC_RELAXED, __HIP_MEMORY_SCOPE_AGENT
#define LDS_WAIT() asm volatile("s_waitcnt lgkmcnt(0)" ::: "memory")
#define VM_WAIT() asm volatile("s_waitcnt vmcnt(0)" ::: "memory")

constexpr int NB = 4, SEQ = 8192, T = NB * SEQ, D = 1024, MEML = 256, NE = 32, TOPK = 4, NLAYER = 2;
constexpr int ZC = 1792;
constexpr int ZC_CA = 256, ZC_CG = 512, ZC_Q = 768, ZC_K = 1024, ZC_V = 1152, ZC_CQ = 1280, ZC_CKV = 1536, ZC_KR = 1664;
constexpr int INC = 1696;
constexpr float LOG2E = 1.4426950408889634f;
constexpr float DN_ALPHA = 1.4142135623730951f;
constexpr float LN_EPS = 1e-5f, RMS_EPS = 1e-6f;
constexpr float QSCALE_G = 0.125f * LOG2E;
constexpr float QSCALE_M = 0.10206207261596575f * LOG2E;
constexpr float QSCALE_X = 0.0625f * LOG2E;
constexpr int MOE_MAXBLK = T * TOPK / 256 + NE;
constexpr int MOE_ROWS = MOE_MAXBLK * 256;

constexpr size_t MiB = 1u << 20;
constexpr size_t WS_CTL = 0, CTL_ZERO_BYTES = 1 * MiB;
constexpr size_t WS_W = 1 * MiB, WL_SIZE = 208 * MiB;
constexpr size_t WL_IN = 0, WL_MLA = 4 * MiB, WL_FC = 5 * MiB, WL_RT = 5 * MiB + 512 * 1024, WL_O = 6 * MiB, WL_XQ = 8 * MiB, WL_XK = 10 * MiB, WL_XV = 12 * MiB,
                 WL_XO = 14 * MiB, WL_GU = 16 * MiB, WL_DN = 144 * MiB;
constexpr size_t WS_MEMB = 418 * MiB, WS_KX = 420 * MiB, WS_VXT = 424 * MiB;
constexpr size_t WS_ROUTE = 428 * MiB;
constexpr size_t WS_H = 430 * MiB, WS_HB = 558 * MiB, WS_F = 622 * MiB, WS_R = 750 * MiB;
constexpr size_t R_Z = 0, R_FC = 112 * MiB, R_QG = 144 * MiB, R_KG = 160 * MiB, R_CQKV = 168 * MiB, R_KR = 192 * MiB, R_QKVM = 194 * MiB, R_YMIX = 258 * MiB, R_Y = 386 * MiB;
constexpr size_t R_XQ = 0, R_SC = 64 * MiB, R_PB = 192 * MiB, R_XO = 256 * MiB;
constexpr size_t R_XS = 0, R_ACT = 272 * MiB;
constexpr size_t WS_MT = 430 * MiB;
constexpr size_t WS_END = WS_R + 544 * MiB;
constexpr int CW_TMO = 0, CW_CODE = 1, CW_BAR = 4096, CW_CNT = 16384, MAXWG = 256, CW_TOK = 65536;

constexpr int NTHREADS = 512, NWAVES = 8;
constexpr int LDS_BYTES = 147456;
constexpr int MISC_OFF = 147456 - 256;

__device__ __forceinline__ unsigned f2bf(float f) { unsigned u = __builtin_bit_cast(unsigned, f); return (u + 0x7fffu + ((u >> 16) & 1u)) >> 16; }
__device__ __forceinline__ unsigned pk2i(float lo, float hi) { return f2bf(lo) | (f2bf(hi) << 16); }
typedef __bf16 hwbf2 __attribute__((ext_vector_type(2))); typedef float hwf2 __attribute__((ext_vector_type(2)));
__device__ __forceinline__ unsigned pk2(float lo, float hi) { const hwf2 v = {lo, hi}; return __builtin_bit_cast(unsigned, __builtin_convertvector(v, hwbf2)); }
__device__ __forceinline__ float bf2f(unsigned b) { return __builtin_bit_cast(float, b << 16); }
__device__ __forceinline__ float bflo(unsigned w) { return __builtin_bit_cast(float, w << 16); }
__device__ __forceinline__ float bfhi(unsigned w) { return __builtin_bit_cast(float, w & 0xffff0000u); }
template <int CTRL> __device__ __forceinline__ float dppf(float v) { return __builtin_bit_cast(float, __builtin_amdgcn_update_dpp(0, __builtin_bit_cast(int, v), CTRL, 0xF, 0xF, true)); }
template <int O, bool MAX> __device__ __forceinline__ float rstep(float v) {
    float o;
    if constexpr (O == 1) o = dppf<0xB1>(v); else if constexpr (O == 2) o = dppf<0x4E>(v); else if constexpr (O == 4) o = dppf<0x141>(v); else if constexpr (O == 8) o = dppf<0x140>(v);
    else { const unsigned u = __builtin_bit_cast(unsigned, v);
        if constexpr (O == 16) { auto r = __builtin_amdgcn_permlane16_swap(u, u, false, false); v = __builtin_bit_cast(float, (unsigned)r[0]); o = __builtin_bit_cast(float, (unsigned)r[1]); }
        else { auto r = __builtin_amdgcn_permlane32_swap(u, u, false, false); v = __builtin_bit_cast(float, (unsigned)r[0]); o = __builtin_bit_cast(float, (unsigned)r[1]); } }
    return MAX ? fmaxf(v, o) : v + o;
}
template <int O> __device__ __forceinline__ float rsum(float v) { return rstep<O, false>(v); }
__device__ __forceinline__ float wave_sum(float v) { v = rsum<1>(v); v = rsum<2>(v); v = rsum<4>(v); v = rsum<8>(v); v = rsum<16>(v); return rsum<32>(v); }
__device__ __forceinline__ float wave_max(float v) { v = rstep<1, true>(v); v = rstep<2, true>(v); v = rstep<4, true>(v); v = rstep<8, true>(v); v = rstep<16, true>(v); return rstep<32, true>(v); }
__device__ __forceinline__ f32x4 ldbf4(const bf16_t* p) { const u32x2 w = *(const u32x2*)p; return (f32x4){bflo(w.x), bfhi(w.x), bflo(w.y), bfhi(w.y)}; }
__device__ __forceinline__ float sigmoidf_(float x) { return __builtin_amdgcn_rcpf(1.f + __expf(-x)); }

#define XB_TMO      128
#define XB_XCNT(j)  (256  + 64 * (j))
#define XB_XSUB(j)  (1280 + 64 * (j))
#define XB_XGEN(j)  (2304 + 64 * (j))
#define XB_TOP      3328
#define XB_TOPGEN   3392
#define XCD_BAR_WORDS 3456
#define XB_SPIN_CAP (1u << 22)
__device__ __forceinline__ unsigned xb_ld(unsigned* p)              { return __hip_atomic_load(p, __ATOMIC_RELAXED, __HIP_MEMORY_SCOPE_AGENT); }
__device__ __forceinline__ unsigned xb_add(unsigned* p, unsigned v) { return __hip_atomic_fetch_add(p, v, __ATOMIC_RELAXED, __HIP_MEMORY_SCOPE_AGENT); }
__device__ __forceinline__ unsigned xb_xcc_id() { return (unsigned)__builtin_amdgcn_s_getreg((3 << 11) | 20) & 0xFu; }
#define XB_SPIN(cond, bar) do { unsigned _sp = 0; while (cond) { __builtin_amdgcn_s_sleep(1); \
    if ((++_sp & 255u) == 0u) { if (xb_ld(&(bar)[XB_TMO])) break; if (_sp > XB_SPIN_CAP) { atomicAdd(&(bar)[XB_TMO], 1u); break; } } } } while (0)
struct XcdBarrier { unsigned* bar; unsigned x; volatile LAS unsigned* st; };
__device__ __forceinline__ XcdBarrier xcd_barrier_post(unsigned* bar, volatile LAS unsigned* st, int tid) {
    XcdBarrier b; b.bar = bar; b.x = xb_xcc_id(); b.st = st;
    if (tid == 0) (void)xb_add(&bar[XB_XCNT(b.x)], 1u);
    return b;
}
__device__ __forceinline__ void xcd_barrier_complete(unsigned* bar, unsigned x, unsigned& nloc, unsigned& nx) {
    const unsigned G = gridDim.x * gridDim.y * gridDim.z;
    unsigned sum, cnt, mine, sp = 0u;
    for (;;) {
        sum = 0u; cnt = 0u; mine = 0u;
#pragma unroll
        for (unsigned j = 0; j < 16; ++j) { const unsigned c = xb_ld(&bar[XB_XCNT(j)]); sum += c; cnt += (c > 0u) ? 1u : 0u; mine = (j == x) ? c : mine; }
        if (sum == G) break;
        __builtin_amdgcn_s_sleep(1);
        if ((++sp & 255u) == 0u) { if (xb_ld(&bar[XB_TMO])) break; if (sp > XB_SPIN_CAP) { atomicAdd(&bar[XB_TMO], 1u); break; } }
    }
    nloc = mine > 0u ? mine : 1u; nx = cnt > 0u ? cnt : 1u;
}
__device__ __forceinline__ void xcd_barrier(const XcdBarrier& b, int tid) {
    asm volatile("s_waitcnt vmcnt(0)" ::: "memory");
    __syncthreads();
    if (tid == 0) {
        unsigned* bar = b.bar;
        __builtin_amdgcn_s_waitcnt(0);
        unsigned nloc = b.st[0], nx = b.st[1];
        if (nloc == 0u) { xcd_barrier_complete(bar, b.x, nloc, nx); b.st[0] = nloc; b.st[1] = nx; }
        const unsigned old = xb_add(&bar[XB_XSUB(b.x)], 1u);
        const unsigned gen = old / nloc;
        if (old + 1u == (gen + 1u) * nloc) {
            __builtin_amdgcn_fence(__ATOMIC_RELEASE, "agent");
            asm volatile("s_waitcnt vmcnt(0)" ::: "memory");
            const unsigned og = xb_add(&bar[XB_TOP], 1u);
            const unsigned tg = og / nx;
            if (og + 1u == (tg + 1u) * nx) xb_add(&bar[XB_TOPGEN], 1u);
            else XB_SPIN(xb_ld(&bar[XB_TOPGEN]) == tg, bar);
            __builtin_amdgcn_fence(__ATOMIC_ACQUIRE, "agent");
            xb_add(&bar[XB_XGEN(b.x)], 1u);
            asm volatile("s_waitcnt vmcnt(0)" ::: "memory");
        } else {
            XB_SPIN(xb_ld(&bar[XB_XGEN(b.x)]) == gen, bar);
            __builtin_amdgcn_fence(__ATOMIC_ACQUIRE, "agent");
            asm volatile("s_waitcnt vmcnt(0)" ::: "memory");
        }
    }
    __syncthreads();
}

__device__ __forceinline__ int hw_lane() { int l; asm volatile("v_mbcnt_lo_u32_b32 %0, -1, 0\n\tv_mbcnt_hi_u32_b32 %0, -1, %0" : "=v"(l)); return l; }
constexpr int XSN_PART_OFF = 141312;
constexpr int EPI_BIAS_OFF = 143360;
struct Unit { int pm, pn, z; long aoff, boff; };
struct GemmDesc { const bf16_t* A; const bf16_t* Bt; int lda, ldb, K; const int* tok = nullptr; };

struct TileOrder {
    int nM, nN, nwg, G, c, mode, lda, ldb;
    __device__ __forceinline__ void init(int nM_, int nN_, int G_, int c_, int mode_, int lda_, int ldb_) { nM = nM_; nN = nN_; nwg = nM * nN; G = G_; c = c_; mode = mode_; lda = lda_; ldb = ldb_; }
    __device__ __forceinline__ bool next(int i, Unit& u) const {
        const long L = (long)i * G + c; if (L >= nwg) return false;
        int wgid = (int)L; { const int q = nwg / 8, r = nwg % 8, xcd = wgid % 8, off = wgid / 8; wgid = (xcd < r ? xcd * (q + 1) : r * (q + 1) + (xcd - r) * q) + off; }
        const int nig = 8 * nN, gid = wgid / nig, fm = gid * 8, gsz = (nM - fm) < 8 ? (nM - fm) : 8;
        u.pm = fm + ((wgid % nig) % gsz); u.pn = (wgid % nig) / gsz; u.z = 0;
        const long ar = (long)u.pm * 256 * lda;
        if (mode == 0)      { u.aoff = ar;                u.boff = (long)u.pn * 256 * ldb; }
        else if (mode == 1) { u.aoff = ar + u.pn * 256;   u.boff = (long)u.pn * 256 * ldb; }
        else if (mode == 2) { u.aoff = ar + u.pn * 256;   u.boff = (long)((u.pm >> 5) * 256) * ldb + u.pn * 256; }
        else if (mode == 3) { u.aoff = ar + u.pn * 256;   u.boff = (long)(u.pn * 256) * ldb + (u.pm >> 5) * 256; }
        else                { u.aoff = ar;                u.boff = (long)(u.pm >> 5) * 1048576 + (long)u.pn * 256 * ldb; }
        return true;
    }
};
struct PreOrder {
    int G, c;
    __device__ __forceinline__ bool next(int i, Unit& u) const {
        const int L = i * G + c; if (L >= 64) return false;
        const int which = L >> 4, t16 = L & 15, l = which >> 1, isv = which & 1;
        u.pm = t16 >> 2; u.pn = t16 & 3; u.z = which;
        const long memb = (long)(WS_MEMB / 2), wk = (long)((WS_W + l * WL_SIZE + WL_XK) / 2), wv = (long)((WS_W + l * WL_SIZE + WL_XV) / 2);
        const long ao = memb, bo = isv ? wv : wk;
        u.aoff = ao + (long)u.pm * 256 * 1024; u.boff = bo + (long)u.pn * 256 * 1024; return true;
    }
};
struct Pre2Order {
    int G, c;
    __device__ __forceinline__ bool next(int i, Unit& u) const {
        const int L = i * G + c; if (L >= 256) return false;
        const int l = L >> 7, which = (L >> 6) & 1, b = (L >> 4) & 3, h = (L >> 2) & 3, j = L & 3;
        const long kx = (long)((WS_KX + (size_t)l * 2 * MiB) / 2), vx = (long)((WS_VXT + (size_t)l * 2 * MiB) / 2), wq = (long)((WS_W + l * WL_SIZE + WL_XQ) / 2), wo = (long)((WS_W + l * WL_SIZE + WL_XO) / 2);
        u.z = (l * 2 + which) * 4 + b;
        if (which == 0) { u.pm = h; u.pn = j; u.aoff = kx + (long)(b * 256) * 1024 + h * 256; u.boff = wq + (long)(j * 256) * 1024 + h * 256; }
        else            { u.pm = j; u.pn = h; u.aoff = wo + (long)(j * 256) * 1024 + h * 256; u.boff = vx + (long)(b * 256) * 1024 + h * 256; }
        return true;
    }
};
struct MoeOrder {
    const LAS int* blk_e; int nblk, nN, G, c;
    __device__ __forceinline__ bool next(int i, Unit& u) const {
        const int x = c & 7, v = c >> 3, per = G >> 3; const long ul = (long)i * per + v; const int rb = x + 8 * (int)(ul / nN), pn = (int)(ul % nN); if (rb >= nblk) return false;
        const int e = blk_e[rb]; u.pm = rb; u.pn = pn; u.z = e;
        u.aoff = (long)rb * 256 * 1024; u.boff = ((long)e * nN * 256 + (long)pn * 256) * 1024; return true;
    }
};

__device__ __forceinline__ u32x4 pk8(const f32x4 a, const f32x4 b) { return (u32x4){pk2(a.x, a.y), pk2(a.z, a.w), pk2(b.x, b.y), pk2(b.z, b.w)}; }
struct EpiBf16 { static constexpr bool TILE = true; static constexpr int NST = 16; static constexpr int NPRE = 0; bf16_t* O; int ldo; const float* bias;
    __device__ __forceinline__ void tile(const f32x4 (&acc)[2][2][4][2], const Unit& u, int wr, int wc, int fr, int fq) const {
        const int col0 = u.pn * 256 + wc * 32 + 8 * fq; f32x4 b[2][2];
#pragma unroll
        for (int bj = 0; bj < 2; ++bj) { b[bj][0] = bias ? *(const f32x4*)(bias + col0 + bj * 128) : (f32x4){0.f, 0.f, 0.f, 0.f}; b[bj][1] = bias ? *(const f32x4*)(bias + col0 + bj * 128 + 4) : (f32x4){0.f, 0.f, 0.f, 0.f}; }
        if (bias) asm volatile("s_waitcnt vmcnt(0)" ::: "memory");
#pragma unroll
        for (int ai = 0; ai < 2; ++ai)
#pragma unroll
            for (int m = 0; m < 4; ++m) { bf16_t* rowp = O + (size_t)(u.pm * 256 + ai * 128 + wr * 64 + m * 16 + fr) * ldo + col0;
#pragma unroll
                for (int bj = 0; bj < 2; ++bj) *(u32x4*)(rowp + bj * 128) = pk8(acc[ai][bj][m][0] + b[bj][0], acc[ai][bj][m][1] + b[bj][1]); }
    }
    __device__ __forceinline__ void st4(const Unit&, int grow, int gcol, f32x4 v) const {
        if (bias) { const f32x4 b = *(const f32x4*)(bias + gcol); v += b; }
        u32x2 w; w.x = pk2(v.x, v.y); w.y = pk2(v.z, v.w); *(u32x2*)(O + (size_t)grow * ldo + gcol) = w; } };
struct EpiF32 { static constexpr bool TILE = false; static constexpr int NST = 0; static constexpr int NPRE = 0; float* O; int ldo; const float* bias0; const float* bias1;
    __device__ __forceinline__ void st4(const Unit&, int grow, int gcol, f32x4 v) const {
        if (bias0) { const f32x4 b = (gcol < 256) ? *(const f32x4*)(bias0 + gcol) : *(const f32x4*)(bias1 + gcol - 256); v += b; }
        *(f32x4*)(O + (size_t)grow * ldo + gcol) = v; } };
struct EpiFCN { static constexpr bool TILE = true; static constexpr int NST = 16; static constexpr int NPRE = 0; bf16_t* Y; const float* bias0; const float* bias1; LAS unsigned char* lds;
    __device__ __forceinline__ void tile(const f32x4 (&acc)[2][2][4][2], const Unit& u, int wr, int wc, int fr_, int fq_) const {
        int fr = fr_, fq = fq_; asm volatile("" : "+v"(fr), "+v"(fq));
        LAS float* part = (LAS float*)(lds + XSN_PART_OFF);
        const float* bp = (u.pn == 0 ? bias0 : bias1) + wc * 32 + 8 * fq; f32x4 b[2][2];
#pragma unroll
        for (int bj = 0; bj < 2; ++bj) { b[bj][0] = *(const f32x4*)(bp + bj * 128); b[bj][1] = *(const f32x4*)(bp + bj * 128 + 4); }
        asm volatile("s_waitcnt vmcnt(0)" ::: "memory");
#pragma unroll
        for (int ai = 0; ai < 2; ++ai)
#pragma unroll
            for (int m = 0; m < 4; ++m) { float ss = 0.f;
#pragma unroll
                for (int bj = 0; bj < 2; ++bj)
#pragma unroll
                    for (int n = 0; n < 2; ++n) { const f32x4 x = acc[ai][bj][m][n] + b[bj][n]; ss += (x.x * x.x + x.y * x.y) + (x.z * x.z + x.w * x.w); }
                ss = rsum<16>(ss); ss = rsum<32>(ss);
                if (fq == 0) part[(ai * 128 + wr * 64 + m * 16 + fr) * 4 + wc] = ss;
                __builtin_amdgcn_sched_barrier(0); }
        asm volatile("s_waitcnt lgkmcnt(0)\n\ts_barrier" ::: "memory");
        asm volatile("" : "+v"(b[0][0]), "+v"(b[0][1]), "+v"(b[1][0]), "+v"(b[1][1]));
#pragma unroll
        for (int ai = 0; ai < 2; ++ai)
#pragma unroll
            for (int m = 0; m < 4; ++m) { const int lrow = ai * 128 + wr * 64 + m * 16 + fr; const f32x4 t = *(const LAS f32x4*)(part + lrow * 4); const float r = __builtin_amdgcn_rsqf(((t.x + t.y) + (t.z + t.w)) * (1.f / 256.f) + RMS_EPS);
#pragma unroll
                for (int bj = 0; bj < 2; ++bj) *(u32x4*)(Y + (size_t)(u.pm * 256 + lrow) * 1024 + u.pn * 256 + bj * 128 + wc * 32 + 8 * fq) = pk8((acc[ai][bj][m][0] + b[bj][0]) * r, (acc[ai][bj][m][1] + b[bj][1]) * r);
                __builtin_amdgcn_sched_barrier(0); }
    } };
struct EpiPre { static constexpr bool TILE = false; static constexpr int NST = 0; static constexpr int NPRE = 0; unsigned char* ws;
    __device__ __forceinline__ void st4(const Unit& u, int grow, int gcol, f32x4 v) const {
        bf16_t* O = (bf16_t*)(ws + ((u.z & 1) ? WS_VXT : WS_KX) + (size_t)(u.z >> 1) * 2 * MiB);
        u32x2 w; w.x = pk2(v.x, v.y); w.y = pk2(v.z, v.w); *(u32x2*)(O + (size_t)grow * 1024 + gcol) = w; } };
struct EpiPre2 { static constexpr bool TILE = false; static constexpr int NST = 0; static constexpr int NPRE = 0; unsigned char* ws;
    __device__ __forceinline__ void st4(const Unit& u, int grow, int gcol, f32x4 v) const {
        bf16_t* O = (bf16_t*)(ws + WS_MT + (size_t)u.z * 2 * MiB);
        u32x2 w; w.x = pk2(v.x, v.y); w.y = pk2(v.z, v.w); *(u32x2*)(O + (size_t)grow * 1024 + gcol) = w; } };
__device__ __forceinline__ void rope2(float& x1, float& x2, float ang) { const float c = __cosf(ang), s = __sinf(ang); const float a = x1 * c - x2 * s, b = x2 * c + x1 * s; x1 = a; x2 = b; }
struct EpiGU { static constexpr bool TILE = true; static constexpr int NST = 8; static constexpr int NPRE = 1; bf16_t* O; const float* bgu; LAS unsigned char* lds;
    __device__ __forceinline__ void prefetch(const Unit& u, int wid, int lane) const {
        const float* b = bgu + (size_t)u.z * 2048 + (lane >> 5) * 1024 + u.pn * 128 + (wid & 3) * 32 + (lane & 31);
        __builtin_amdgcn_global_load_lds((const unsigned*)b, (LAS unsigned*)(lds + EPI_BIAS_OFF + wid * 256), 4, 0, 0); }
    __device__ __forceinline__ void tile(const f32x4 (&acc)[2][2][4][2], const Unit& u, int wr, int wc, int fr, int fq) const {
        const int acol = u.pn * 128 + wc * 32 + 8 * fq; const LAS float* b = (const LAS float*)(lds + EPI_BIAS_OFF + (wr * 4 + wc) * 256) + 8 * fq;
        const f32x4 bg0 = *(const LAS f32x4*)b, bg1 = *(const LAS f32x4*)(b + 4); f32x4 bu0 = *(const LAS f32x4*)(b + 32), bu1 = *(const LAS f32x4*)(b + 36);
        bu0 += 1.f; bu1 += 1.f;
#define GU_PAIR(G, U, BG, BU, I) ({ hwf2 g_ = hwf2{G[I], G[I + 1]} + hwf2{BG[I], BG[I + 1]}, u_ = hwf2{U[I], U[I + 1]} + hwf2{BU[I], BU[I + 1]};   \
            g_.x = fminf(g_.x, 7.f); g_.y = fminf(g_.y, 7.f); u_.x = __builtin_amdgcn_fmed3f(u_.x, -6.f, 8.f); u_.y = __builtin_amdgcn_fmed3f(u_.y, -6.f, 8.f);          \
            hwf2 e_ = g_ * -2.45546696f; e_.x = __builtin_amdgcn_exp2f(e_.x); e_.y = __builtin_amdgcn_exp2f(e_.y); e_ = e_ + 1.f;                                       \
            e_.x = __builtin_amdgcn_rcpf(e_.x); e_.y = __builtin_amdgcn_rcpf(e_.y); const hwf2 a_ = (g_ * u_) * e_; pk2(a_.x, a_.y); })
#pragma unroll
        for (int ai = 0; ai < 2; ++ai)
#pragma unroll
            for (int m = 0; m < 4; ++m) { const f32x4 g0 = acc[ai][0][m][0], g1 = acc[ai][0][m][1], u0 = acc[ai][1][m][0], u1 = acc[ai][1][m][1];
                u32x4 o; o.x = GU_PAIR(g0, u0, bg0, bu0, 0); o.y = GU_PAIR(g0, u0, bg0, bu0, 2); o.z = GU_PAIR(g1, u1, bg1, bu1, 0); o.w = GU_PAIR(g1, u1, bg1, bu1, 2);
                *(u32x4*)(O + (size_t)(u.pm * 256 + ai * 128 + wr * 64 + m * 16 + fr) * 1024 + acol) = o;
                __builtin_amdgcn_sched_barrier(0); }
#undef GU_PAIR
    }
    __device__ __forceinline__ void st4x2(const Unit& u, int grow, int acol, f32x4 g, f32x4 up) const {
        const float* b = bgu + (size_t)u.z * 2048; const f32x4 bg = *(const f32x4*)(b + acol), bu = *(const f32x4*)(b + 1024 + acol);
        g += bg; up += bu; f32x4 a;
#pragma unroll
        for (int i = 0; i < 4; ++i) { const float gg = fminf(g[i], 7.f), uu = fminf(fmaxf(up[i], -7.f), 7.f); a[i] = (uu + 1.f) * (gg * sigmoidf_(1.702f * gg)); }
        u32x2 w; w.x = pk2(a.x, a.y); w.y = pk2(a.z, a.w); *(u32x2*)(O + (size_t)grow * 1024 + acol) = w; } };
struct EpiDown { static constexpr bool TILE = true; static constexpr int NST = 16; static constexpr int NPRE = 1; bf16_t* O; const float* bdn; LAS unsigned char* lds;
    __device__ __forceinline__ void prefetch(const Unit& u, int wid, int lane) const {
        const float* b = bdn + (size_t)u.z * 1024 + u.pn * 256 + (lane >> 5) * 128 + (wid & 3) * 32 + (lane & 31);
        __builtin_amdgcn_global_load_lds((const unsigned*)b, (LAS unsigned*)(lds + EPI_BIAS_OFF + wid * 256), 4, 0, 0); }
    __device__ __forceinline__ void tile(const f32x4 (&acc)[2][2][4][2], const Unit& u, int wr, int wc, int fr, int fq) const {
        const int col0 = u.pn * 256 + wc * 32 + 8 * fq; const LAS float* bl = (const LAS float*)(lds + EPI_BIAS_OFF + (wr * 4 + wc) * 256) + 8 * fq; f32x4 b[2][2];
#pragma unroll
        for (int bj = 0; bj < 2; ++bj) { b[bj][0] = *(const LAS f32x4*)(bl + 32 * bj); b[bj][1] = *(const LAS f32x4*)(bl + 32 * bj + 4); }
#pragma unroll
        for (int ai = 0; ai < 2; ++ai)
#pragma unroll
            for (int m = 0; m < 4; ++m) { bf16_t* rowp = O + (size_t)(u.pm * 256 + ai * 128 + wr * 64 + m * 16 + fr) * 1024 + col0;
#pragma unroll
                for (int bj = 0; bj < 2; ++bj) *(u32x4*)(rowp + bj * 128) = pk8(acc[ai][bj][m][0] + b[bj][0], acc[ai][bj][m][1] + b[bj][1]); }
    }
    __device__ __forceinline__ void st4(const Unit& u, int grow, int gcol, f32x4 v) const {
        const f32x4 b = *(const f32x4*)(bdn + (size_t)u.z * 1024 + gcol); v += b;
        u32x2 w; w.x = pk2(v.x, v.y); w.y = pk2(v.z, v.w); *(u32x2*)(O + (size_t)grow * 1024 + gcol) = w; } };

struct EpiXS { static constexpr bool TILE = true; static constexpr int NST = 16; static constexpr int NPRE = 0; bf16_t* P; float* RS;
    __device__ __forceinline__ void tile(const f32x4 (&acc)[2][2][4][2], const Unit& u, int wr, int wc, int fr, int fq) const {
#pragma unroll
        for (int ai = 0; ai < 2; ++ai)
#pragma unroll
            for (int m = 0; m < 4; ++m) { const int grow = u.pm * 256 + ai * 128 + wr * 64 + m * 16 + fr; float rs = 0.f;
#pragma unroll
                for (int bj = 0; bj < 2; ++bj) { f32x4 p0, p1;
#pragma unroll
                    for (int i = 0; i < 4; ++i) { p0[i] = __builtin_amdgcn_exp2f(fminf(acc[ai][bj][m][0][i], 100.f)); p1[i] = __builtin_amdgcn_exp2f(fminf(acc[ai][bj][m][1][i], 100.f)); }
                    rs += ((p0.x + p0.y) + (p0.z + p0.w)) + ((p1.x + p1.y) + (p1.z + p1.w));
                    u32x4 w; w.x = pk2(p0.x, p0.y); w.y = pk2(p0.z, p0.w); w.z = pk2(p1.x, p1.y); w.w = pk2(p1.z, p1.w);
                    *(u32x4*)(P + (size_t)grow * 1024 + u.pn * 256 + bj * 128 + wc * 32 + 8 * fq) = w; }
                rs = rsum<16>(rs); rs = rsum<32>(rs);
                if (fq == 0) RS[((size_t)grow * 4 + u.pn) * 4 + wc] = rs;
                __builtin_amdgcn_sched_barrier(0); }
    } };
struct EpiXSN { static constexpr bool TILE = true; static constexpr int NST = 16; static constexpr int NPRE = 0; bf16_t* P; LAS unsigned char* lds;
    __device__ __forceinline__ void tile(const f32x4 (&acc)[2][2][4][2], const Unit& u, int wr, int wc, int fr_, int fq_) const {
        int fr = fr_, fq = fq_; asm volatile("" : "+v"(fr), "+v"(fq));
        LAS float* part = (LAS float*)(lds + XSN_PART_OFF);
#pragma unroll
        for (int ai = 0; ai < 2; ++ai)
#pragma unroll
            for (int m = 0; m < 4; ++m) { float rs = 0.f;
#pragma unroll
                for (int bj = 0; bj < 2; ++bj)
#pragma unroll
                    for (int n = 0; n < 2; ++n) { f32x4 q;
#pragma unroll
                        for (int i = 0; i < 4; ++i) q[i] = __builtin_amdgcn_exp2f(fminf(acc[ai][bj][m][n][i], 100.f));
                        rs += (q.x + q.y) + (q.z + q.w); }
                rs = rsum<16>(rs); rs = rsum<32>(rs);
                if (fq == 0) part[(ai * 128 + wr * 64 + m * 16 + fr) * 4 + wc] = rs;
                __builtin_amdgcn_sched_barrier(0); }
        asm volatile("s_waitcnt lgkmcnt(0)\n\ts_barrier" ::: "memory");
        float cap = 100.f; asm volatile("" : "+v"(cap));
#pragma unroll
        for (int ai = 0; ai < 2; ++ai)
#pragma unroll
            for (int m = 0; m < 4; ++m) { const int lrow = ai * 128 + wr * 64 + m * 16 + fr; const f32x4 t = *(const LAS f32x4*)(part + lrow * 4); const float r = __builtin_amdgcn_rcpf((t.x + t.y) + (t.z + t.w));
#pragma unroll
                for (int bj = 0; bj < 2; ++bj) { f32x4 q0, q1;
#pragma unroll
                    for (int i = 0; i < 4; ++i) { q0[i] = __builtin_amdgcn_exp2f(fminf(acc[ai][bj][m][0][i], cap)) * r; q1[i] = __builtin_amdgcn_exp2f(fminf(acc[ai][bj][m][1][i], cap)) * r; }
                    *(u32x4*)(P + (size_t)(u.pm * 256 + lrow) * 1024 + u.pn * 256 + bj * 128 + wc * 32 + 8 * fq) = pk8(q0, q1); }
                __builtin_amdgcn_sched_barrier(0); }
    } };
struct EpiXO { static constexpr bool TILE = true; static constexpr int NST = 16; static constexpr int NPRE = 0; bf16_t* O; const float* RS;
    __device__ __forceinline__ void tile(const f32x4 (&acc)[2][2][4][2], const Unit& u, int wr, int wc, int fr, int fq) const {
        const int col0 = u.pn * 256 + wc * 32 + 8 * fq; float rr[2][4];
#pragma unroll
        for (int ai = 0; ai < 2; ++ai)
#pragma unroll
            for (int m = 0; m < 4; ++m) { const int grow = u.pm * 256 + ai * 128 + wr * 64 + m * 16 + fr; const f32x4 q = *(const f32x4*)(RS + ((size_t)grow * 4 + u.pn) * 4); rr[ai][m] = __builtin_amdgcn_rcpf((q.x + q.y) + (q.z + q.w)); }
        asm volatile("s_waitcnt vmcnt(0)" ::: "memory");
#pragma unroll
        for (int ai = 0; ai < 2; ++ai)
#pragma unroll
            for (int m = 0; m < 4; ++m) { const int grow = u.pm * 256 + ai * 128 + wr * 64 + m * 16 + fr; const float r = rr[ai][m];
#pragma unroll
                for (int bj = 0; bj < 2; ++bj) *(u32x4*)(O + (size_t)grow * 1024 + col0 + bj * 128) = pk8(acc[ai][bj][m][0] * r, acc[ai][bj][m][1] * r); }
    }
    __device__ __forceinline__ void st4(const Unit&, int grow, int gcol, f32x4 v) const {
        const f32x4 q = *(const f32x4*)(RS + ((size_t)grow * 4 + (gcol >> 8)) * 4); const float r = __builtin_amdgcn_rcpf((q.x + q.y) + (q.z + q.w)); v = v * r;
        u32x2 w; w.x = pk2(v.x, v.y); w.y = pk2(v.z, v.w); *(u32x2*)(O + (size_t)grow * 1024 + gcol) = w; } };

template <bool PAIR, class Sched, class Epi>
__device__ __forceinline__ void sgemm_phase(const int tid, const GemmDesc g, const Sched& S, const Epi& E) {
    const int wid = tid >> 6, lane = tid & 63, r32 = lane & 31, hi = lane >> 5;
    Unit u;
    for (int i = 0; S.next(i, u); ++i) {
        const int grow = u.pm * 256 + wid * 32 + r32;
        const bf16_t* Ap = g.A + u.aoff + (long)(wid * 32 + r32) * g.lda + hi * 8;
        const bf16_t* Bp = g.Bt + u.boff + (long)r32 * g.ldb + hi * 8;
#pragma unroll 1
        for (int pass = 0; pass < 2; ++pass) {
            int cbs[4];
#pragma unroll
            for (int j = 0; j < 4; ++j) cbs[j] = PAIR ? ((j & 1) + 2 * pass + 4 * (j >> 1)) : (4 * pass + j);
            f32x16 acc[4];
#pragma unroll
            for (int j = 0; j < 4; ++j) acc[j] = f32x16{};
#pragma unroll 2
            for (int k0 = 0; k0 < g.K; k0 += 16) {
                const bf16x8 a = *(const bf16x8*)(Ap + k0);
#pragma unroll
                for (int j = 0; j < 4; ++j) { const bf16x8 b = *(const bf16x8*)(Bp + (long)cbs[j] * 32 * g.ldb + k0); acc[j] = __builtin_amdgcn_mfma_f32_32x32x16_bf16(b, a, acc[j], 0, 0, 0); }
            }
            if constexpr (PAIR) {
#pragma unroll
                for (int j = 0; j < 2; ++j)
#pragma unroll
                    for (int q = 0; q < 4; ++q) { const f32x4 gv = {acc[j][4 * q], acc[j][4 * q + 1], acc[j][4 * q + 2], acc[j][4 * q + 3]};
                        const f32x4 uv = {acc[j + 2][4 * q], acc[j + 2][4 * q + 1], acc[j + 2][4 * q + 2], acc[j + 2][4 * q + 3]};
                        E.st4x2(u, grow, u.pn * 128 + cbs[j] * 32 + 8 * q + 4 * hi, gv, uv); }
            } else {
#pragma unroll
                for (int j = 0; j < 4; ++j)
#pragma unroll
                    for (int q = 0; q < 4; ++q) { const f32x4 v = {acc[j][4 * q], acc[j][4 * q + 1], acc[j][4 * q + 2], acc[j][4 * q + 3]};
                        E.st4(u, grow, u.pn * 256 + cbs[j] * 32 + 8 * q + 4 * hi, v); }
            }
        }
    }
}

namespace pg8 {
constexpr int BK = 64, HALF = 128, HTB = HALF * BK * 2, STAGE_BYTES = 8 * HTB;
__device__ __forceinline__ int lds_byte(int r, int c) { const int st = (r >> 4) * 2 + (c >> 5), rr = r & 15, cc = c & 31, ob = rr * 64 + cc * 2; return st * 1024 + (ob ^ (((ob >> 9) & 1) << 5)); }
__device__ __forceinline__ void stage_rc(int b, int& R, int& C) { const int st = b / 1024, sb = b % 1024, swz = sb ^ (((sb >> 9) & 1) << 5); R = (st >> 1) * 16 + swz / 64; C = (st & 1) * 32 + (swz % 64) / 2; }
__device__ __forceinline__ int perm32(int rho) { const int n = rho >> 4, i = rho & 15; return 8 * (i >> 2) + 4 * n + (i & 3); }
template <bool PAIR, class Epi>
__device__ __forceinline__ void run_epi(const Epi& E, const f32x4 (&acc)[2][2][4][2], const Unit& u, int wr, int wc, int fr, int fq) {
    if constexpr (Epi::TILE) { E.tile(acc, u, wr, wc, fr, fq); return; } else {
#pragma unroll
    for (int ai = 0; ai < 2; ++ai)
#pragma unroll
        for (int m = 0; m < 4; ++m) { const int grow = u.pm * 256 + ai * HALF + wr * 64 + m * 16 + fr;
            if constexpr (PAIR) {
#pragma unroll
                for (int n = 0; n < 2; ++n) E.st4x2(u, grow, u.pn * 128 + wc * 32 + 8 * fq + 4 * n, acc[ai][0][m][n], acc[ai][1][m][n]);
            } else {
#pragma unroll
                for (int bj = 0; bj < 2; ++bj)
#pragma unroll
                    for (int n = 0; n < 2; ++n) E.st4(u, grow, u.pn * 256 + bj * HALF + wc * 32 + 8 * fq + 4 * n, acc[ai][bj][m][n]);
            }
            __builtin_amdgcn_sched_barrier(0); }
    }
}
template <bool PAIR, bool GATH, class Sched, class Epi>
__device__ __forceinline__ void gemm_phase(const int tid, LAS unsigned char* lds, const GemmDesc g, const Sched& S, const Epi& E) {
    const int wid = __builtin_amdgcn_readfirstlane(tid >> 6), lane = tid & 63, wr = wid >> 2, wc = wid & 3, fr = lane & 15, fq = lane >> 4;
    const int K = g.K, nt = K / BK;
    unsigned voffA[2], voffB[2]; int RA[2], CA[2];
#define PG8_VOFFS() do { const int t_ = wid * 64 + hw_lane(); _Pragma("unroll") for (int i = 0; i < 2; ++i) { int R, C; stage_rc(t_ * 16 + i * 8192, R, C); const int Rb = (R & ~31) + perm32(R & 31); RA[i] = R; CA[i] = C * 2; \
        voffA[i] = (unsigned)(R * g.lda + C) * 2u; voffB[i] = (unsigned)(Rb * g.ldb + C) * 2u; } } while (0)
    PG8_VOFFS();
    unsigned cvA[2][2], nvA[2][2];
#define PG8_GVOFF(U, V) do { if constexpr (GATH) { _Pragma("unroll") for (int h_ = 0; h_ < 2; ++h_) _Pragma("unroll") for (int i_ = 0; i_ < 2; ++i_) \
        V[h_][i_] = (unsigned)g.tok[(U).pm * 256 + h_ * HALF + RA[i_]] * (unsigned)(g.lda * 2) + (unsigned)CA[i_]; } } while (0)
    const size_t kstep = (size_t)(BK * 2);
    const size_t hstepA = (size_t)HALF * g.lda * 2, hstepB = (size_t)HALF * g.ldb * 2;
    const unsigned ldsw = (unsigned)wid * 1024u;
    const int aoff = lds_byte(wr * 64 + fr, fq * 8), boff = lds_byte(wc * 32 + fr, fq * 8);
#define PG8_SA(b, h) (((b) * 2 + (h)) * HTB)
#define PG8_SB(b, h) ((4 + (b) * 2 + (h)) * HTB)
#define PG8_STAGE(bufoff, gbase, voff) do { _Pragma("unroll") for (int _i = 0; _i < 2; ++_i) \
        __builtin_amdgcn_global_load_lds((const unsigned*)((const char*)(gbase) + (voff)[_i]), (LAS unsigned*)(lds + (bufoff) + ldsw + _i * 8192), 16, 0, 0); } while (0)
#define PG8_STA(b, h, base, V) do { if constexpr (GATH) PG8_STAGE(PG8_SA(b, h), base, V[h]); else PG8_STAGE(PG8_SA(b, h), (base) + (h) * hstepA, voffA); } while (0)
#define PG8_LDA(dst, b, h) do { _Pragma("unroll") for (int m = 0; m < 4; ++m) _Pragma("unroll") for (int k = 0; k < 2; ++k) dst[m][k] = *(const LAS bf16x8*)(lds + PG8_SA(b, h) + aoff + m * 2048 + k * 1024); } while (0)
#define PG8_LDB(dst, b, h) do { _Pragma("unroll") for (int n = 0; n < 2; ++n) _Pragma("unroll") for (int k = 0; k < 2; ++k) dst[n][k] = *(const LAS bf16x8*)(lds + PG8_SB(b, h) + boff + n * 2048 + k * 1024); } while (0)
#define PG8_MMA(ai, bj, At, Bt) do { __builtin_amdgcn_s_setprio(1); _Pragma("unroll") for (int m = 0; m < 4; ++m) _Pragma("unroll") for (int n = 0; n < 2; ++n) _Pragma("unroll") for (int k = 0; k < 2; ++k) \
        acc[ai][bj][m][n] = __builtin_amdgcn_mfma_f32_16x16x32_bf16(Bt[n][k], At[m][k], acc[ai][bj][m][n], 0, 0, 0); __builtin_amdgcn_s_setprio(0); } while (0)
#define PG8_WAIT_V(n) asm volatile("s_waitcnt vmcnt(" #n ")" ::: "memory")
#define PG8_WAIT_VN(n) asm volatile("s_waitcnt vmcnt(%0)" :: "n"(n) : "memory")
#define PG8_WAIT_L(n) asm volatile("s_waitcnt lgkmcnt(" #n ")" ::: "memory")
#define PG8_BAR __builtin_amdgcn_s_barrier()
#define PG8_SCHED __builtin_amdgcn_sched_barrier(0)
    Unit cur, nxt; int ui = 0;
    if (!S.next(0, cur)) return;
    bool has_next = S.next(1, nxt);
    f32x4 acc[2][2][4][2];
    float zf = 0.f; asm volatile("" : "+v"(zf)); const f32x4 Z4 = {zf, zf, zf, zf};
#pragma unroll
    for (int a = 0; a < 2; ++a)
#pragma unroll
        for (int b = 0; b < 2; ++b)
#pragma unroll
            for (int m = 0; m < 4; ++m)
#pragma unroll
                for (int n = 0; n < 2; ++n) acc[a][b][m][n] = Z4;
    bf16x8 At[4][2], B0[2][2], B1[2][2];
    const char* cA = (const char*)g.A + (GATH ? (size_t)0 : (size_t)cur.aoff * 2); const char* cB = (const char*)g.Bt + (size_t)cur.boff * 2;
    const char* nA = (has_next && !GATH) ? (const char*)g.A + (size_t)nxt.aoff * 2 : cA; const char* nB = has_next ? (const char*)g.Bt + (size_t)nxt.boff * 2 : cB;
    PG8_GVOFF(cur, cvA);
    if constexpr (GATH) { if (has_next) PG8_GVOFF(nxt, nvA); else { _Pragma("unroll") for (int h_ = 0; h_ < 2; ++h_) _Pragma("unroll") for (int i_ = 0; i_ < 2; ++i_) nvA[h_][i_] = cvA[h_][i_]; } }
    PG8_STAGE(PG8_SB(0, 0), cB, voffB); PG8_STAGE(PG8_SB(0, 1), cB + hstepB, voffB); PG8_STA(0, 0, cA, cvA); PG8_STA(0, 1, cA, cvA);
    PG8_STAGE(PG8_SB(1, 0), cB + kstep, voffB); PG8_STA(1, 0, cA + kstep, cvA); PG8_STAGE(PG8_SB(1, 1), cB + hstepB + kstep, voffB); PG8_STA(1, 1, cA + kstep, cvA);
    PG8_WAIT_V(0);
    if (wr == 1) PG8_BAR;
    PG8_BAR;
    constexpr int WX = 8 + Epi::NST + Epi::NPRE;
#define PG8_WAIT_X() do { if constexpr (WX == 8) PG8_WAIT_V(8); else { if (fst) PG8_WAIT_VN(WX); else PG8_WAIT_V(8); } } while (0)
    for (;;) {
        int fst = 1; asm volatile("" : "+s"(fst));
#pragma unroll 1
        for (int t = 0; t < nt; t += 2) {
            const bool last = (t == nt - 2);
            const char* a1 = cA + (size_t)(t + 1) * kstep;
            const char* a2 = last ? nA : cA + (size_t)(t + 2) * kstep; const char* b2 = last ? nB : cB + (size_t)(t + 2) * kstep;
            const char* a3 = a2 + kstep; const char* b3 = b2 + kstep;
            unsigned sv[2][2];
            if constexpr (GATH) { _Pragma("unroll") for (int h_ = 0; h_ < 2; ++h_) _Pragma("unroll") for (int i_ = 0; i_ < 2; ++i_) sv[h_][i_] = last ? nvA[h_][i_] : cvA[h_][i_]; }
            PG8_LDB(B0, 0, 0); PG8_LDB(B1, 0, 1); PG8_SCHED; PG8_LDA(At, 0, 0); if (!fst) PG8_STA(1, 1, a1, cvA); else { if constexpr (Epi::NPRE == 1) E.prefetch(cur, wid, lane); }
            PG8_WAIT_X(); PG8_WAIT_L(0); PG8_BAR; PG8_MMA(0, 0, At, B0); PG8_MMA(0, 1, At, B1); PG8_BAR; PG8_SCHED;
            PG8_LDA(At, 0, 1); PG8_STAGE(PG8_SB(0, 0), b2, voffB); PG8_STAGE(PG8_SB(0, 1), b2 + hstepB, voffB); PG8_STA(0, 0, a2, sv);
            PG8_WAIT_X(); PG8_WAIT_L(0); PG8_BAR; PG8_MMA(1, 0, At, B0); PG8_MMA(1, 1, At, B1); PG8_BAR; PG8_SCHED;
            PG8_LDB(B0, 1, 0); PG8_LDB(B1, 1, 1); PG8_SCHED; PG8_LDA(At, 1, 0); PG8_STA(0, 1, a2, sv);
            PG8_WAIT_X(); PG8_WAIT_L(0); PG8_BAR; PG8_MMA(0, 0, At, B0); PG8_MMA(0, 1, At, B1); PG8_BAR; PG8_SCHED;
            PG8_LDA(At, 1, 1); PG8_STAGE(PG8_SB(1, 0), b3, voffB); PG8_STAGE(PG8_SB(1, 1), b3 + hstepB, voffB); PG8_STA(1, 0, a3, sv);
            PG8_WAIT_V(8); PG8_WAIT_L(0); PG8_BAR; PG8_MMA(1, 0, At, B0); PG8_MMA(1, 1, At, B1); PG8_BAR; PG8_SCHED;
            fst = 0;
        }
        if (wr == 0) PG8_BAR;
        PG8_STA(1, 1, nA + kstep, nvA);
        Unit nn; const bool has_nn = has_next && S.next(ui + 2, nn);
        unsigned n2vA[2][2];
        if constexpr (GATH) { if (has_nn) PG8_GVOFF(nn, n2vA); else { _Pragma("unroll") for (int h_ = 0; h_ < 2; ++h_) _Pragma("unroll") for (int i_ = 0; i_ < 2; ++i_) n2vA[h_][i_] = nvA[h_][i_]; } }
        { const int le_ = hw_lane(); run_epi<PAIR>(E, acc, cur, wr, wc, le_ & 15, le_ >> 4); }
        if (!has_next) break;
#pragma unroll
        for (int a = 0; a < 2; ++a)
#pragma unroll
            for (int b = 0; b < 2; ++b)
#pragma unroll
                for (int m = 0; m < 4; ++m)
#pragma unroll
                    for (int n = 0; n < 2; ++n) acc[a][b][m][n] = Z4;
        PG8_VOFFS();
        cur = nxt; cA = nA; cB = nB; ++ui;
        if constexpr (GATH) { _Pragma("unroll") for (int h_ = 0; h_ < 2; ++h_) _Pragma("unroll") for (int i_ = 0; i_ < 2; ++i_) { cvA[h_][i_] = nvA[h_][i_]; nvA[h_][i_] = n2vA[h_][i_]; } }
        has_next = has_nn;
        if (has_nn) { nxt = nn; if constexpr (!GATH) nA = (const char*)g.A + (size_t)nn.aoff * 2; nB = (const char*)g.Bt + (size_t)nn.boff * 2; }
        if (wr == 1) PG8_BAR;
    }
#undef PG8_WAIT_X
#undef PG8_VOFFS
    PG8_WAIT_V(0);
    PG8_BAR;
#undef PG8_SA
#undef PG8_SB
#undef PG8_STAGE
#undef PG8_LDA
#undef PG8_STA
#undef PG8_GVOFF
#undef PG8_LDB
#undef PG8_MMA
#undef PG8_WAIT_V
#undef PG8_WAIT_VN
#undef PG8_WAIT_L
#undef PG8_BAR
#undef PG8_SCHED
}
}

struct Args { const float* in[37]; float* out; unsigned char* ws; int lo, hi, pad0, pad1; };
enum { I_X = 0, I_MEM, I_LNIN_G, I_LNIN_B, I_WIN, I_WF, I_BF, I_DWW, I_DWB, I_CLG, I_CLB, I_WPW, I_BPW, I_QG, I_KG, I_MQG, I_WUQ, I_MKG, I_WUKV, I_GRPG, I_WO, I_LN1G, I_LN1B,
       I_WXQ, I_WXK, I_WXV, I_WXO, I_LN2G, I_LN2B, I_WR, I_BR, I_WGU, I_BGU, I_WDN, I_BDN, I_LN3G, I_LN3B };

__device__ __forceinline__ int rope_perm16(int d) { const int half = d >> 4, dd = d & 15; return half * 16 + ((dd < 8) ? 2 * dd : 2 * (dd - 8) + 1); }
__device__ __forceinline__ int rope_perm32(int d) { const int half = d >> 5, dd = d & 31; return half * 32 + ((dd < 16) ? 2 * dd : 2 * (dd - 16) + 1); }
__device__ __forceinline__ int map_row(int mode, int n) {
    switch (mode) {
    case 1: if (n < 256) return -1; if (n < 768) return n; if (n < 1152) { const int m = n - 768; return 768 + (m & ~63) + rope_perm32(m & 63); } if (n < 1664) return n; return 1664 + rope_perm16(n - 1664);
    case 2: { const int h = n / 96, p = n % 96; return h * 128 + (p < 64 ? p : 64 + rope_perm16(p - 64)); }
    case 3: return 512 + n;
    case 4: { const int half = n >> 10, m = n & 1023; return (m >> 7) * 256 + half * 128 + (m & 127); }
    default: return n;
    }
}
__device__ __forceinline__ void cp_item(const float* __restrict__ W, bf16_t* dst, float scale, int item, int lane) {
    const int r0 = (item >> 4) * 64 + (lane >> 4), c0 = (item & 15) * 64 + (lane & 15) * 4;
#pragma unroll
    for (int i = 0; i < 16; ++i) { const f32x4 v = *(const f32x4*)(W + (size_t)(r0 + 4 * i) * 1024 + c0) * scale; u32x2 w; w.x = pk2(v.x, v.y); w.y = pk2(v.z, v.w); *(u32x2*)(dst + (size_t)(r0 + 4 * i) * 1024 + c0) = w; }
}
__device__ __forceinline__ int fnet_j(int cc) { const int jp = cc >> 1, second = cc & 1; return jp == 0 ? (second ? 32 : 0) : (second ? 64 - jp : jp); }
__device__ __forceinline__ void tr_item(const float* __restrict__ W, int N, bf16_t* dst, int ldd, int koff, const float* kgain, float scale, int mode, int rowbase, LAS float* scr, int item, int lane, int kperm = 0) {
    const int nblk = (N + 63) >> 6, kb = item / nblk, nb = item - kb * nblk, k0 = kb * 64, n0 = nb * 64;
    const int nq = (lane & 15) * 4, kq = lane >> 4;
    const bool ok = (n0 + nq) < N;
    f32x4 v[16];
#pragma unroll
    for (int i = 0; i < 16; ++i) { const int kk = 4 * i + kq; const int ksrc = kperm ? (((k0 + kk) & ~63) + fnet_j((k0 + kk) & 63)) : (k0 + kk); v[i] = ok ? *(const f32x4*)(W + (size_t)ksrc * N + n0 + nq) : (f32x4){0.f, 0.f, 0.f, 0.f}; }
#pragma unroll
    for (int i = 0; i < 16; ++i) { const int kk = 4 * i + kq; const float gs = (kgain ? kgain[k0 + kk] : 1.f) * scale;
        scr[kk * 65 + nq + 0] = v[i].x * gs; scr[kk * 65 + nq + 1] = v[i].y * gs; scr[kk * 65 + nq + 2] = v[i].z * gs; scr[kk * 65 + nq + 3] = v[i].w * gs; }
    LDS_WAIT(); asm volatile("" ::: "memory");
    const int c = lane & 7;
#pragma unroll
    for (int j = 0; j < 8; ++j) { const int n = (lane >> 3) + 8 * j;
        if (n0 + n < N) { const int row = map_row(mode, n0 + n);
            if (row >= 0) { const LAS float* s = scr + (8 * c) * 65 + n;
                u32x4 o; o.x = pk2(s[0 * 65], s[1 * 65]); o.y = pk2(s[2 * 65], s[3 * 65]); o.z = pk2(s[4 * 65], s[5 * 65]); o.w = pk2(s[6 * 65], s[7 * 65]);
                *(u32x4*)(dst + (size_t)(rowbase + row) * ldd + koff + k0 + 8 * c) = o; } } }
    LDS_WAIT(); asm volatile("" ::: "memory");
}
constexpr int IT_IN = 16 * 27, IT_UQ = 4 * 6, IT_UKV = 2 * 8, IT_F = 16, IT_SQ = 256, IT_GU = 32 * 512, IT_DN = 32 * 256;
constexpr int IT_SMALL = IT_IN + IT_UQ + IT_UKV + 2 * IT_F + 5 * IT_SQ, IT_MOE = IT_GU + IT_DN;

struct R8 { f32x4 lo, hi; };
__device__ __forceinline__ R8 unpack8(const u32x4 w) { R8 r; r.lo = (f32x4){bflo(w.x), bfhi(w.x), bflo(w.y), bfhi(w.y)}; r.hi = (f32x4){bflo(w.z), bfhi(w.z), bflo(w.w), bfhi(w.w)}; return r; }
__device__ __forceinline__ u32x4 pack8(const R8& r) { return (u32x4){pk2(r.lo.x, r.lo.y), pk2(r.lo.z, r.lo.w), pk2(r.hi.x, r.hi.y), pk2(r.hi.z, r.hi.w)}; }
__device__ __forceinline__ float hsum8(const R8& r) { return ((r.lo.x + r.lo.y) + (r.lo.z + r.lo.w)) + ((r.hi.x + r.hi.y) + (r.hi.z + r.hi.w)); }
__device__ __forceinline__ float hsq8(const R8& r) { return ((r.lo.x * r.lo.x + r.lo.y * r.lo.y) + (r.lo.z * r.lo.z + r.lo.w * r.lo.w)) + ((r.hi.x * r.hi.x + r.hi.y * r.hi.y) + (r.hi.z * r.hi.z + r.hi.w * r.hi.w)); }
template <int NR>
__device__ __forceinline__ void ln_rows(R8 (&v)[NR][2], const float* g, const float* b, int lane) {
    float mean[NR], rstd[NR];
#pragma unroll
    for (int q = 0; q < NR; ++q) mean[q] = hsum8(v[q][0]) + hsum8(v[q][1]);
#pragma unroll
    for (int q = 0; q < NR; ++q) mean[q] = rsum<2>(rsum<1>(mean[q]));
#pragma unroll
    for (int q = 0; q < NR; ++q) mean[q] = rsum<8>(rsum<4>(mean[q]));
#pragma unroll
    for (int q = 0; q < NR; ++q) mean[q] = rsum<32>(rsum<16>(mean[q]));
#pragma unroll
    for (int q = 0; q < NR; ++q) { mean[q] *= (1.f / D);
#pragma unroll
        for (int j = 0; j < 2; ++j) { v[q][j].lo = v[q][j].lo - mean[q]; v[q][j].hi = v[q][j].hi - mean[q]; }
        rstd[q] = hsq8(v[q][0]) + hsq8(v[q][1]); }
#pragma unroll
    for (int q = 0; q < NR; ++q) rstd[q] = rsum<2>(rsum<1>(rstd[q]));
#pragma unroll
    for (int q = 0; q < NR; ++q) rstd[q] = rsum<8>(rsum<4>(rstd[q]));
#pragma unroll
    for (int q = 0; q < NR; ++q) rstd[q] = rsum<32>(rsum<16>(rstd[q]));
#pragma unroll
    for (int j = 0; j < 2; ++j) { const f32x4 g0 = *(const f32x4*)(g + 512 * j + 8 * lane), g1 = *(const f32x4*)(g + 512 * j + 8 * lane + 4), b0 = *(const f32x4*)(b + 512 * j + 8 * lane), b1 = *(const f32x4*)(b + 512 * j + 8 * lane + 4);
#pragma unroll
        for (int q = 0; q < NR; ++q) { const float r = __builtin_amdgcn_rsqf(rstd[q] * (1.f / D) + LN_EPS); v[q][j].lo = v[q][j].lo * r * g0 + b0; v[q][j].hi = v[q][j].hi * r * g1 + b1; } }
}
__device__ __forceinline__ void store_row_bf16(bf16_t* row, const R8 (&v)[2], int lane) {
#pragma unroll
    for (int j = 0; j < 2; ++j) *(u32x4*)(row + 512 * j + 8 * lane) = pack8(v[j]);
}
__device__ __forceinline__ void store_row_f32(float* row, const R8 (&v)[2], int lane) {
#pragma unroll
    for (int j = 0; j < 2; ++j) { *(f32x4*)(row + 512 * j + 8 * lane) = v[j].lo; *(f32x4*)(row + 512 * j + 8 * lane + 4) = v[j].hi; }
}

struct MoeWItem { const float* W; bf16_t* dst; int N, mode, rowbase, k0, n0; };
__device__ __forceinline__ MoeWItem moe_w_item(const Args& a, int it) {
    MoeWItem m; const int l = it / IT_MOE; int r = it - l * IT_MOE; unsigned char* wl = a.ws + WS_W + (size_t)l * WL_SIZE; int item;
    if (r < IT_GU) { const int e = r >> 9; m.W = a.in[I_WGU] + ((size_t)l * NE + e) * 1024 * 2048; m.N = 2048; m.dst = (bf16_t*)(wl + WL_GU); m.mode = 4; m.rowbase = e * 2048; item = r & 511; }
    else { r -= IT_GU; const int e = r >> 8; m.W = a.in[I_WDN] + ((size_t)l * NE + e) * 1024 * 1024; m.N = 1024; m.dst = (bf16_t*)(wl + WL_DN); m.mode = 0; m.rowbase = e * 1024; item = r & 255; }
    const int nblk = m.N >> 6, kb = item / nblk, nb = item - kb * nblk; m.k0 = kb * 64; m.n0 = nb * 64; return m;
}
__device__ __forceinline__ void moe_w_load(const MoeWItem& m, int lane, f32x4 (&v)[16]) {
    const float* src = m.W + (size_t)(m.k0 + 2 * (lane >> 4)) * m.N + m.n0 + (lane & 15) * 4;
#pragma unroll
    for (int i = 0; i < 8; ++i) { v[2 * i] = __builtin_nontemporal_load((const f32x4*)(src + (size_t)(8 * i) * m.N)); v[2 * i + 1] = __builtin_nontemporal_load((const f32x4*)(src + (size_t)(8 * i + 1) * m.N)); }
}
__device__ __forceinline__ void moe_w_finish(const MoeWItem& m, int lane, const f32x4 (&v)[16], LAS float* scr) {
    const int l = lane & 15, kq = lane >> 4; LAS unsigned* sw = (LAS unsigned*)scr;
#pragma unroll
    for (int i = 0; i < 8; ++i) { LAS unsigned* w = sw + (4 * l) * 32 + 4 * (i ^ (l & 7)) + kq;
        w[0] = pk2(v[2 * i].x, v[2 * i + 1].x); w[32] = pk2(v[2 * i].y, v[2 * i + 1].y); w[64] = pk2(v[2 * i].z, v[2 * i + 1].z); w[96] = pk2(v[2 * i].w, v[2 * i + 1].w); }
    LDS_WAIT(); asm volatile("" ::: "memory");
    const int c = lane & 7;
#pragma unroll
    for (int j = 0; j < 8; ++j) { const int n = (lane >> 3) + 8 * j; const int row = map_row(m.mode, m.n0 + n);
        const u32x4 o = *(const LAS u32x4*)(sw + n * 32 + 4 * (c ^ ((n >> 2) & 7)));
        *(u32x4*)(m.dst + (size_t)(m.rowbase + row) * 1024 + m.k0 + 8 * c) = o; }
    LDS_WAIT(); asm volatile("" ::: "memory");
}
__device__ __forceinline__ void moe_weight_items(const int tid, const int bid, const Args& a, LAS unsigned char* lds) {
    const int lane = tid & 63, wave = tid >> 6;
    const int gw = bid * NWAVES + wave, NGW = gridDim.x * NWAVES;
    LAS float* scr = (LAS float*)(lds + wave * 16640);
    static_assert((NLAYER * IT_MOE) % (256 * NWAVES * 2) == 0, "every wave converts an even number of tiles");
    f32x4 va[16], vb[16];
    MoeWItem ma = moe_w_item(a, gw), mb; moe_w_load(ma, lane, va);
#pragma unroll 1
    for (int it = gw; it < NLAYER * IT_MOE; it += 2 * NGW) {
        mb = moe_w_item(a, it + NGW); moe_w_load(mb, lane, vb);
        moe_w_finish(ma, lane, va, scr);
        if (it + 2 * NGW < NLAYER * IT_MOE) { ma = moe_w_item(a, it + 2 * NGW); moe_w_load(ma, lane, va); }
        moe_w_finish(mb, lane, vb, scr);
    }
}
__device__ __forceinline__ void phase_pre0(const int tid, const int bid, const Args& a, LAS unsigned char* lds) {
    const int lane = tid & 63, wave = tid >> 6;
    const int gw = bid * NWAVES + wave, NGW = gridDim.x * NWAVES;
    const long gt = (long)bid * NTHREADS + tid, NGT = (long)gridDim.x * NTHREADS;
    unsigned char* ws = a.ws;
    LAS float* scr = (LAS float*)(lds + wave * 16640);
    for (int it = gw; it < NLAYER * IT_SMALL; it += NGW) {
        const int l = it / IT_SMALL; int r = it - l * IT_SMALL;
        unsigned char* wl = ws + WS_W + (size_t)l * WL_SIZE;
        if (r < IT_IN) { tr_item(a.in[I_WIN] + (size_t)l * 1024 * INC, INC, (bf16_t*)(wl + WL_IN), 1024, 0, nullptr, 1.f, 1, 0, scr, r, lane); continue; } r -= IT_IN;
        if (r < IT_UQ) { tr_item(a.in[I_WUQ] + (size_t)l * 256 * 384, 384, (bf16_t*)(wl + WL_MLA), 384, 0, a.in[I_MQG] + l * 256, QSCALE_M, 2, 0, scr, r, lane); continue; } r -= IT_UQ;
        if (r < IT_UKV) { tr_item(a.in[I_WUKV] + (size_t)l * 128 * 512, 512, (bf16_t*)(wl + WL_MLA), 384, 256, a.in[I_MKG] + l * 128, 1.f, 3, 0, scr, r, lane); continue; } r -= IT_UKV;
        if (r < IT_F) { tr_item(a.in[I_WF] + (size_t)l * 65536, 256, (bf16_t*)(wl + WL_FC), 256, 0, nullptr, 1.f, 0, 0, scr, r, lane, 1); continue; } r -= IT_F;
        if (r < IT_F) { tr_item(a.in[I_WPW] + (size_t)l * 65536, 256, (bf16_t*)(wl + WL_FC), 256, 0, nullptr, 1.f, 0, 256, scr, r, lane); continue; } r -= IT_F;
        if (r < IT_SQ) { tr_item(a.in[I_WO] + (size_t)l * D * D, D, (bf16_t*)(wl + WL_O), D, 0, a.in[I_GRPG] + l * 1024, 1.f, 0, 0, scr, r, lane); continue; } r -= IT_SQ;
        if (r < IT_SQ) { cp_item(a.in[I_WXQ] + (size_t)l * D * D, (bf16_t*)(wl + WL_XQ), QSCALE_X, r, lane); continue; } r -= IT_SQ;
        if (r < IT_SQ) { tr_item(a.in[I_WXK] + (size_t)l * D * D, D, (bf16_t*)(wl + WL_XK), D, 0, nullptr, 1.f, 0, 0, scr, r, lane); continue; } r -= IT_SQ;
        if (r < IT_SQ) { tr_item(a.in[I_WXV] + (size_t)l * D * D, D, (bf16_t*)(wl + WL_XV), D, 0, nullptr, 1.f, 0, 0, scr, r, lane); continue; } r -= IT_SQ;
        { tr_item(a.in[I_WXO] + (size_t)l * D * D, D, (bf16_t*)(wl + WL_XO), D, 0, nullptr, 1.f, 0, 0, scr, r, lane); }
    }
    for (long idx = gt; idx < (long)NLAYER * 256 * 1024; idx += NGT) {
        const int l = (int)(idx >> 18), k = (int)(idx >> 8) & 1023, n = (int)idx & 255, g = n >> 6, cc = n & 63, jp = cc >> 1, second = cc & 1;
        const int mult = (jp == 0 && second) ? 32 : jp; const bool use_cos = (second == 0) || (jp == 0);
        const float* w = a.in[I_WIN] + ((size_t)l * 1024 + k) * INC + g * 64; float acc = 0.f;
#pragma unroll 8
        for (int c = 0; c < 64; ++c) { const float fr = (float)((mult * c) & 63) * (1.f / 64.f); const float cv = __builtin_amdgcn_cosf(fr), sv = -__builtin_amdgcn_sinf(fr); acc += w[c] * (use_cos ? cv : sv); }
        ((bf16_t*)(ws + WS_W + (size_t)l * WL_SIZE + WL_IN))[(size_t)n * 1024 + k] = (bf16_t)f2bf(acc);
    }
    for (long idx = gt; idx < (long)NLAYER * 96 * 1024; idx += NGT) { const int l = (int)(idx / (96 * 1024)); const long r = idx % (96 * 1024);
        ((bf16_t*)(ws + WS_W + (size_t)l * WL_SIZE + WL_IN))[(size_t)INC * 1024 + r] = 0; }
    for (long idx = gt; idx < (long)NLAYER * 1024 * 384; idx += NGT) { const int l = (int)(idx / (1024 * 384)); const int r = (int)(idx % (1024 * 384)), row = r / 384, k = r % 384;
        const bool pad = (row < 512) ? (k >= 256 || (row & 127) >= 96) : (k < 256);
        if (pad) ((bf16_t*)(ws + WS_W + (size_t)l * WL_SIZE + WL_MLA))[r] = 0; }
    for (long idx = gt; idx < (long)NLAYER * 32 * 1024; idx += NGT) { const int l = (int)(idx >> 15), e = (int)(idx >> 10) & 31, k = (int)idx & 1023;
        const float w = a.in[I_WR][((size_t)l * 1024 + k) * 32 + e]; const unsigned hb = f2bf(w); const unsigned lb = f2bf(w - bf2f(hb));
        bf16_t* wr = (bf16_t*)(ws + WS_W + (size_t)l * WL_SIZE + WL_RT); wr[e * 1024 + k] = (bf16_t)hb; wr[32768 + e * 1024 + k] = (bf16_t)lb; }
    for (long idx = gt; idx < (long)NB * MEML * D / 4; idx += NGT) { const f32x4 v = *(const f32x4*)(a.in[I_MEM] + idx * 4); u32x2 w; w.x = pk2(v.x, v.y); w.y = pk2(v.z, v.w); *(u32x2*)((bf16_t*)(ws + WS_MEMB) + idx * 4) = w; }
    for (int m0 = gw; m0 < T; m0 += 4 * NGW) { R8 v[4][2];
#pragma unroll
        for (int q = 0; q < 4; ++q) { const float* xr = a.in[I_X] + (size_t)(m0 + q * NGW) * D;
#pragma unroll
            for (int j = 0; j < 2; ++j) { v[q][j].lo = *(const f32x4*)(xr + 512 * j + 8 * lane); v[q][j].hi = *(const f32x4*)(xr + 512 * j + 8 * lane + 4); } }
        ln_rows<4>(v, a.in[I_LNIN_G], a.in[I_LNIN_B], lane);
#pragma unroll
        for (int q = 0; q < 4; ++q) store_row_bf16((bf16_t*)(ws + WS_HB) + (size_t)(m0 + q * NGW) * D, v[q], lane); }
}

struct LayerCtx {
    int l; unsigned char* ws; unsigned char* wl;
    bf16_t *Z, *FC, *QG, *KG, *CQKV, *KR, *QKVM, *Y, *XQ, *PB, *XO, *XS, *ACT, *YS, *HB;
    float *YMIX, *RS; bf16_t* FB;
    int *RE, *RR, *DEST, *TOK; float* GATE; unsigned* cnt;
};
__device__ __forceinline__ LayerCtx make_ctx(const Args& a, int l) {
    LayerCtx c; c.l = l; c.ws = a.ws; c.wl = a.ws + WS_W + (size_t)l * WL_SIZE; unsigned char* r = a.ws + WS_R;
    c.Z = (bf16_t*)(r + R_Z); c.FC = (bf16_t*)(r + R_FC); c.QG = (bf16_t*)(r + R_QG); c.KG = (bf16_t*)(r + R_KG); c.CQKV = (bf16_t*)(r + R_CQKV); c.KR = (bf16_t*)(r + R_KR);
    c.QKVM = (bf16_t*)(r + R_QKVM); c.YMIX = (float*)(r + R_YMIX); c.Y = (bf16_t*)(r + R_Y);
    c.XQ = (bf16_t*)(r + R_XQ); c.RS = (float*)(a.ws + WS_F + 64 * MiB); c.PB = (bf16_t*)(r + R_PB); c.XO = (bf16_t*)(r + R_XO);
    c.XS = (bf16_t*)(r + R_XS); c.ACT = (bf16_t*)(r + R_ACT); c.YS = (bf16_t*)(r + R_XS);
    c.HB = (bf16_t*)(a.ws + WS_HB); c.FB = (bf16_t*)(a.ws + WS_F);
    c.RE = (int*)(a.ws + WS_ROUTE); c.RR = c.RE + T * 4; c.GATE = (float*)(c.RR + T * 4); c.DEST = (int*)(c.GATE + T * 4);
    c.cnt = (unsigned*)(a.ws + WS_CTL) + CW_CNT + MAXWG * 32 * l; c.TOK = (int*)(a.ws + WS_CTL) + CW_TOK;
    return c;
}
constexpr float L2_THETA = 13.287712379549449f;

__device__ __forceinline__ void conv_item(const int tid, const Args& a, const LayerCtx& c, int item, LAS unsigned char* lds) {
    const int lane = tid & 63, wave = tid >> 6;
    LAS float* U = (LAS float*)lds; LAS float* CO = (LAS float*)lds;
    const int t0 = item * 64, b = t0 >> 13, s0 = t0 & (SEQ - 1);
#pragma unroll
    for (int i = 0; i < 6; ++i) { const int idx = tid + NTHREADS * i, row = idx >> 5, c8 = (idx & 31) * 8, sq = s0 - 15 + row;
        if (row < 94) { f32x4 u0 = {0.f, 0.f, 0.f, 0.f}, u1 = {0.f, 0.f, 0.f, 0.f};
            if (sq >= 0 && sq < SEQ) { const bf16_t* z = c.Z + (size_t)(b * SEQ + sq) * ZC; const R8 av = unpack8(*(const u32x4*)(z + ZC_CA + c8)), gv = unpack8(*(const u32x4*)(z + ZC_CG + c8));
#pragma unroll
                for (int e = 0; e < 4; ++e) { u0[e] = av.lo[e] * sigmoidf_(gv.lo[e]); u1[e] = av.hi[e] * sigmoidf_(gv.hi[e]); } }
            *(LAS f32x4*)(U + row * 256 + c8) = u0; *(LAS f32x4*)(U + row * 256 + c8 + 4) = u1; } }
    __syncthreads();
    { const int ch = tid & 255, half = tid >> 8; const float* dw = a.in[I_DWW] + (size_t)c.l * 31 * 256 + ch; const float bias = a.in[I_DWB][c.l * 256 + ch];
      float wv[31], win[62];
#pragma unroll
      for (int w = 0; w < 31; ++w) wv[w] = dw[w * 256];
#pragma unroll
      for (int r = 0; r < 62; ++r) win[r] = U[(half * 32 + r) * 256 + ch];
      __syncthreads();
#pragma unroll
      for (int o = 0; o < 32; ++o) { float acc = bias;
#pragma unroll
          for (int w = 0; w < 31; ++w) acc += win[o + w] * wv[w];
          CO[(half * 32 + o) * 256 + ch] = acc; } }
    __syncthreads();
    { const float* cg = a.in[I_CLG] + c.l * 256; const float* cb = a.in[I_CLB] + c.l * 256;
      const f32x4 gg = *(const f32x4*)(cg + 4 * lane), bb = *(const f32x4*)(cb + 4 * lane);
#pragma unroll
      for (int q0 = 0; q0 < 8; q0 += 4) { f32x4 x[4]; float mean[4], var[4];
#pragma unroll
          for (int q = 0; q < 4; ++q) { x[q] = *(const LAS f32x4*)(CO + (wave * 8 + q0 + q) * 256 + 4 * lane); mean[q] = (x[q].x + x[q].y) + (x[q].z + x[q].w); }
#pragma unroll
          for (int q = 0; q < 4; ++q) mean[q] = wave_sum(mean[q]);
#pragma unroll
          for (int q = 0; q < 4; ++q) { x[q] = x[q] - mean[q] * (1.f / 256.f); var[q] = (x[q].x * x[q].x + x[q].y * x[q].y) + (x[q].z * x[q].z + x[q].w * x[q].w); }
#pragma unroll
          for (int q = 0; q < 4; ++q) var[q] = wave_sum(var[q]);
#pragma unroll
          for (int q = 0; q < 4; ++q) { const float rstd = __builtin_amdgcn_rsqf(var[q] * (1.f / 256.f) + LN_EPS); f32x4 y = x[q] * rstd * gg + bb;
#pragma unroll
              for (int e = 0; e < 4; ++e) y[e] = y[e] * sigmoidf_(y[e]);
              u32x2 w; w.x = pk2(y.x, y.y); w.y = pk2(y.z, y.w); *(u32x2*)(c.FC + (size_t)(t0 + wave * 8 + q0 + q) * 512 + 256 + 4 * lane) = w; } } }
    __syncthreads();
}

struct QkRaw { u32x2 q; unsigned k; u32x2 cq; unsigned ckv; unsigned kr; };
struct QkConst { float qg0, qg1, qg2, qg3, kg0, kg1, fq0, fq1, fk, fr; };
__device__ __forceinline__ QkConst qkprep_const(const Args& a, const LayerCtx& c, int lane) { QkConst k;
    { const int p = 4 * (lane & 15), half = p >> 5, i0 = (p & 31) >> 1; const float* qg = a.in[I_QG] + c.l * 64 + half * 32;
      k.qg0 = qg[i0]; k.qg1 = qg[16 + i0]; k.qg2 = qg[i0 + 1]; k.qg3 = qg[16 + i0 + 1];
      k.fq0 = __builtin_amdgcn_exp2f(-(float)i0 * (L2_THETA / 16.f)); k.fq1 = __builtin_amdgcn_exp2f(-(float)(i0 + 1) * (L2_THETA / 16.f)); }
    { const int p = (2 * lane) & 63, half = p >> 5, i0 = (p & 31) >> 1; const float* kg = a.in[I_KG] + c.l * 64 + half * 32;
      k.kg0 = kg[i0]; k.kg1 = kg[16 + i0]; k.fk = __builtin_amdgcn_exp2f(-(float)i0 * (L2_THETA / 16.f)); }
    k.fr = __builtin_amdgcn_exp2f(-(float)(lane & 7) * (L2_THETA / 8.f)); return k; }
__device__ __forceinline__ QkRaw qkprep_load(const LayerCtx& c, int t, int lane) { const bf16_t* z = c.Z + (size_t)t * ZC; QkRaw r;
    r.q = *(const u32x2*)(z + ZC_Q + 4 * lane); r.k = *(const unsigned*)(z + ZC_K + 2 * lane); r.cq = *(const u32x2*)(z + ZC_CQ + 4 * lane); r.ckv = *(const unsigned*)(z + ZC_CKV + 2 * lane);
    r.kr = (lane < 16) ? *(const unsigned*)(z + ZC_KR + 2 * lane) : 0u; return r; }
__device__ __forceinline__ void qkprep_row(const LayerCtx& c, int t, int lane, const QkRaw& raw, const QkConst& kc) {
    const int s = t & (SEQ - 1); const float prow = (float)(s >> 6), pcol = (float)(s & 63);
    {
        const u32x2 w = raw.q; float x0 = bflo(w.x), x1 = bfhi(w.x), x2 = bflo(w.y), x3 = bfhi(w.y);
        float ss = (x0 * x0 + x1 * x1) + (x2 * x2 + x3 * x3);
        ss = rsum<1>(ss); ss = rsum<2>(ss); ss = rsum<4>(ss); ss = rsum<8>(ss);
        const float rstd = __builtin_amdgcn_rsqf(ss * (1.f / 64.f) + RMS_EPS);
        const int half = (lane & 15) >> 3;
        x0 *= rstd * kc.qg0; x1 *= rstd * kc.qg1; x2 *= rstd * kc.qg2; x3 *= rstd * kc.qg3;
        const float pos = half ? pcol : prow;
        rope2(x0, x1, pos * kc.fq0); rope2(x2, x3, pos * kc.fq1);
        u32x2 o; o.x = pk2(x0 * QSCALE_G, x1 * QSCALE_G); o.y = pk2(x2 * QSCALE_G, x3 * QSCALE_G); *(u32x2*)(c.QG + (size_t)t * 256 + 4 * lane) = o;
    }
    {
        const unsigned w = raw.k; float x0 = bflo(w), x1 = bfhi(w);
        float ss = x0 * x0 + x1 * x1;
        ss = rsum<1>(ss); ss = rsum<2>(ss); ss = rsum<4>(ss); ss = rsum<8>(ss); ss = rsum<16>(ss);
        const float rstd = __builtin_amdgcn_rsqf(ss * (1.f / 64.f) + RMS_EPS);
        const int half = (lane >> 4) & 1;
        x0 *= rstd * kc.kg0; x1 *= rstd * kc.kg1;
        rope2(x0, x1, (half ? pcol : prow) * kc.fk);
        *(unsigned*)(c.KG + (size_t)t * 128 + 2 * lane) = pk2(x0, x1);
    }
    {
        const u32x2 w = raw.cq; const float x0 = bflo(w.x), x1 = bfhi(w.x), x2 = bflo(w.y), x3 = bfhi(w.y);
        const float rstd = __builtin_amdgcn_rsqf(wave_sum((x0 * x0 + x1 * x1) + (x2 * x2 + x3 * x3)) * (1.f / 256.f) + RMS_EPS);
        u32x2 o; o.x = pk2(x0 * rstd, x1 * rstd); o.y = pk2(x2 * rstd, x3 * rstd); *(u32x2*)(c.CQKV + (size_t)t * 384 + 4 * lane) = o;
    }
    {
        const unsigned w = raw.ckv; const float x0 = bflo(w), x1 = bfhi(w);
        const float rstd = __builtin_amdgcn_rsqf(wave_sum(x0 * x0 + x1 * x1) * (1.f / 128.f) + RMS_EPS);
        *(unsigned*)(c.CQKV + (size_t)t * 384 + 256 + 2 * lane) = pk2(x0 * rstd, x1 * rstd);
    }
    if (lane < 16) {
        const unsigned w = raw.kr; float x0 = bflo(w), x1 = bfhi(w);
        const int half = lane >> 3;
        rope2(x0, x1, (half ? pcol : prow) * kc.fr);
        *(unsigned*)(c.KR + (size_t)t * 32 + 2 * lane) = pk2(x0, x1);
    }
}

__device__ __forceinline__ void dft_table(const int tid, LAS unsigned char* lds) {
    LAS f32x2* tw = (LAS f32x2*)lds;
    for (int m = tid; m < SEQ; m += NTHREADS) { const float x = (float)m * (1.f / 4096.f); tw[m] = (f32x2){cospif(x), sinpif(x)}; }
    __syncthreads();
}
__device__ __forceinline__ void dft_naive_unit(const int tid, const LayerCtx& c, int unit, LAS unsigned char* lds) {
    const LAS f32x2* tw = (const LAS f32x2*)lds;
    const int kk = tid >> 7, pair = tid & 127, g = pair >> 5, jp = pair & 31;
    const int b = unit >> 11, k = ((unit & 2047) << 2) + kk;
    const bf16_t* zp = c.Z + (size_t)b * SEQ * ZC + g * 64 + 2 * jp;
    float acc0 = 0.f, acc1 = 0.f; int idx = 0;
    for (int s = 0; s < SEQ; ++s) { const unsigned w = *(const unsigned*)(zp + (size_t)s * ZC); const f32x2 cs = tw[idx]; idx = (idx + k) & (SEQ - 1);
        acc0 += bflo(w) * cs.x; acc1 += bfhi(w) * (jp == 0 ? cs.x : cs.y); }
    bf16_t* o = c.FC + (size_t)(b * SEQ + k) * 512 + g * 64;
    if (jp == 0) { o[0] = (bf16_t)f2bf(acc0); o[32] = (bf16_t)f2bf(acc1); }
    else { o[jp] = (bf16_t)f2bf(acc0 + acc1); o[64 - jp] = (bf16_t)f2bf(acc0 - acc1); }
}

namespace fft {
constexpr int L_XI = 16384, L_FI = 32768, L_CS = 65536;
__device__ __forceinline__ float cosrev(float x) { return __builtin_amdgcn_cosf(x); }
__device__ __forceinline__ float sinrev(float x) { return __builtin_amdgcn_sinf(x); }
__device__ __forceinline__ void build_table(const int tid, LAS unsigned char* lds) {
#pragma unroll 1
    for (int e = tid; e < 4096; e += NTHREADS) { const int lane = e & 63, cs = (e >> 6) & 1, ks = (e >> 7) & 7, nb = e >> 10; const int k1 = 32 * nb + (lane & 31), h = lane >> 5;
        unsigned w[4];
#pragma unroll
        for (int j = 0; j < 4; ++j) { const int m0 = ((16 * ks + 8 * h + 2 * j) * k1) & 127, m1 = ((16 * ks + 8 * h + 2 * j + 1) * k1) & 127; const float f0 = (float)m0 * (1.f / 128.f), f1 = (float)m1 * (1.f / 128.f);
            w[j] = cs ? pk2(sinrev(f0), sinrev(f1)) : pk2(cosrev(f0), cosrev(f1)); }
        *(LAS u32x4*)(lds + L_CS + e * 16) = (u32x4){w[0], w[1], w[2], w[3]}; }
}
struct F64Frags { bf16x8 c[2][2], s[2][2]; };
__device__ __forceinline__ void build_f64(const int tid, F64Frags& F) {
    const int wid = tid >> 6, lane = tid & 63, r32 = lane & 31, hi = lane >> 5, k2 = 32 * (wid >> 2) + r32;
#pragma unroll
    for (int mb = 0; mb < 2; ++mb)
#pragma unroll
        for (int st = 0; st < 2; ++st) { unsigned wc[4], wsn[4];
#pragma unroll
            for (int jj = 0; jj < 4; ++jj) { const int j0 = 2 * jj, j1 = 2 * jj + 1;
                const int sa = 32 * mb + 16 * st + 8 * (j0 >> 2) + 4 * hi + (j0 & 3), sb = 32 * mb + 16 * st + 8 * (j1 >> 2) + 4 * hi + (j1 & 3);
                const float fa = (float)((sa * k2) & 63) * (1.f / 64.f), fb = (float)((sb * k2) & 63) * (1.f / 64.f);
                wc[jj] = pk2(cosrev(fa), cosrev(fb)); wsn[jj] = pk2(sinrev(fa), sinrev(fb)); }
            F.c[mb][st] = __builtin_bit_cast(bf16x8, (u32x4){wc[0], wc[1], wc[2], wc[3]}); F.s[mb][st] = __builtin_bit_cast(bf16x8, (u32x4){wsn[0], wsn[1], wsn[2], wsn[3]}); }
}
__device__ __forceinline__ bf16x8 negbf(bf16x8 x) { u32x4 w = __builtin_bit_cast(u32x4, x); w ^= 0x80008000u; return __builtin_bit_cast(bf16x8, w); }
__device__ __forceinline__ void unit(const int tid, const LayerCtx& c, const int u, LAS unsigned char* lds, const F64Frags& F) {
    const int wid = tid >> 6, lane = tid & 63, r32 = lane & 31, hi = lane >> 5, nb = wid & 3, kb = wid >> 2;
    const int b = u >> 7, g = (u >> 5) & 3, jp = u & 31;
    const bf16_t* zp = c.Z + (size_t)b * SEQ * ZC + g * 64 + 2 * jp;
#pragma unroll 4
    for (int i = 0; i < 16; ++i) { const int sx = tid + NTHREADS * i, s2 = sx & 63, s1 = sx >> 6; const unsigned w = *(const unsigned*)(zp + (size_t)sx * ZC);
        const int off = s2 * 256 + ((((s1 >> 3) ^ (s2 & 15))) << 4) + (s1 & 7) * 2;
        *(LAS unsigned short*)(lds + off) = (unsigned short)(w & 0xffffu); *(LAS unsigned short*)(lds + L_XI + off) = (unsigned short)(w >> 16); }
    __syncthreads();
    f32x16 GR[2], GI[2];
#pragma unroll
    for (int mb = 0; mb < 2; ++mb) { GR[mb] = f32x16{}; GI[mb] = f32x16{}; }
#pragma unroll
    for (int ks = 0; ks < 8; ++ks) {
        const bf16x8 cf = *(const LAS bf16x8*)(lds + L_CS + ((nb * 8 + ks) * 2 + 0) * 1024 + lane * 16), sf = *(const LAS bf16x8*)(lds + L_CS + ((nb * 8 + ks) * 2 + 1) * 1024 + lane * 16);
#pragma unroll
        for (int mb = 0; mb < 2; ++mb) { const int row = 32 * mb + r32, off = row * 256 + (((2 * ks + hi) ^ (row & 15)) << 4);
            const bf16x8 xr = *(const LAS bf16x8*)(lds + off), xi = *(const LAS bf16x8*)(lds + L_XI + off); const bf16x8 nxr = negbf(xr);
            GR[mb] = __builtin_amdgcn_mfma_f32_32x32x16_bf16(xr, cf, GR[mb], 0, 0, 0); GR[mb] = __builtin_amdgcn_mfma_f32_32x32x16_bf16(xi, sf, GR[mb], 0, 0, 0);
            GI[mb] = __builtin_amdgcn_mfma_f32_32x32x16_bf16(xi, cf, GI[mb], 0, 0, 0); GI[mb] = __builtin_amdgcn_mfma_f32_32x32x16_bf16(nxr, sf, GI[mb], 0, 0, 0); }
    }
    const int k1 = 32 * nb + r32;
    bf16x8 ar[2][2], ai[2][2];
#pragma unroll
    for (int mb = 0; mb < 2; ++mb) {
#pragma unroll
        for (int r = 0; r < 16; ++r) { const int s2v = 32 * mb + (r & 3) + 8 * (r >> 2) + 4 * hi; const float fr = (float)((s2v * k1) & (SEQ - 1)) * (1.f / 8192.f);
            const float tc = cosrev(fr), ts = sinrev(fr), gr = GR[mb][r], gi = GI[mb][r]; GR[mb][r] = gr * tc + gi * ts; GI[mb][r] = gi * tc - gr * ts; }
#pragma unroll
        for (int st = 0; st < 2; ++st) {
            const u32x4 wr = {pk2(GR[mb][8 * st], GR[mb][8 * st + 1]), pk2(GR[mb][8 * st + 2], GR[mb][8 * st + 3]), pk2(GR[mb][8 * st + 4], GR[mb][8 * st + 5]), pk2(GR[mb][8 * st + 6], GR[mb][8 * st + 7])};
            const u32x4 wi = {pk2(GI[mb][8 * st], GI[mb][8 * st + 1]), pk2(GI[mb][8 * st + 2], GI[mb][8 * st + 3]), pk2(GI[mb][8 * st + 4], GI[mb][8 * st + 5]), pk2(GI[mb][8 * st + 6], GI[mb][8 * st + 7])};
            ar[mb][st] = __builtin_bit_cast(bf16x8, wr); ai[mb][st] = __builtin_bit_cast(bf16x8, wi); }
    }
    __syncthreads();
    f32x16 ZR = f32x16{}, ZI = f32x16{};
#pragma unroll
    for (int mb = 0; mb < 2; ++mb)
#pragma unroll
        for (int st = 0; st < 2; ++st) { const bf16x8 nar = negbf(ar[mb][st]);
            ZR = __builtin_amdgcn_mfma_f32_32x32x16_bf16(ar[mb][st], F.c[mb][st], ZR, 0, 0, 0); ZR = __builtin_amdgcn_mfma_f32_32x32x16_bf16(ai[mb][st], F.s[mb][st], ZR, 0, 0, 0);
            ZI = __builtin_amdgcn_mfma_f32_32x32x16_bf16(ai[mb][st], F.c[mb][st], ZI, 0, 0, 0); ZI = __builtin_amdgcn_mfma_f32_32x32x16_bf16(nar, F.s[mb][st], ZI, 0, 0, 0); }
    { const int k2 = 32 * kb + r32;
#pragma unroll
      for (int q = 0; q < 4; ++q) { const int kk = k2 * 128 + 32 * nb + 8 * q + 4 * hi;
          *(LAS f32x4*)(lds + kk * 4) = (f32x4){ZR[4 * q], ZR[4 * q + 1], ZR[4 * q + 2], ZR[4 * q + 3]}; *(LAS f32x4*)(lds + L_FI + kk * 4) = (f32x4){ZI[4 * q], ZI[4 * q + 1], ZI[4 * q + 2], ZI[4 * q + 3]}; } }
    __syncthreads();
    bf16_t* op = c.FC + (size_t)b * SEQ * 512 + g * 64 + 2 * jp;
#pragma unroll 4
    for (int i = 0; i < 16; ++i) { const int k = tid + NTHREADS * i, kr = (SEQ - k) & (SEQ - 1);
        const float a0 = *(const LAS float*)(lds + k * 4), a1 = *(const LAS float*)(lds + kr * 4); float y0 = a0, y1 = a1;
        if (jp == 0) { const float b0 = *(const LAS float*)(lds + L_FI + k * 4), b1 = *(const LAS float*)(lds + L_FI + kr * 4); y0 = 0.5f * (a0 + a1); y1 = 0.5f * (b0 + b1); }
        *(unsigned*)(op + (size_t)k * 512) = pk2(y0, y1); }
    __syncthreads();
}
}

struct AttnSrc { const bf16_t* Q; int qp; const bf16_t* K; int kp; const bf16_t* K2; int k2p; const bf16_t* V; int vp; bf16_t* O; int op; };
__device__ __forceinline__ AttnSrc gqa_src(unsigned char* ws, int b, int h) {
    AttnSrc A; const size_t r0 = (size_t)b * SEQ; unsigned char* r = ws + WS_R;
    A.Q = (const bf16_t*)(r + R_QG) + r0 * 256 + h * 64; A.qp = 256; A.K = (const bf16_t*)(r + R_KG) + r0 * 128 + (h >> 1) * 64; A.kp = 128; A.K2 = nullptr; A.k2p = 0;
    A.V = (const bf16_t*)(r + R_Z) + r0 * ZC + ZC_V + (h >> 1) * 64; A.vp = ZC; A.O = (bf16_t*)(r + R_YMIX) + r0 * 512 + h * 64; A.op = 512; return A;
}
__device__ __forceinline__ AttnSrc mla_src(unsigned char* ws, int b, int h) {
    AttnSrc A; const size_t r0 = (size_t)b * SEQ; unsigned char* r = ws + WS_R; const bf16_t* qkvm = (const bf16_t*)(r + R_QKVM);
    A.Q = qkvm + r0 * 1024 + h * 128; A.qp = 1024; A.K = qkvm + r0 * 1024 + 512 + h * 128; A.kp = 1024; A.K2 = (const bf16_t*)(r + R_KR) + r0 * 32; A.k2p = 32;
    A.V = qkvm + r0 * 1024 + 512 + h * 128 + 64; A.vp = 1024; A.O = (bf16_t*)(r + R_YMIX) + r0 * 512 + 256 + h * 64; A.op = 512; return A;
}

namespace att {
using s16x4 = __attribute__((ext_vector_type(4))) short;
constexpr float ATT_THR = 8.f;
#define ATT_SBAR() __builtin_amdgcn_sched_barrier(0)
__device__ __forceinline__ int crow(int r, int hi) { return (r & 3) + 8 * (r >> 2) + 4 * hi; }
__device__ __forceinline__ unsigned cvtpk(float lo, float hi) { unsigned r; asm volatile("v_cvt_pk_bf16_f32 %0, %1, %2" : "=v"(r) : "v"(lo), "v"(hi)); return r; }
template <int KROW> __device__ __forceinline__ int kswz(int row, int colB) { return (KROW == 128) ? row * 128 + (colB ^ (((row >> 1) & 7) << 4)) : row * 256 + (colB ^ ((row & 15) << 4)); }
__device__ __forceinline__ void partialSM(f32x16& p0, f32x16& p1, float& m_reg, f32x16& negm, float& alpha, const bool first) {
    float pa = fmaxf(fmaxf(p0[0], p0[1]), p0[2]), pb = fmaxf(fmaxf(p1[0], p1[1]), p1[2]);
#pragma unroll
    for (int r = 3; r < 15; r += 2) { pa = fmaxf(fmaxf(pa, p0[r]), p0[r + 1]); pb = fmaxf(fmaxf(pb, p1[r]), p1[r + 1]); }
    float pmax = fmaxf(fmaxf(pa, pb), fmaxf(p0[15], p1[15]));
    { auto rr = __builtin_amdgcn_permlane32_swap(__float_as_uint(pmax), __float_as_uint(pmax), false, false); pmax = fmaxf(__uint_as_float(rr[0]), __uint_as_float(rr[1])); }
    alpha = 1.f;
    if (first || !__all(pmax <= ATT_THR)) {
        const float delta = first ? pmax : fmaxf(pmax, 0.f);
        m_reg += delta; alpha = first ? 1.f : __builtin_amdgcn_exp2f(-delta);
#pragma unroll
        for (int r = 0; r < 16; ++r) { p0[r] -= delta; p1[r] -= delta; negm[r] = -m_reg; }
    }
#pragma unroll
    for (int r = 0; r < 16; ++r) p0[r] = __builtin_amdgcn_exp2f(p0[r]);
}
__device__ __forceinline__ void finishSM(f32x16& p0, f32x16& p1, bf16x8& pa0, bf16x8& pa1, bf16x8& pa2, bf16x8& pa3) {
#pragma unroll
    for (int r = 0; r < 16; ++r) p1[r] = __builtin_amdgcn_exp2f(p1[r]);
#define ATT_PK4(P, BASE, OUT) do { unsigned a0 = cvtpk(P[BASE + 0], P[BASE + 1]), a1 = cvtpk(P[BASE + 2], P[BASE + 3]);   \
    unsigned b0 = cvtpk(P[BASE + 4], P[BASE + 5]), b1 = cvtpk(P[BASE + 6], P[BASE + 7]);                              \
    auto r0 = __builtin_amdgcn_permlane32_swap(a0, b0, false, false); auto r1 = __builtin_amdgcn_permlane32_swap(a1, b1, false, false); \
    u32x4 w = {r0[0], r1[0], r0[1], r1[1]}; OUT = __builtin_bit_cast(bf16x8, w); } while (0)
    ATT_PK4(p0, 0, pa0); ATT_PK4(p0, 8, pa1); ATT_PK4(p1, 0, pa2); ATT_PK4(p1, 8, pa3);
#undef ATT_PK4
}
template <int DK, int KROW>
__device__ __forceinline__ void qkt(f32x16& p0, f32x16& p1, const LAS unsigned char* Ks, const bf16x8* qr, const f32x16& negm, int r32, int hi) {
#pragma unroll
    for (int d0 = 0; d0 < DK / 16; ++d0) { const int cb = (d0 * 16 + hi * 8) * 2;
        const bf16x8 b0 = *(const LAS bf16x8*)(Ks + kswz<KROW>(r32, cb));
        const bf16x8 b1 = *(const LAS bf16x8*)(Ks + kswz<KROW>(32 + r32, cb));
        if (d0 == 0) { p0 = __builtin_amdgcn_mfma_f32_32x32x16_bf16(b0, qr[0], negm, 0, 0, 0); p1 = __builtin_amdgcn_mfma_f32_32x32x16_bf16(b1, qr[0], negm, 0, 0, 0); }
        else { p0 = __builtin_amdgcn_mfma_f32_32x32x16_bf16(b0, qr[d0], p0, 0, 0, 0); p1 = __builtin_amdgcn_mfma_f32_32x32x16_bf16(b1, qr[d0], p1, 0, 0, 0); } }
}
__device__ __forceinline__ int v_st(int k, int c) { const int kk = (k & ~0xC) | ((k & 4) << 1) | ((k & 8) >> 1); return ((kk >> 3) * 2 + (c >> 5)) * 512 + ((kk & 7) * 32 + (c & 31)) * 2; }
__device__ __forceinline__ int v_rd_base(int lane) { return ((lane & 3) << 3) | (((lane >> 2) & 3) << 6) | (((lane >> 4) & 1) << 5) | (((lane >> 5) & 1) << 8); }
constexpr int v_rd_off(int d0, int ks, int half) { return d0 * 512 + ks * 2048 + half * 1024; }
template <int OFF> __device__ __forceinline__ s16x4 tr_read(int vb) { s16x4 r; asm volatile("ds_read_b64_tr_b16 %0, %1 offset:%2" : "=&v"(r) : "v"(vb), "i"(OFF) : "memory"); return r; }
template <int KS> __device__ __forceinline__ void pv_half(f32x16* o, int vb, bf16x8 paA, bf16x8 paB) {
    const s16x4 a0 = tr_read<v_rd_off(0, KS, 0)>(vb), b0 = tr_read<v_rd_off(0, KS, 1)>(vb), c0 = tr_read<v_rd_off(1, KS, 0)>(vb), d0 = tr_read<v_rd_off(1, KS, 1)>(vb);
    const s16x4 a1 = tr_read<v_rd_off(0, KS + 1, 0)>(vb), b1 = tr_read<v_rd_off(0, KS + 1, 1)>(vb), c1 = tr_read<v_rd_off(1, KS + 1, 0)>(vb), d1 = tr_read<v_rd_off(1, KS + 1, 1)>(vb);
    const bf16x8 ones = {0x3F80, 0x3F80, 0x3F80, 0x3F80, 0x3F80, 0x3F80, 0x3F80, 0x3F80};
    asm volatile("s_waitcnt lgkmcnt(0)" ::: "memory"); ATT_SBAR();
#define ATT_PK(L, H) (bf16x8){L[0], L[1], L[2], L[3], H[0], H[1], H[2], H[3]}
    o[0] = __builtin_amdgcn_mfma_f32_32x32x16_bf16(paA, ATT_PK(a0, b0), o[0], 0, 0, 0); o[1] = __builtin_amdgcn_mfma_f32_32x32x16_bf16(paA, ATT_PK(c0, d0), o[1], 0, 0, 0); o[2] = __builtin_amdgcn_mfma_f32_32x32x16_bf16(paA, ones, o[2], 0, 0, 0);
    o[0] = __builtin_amdgcn_mfma_f32_32x32x16_bf16(paB, ATT_PK(a1, b1), o[0], 0, 0, 0); o[1] = __builtin_amdgcn_mfma_f32_32x32x16_bf16(paB, ATT_PK(c1, d1), o[1], 0, 0, 0); o[2] = __builtin_amdgcn_mfma_f32_32x32x16_bf16(paB, ones, o[2], 0, 0, 0);
#undef ATT_PK
}
__device__ __forceinline__ void pv_d0(f32x16* o, int vb, bf16x8 pa0, bf16x8 pa1, bf16x8 pa2, bf16x8 pa3) { pv_half<0>(o, vb, pa0, pa1); pv_half<2>(o, vb, pa2, pa3); }

#define ATT_WAITBAR(N) asm volatile("s_waitcnt vmcnt(" #N ") lgkmcnt(0)\n\ts_barrier" ::: "memory")
template <int DK>
__device__ __forceinline__ void unit(const int tid, const AttnSrc& A, const int q0, LAS unsigned char* lds) {
    constexpr int QP = (DK == 64) ? 256 : 1024, KP = (DK == 64) ? 128 : 1024, K2P = 32, VP = (DK == 64) ? ZC : 1024, OP = 512;
    constexpr int KROW = (DK == 64) ? 128 : 256, SHM_K = 64 * KROW, SHM_V = 64 * 64 * 2, ND = DK / 16, NT = SEQ / 64, NKI = SHM_K / 8192;
    const int wid = __builtin_amdgcn_readfirstlane(tid >> 6), lane = tid & 63, r32 = lane & 31, hi = lane >> 5;
    LAS unsigned char* V_lds = lds; LAS unsigned char* K_lds = lds + 3 * SHM_V;
    LAS float* al_l = (LAS float*)(lds + 3 * SHM_V + 3 * SHM_K) + wid * 32;
    float m_reg = 0.f; f32x16 o[3] = {}; f32x16 negm = f32x16{}; bf16x8 qr[ND];
    const int qrow = q0 + wid * 32 + r32;
    const bf16_t* Qw = A.Q + (size_t)qrow * QP + hi * 8;
#pragma unroll
    for (int d0 = 0; d0 < ND; ++d0) qr[d0] = *(const bf16x8*)(Qw + d0 * 16);
    if constexpr (DK > 64) {
        const int sq = qrow & (SEQ - 1); const float prow = (float)(sq >> 6), pcol = (float)(sq & 63);
#pragma unroll
        for (int d0 = 4; d0 < 6; ++d0) { u32x4 w = __builtin_bit_cast(u32x4, qr[d0]); const float pos = (d0 == 4) ? prow : pcol;
#pragma unroll
            for (int j = 0; j < 4; ++j) { float x0 = bflo(w[j]), x1 = bfhi(w[j]); rope2(x0, x1, pos * __builtin_amdgcn_exp2f(-(float)(4 * hi + j) * (13.287712379549449f / 8.f))); w[j] = pk2i(x0, x1); }
            qr[d0] = __builtin_bit_cast(bf16x8, w); }
    }
    const bf16_t* Vsrc; const bf16_t* Ksrc[NKI]; int kstepE[NKI];
    { const int kk = 8 * wid + ((lane & 31) >> 2), kv = (kk & ~0xC) | ((kk & 4) << 1) | ((kk & 8) >> 1); Vsrc = A.V + (size_t)kv * VP + 32 * (lane >> 5) + 8 * (lane & 3); }
#pragma unroll
    for (int i = 0; i < NKI; ++i) {
        if constexpr (DK == 64) { const int row = 8 * wid + (lane >> 3), chunk = (lane & 7) ^ ((row >> 1) & 7); Ksrc[i] = A.K + (size_t)row * KP + chunk * 8; kstepE[i] = KP; }
        else { const int row = 4 * (i * 8 + wid) + (lane >> 4), chunk = (lane & 15) ^ (row & 15);
            if (chunk >= 8 && chunk < 12) { Ksrc[i] = A.K2 + (size_t)row * K2P + (chunk - 8) * 8; kstepE[i] = K2P; }
            else { Ksrc[i] = A.K + (size_t)row * KP + (chunk < 8 ? chunk : 0) * 8; kstepE[i] = KP; } }
    }
    const unsigned ldsw = (unsigned)wid * 1024u;
#define ATT_DMA_V(t, slot) __builtin_amdgcn_global_load_lds((const unsigned*)(Vsrc + (size_t)(t) * 64 * VP), (LAS unsigned*)(V_lds + (slot) * SHM_V + ldsw), 16, 0, 0)
#define ATT_DMA_K(t, slot) do { _Pragma("unroll") for (int i_ = 0; i_ < NKI; ++i_) \
        __builtin_amdgcn_global_load_lds((const unsigned*)(Ksrc[i_] + (size_t)(t) * 64 * kstepE[i_]), (LAS unsigned*)(K_lds + (slot) * SHM_K + i_ * 8192 + ldsw), 16, 0, 0); } while (0)
    const int vb0 = (int)(uintptr_t)V_lds + v_rd_base(lane);
#define ATT_RESC(a) do { if (__any((a) < 1.f)) { if (hi == 0) al_l[r32] = (a); asm volatile("s_waitcnt lgkmcnt(0)" ::: "memory"); \
    _Pragma("unroll") for (int d = 0; d < 3; ++d) _Pragma("unroll") for (int r = 0; r < 16; ++r) o[d][r] *= al_l[crow(r, hi)]; } } while (0)
    f32x16 pA0, pA1, pB0, pB1; float alA, alB; bf16x8 pa0, pa1, pa2, pa3;
    ATT_DMA_K(0, 0); ATT_DMA_V(0, 0); ATT_DMA_K(1, 1);
    ATT_WAITBAR(0);
    ATT_DMA_K(2, 2); ATT_DMA_V(1, 1);
    qkt<DK, KROW>(pA0, pA1, K_lds, qr, negm, r32, hi); partialSM(pA0, pA1, m_reg, negm, alA, true);
    if constexpr (NKI == 1) ATT_WAITBAR(2); else ATT_WAITBAR(3);
#define ATT_STEP(PC0, PC1, PP0, PP1, ALC, j, SK, SV) do { \
        const bool hk_ = (j) + 2 < NT, hv_ = (j) + 1 < NT; \
        if (hk_) ATT_DMA_K((j) + 2, ((SK) + 2) % 3); if (hv_) ATT_DMA_V((j) + 1, ((SV) + 2) % 3); \
        ATT_SBAR(); qkt<DK, KROW>(PC0, PC1, K_lds + (SK) * SHM_K, qr, negm, r32, hi); \
        finishSM(PP0, PP1, pa0, pa1, pa2, pa3); ATT_SBAR(); \
        pv_d0(o, vb0 + (SV) * SHM_V, pa0, pa1, pa2, pa3); partialSM(PC0, PC1, m_reg, negm, ALC, false); \
        if (hk_) { if constexpr (NKI == 1) ATT_WAITBAR(2); else ATT_WAITBAR(3); } else if (hv_) ATT_WAITBAR(1); else ATT_WAITBAR(0); \
        ATT_RESC(ALC); } while (0)
    static_assert((NT - 2) % 6 == 0, "steps 1 .. NT-2 are a whole number of 6-step periods");
#pragma unroll 1
    for (int j = 1; j + 1 < NT; j += 6) {
        ATT_STEP(pB0, pB1, pA0, pA1, alB, j,     1, 0);
        ATT_STEP(pA0, pA1, pB0, pB1, alA, j + 1, 2, 1);
        ATT_STEP(pB0, pB1, pA0, pA1, alB, j + 2, 0, 2);
        ATT_STEP(pA0, pA1, pB0, pB1, alA, j + 3, 1, 0);
        ATT_STEP(pB0, pB1, pA0, pA1, alB, j + 4, 2, 1);
        ATT_STEP(pA0, pA1, pB0, pB1, alA, j + 5, 0, 2);
    }
    ATT_STEP(pB0, pB1, pA0, pA1, alB, NT - 1, (NT - 1) % 3, (NT - 2) % 3);
    finishSM(pB0, pB1, pa0, pa1, pa2, pa3); ATT_SBAR();
    pv_d0(o, vb0 + ((NT - 1) % 3) * SHM_V, pa0, pa1, pa2, pa3);
    float rli[16];
#pragma unroll
    for (int r = 0; r < 16; ++r) rli[r] = __builtin_amdgcn_rcpf(o[2][r]);
    bf16_t* Ow = A.O + (size_t)(q0 + wid * 32) * OP + ((lane & 1) ? 32 + r32 - 1 : r32);
#pragma unroll
    for (int r = 0; r < 16; ++r) { const float a0 = o[0][r] * rli[r], a1 = o[1][r] * rli[r];
        const float got = dppf<0xB1>((lane & 1) ? a0 : a1);
        *(unsigned*)(Ow + (size_t)crow(r, hi) * OP) = (lane & 1) ? pk2(got, a1) : pk2(a0, got); }
    ATT_WAITBAR(0);
#undef ATT_DMA_V
#undef ATT_DMA_K
#undef ATT_RESC
#undef ATT_STEP
}
#undef ATT_WAITBAR
#undef ATT_SBAR
}

__device__ __forceinline__ void grpnorm_hi_rows8(const LayerCtx& c, int t0, int tstride, int lane) {
    R8 v[8]; float ss[8];
#pragma unroll
    for (int q = 0; q < 8; ++q) { v[q] = unpack8(*(const u32x4*)((const bf16_t*)c.YMIX + (size_t)(t0 + q * tstride) * 512 + 8 * lane)); ss[q] = hsq8(v[q]); }
#pragma unroll
    for (int q = 0; q < 8; ++q) { float x = ss[q]; x = rsum<1>(x); x = rsum<2>(x); x = rsum<4>(x); x = rsum<8>(x); ss[q] = rsum<16>(x); }
#pragma unroll
    for (int q = 0; q < 8; ++q) { const float r = __builtin_amdgcn_rsqf(ss[q] * (1.f / 256.f) + RMS_EPS);
        *(u32x4*)(c.Y + (size_t)(t0 + q * tstride) * 1024 + 512 + 8 * lane) = pk8(v[q].lo * r, v[q].hi * r); }
}
template <int NR>
__device__ __forceinline__ void resln_load(const LayerCtx& c, int t0, int tstride, int lane, u32x4 (&hw)[NR][2], u32x4 (&fw)[NR][2]) {
#pragma unroll
    for (int q = 0; q < NR; ++q) { const bf16_t* hr = c.HB + (size_t)(t0 + q * tstride) * D; const bf16_t* fr = c.FB + (size_t)(t0 + q * tstride) * D;
#pragma unroll
        for (int j = 0; j < 2; ++j) { hw[q][j] = *(const u32x4*)(hr + 512 * j + 8 * lane); fw[q][j] = *(const u32x4*)(fr + 512 * j + 8 * lane); } }
}
template <int NR>
__device__ __forceinline__ void resln_finish(const LayerCtx& c, int t0, int tstride, const float* g, const float* b, int lane, const u32x4 (&hw)[NR][2], const u32x4 (&fw)[NR][2], R8 (&v)[NR][2]) {
#pragma unroll
    for (int q = 0; q < NR; ++q)
#pragma unroll
        for (int j = 0; j < 2; ++j) { const R8 h = unpack8(hw[q][j]), f = unpack8(fw[q][j]); v[q][j].lo = h.lo * DN_ALPHA + f.lo; v[q][j].hi = h.hi * DN_ALPHA + f.hi; }
    ln_rows<NR>(v, g, b, lane);
#pragma unroll
    for (int q = 0; q < NR; ++q) store_row_bf16(c.HB + (size_t)(t0 + q * tstride) * D, v[q], lane);
}
template <int NR>
__device__ __forceinline__ void resln_rows(const LayerCtx& c, int t0, int tstride, const float* g, const float* b, int lane, R8 (&v)[NR][2]) {
    u32x4 hw[NR][2], fw[NR][2];
    resln_load<NR>(c, t0, tstride, lane, hw, fw);
    resln_finish<NR>(c, t0, tstride, g, b, lane, hw, fw, v);
}
constexpr int RT_LO = 65536, RT_LOGT = 40960;
__device__ __forceinline__ void ln2_router_group(const int tid, const Args& a, const LayerCtx& c, const int grp, const int grp_next, LAS unsigned char* lds, const bf16x8 (&bh)[8], const bf16x8 (&bl)[8], LAS unsigned* lcnt, u32x4 (&hw)[4][2], u32x4 (&fw)[4][2]) {
    const int wid = tid >> 6, lane = tid & 63, r32 = lane & 31, hi = lane >> 5;
    { R8 v[4][2];
      resln_finish<4>(c, grp * 32 + wid * 4, 1, a.in[I_LN2G] + c.l * D, a.in[I_LN2B] + c.l * D, lane, hw, fw, v);
#pragma unroll
      for (int q = 0; q < 4; ++q) { const int row = wid * 4 + q;
#pragma unroll
          for (int j = 0; j < 2; ++j) { const int chunk = 64 * j + lane; const int off = row * 2048 + ((chunk ^ (row & 15)) << 4);
              const R8 x = v[q][j]; const unsigned h0 = f2bf(x.lo.x), h1 = f2bf(x.lo.y), h2 = f2bf(x.lo.z), h3 = f2bf(x.lo.w), h4 = f2bf(x.hi.x), h5 = f2bf(x.hi.y), h6 = f2bf(x.hi.z), h7 = f2bf(x.hi.w);
              const u32x4 wh = {h0 | (h1 << 16), h2 | (h3 << 16), h4 | (h5 << 16), h6 | (h7 << 16)};
              const u32x4 wl = {pk2(x.lo.x - bf2f(h0), x.lo.y - bf2f(h1)), pk2(x.lo.z - bf2f(h2), x.lo.w - bf2f(h3)), pk2(x.hi.x - bf2f(h4), x.hi.y - bf2f(h5)), pk2(x.hi.z - bf2f(h6), x.hi.w - bf2f(h7))};
              *(LAS u32x4*)(lds + off) = wh; *(LAS u32x4*)(lds + RT_LO + off) = wl; } } }
    resln_load<4>(c, (grp_next < T / 32 ? grp_next : grp) * 32 + wid * 4, 1, lane, hw, fw);
    __syncthreads();
    f32x16 acc = f32x16{};
#pragma unroll
    for (int ks = 0; ks < 8; ++ks) { const int chunk = 16 * wid + 2 * ks + hi; const int off = r32 * 2048 + ((chunk ^ (r32 & 15)) << 4);
        const bf16x8 ah = *(const LAS bf16x8*)(lds + off), al = *(const LAS bf16x8*)(lds + RT_LO + off);
        acc = __builtin_amdgcn_mfma_f32_32x32x16_bf16(ah, bh[ks], acc, 0, 0, 0); acc = __builtin_amdgcn_mfma_f32_32x32x16_bf16(ah, bl[ks], acc, 0, 0, 0); acc = __builtin_amdgcn_mfma_f32_32x32x16_bf16(al, bh[ks], acc, 0, 0, 0); }
    __syncthreads();
    { LAS float* red = (LAS float*)lds;
#pragma unroll
      for (int r = 0; r < 16; ++r) { const int tok = (r & 3) + 8 * (r >> 2) + 4 * hi; red[(wid * 32 + tok) * 33 + r32] = acc[r]; } }
    __syncthreads();
    { const LAS float* red = (const LAS float*)lds; LAS float* logt = (LAS float*)(lds + RT_LOGT); const float* br = a.in[I_BR] + c.l * 32;
#pragma unroll
      for (int i = 0; i < 2; ++i) { const int idx = tid + NTHREADS * i, tok = idx >> 5, e = idx & 31; float sres = br[e];
#pragma unroll
          for (int w = 0; w < 8; ++w) sres += red[(w * 32 + tok) * 33 + e];
          logt[tok * 33 + e] = sres; } }
    __syncthreads();
    { const LAS float* logt = (const LAS float*)(lds + RT_LOGT);
#pragma unroll 1
      for (int q = 0; q < 4; ++q) { const int tok = wid * 4 + q, t = grp * 32 + tok;
          float mine = (lane < 32) ? logt[tok * 33 + lane] : -3.0e38f;
          float tv[4]; int ti[4];
#pragma unroll
          for (int k = 0; k < 4; ++k) { const float best = wave_max(mine); const unsigned long long mk = __ballot(mine == best); const int bi = __ffsll((long long)mk) - 1;
              tv[k] = best; ti[k] = bi; if (lane == bi) mine = -3.0e38f; }
          const float e1 = __expf(tv[1] - tv[0]), e2 = __expf(tv[2] - tv[0]), e3 = __expf(tv[3] - tv[0]); const float rs = 1.f / (1.f + e1 + e2 + e3);
          if (lane < 4) { const int e = lane == 0 ? ti[0] : lane == 1 ? ti[1] : lane == 2 ? ti[2] : ti[3]; const float gt = (lane == 0 ? 1.f : lane == 1 ? e1 : lane == 2 ? e2 : e3) * rs;
              const unsigned rank = __hip_atomic_fetch_add(lcnt + e, 1u, __ATOMIC_RELAXED, __HIP_MEMORY_SCOPE_WORKGROUP);
              c.RE[t * 4 + lane] = e; c.RR[t * 4 + lane] = (int)rank; c.GATE[t * 4 + lane] = gt; } } }
    __syncthreads();
}
constexpr int TBL_OFF = 131072, TBL_PSTART = TBL_OFF + 2304, TBL_NBLK = TBL_PSTART + 256, TBL_WBASE = TBL_NBLK + 64, TBL_CNT = TBL_WBASE + 128, TBL_PART = TBL_OFF + 4096, TBL_LCNT = TBL_OFF + 8192;
__device__ __forceinline__ void moe_tables(const int tid, const int bid, const LayerCtx& c, LAS unsigned char* lds) {
    LAS int* blk_e = (LAS int*)(lds + TBL_OFF); LAS int* pstart = (LAS int*)(lds + TBL_PSTART); LAS int* nblk = (LAS int*)(lds + TBL_NBLK); LAS int* wbase = (LAS int*)(lds + TBL_WBASE);
    LAS int* cntL = (LAS int*)(lds + TBL_CNT); LAS int* part = (LAS int*)(lds + TBL_PART);
    { const int e = tid & 31, pr = tid >> 5; int tot = 0, pf = 0;
#pragma unroll 4
      for (int w = pr * 16; w < pr * 16 + 16; ++w) { const int v = (int)__hip_atomic_load(c.cnt + w * 32 + e, RLX_AGENT); tot += v; pf += (w < bid) ? v : 0; }
      part[pr * 32 + e] = tot; part[512 + pr * 32 + e] = pf; }
    __syncthreads();
    if (tid < 32) { int tot = 0, pf = 0;
#pragma unroll 4
        for (int pr = 0; pr < 16; ++pr) { tot += part[pr * 32 + tid]; pf += part[512 + pr * 32 + tid]; }
        cntL[tid] = tot; wbase[tid] = pf; }
    __syncthreads();
    if (tid < 32) { int pos = 0;
#pragma unroll 1
        for (int e = 0; e < tid; ++e) pos += (cntL[e] + 255) >> 8;
        pstart[tid] = pos * 256; wbase[tid] += pos * 256;
        if (tid == 31) nblk[0] = pos + ((cntL[31] + 255) >> 8); }
    __syncthreads();
#pragma unroll 1
    for (int rb = tid; rb < MOE_MAXBLK; rb += NTHREADS) { int e = 0;
#pragma unroll 1
        for (int q = 1; q < NE; ++q) e += (pstart[q] <= rb * 256) ? 1 : 0;
        blk_e[rb] = e; }
    __syncthreads();
}
__device__ __forceinline__ void gather_rows2(const LayerCtx& c, int t0, int lane, const LAS int* wbase) {
    u32x4 hv[2][2]; int dest[2][4];
#pragma unroll
    for (int q = 0; q < 2; ++q) { const int t = t0 + q;
        hv[q][0] = *(const u32x4*)(c.HB + (size_t)t * D + 8 * lane); hv[q][1] = *(const u32x4*)(c.HB + (size_t)t * D + 512 + 8 * lane);
        const u32x4 e4 = *(const u32x4*)(c.RE + t * 4), r4 = *(const u32x4*)(c.RR + t * 4);
#pragma unroll
        for (int k = 0; k < 4; ++k) dest[q][k] = wbase[e4[k]] + (int)r4[k]; }
#pragma unroll
    for (int q = 0; q < 2; ++q) { const int t = t0 + q;
#pragma unroll
        for (int k = 0; k < 4; ++k) { *(u32x4*)(c.XS + (size_t)dest[q][k] * D + 8 * lane) = hv[q][0]; *(u32x4*)(c.XS + (size_t)dest[q][k] * D + 512 + 8 * lane) = hv[q][1]; }
        if (lane == 0) *(u32x4*)(c.DEST + t * 4) = (u32x4){(unsigned)dest[q][0], (unsigned)dest[q][1], (unsigned)dest[q][2], (unsigned)dest[q][3]}; }
}
__device__ __forceinline__ void combine_idx(const LayerCtx& c, int t0, int tstride, u32x4 (&dn)[2], f32x4 (&gn)[2]) {
#pragma unroll
    for (int q = 0; q < 2; ++q) { const int t = t0 + q * tstride; dn[q] = *(const u32x4*)(c.DEST + t * 4); gn[q] = *(const f32x4*)(c.GATE + t * 4); } }
__device__ __forceinline__ void combine_rows2(const Args& a, const LayerCtx& c, int t0, int tnext, int tstride, int lane, float* out2, u32x4 (&dn)[2], f32x4 (&gn)[2]) {
    u32x4 d4[2]; f32x4 g4[2]; u32x4 hw[2][2], yw[2][4][2];
#pragma unroll
    for (int q = 0; q < 2; ++q) { const int t = t0 + q * tstride; d4[q] = dn[q]; g4[q] = gn[q];
        hw[q][0] = *(const u32x4*)(c.HB + (size_t)t * D + 8 * lane); hw[q][1] = *(const u32x4*)(c.HB + (size_t)t * D + 512 + 8 * lane); }
#pragma unroll
    for (int q = 0; q < 2; ++q)
#pragma unroll
        for (int k = 0; k < 4; ++k) { const bf16_t* y = c.YS + (size_t)d4[q][k] * D; yw[q][k][0] = *(const u32x4*)(y + 8 * lane); yw[q][k][1] = *(const u32x4*)(y + 512 + 8 * lane); }
    combine_idx(c, tnext, tstride, dn, gn);
    R8 v[2][2];
#pragma unroll
    for (int q = 0; q < 2; ++q)
#pragma unroll
        for (int j = 0; j < 2; ++j) { const R8 h = unpack8(hw[q][j]); v[q][j].lo = h.lo * DN_ALPHA; v[q][j].hi = h.hi * DN_ALPHA;
#pragma unroll
            for (int k = 0; k < 4; ++k) { const R8 y = unpack8(yw[q][k][j]); v[q][j].lo += y.lo * g4[q][k]; v[q][j].hi += y.hi * g4[q][k]; } }
    ln_rows<2>(v, a.in[I_LN3G] + c.l * D, a.in[I_LN3B] + c.l * D, lane);
#pragma unroll
    for (int q = 0; q < 2; ++q) { const int t = t0 + q * tstride; store_row_bf16(c.HB + (size_t)t * D, v[q], lane); if (out2) store_row_f32(out2 + (size_t)t * D, v[q], lane); }
}
constexpr int NPH_LAYER = 17, NPH_PRE = 3, NPHASES = NPH_PRE + NLAYER * NPH_LAYER;
#ifndef USE_PG8
#define USE_PG8 1
#endif
#if USE_PG8
#define GEMM_CALL(PAIR, g, S, E) do { int tid_ = tid; asm volatile("" : "+v"(tid_)); pg8::gemm_phase<PAIR, false>(tid_, lds, g, S, E); } while (0)
#define GEMM_CALL_GATHER(PAIR, g, S, E) do { int tid_ = tid; asm volatile("" : "+v"(tid_)); pg8::gemm_phase<PAIR, true>(tid_, lds, g, S, E); } while (0)
#else
#define GEMM_CALL(PAIR, g, S, E) sgemm_phase<PAIR>(tid, g, S, E)
#endif

__global__ void __launch_bounds__(NTHREADS, 2) fwd(Args a) {
    extern __shared__ __attribute__((aligned(16))) unsigned char lds_raw[];
    LAS unsigned char* lds = (LAS unsigned char*)lds_raw;
    volatile LAS unsigned* MISC = (volatile LAS unsigned*)(lds + MISC_OFF);
    const int G = gridDim.x, NGW = G * NWAVES;
    const int wave_s = __builtin_amdgcn_readfirstlane((int)threadIdx.x >> 6);
#define HW_TID() (wave_s * 64 + hw_lane())
    if (threadIdx.x < 64) MISC[threadIdx.x] = 0u;
    __syncthreads();
    unsigned* ctl = (unsigned*)(a.ws + WS_CTL);
    XcdBarrier bar; bar.bar = ctl + CW_BAR; bar.x = 0; bar.st = nullptr;
    if (N_LAUNCH_MODE == 1) bar = xcd_barrier_post(ctl + CW_BAR, MISC + 8, (int)threadIdx.x);
    const int lo = a.lo, hi = a.hi;
#define PH_TID int tid = HW_TID(); asm volatile("" : "+v"(tid)); int bid = blockIdx.x; asm volatile("" : "+s"(bid)); const __attribute__((address_space(4))) Args* ap_ = (const __attribute__((address_space(4))) Args*)__builtin_amdgcn_kernarg_segment_ptr(); asm volatile("" : "+s"(ap_)); const Args& a = *(const Args*)ap_; const int lane = tid & 63, wave = tid >> 6, gw = bid * NWAVES + wave; (void)lane; (void)gw
#define PH_BEGIN int lv = l; asm volatile("" : "+s"(lv)); PH_TID; const LayerCtx c = make_ctx(a, lv)
#define IN(k) (lo <= (k) && (k) < hi)
#define SEAM(k) do { if (N_LAUNCH_MODE == 1 && IN(k) && IN((k) + 1)) xcd_barrier(bar, HW_TID()); } while (0)

    if (IN(0)) { PH_TID; phase_pre0(tid, bid, a, lds); } SEAM(0);
    if (IN(1)) { PH_TID;
        GemmDesc g{(const bf16_t*)a.ws, (const bf16_t*)a.ws, 1024, 1024, 1024}; PreOrder S{G, bid}; EpiPre E{a.ws};
        GEMM_CALL(false, g, S, E);
    } SEAM(1);
    if (IN(2)) { PH_TID;
        GemmDesc g{(const bf16_t*)a.ws, (const bf16_t*)a.ws, 1024, 1024, 256}; Pre2Order S{G, bid}; EpiPre2 E{a.ws};
        GEMM_CALL(false, g, S, E);
    } SEAM(2);

    for (int l = 0; l < NLAYER; ++l) {
        const int pb = NPH_PRE + NPH_LAYER * l;
        if (IN(pb + 0)) { PH_BEGIN;
            GemmDesc g{c.HB, (const bf16_t*)(c.wl + WL_IN), 1024, 1024, 1024}; TileOrder S; S.init(T / 256, ZC / 256, G, bid, 0, 1024, 1024);
            EpiBf16 E{c.Z, ZC, nullptr}; GEMM_CALL(false, g, S, E);
        } SEAM(pb + 0);
        if (IN(pb + 1)) { PH_BEGIN;
            { fft::build_table(tid, lds); fft::F64Frags FF; fft::build_f64(tid, FF); __syncthreads();
              for (int u = bid; u < 512; u += G) fft::unit(tid, c, u, lds, FF); }
            __syncthreads();
            for (int it = bid; it < T / 64; it += G) conv_item(tid, a, c, it, lds);
            const QkConst kc = qkprep_const(a, c, lane);
            for (int t = gw; t < T; t += 4 * NGW) { QkRaw raw[4];
#pragma unroll
                for (int q = 0; q < 4; ++q) raw[q] = qkprep_load(c, t + q * NGW, lane);
#pragma unroll
                for (int q = 0; q < 4; ++q) qkprep_row(c, t + q * NGW, lane, raw[q], kc); }
        } SEAM(pb + 1);
        if (IN(pb + 2)) { PH_BEGIN;
            { GemmDesc g{c.CQKV, (const bf16_t*)(c.wl + WL_MLA), 384, 384, 384}; TileOrder S; S.init(T / 256, 4, G, bid, 0, 384, 384);
              EpiBf16 E{c.QKVM, 1024, nullptr}; GEMM_CALL(false, g, S, E); }
            { GemmDesc g{c.FC, (const bf16_t*)(c.wl + WL_FC), 512, 256, 256}; TileOrder S; S.init(T / 256, 2, G, bid, 1, 512, 256);
              EpiFCN E{c.Y, a.in[I_BF] + lv * 256, a.in[I_BPW] + lv * 256, lds}; GEMM_CALL(false, g, S, E); }
        } SEAM(pb + 2);
        if (IN(pb + 3)) { PH_BEGIN;
            for (int U = bid; U < 1024; U += G) { const int x = U & 511, b = x >> 7, h = (x >> 5) & 3, qb = x & 31;
                if (lv == 0 && (U >> 8) == ((bid >> 3) & 3)) { int tw = tid; asm volatile("" : "+v"(tw)); moe_weight_items(tw, bid, a, lds); __syncthreads(); }
                unsigned char* wsb = a.ws; asm volatile("" : "+s"(wsb));
                int tu = tid; asm volatile("" : "+v"(tu));
                if (U < 512) { const AttnSrc A = gqa_src(wsb, b, h); att::unit<64>(tu, A, qb * 256, lds); }
                else         { const AttnSrc A = mla_src(wsb, b, h); att::unit<96>(tu, A, qb * 256, lds); } }
        } SEAM(pb + 3);
        if (IN(pb + 4)) { PH_BEGIN; for (int t = gw; t < T; t += 8 * NGW) grpnorm_hi_rows8(c, t, NGW, lane); } SEAM(pb + 4);
        if (IN(pb + 5)) { PH_BEGIN;
            GemmDesc g{c.Y, (const bf16_t*)(c.wl + WL_O), 1024, 1024, 1024}; TileOrder S; S.init(T / 256, 4, G, bid, 0, 1024, 1024);
            EpiBf16 E{c.FB, 1024, nullptr}; GEMM_CALL(false, g, S, E);
        } SEAM(pb + 5);
        if (IN(pb + 6)) { PH_BEGIN; for (int t = gw; t < T; t += 4 * NGW) { R8 v[4][2]; resln_rows<4>(c, t, NGW, a.in[I_LN1G] + lv * D, a.in[I_LN1B] + lv * D, lane, v); } } SEAM(pb + 6);
        if (IN(pb + 7)) { PH_BEGIN;
            GemmDesc g{c.HB, (const bf16_t*)(a.ws + WS_MT + (size_t)((lv * 2 + 0) * 4) * 2 * MiB), 1024, 1024, 1024}; TileOrder S; S.init(T / 256, 4, G, bid, 4, 1024, 1024);
            EpiXSN E{c.PB, lds}; GEMM_CALL(false, g, S, E);
        } SEAM(pb + 10);
        if (IN(pb + 11)) { PH_BEGIN;
            GemmDesc g{c.PB, (const bf16_t*)(a.ws + WS_MT + (size_t)((lv * 2 + 1) * 4) * 2 * MiB), 1024, 1024, 1024}; TileOrder S; S.init(T / 256, 4, G, bid, 4, 1024, 1024);
            EpiBf16 E{c.FB, 1024, nullptr}; GEMM_CALL(false, g, S, E);
        } SEAM(pb + 11);
        if (IN(pb + 12)) { PH_BEGIN; LAS unsigned* lcnt = (LAS unsigned*)(lds + TBL_LCNT);
            if (tid < 32) lcnt[tid] = 0u;
            bf16x8 bh[8], bl[8];
            { const bf16_t* wr = (const bf16_t*)(c.wl + WL_RT) + (size_t)(lane & 31) * 1024 + 128 * wave + 8 * (lane >> 5);
#pragma unroll
              for (int ks = 0; ks < 8; ++ks) { bh[ks] = *(const bf16x8*)(wr + 16 * ks); bl[ks] = *(const bf16x8*)(wr + 32768 + 16 * ks); } }
            __syncthreads();
            { u32x4 hw[4][2], fw[4][2]; static_assert(MAXWG <= T / 32, "every workgroup has a first group"); resln_load<4>(c, bid * 32 + wave * 4, 1, lane, hw, fw);
              for (int grp = bid; grp < T / 32; grp += G) ln2_router_group(tid, a, c, grp, grp + G, lds, bh, bl, lcnt, hw, fw); }
            __syncthreads();
            if (tid < 32) __hip_atomic_store(c.cnt + bid * 32 + tid, lcnt[tid], RLX_AGENT);
        } SEAM(pb + 12);
        if (IN(pb + 13)) { PH_BEGIN; moe_tables(tid, bid, c, lds); const LAS int* wbase = (const LAS int*)(lds + TBL_WBASE);
            { const int gi = tid >> 7, pr = tid & 127; const int grp = bid + G * gi;
              if (grp < T / 32) { const int t = grp * 32 + (pr >> 2), k = pr & 3; const int dest = wbase[c.RE[t * 4 + k]] + c.RR[t * 4 + k]; c.TOK[dest] = t; c.DEST[t * 4 + k] = dest; } }
        } SEAM(pb + 13);
        if (IN(pb + 14)) { PH_BEGIN;
            const int nblk = *(const LAS int*)(lds + TBL_NBLK);
            GemmDesc g{c.HB, (const bf16_t*)(c.wl + WL_GU), 1024, 1024, 1024, c.TOK}; MoeOrder S{(const LAS int*)(lds + TBL_OFF), nblk, 8, G, bid};
            EpiGU E{c.ACT, a.in[I_BGU] + (size_t)lv * NE * 2048, lds}; GEMM_CALL_GATHER(true, g, S, E);
        } SEAM(pb + 14);
        if (IN(pb + 15)) { PH_BEGIN;
            const int nblk = *(const LAS int*)(lds + TBL_NBLK);
            GemmDesc g{c.ACT, (const bf16_t*)(c.wl + WL_DN), 1024, 1024, 1024}; MoeOrder S{(const LAS int*)(lds + TBL_OFF), nblk, 4, G, bid};
            EpiDown E{c.YS, a.in[I_BDN] + (size_t)lv * NE * 1024, lds}; GEMM_CALL(false, g, S, E);
        } SEAM(pb + 15);
        if (IN(pb + 16)) { PH_BEGIN; u32x4 dn[2]; f32x4 gn[2]; combine_idx(c, gw, NGW, dn, gn);
            for (int t = gw; t < T; t += 2 * NGW) combine_rows2(a, c, t, (t + 2 * NGW < T) ? t + 2 * NGW : t, NGW, lane, (lv == NLAYER - 1) ? a.out : nullptr, dn, gn); } SEAM(pb + 16);
    }
#undef IN
#undef SEAM
}

extern "C" void kernel_launch(void* const* d_in, const int* in_sizes, int n_in, void* d_out, int out_size, void* d_ws, size_t ws_size, hipStream_t stream) {
    static int grid = 0;
    if (grid == 0) {
        if (n_in != 37 || in_sizes[0] != T * D || out_size != T * D || ws_size < WS_END) {
            fprintf(stderr, "kernel_launch: unexpected shapes: n_in %d in0 %d out %d ws %zu (need %zu)\n", n_in, n_in > 0 ? in_sizes[0] : -1, out_size, ws_size, (size_t)WS_END); grid = -1; return; }
        int dev = 0, cus = 0;
        if (hipGetDevice(&dev) != hipSuccess || hipDeviceGetAttribute(&cus, hipDeviceAttributeMultiprocessorCount, dev) != hipSuccess) { grid = -1; return; }
        if (hipFuncSetAttribute((const void*)fwd, hipFuncAttributeMaxDynamicSharedMemorySize, LDS_BYTES) != hipSuccess) { fprintf(stderr, "kernel_launch: hipFuncSetAttribute failed\n"); grid = -1; return; }
        int per_cu = 0;
        if (hipOccupancyMaxActiveBlocksPerMultiprocessor(&per_cu, (const void*)fwd, NTHREADS, LDS_BYTES) != hipSuccess || per_cu < 1) fprintf(stderr, "kernel_launch: occupancy query reports %d\n", per_cu);
        (void)hipGetLastError();
        grid = MAXWG;
        if (cus < MAXWG) fprintf(stderr, "kernel_launch: only %d CUs: the 256-workgroup persistent grid cannot be resident; the grid barrier will time out\n", cus);
    }
    if (grid < 0) return;
    (void)hipMemsetAsync((char*)d_ws + WS_CTL, 0, CTL_ZERO_BYTES, stream);
    Args a{};
    for (int i = 0; i < 37; ++i) a.in[i] = (const float*)d_in[i];
    a.out = (float*)d_out; a.ws = (unsigned char*)d_ws; a.pad0 = 0; a.pad1 = 0;
    if (N_LAUNCH_MODE == 1) { a.lo = 0; a.hi = NPHASES; hipLaunchKernelGGL(fwd, dim3(grid), dim3(NTHREADS), LDS_BYTES, stream, a); }
    else for (int p = 0; p < NPHASES; ++p) { a.lo = p; a.hi = p + 1; hipLaunchKernelGGL(fwd, dim3(grid), dim3(NTHREADS), LDS_BYTES, stream, a); }
    const hipError_t le = hipPeekAtLastError();
    if (le != hipSuccess) fprintf(stderr, "kernel_launch: launch failed: %s\n", hipGetErrorName(le));
}
```

```cpp
#include <hip/hip_runtime.h>
#include <cstdio>
#include <cstdint>

#ifndef N_LAUNCH_MODE
#define N_LAUNCH_MODE 1
#endif

#define LAS __attribute__((address_space(3)))
#define GAS __attribute__((address_space(1)))
typedef unsigned short bf16_t;
typedef short bf16x8 __attribute__((ext_vector_type(8)));
typedef float f32x4 __attribute__((ext_vector_type(4)));
typedef float f32x2 __attribute__((ext_vector_type(2)));
typedef float f32x16 __attribute__((ext_vector_type(16)));
typedef unsigned u32x4 __attribute__((ext_vector_type(4)));
typedef unsigned u32x2 __attribute__((ext_vector_type(2)));
typedef GAS unsigned gu32;
#define RLX_AGENT __ATOMIC_RELAXED, __HIP_MEMORY_SCOPE_AGENT
#define LDS_WAIT() asm volatile("s_waitcnt lgkmcnt(0)" ::: "memory")
#define VM_WAIT() asm volatile("s_waitcnt vmcnt(0)" ::: "memory")

constexpr int NB = 4, SEQ = 8192, T = NB * SEQ, D = 1024, MEML = 256, NE = 32, TOPK = 4, NLAYER = 2;
constexpr int ZC = 1792;
constexpr int ZC_CA = 256, ZC_CG = 512, ZC_Q = 768, ZC_K = 1024, ZC_V = 1152, ZC_CQ = 1280, ZC_CKV = 1536, ZC_KR = 1664;
constexpr int INC = 1696;
constexpr float LOG2E = 1.4426950408889634f;
constexpr float DN_ALPHA = 1.4142135623730951f;
constexpr float LN_EPS = 1e-5f, RMS_EPS = 1e-6f;
constexpr float QSCALE_G = 0.125f * LOG2E;
constexpr float QSCALE_M = 0.10206207261596575f * LOG2E;
constexpr float QSCALE_X = 0.0625f * LOG2E;
constexpr int MOE_MAXBLK = T * TOPK / 256 + NE;
constexpr int MOE_ROWS = MOE_MAXBLK * 256;

constexpr size_t MiB = 1u << 20;
constexpr size_t WS_CTL = 0, CTL_ZERO_BYTES = 1 * MiB;
constexpr size_t WS_W = 1 * MiB, WL_SIZE = 208 * MiB;
constexpr size_t WL_IN = 0, WL_MLA = 4 * MiB, WL_FC = 5 * MiB, WL_RT = 5 * MiB + 512 * 1024, WL_O = 6 * MiB, WL_XQ = 8 * MiB, WL_XK = 10 * MiB, WL_XV = 12 * MiB,
                 WL_XO = 14 * MiB, WL_GU = 16 * MiB, WL_DN = 144 * MiB;
constexpr size_t WS_MEMB = 418 * MiB, WS_KX = 420 * MiB, WS_VXT = 424 * MiB;
constexpr size_t WS_ROUTE = 428 * MiB;
constexpr size_t WS_H = 430 * MiB, WS_HB = 558 * MiB, WS_F = 622 * MiB, WS_R = 750 * MiB;
constexpr size_t R_Z = 0, R_FC = 112 * MiB, R_QG = 144 * MiB, R_KG = 160 * MiB, R_CQKV = 168 * MiB, R_KR = 192 * MiB, R_QKVM = 194 * MiB, R_YMIX = 258 * MiB, R_Y = 386 * MiB;
constexpr size_t R_XQ = 0, R_SC = 64 * MiB, R_PB = 192 * MiB, R_XO = 256 * MiB;
constexpr size_t R_XS = 0, R_ACT = 272 * MiB;
constexpr size_t WS_ZT = 466 * MiB;
constexpr size_t WS_MT = 430 * MiB;
constexpr size_t WS_END = WS_R + 544 * MiB;
constexpr int CW_TMO = 0, CW_CODE = 1, CW_BAR = 4096, CW_CNT = 16384, MAXWG = 256, CW_TOK = 65536;

constexpr int NTHREADS = 512, NWAVES = 8;
constexpr int LDS_BYTES = 147456;
constexpr int MISC_OFF = 147456 - 256;

__device__ __forceinline__ unsigned f2bf(float f) { unsigned u = __builtin_bit_cast(unsigned, f); return (u + 0x7fffu + ((u >> 16) & 1u)) >> 16; }
__device__ __forceinline__ unsigned pk2i(float lo, float hi) { return f2bf(lo) | (f2bf(hi) << 16); }
typedef __bf16 hwbf2 __attribute__((ext_vector_type(2))); typedef float hwf2 __attribute__((ext_vector_type(2)));
__device__ __forceinline__ unsigned pk2(float lo, float hi) { const hwf2 v = {lo, hi}; return __builtin_bit_cast(unsigned, __builtin_convertvector(v, hwbf2)); }
__device__ __forceinline__ float bf2f(unsigned b) { return __builtin_bit_cast(float, b << 16); }
__device__ __forceinline__ float bflo(unsigned w) { return __builtin_bit_cast(float, w << 16); }
__device__ __forceinline__ float bfhi(unsigned w) { return __builtin_bit_cast(float, w & 0xffff0000u); }
template <int CTRL> __device__ __forceinline__ float dppf(float v) { return __builtin_bit_cast(float, __builtin_amdgcn_update_dpp(0, __builtin_bit_cast(int, v), CTRL, 0xF, 0xF, true)); }
template <int O, bool MAX> __device__ __forceinline__ float rstep(float v) {
    float o;
    if constexpr (O == 1) o = dppf<0xB1>(v); else if constexpr (O == 2) o = dppf<0x4E>(v); else if constexpr (O == 4) o = dppf<0x141>(v); else if constexpr (O == 8) o = dppf<0x140>(v);
    else { const unsigned u = __builtin_bit_cast(unsigned, v);
        if constexpr (O == 16) { auto r = __builtin_amdgcn_permlane16_swap(u, u, false, false); v = __builtin_bit_cast(float, (unsigned)r[0]); o = __builtin_bit_cast(float, (unsigned)r[1]); }
        else { auto r = __builtin_amdgcn_permlane32_swap(u, u, false, false); v = __builtin_bit_cast(float, (unsigned)r[0]); o = __builtin_bit_cast(float, (unsigned)r[1]); } }
    return MAX ? fmaxf(v, o) : v + o;
}
template <int O> __device__ __forceinline__ float rsum(float v) { return rstep<O, false>(v); }
__device__ __forceinline__ float wave_sum(float v) { v = rsum<1>(v); v = rsum<2>(v); v = rsum<4>(v); v = rsum<8>(v); v = rsum<16>(v); return rsum<32>(v); }
__device__ __forceinline__ float wave_max(float v) { v = rstep<1, true>(v); v = rstep<2, true>(v); v = rstep<4, true>(v); v = rstep<8, true>(v); v = rstep<16, true>(v); return rstep<32, true>(v); }
__device__ __forceinline__ f32x4 ldbf4(const bf16_t* p) { const u32x2 w = *(const u32x2*)p; return (f32x4){bflo(w.x), bfhi(w.x), bflo(w.y), bfhi(w.y)}; }
__device__ __forceinline__ float sigmoidf_(float x) { return __builtin_amdgcn_rcpf(1.f + __expf(-x)); }

#define XB_TMO      128
#define XB_XCNT(j)  (256  + 64 * (j))
#define XB_XSUB(j)  (1280 + 64 * (j))
#define XB_XGEN(j)  (2304 + 64 * (j))
#define XB_TOP      3328
#define XB_TOPGEN   3392
#define XCD_BAR_WORDS 3456
#define XB_SPIN_CAP (1u << 22)
__device__ __forceinline__ unsigned xb_ld(unsigned* p)              { return __hip_atomic_load(p, __ATOMIC_RELAXED, __HIP_MEMORY_SCOPE_AGENT); }
__device__ __forceinline__ unsigned xb_add(unsigned* p, unsigned v) { return __hip_atomic_fetch_add(p, v, __ATOMIC_RELAXED, __HIP_MEMORY_SCOPE_AGENT); }
__device__ __forceinline__ unsigned xb_xcc_id() { return (unsigned)__builtin_amdgcn_s_getreg((3 << 11) | 20) & 0xFu; }
#define XB_SPIN(cond, bar) do { unsigned _sp = 0; while (cond) { __builtin_amdgcn_s_sleep(1); \
    if ((++_sp & 255u) == 0u) { if (xb_ld(&(bar)[XB_TMO])) break; if (_sp > XB_SPIN_CAP) { atomicAdd(&(bar)[XB_TMO], 1u); break; } } } } while (0)
struct XcdBarrier { unsigned* bar; unsigned x; volatile LAS unsigned* st; };
__device__ __forceinline__ XcdBarrier xcd_barrier_post(unsigned* bar, volatile LAS unsigned* st, int tid) {
    XcdBarrier b; b.bar = bar; b.x = xb_xcc_id(); b.st = st;
    if (tid == 0) (void)xb_add(&bar[XB_XCNT(b.x)], 1u);
    return b;
}
__device__ __forceinline__ void xcd_barrier_complete(unsigned* bar, unsigned x, unsigned& nloc, unsigned& nx) {
    const unsigned G = gridDim.x * gridDim.y * gridDim.z;
    unsigned sum, cnt, mine, sp = 0u;
    for (;;) {
        sum = 0u; cnt = 0u; mine = 0u;
#pragma unroll
        for (unsigned j = 0; j < 16; ++j) { const unsigned c = xb_ld(&bar[XB_XCNT(j)]); sum += c; cnt += (c > 0u) ? 1u : 0u; mine = (j == x) ? c : mine; }
        if (sum == G) break;
        __builtin_amdgcn_s_sleep(1);
        if ((++sp & 255u) == 0u) { if (xb_ld(&bar[XB_TMO])) break; if (sp > XB_SPIN_CAP) { atomicAdd(&bar[XB_TMO], 1u); break; } }
    }
    nloc = mine > 0u ? mine : 1u; nx = cnt > 0u ? cnt : 1u;
}
__device__ __forceinline__ void xcd_barrier(const XcdBarrier& b, int tid) {
    asm volatile("s_waitcnt vmcnt(0)" ::: "memory");
    __syncthreads();
    if (tid == 0) {
        unsigned* bar = b.bar;
        __builtin_amdgcn_s_waitcnt(0);
        unsigned nloc = b.st[0], nx = b.st[1];
        if (nloc == 0u) { xcd_barrier_complete(bar, b.x, nloc, nx); b.st[0] = nloc; b.st[1] = nx; }
        const unsigned old = xb_add(&bar[XB_XSUB(b.x)], 1u);
        const unsigned gen = old / nloc;
        if (old + 1u == (gen + 1u) * nloc) {
            __builtin_amdgcn_fence(__ATOMIC_RELEASE, "agent");
            asm volatile("s_waitcnt vmcnt(0)" ::: "memory");
            const unsigned og = xb_add(&bar[XB_TOP], 1u);
            const unsigned tg = og / nx;
            if (og + 1u == (tg + 1u) * nx) xb_add(&bar[XB_TOPGEN], 1u);
            else XB_SPIN(xb_ld(&bar[XB_TOPGEN]) == tg, bar);
            __builtin_amdgcn_fence(__ATOMIC_ACQUIRE, "agent");
            xb_add(&bar[XB_XGEN(b.x)], 1u);
            asm volatile("s_waitcnt vmcnt(0)" ::: "memory");
        } else {
            XB_SPIN(xb_ld(&bar[XB_XGEN(b.x)]) == gen, bar);
            __builtin_amdgcn_fence(__ATOMIC_ACQUIRE, "agent");
            asm volatile("s_waitcnt vmcnt(0)" ::: "memory");
        }
    }
    __syncthreads();
}

__device__ __forceinline__ int hw_lane() { int l; asm volatile("v_mbcnt_lo_u32_b32 %0, -1, 0\n\tv_mbcnt_hi_u32_b32 %0, -1, %0" : "=v"(l)); return l; }
constexpr int XSN_PART_OFF = 141312;
constexpr int EPI_BIAS_OFF = 143360;
struct Unit { int pm, pn, z; long aoff, boff; };
struct GemmDesc { const bf16_t* A; const bf16_t* Bt; int lda, ldb, K; const int* tok = nullptr; };

struct TileOrder {
    int nM, nN, nwg, G, c, mode, lda, ldb;
    __device__ __forceinline__ void init(int nM_, int nN_, int G_, int c_, int mode_, int lda_, int ldb_) { nM = nM_; nN = nN_; nwg = nM * nN; G = G_; c = c_; mode = mode_; lda = lda_; ldb = ldb_; }
    __device__ __forceinline__ bool next(int i, Unit& u) const {
        const long L = (long)i * G + c; if (L >= nwg) return false;
        int wgid = (int)L; { const int q = nwg / 8, r = nwg % 8, xcd = wgid % 8, off = wgid / 8; wgid = (xcd < r ? xcd * (q + 1) : r * (q + 1) + (xcd - r) * q) + off; }
        const int nig = 8 * nN, gid = wgid / nig, fm = gid * 8, gsz = (nM - fm) < 8 ? (nM - fm) : 8;
        u.pm = fm + ((wgid % nig) % gsz); u.pn = (wgid % nig) / gsz; u.z = 0;
        const long ar = (long)u.pm * 256 * lda;
        if (mode == 0)      { u.aoff = ar;                u.boff = (long)u.pn * 256 * ldb; }
        else if (mode == 1) { u.aoff = ar + u.pn * 256;   u.boff = (long)u.pn * 256 * ldb; }
        else if (mode == 2) { u.aoff = ar + u.pn * 256;   u.boff = (long)((u.pm >> 5) * 256) * ldb + u.pn * 256; }
        else if (mode == 3) { u.aoff = ar + u.pn * 256;   u.boff = (long)(u.pn * 256) * ldb + (u.pm >> 5) * 256; }
        else                { u.aoff = ar;                u.boff = (long)(u.pm >> 5) * 1048576 + (long)u.pn * 256 * ldb; }
        return true;
    }
};
struct PreOrder {
    int G, c;
    __device__ __forceinline__ bool next(int i, Unit& u) const {
        const int L = i * G + c; if (L >= 64) return false;
        const int which = L >> 4, t16 = L & 15, l = which >> 1, isv = which & 1;
        u.pm = t16 >> 2; u.pn = t16 & 3; u.z = which;
        const long memb = (long)(WS_MEMB / 2), wk = (long)((WS_W + l * WL_SIZE + WL_XK) / 2), wv = (long)((WS_W + l * WL_SIZE + WL_XV) / 2);
        const long ao = memb, bo = isv ? wv : wk;
        u.aoff = ao + (long)u.pm * 256 * 1024; u.boff = bo + (long)u.pn * 256 * 1024; return true;
    }
};
struct Pre2Order {
    int G, c;
    __device__ __forceinline__ bool next(int i, Unit& u) const {
        const int L = i * G + c; if (L >= 256) return false;
        const int l = L >> 7, which = (L >> 6) & 1, b = (L >> 4) & 3, h = (L >> 2) & 3, j = L & 3;
        const long kx = (long)((WS_KX + (size_t)l * 2 * MiB) / 2), vx = (long)((WS_VXT + (size_t)l * 2 * MiB) / 2), wq = (long)((WS_W + l * WL_SIZE + WL_XQ) / 2), wo = (long)((WS_W + l * WL_SIZE + WL_XO) / 2);
        u.z = (l * 2 + which) * 4 + b;
        if (which == 0) { u.pm = h; u.pn = j; u.aoff = kx + (long)(b * 256) * 1024 + h * 256; u.boff = wq + (long)(j * 256) * 1024 + h * 256; }
        else            { u.pm = j; u.pn = h; u.aoff = wo + (long)(j * 256) * 1024 + h * 256; u.boff = vx + (long)(b * 256) * 1024 + h * 256; }
        return true;
    }
};
struct MoeOrder {
    const LAS int* blk_e; int nblk, nN, G, c;
    __device__ __forceinline__ bool next(int i, Unit& u) const {
        const int x = c & 7, v = c >> 3, per = G >> 3; const long ul = (long)i * per + v; const int rb = x + 8 * (int)(ul / nN), pn = (int)(ul % nN); if (rb >= nblk) return false;
        const int e = blk_e[rb]; u.pm = rb; u.pn = pn; u.z = e;
        u.aoff = (long)rb * 256 * 1024; u.boff = ((long)e * nN * 256 + (long)pn * 256) * 1024; return true;
    }
};

__device__ __forceinline__ u32x4 pk8(const f32x4 a, const f32x4 b) { return (u32x4){pk2(a.x, a.y), pk2(a.z, a.w), pk2(b.x, b.y), pk2(b.z, b.w)}; }
struct EpiBf16 { static constexpr bool TILE = true; static constexpr int NST = 16; static constexpr int NPRE = 0; bf16_t* O; int ldo; const float* bias;
    __device__ __forceinline__ void tile(const f32x4 (&acc)[2][2][4][2], const Unit& u, int wr, int wc, int fr, int fq) const {
        const int col0 = u.pn * 256 + wc * 32 + 8 * fq; f32x4 b[2][2];
#pragma unroll
        for (int bj = 0; bj < 2; ++bj) { b[bj][0] = bias ? *(const f32x4*)(bias + col0 + bj * 128) : (f32x4){0.f, 0.f, 0.f, 0.f}; b[bj][1] = bias ? *(const f32x4*)(bias + col0 + bj * 128 + 4) : (f32x4){0.f, 0.f, 0.f, 0.f}; }
        if (bias) asm volatile("s_waitcnt vmcnt(0)" ::: "memory");
#pragma unroll
        for (int ai = 0; ai < 2; ++ai)
#pragma unroll
            for (int m = 0; m < 4; ++m) { bf16_t* rowp = O + (size_t)(u.pm * 256 + ai * 128 + wr * 64 + m * 16 + fr) * ldo + col0;
#pragma unroll
                for (int bj = 0; bj < 2; ++bj) *(u32x4*)(rowp + bj * 128) = pk8(acc[ai][bj][m][0] + b[bj][0], acc[ai][bj][m][1] + b[bj][1]); }
    }
    __device__ __forceinline__ void st4(const Unit&, int grow, int gcol, f32x4 v) const {
        if (bias) { const f32x4 b = *(const f32x4*)(bias + gcol); v += b; }
        u32x2 w; w.x = pk2(v.x, v.y); w.y = pk2(v.z, v.w); *(u32x2*)(O + (size_t)grow * ldo + gcol) = w; } };
struct EpiInProj { static constexpr bool TILE = true; static constexpr int NST = 16; static constexpr int NPRE = 0; bf16_t* O; unsigned* ZT;
    __device__ __forceinline__ void tile(const f32x4 (&acc)[2][2][4][2], const Unit& u, int wr, int wc, int fr, int fq) const {
        if (u.pn == 0) {
#pragma unroll
            for (int ai = 0; ai < 2; ++ai)
#pragma unroll
                for (int m = 0; m < 4; ++m) { const int t = u.pm * 256 + ai * 128 + wr * 64 + m * 16 + fr; unsigned* zr = ZT + ((size_t)(t >> 13) * 128) * 8192 + (t & 8191);
#pragma unroll
                    for (int bj = 0; bj < 2; ++bj)
#pragma unroll
                        for (int n = 0; n < 2; ++n) { const int p0 = (bj * 128 + wc * 32 + 8 * fq + 4 * n) >> 1; const f32x4 v = acc[ai][bj][m][n];
                            zr[(size_t)p0 * 8192] = pk2(v.x, v.y); zr[(size_t)(p0 + 1) * 8192] = pk2(v.z, v.w); } }
        } else { const int col0 = u.pn * 256 + wc * 32 + 8 * fq;
#pragma unroll
            for (int ai = 0; ai < 2; ++ai)
#pragma unroll
                for (int m = 0; m < 4; ++m) { bf16_t* rowp = O + (size_t)(u.pm * 256 + ai * 128 + wr * 64 + m * 16 + fr) * ZC + col0;
#pragma unroll
                    for (int bj = 0; bj < 2; ++bj) *(u32x4*)(rowp + bj * 128) = pk8(acc[ai][bj][m][0], acc[ai][bj][m][1]); } }
    } };
struct EpiF32 { static constexpr bool TILE = false; static constexpr int NST = 0; static constexpr int NPRE = 0; float* O; int ldo; const float* bias0; const float* bias1;
    __device__ __forceinline__ void st4(const Unit&, int grow, int gcol, f32x4 v) const {
        if (bias0) { const f32x4 b = (gcol < 256) ? *(const f32x4*)(bias0 + gcol) : *(const f32x4*)(bias1 + gcol - 256); v += b; }
        *(f32x4*)(O + (size_t)grow * ldo + gcol) = v; } };
struct EpiFCN { static constexpr bool TILE = true; static constexpr int NST = 16; static constexpr int NPRE = 0; bf16_t* Y; const float* bias0; const float* bias1; LAS unsigned char* lds;
    __device__ __forceinline__ void tile(const f32x4 (&acc)[2][2][4][2], const Unit& u, int wr, int wc, int fr_, int fq_) const {
        int fr = fr_, fq = fq_; asm volatile("" : "+v"(fr), "+v"(fq));
        LAS float* part = (LAS float*)(lds + XSN_PART_OFF);
        const float* bp = (u.pn == 0 ? bias0 : bias1) + wc * 32 + 8 * fq; f32x4 b[2][2];
#pragma unroll
        for (int bj = 0; bj < 2; ++bj) { b[bj][0] = *(const f32x4*)(bp + bj * 128); b[bj][1] = *(const f32x4*)(bp + bj * 128 + 4); }
        asm volatile("s_waitcnt vmcnt(0)" ::: "memory");
#pragma unroll
        for (int ai = 0; ai < 2; ++ai)
#pragma unroll
            for (int m = 0; m < 4; ++m) { float ss = 0.f;
#pragma unroll
                for (int bj = 0; bj < 2; ++bj)
#pragma unroll
                    for (int n = 0; n < 2; ++n) { const f32x4 x = acc[ai][bj][m][n] + b[bj][n]; ss += (x.x * x.x + x.y * x.y) + (x.z * x.z + x.w * x.w); }
                ss = rsum<16>(ss); ss = rsum<32>(ss);
                if (fq == 0) part[(ai * 128 + wr * 64 + m * 16 + fr) * 4 + wc] = ss;
                __builtin_amdgcn_sched_barrier(0); }
        asm volatile("s_waitcnt lgkmcnt(0)\n\ts_barrier" ::: "memory");
        asm volatile("" : "+v"(b[0][0]), "+v"(b[0][1]), "+v"(b[1][0]), "+v"(b[1][1]));
#pragma unroll
        for (int ai = 0; ai < 2; ++ai)
#pragma unroll
            for (int m = 0; m < 4; ++m) { const int lrow = ai * 128 + wr * 64 + m * 16 + fr; const f32x4 t = *(const LAS f32x4*)(part + lrow * 4); const float r = __builtin_amdgcn_rsqf(((t.x + t.y) + (t.z + t.w)) * (1.f / 256.f) + RMS_EPS);
#pragma unroll
                for (int bj = 0; bj < 2; ++bj) *(u32x4*)(Y + (size_t)(u.pm * 256 + lrow) * 1024 + u.pn * 256 + bj * 128 + wc * 32 + 8 * fq) = pk8((acc[ai][bj][m][0] + b[bj][0]) * r, (acc[ai][bj][m][1] + b[bj][1]) * r);
                __builtin_amdgcn_sched_barrier(0); }
    } };
struct EpiPre { static constexpr bool TILE = false; static constexpr int NST = 0; static constexpr int NPRE = 0; unsigned char* ws;
    __device__ __forceinline__ void st4(const Unit& u, int grow, int gcol, f32x4 v) const {
        bf16_t* O = (bf16_t*)(ws + ((u.z & 1) ? WS_VXT : WS_KX) + (size_t)(u.z >> 1) * 2 * MiB);
        u32x2 w; w.x = pk2(v.x, v.y); w.y = pk2(v.z, v.w); *(u32x2*)(O + (size_t)grow * 1024 + gcol) = w; } };
struct EpiPre2 { static constexpr bool TILE = false; static constexpr int NST = 0; static constexpr int NPRE = 0; unsigned char* ws;
    __device__ __forceinline__ void st4(const Unit& u, int grow, int gcol, f32x4 v) const {
        bf16_t* O = (bf16_t*)(ws + WS_MT + (size_t)u.z * 2 * MiB);
        u32x2 w; w.x = pk2(v.x, v.y); w.y = pk2(v.z, v.w); *(u32x2*)(O + (size_t)grow * 1024 + gcol) = w; } };
__device__ __forceinline__ void rope2(float& x1, float& x2, float ang) { const float c = __cosf(ang), s = __sinf(ang); const float a = x1 * c - x2 * s, b = x2 * c + x1 * s; x1 = a; x2 = b; }
struct EpiGU { static constexpr bool TILE = true; static constexpr int NST = 8; static constexpr int NPRE = 1; bf16_t* O; const float* bgu; LAS unsigned char* lds;
    __device__ __forceinline__ void prefetch(const Unit& u, int wid, int lane) const {
        const float* b = bgu + (size_t)u.z * 2048 + (lane >> 5) * 1024 + u.pn * 128 + (wid & 3) * 32 + (lane & 31);
        __builtin_amdgcn_global_load_lds((const unsigned*)b, (LAS unsigned*)(lds + EPI_BIAS_OFF + wid * 256), 4, 0, 0); }
    __device__ __forceinline__ void tile(const f32x4 (&acc)[2][2][4][2], const Unit& u, int wr, int wc, int fr, int fq) const {
        const int acol = u.pn * 128 + wc * 32 + 8 * fq; const LAS float* b = (const LAS float*)(lds + EPI_BIAS_OFF + (wr * 4 + wc) * 256) + 8 * fq;
        const f32x4 bg0 = *(const LAS f32x4*)b, bg1 = *(const LAS f32x4*)(b + 4); f32x4 bu0 = *(const LAS f32x4*)(b + 32), bu1 = *(const LAS f32x4*)(b + 36);
        bu0 += 1.f; bu1 += 1.f;
#define GU_PAIR(G, U, BG, BU, I) ({ hwf2 g_ = hwf2{G[I], G[I + 1]} + hwf2{BG[I], BG[I + 1]}, u_ = hwf2{U[I], U[I + 1]} + hwf2{BU[I], BU[I + 1]};   \
            g_.x = fminf(g_.x, 7.f); g_.y = fminf(g_.y, 7.f); u_.x = __builtin_amdgcn_fmed3f(u_.x, -6.f, 8.f); u_.y = __builtin_amdgcn_fmed3f(u_.y, -6.f, 8.f);          \
            hwf2 e_ = g_ * -2.45546696f; e_.x = __builtin_amdgcn_exp2f(e_.x); e_.y = __builtin_amdgcn_exp2f(e_.y); e_ = e_ + 1.f;                                       \
            e_.x = __builtin_amdgcn_rcpf(e_.x); e_.y = __builtin_amdgcn_rcpf(e_.y); const hwf2 a_ = (g_ * u_) * e_; pk2(a_.x, a_.y); })
#pragma unroll
        for (int ai = 0; ai < 2; ++ai)
#pragma unroll
            for (int m = 0; m < 4; ++m) { const f32x4 g0 = acc[ai][0][m][0], g1 = acc[ai][0][m][1], u0 = acc[ai][1][m][0], u1 = acc[ai][1][m][1];
                u32x4 o; o.x = GU_PAIR(g0, u0, bg0, bu0, 0); o.y = GU_PAIR(g0, u0, bg0, bu0, 2); o.z = GU_PAIR(g1, u1, bg1, bu1, 0); o.w = GU_PAIR(g1, u1, bg1, bu1, 2);
                *(u32x4*)(O + (size_t)(u.pm * 256 + ai * 128 + wr * 64 + m * 16 + fr) * 1024 + acol) = o;
                __builtin_amdgcn_sched_barrier(0); }
#undef GU_PAIR
    }
    __device__ __forceinline__ void st4x2(const Unit& u, int grow, int acol, f32x4 g, f32x4 up) const {
        const float* b = bgu + (size_t)u.z * 2048; const f32x4 bg = *(const f32x4*)(b + acol), bu = *(const f32x4*)(b + 1024 + acol);
        g += bg; up += bu; f32x4 a;
#pragma unroll
        for (int i = 0; i < 4; ++i) { const float gg = fminf(g[i], 7.f), uu = fminf(fmaxf(up[i], -7.f), 7.f); a[i] = (uu + 1.f) * (gg * sigmoidf_(1.702f * gg)); }
        u32x2 w; w.x = pk2(a.x, a.y); w.y = pk2(a.z, a.w); *(u32x2*)(O + (size_t)grow * 1024 + acol) = w; } };
struct EpiDown { static constexpr bool TILE = true; static constexpr int NST = 16; static constexpr int NPRE = 1; bf16_t* O; const float* bdn; LAS unsigned char* lds;
    __device__ __forceinline__ void prefetch(const Unit& u, int wid, int lane) const {
        const float* b = bdn + (size_t)u.z * 1024 + u.pn * 256 + (lane >> 5) * 128 + (wid & 3) * 32 + (lane & 31);
        __builtin_amdgcn_global_load_lds((const unsigned*)b, (LAS unsigned*)(lds + EPI_BIAS_OFF + wid * 256), 4, 0, 0); }
    __device__ __forceinline__ void tile(const f32x4 (&acc)[2][2][4][2], const Unit& u, int wr, int wc, int fr, int fq) const {
        const int col0 = u.pn * 256 + wc * 32 + 8 * fq; const LAS float* bl = (const LAS float*)(lds + EPI_BIAS_OFF + (wr * 4 + wc) * 256) + 8 * fq; f32x4 b[2][2];
#pragma unroll
        for (int bj = 0; bj < 2; ++bj) { b[bj][0] = *(const LAS f32x4*)(bl + 32 * bj); b[bj][1] = *(const LAS f32x4*)(bl + 32 * bj + 4); }
#pragma unroll
        for (int ai = 0; ai < 2; ++ai)
#pragma unroll
            for (int m = 0; m < 4; ++m) { bf16_t* rowp = O + (size_t)(u.pm * 256 + ai * 128 + wr * 64 + m * 16 + fr) * 1024 + col0;
#pragma unroll
                for (int bj = 0; bj < 2; ++bj) *(u32x4*)(rowp + bj * 128) = pk8(acc[ai][bj][m][0] + b[bj][0], acc[ai][bj][m][1] + b[bj][1]); }
    }
    __device__ __forceinline__ void st4(const Unit& u, int grow, int gcol, f32x4 v) const {
        const f32x4 b = *(const f32x4*)(bdn + (size_t)u.z * 1024 + gcol); v += b;
        u32x2 w; w.x = pk2(v.x, v.y); w.y = pk2(v.z, v.w); *(u32x2*)(O + (size_t)grow * 1024 + gcol) = w; } };

struct EpiXS { static constexpr bool TILE = true; static constexpr int NST = 16; static constexpr int NPRE = 0; bf16_t* P; float* RS;
    __device__ __forceinline__ void tile(const f32x4 (&acc)[2][2][4][2], const Unit& u, int wr, int wc, int fr, int fq) const {
#pragma unroll
        for (int ai = 0; ai < 2; ++ai)
#pragma unroll
            for (int m = 0; m < 4; ++m) { const int grow = u.pm * 256 + ai * 128 + wr * 64 + m * 16 + fr; float rs = 0.f;
#pragma unroll
                for (int bj = 0; bj < 2; ++bj) { f32x4 p0, p1;
#pragma unroll
                    for (int i = 0; i < 4; ++i) { p0[i] = __builtin_amdgcn_exp2f(fminf(acc[ai][bj][m][0][i], 100.f)); p1[i] = __builtin_amdgcn_exp2f(fminf(acc[ai][bj][m][1][i], 100.f)); }
                    rs += ((p0.x + p0.y) + (p0.z + p0.w)) + ((p1.x + p1.y) + (p1.z + p1.w));
                    u32x4 w; w.x = pk2(p0.x, p0.y); w.y = pk2(p0.z, p0.w); w.z = pk2(p1.x, p1.y); w.w = pk2(p1.z, p1.w);
                    *(u32x4*)(P + (size_t)grow * 1024 + u.pn * 256 + bj * 128 + wc * 32 + 8 * fq) = w; }
                rs = rsum<16>(rs); rs = rsum<32>(rs);
                if (fq == 0) RS[((size_t)grow * 4 + u.pn) * 4 + wc] = rs;
                __builtin_amdgcn_sched_barrier(0); }
    } };
struct EpiXSN { static constexpr bool TILE = true; static constexpr int NST = 16; static constexpr int NPRE = 0; bf16_t* P; LAS unsigned char* lds;
    __device__ __forceinline__ void tile(const f32x4 (&acc)[2][2][4][2], const Unit& u, int wr, int wc, int fr_, int fq_) const {
        int fr = fr_, fq = fq_; asm volatile("" : "+v"(fr), "+v"(fq));
        LAS float* part = (LAS float*)(lds + XSN_PART_OFF);
#pragma unroll
        for (int ai = 0; ai < 2; ++ai)
#pragma unroll
            for (int m = 0; m < 4; ++m) { float rs = 0.f;
#pragma unroll
                for (int bj = 0; bj < 2; ++bj)
#pragma unroll
                    for (int n = 0; n < 2; ++n) { f32x4 q;
#pragma unroll
                        for (int i = 0; i < 4; ++i) q[i] = __builtin_amdgcn_exp2f(fminf(acc[ai][bj][m][n][i], 100.f));
                        rs += (q.x + q.y) + (q.z + q.w); }
                rs = rsum<16>(rs); rs = rsum<32>(rs);
                if (fq == 0) part[(ai * 128 + wr * 64 + m * 16 + fr) * 4 + wc] = rs;
                __builtin_amdgcn_sched_barrier(0); }
        asm volatile("s_waitcnt lgkmcnt(0)\n\ts_barrier" ::: "memory");
        float cap = 100.f; asm volatile("" : "+v"(cap));
#pragma unroll
        for (int ai = 0; ai < 2; ++ai)
#pragma unroll
            for (int m = 0; m < 4; ++m) { const int lrow = ai * 128 + wr * 64 + m * 16 + fr; const f32x4 t = *(const LAS f32x4*)(part + lrow * 4); const float r = __builtin_amdgcn_rcpf((t.x + t.y) + (t.z + t.w));
#pragma unroll
                for (int bj = 0; bj < 2; ++bj) { f32x4 q0, q1;
#pragma unroll
                    for (int i = 0; i < 4; ++i) { q0[i] = __builtin_amdgcn_exp2f(fminf(acc[ai][bj][m][0][i], cap)) * r; q1[i] = __builtin_amdgcn_exp2f(fminf(acc[ai][bj][m][1][i], cap)) * r; }
                    *(u32x4*)(P + (size_t)(u.pm * 256 + lrow) * 1024 + u.pn * 256 + bj * 128 + wc * 32 + 8 * fq) = pk8(q0, q1); }
                __builtin_amdgcn_sched_barrier(0); }
    } };
struct EpiXO { static constexpr bool TILE = true; static constexpr int NST = 16; static constexpr int NPRE = 0; bf16_t* O; const float* RS;
    __device__ __forceinline__ void tile(const f32x4 (&acc)[2][2][4][2], const Unit& u, int wr, int wc, int fr, int fq) const {
        const int col0 = u.pn * 256 + wc * 32 + 8 * fq; float rr[2][4];
#pragma unroll
        for (int ai = 0; ai < 2; ++ai)
#pragma unroll
            for (int m = 0; m < 4; ++m) { const int grow = u.pm * 256 + ai * 128 + wr * 64 + m * 16 + fr; const f32x4 q = *(const f32x4*)(RS + ((size_t)grow * 4 + u.pn) * 4); rr[ai][m] = __builtin_amdgcn_rcpf((q.x + q.y) + (q.z + q.w)); }
        asm volatile("s_waitcnt vmcnt(0)" ::: "memory");
#pragma unroll
        for (int ai = 0; ai < 2; ++ai)
#pragma unroll
            for (int m = 0; m < 4; ++m) { const int grow = u.pm * 256 + ai * 128 + wr * 64 + m * 16 + fr; const float r = rr[ai][m];
#pragma unroll
                for (int bj = 0; bj < 2; ++bj) *(u32x4*)(O + (size_t)grow * 1024 + col0 + bj * 128) = pk8(acc[ai][bj][m][0] * r, acc[ai][bj][m][1] * r); }
    }
    __device__ __forceinline__ void st4(const Unit&, int grow, int gcol, f32x4 v) const {
        const f32x4 q = *(const f32x4*)(RS + ((size_t)grow * 4 + (gcol >> 8)) * 4); const float r = __builtin_amdgcn_rcpf((q.x + q.y) + (q.z + q.w)); v = v * r;
        u32x2 w; w.x = pk2(v.x, v.y); w.y = pk2(v.z, v.w); *(u32x2*)(O + (size_t)grow * 1024 + gcol) = w; } };

template <bool PAIR, class Sched, class Epi>
__device__ __forceinline__ void sgemm_phase(const int tid, const GemmDesc g, const Sched& S, const Epi& E) {
    const int wid = tid >> 6, lane = tid & 63, r32 = lane & 31, hi = lane >> 5;
    Unit u;
    for (int i = 0; S.next(i, u); ++i) {
        const int grow = u.pm * 256 + wid * 32 + r32;
        const bf16_t* Ap = g.A + u.aoff + (long)(wid * 32 + r32) * g.lda + hi * 8;
        const bf16_t* Bp = g.Bt + u.boff + (long)r32 * g.ldb + hi * 8;
#pragma unroll 1
        for (int pass = 0; pass < 2; ++pass) {
            int cbs[4];
#pragma unroll
            for (int j = 0; j < 4; ++j) cbs[j] = PAIR ? ((j & 1) + 2 * pass + 4 * (j >> 1)) : (4 * pass + j);
            f32x16 acc[4];
#pragma unroll
            for (int j = 0; j < 4; ++j) acc[j] = f32x16{};
#pragma unroll 2
            for (int k0 = 0; k0 < g.K; k0 += 16) {
                const bf16x8 a = *(const bf16x8*)(Ap + k0);
#pragma unroll
                for (int j = 0; j < 4; ++j) { const bf16x8 b = *(const bf16x8*)(Bp + (long)cbs[j] * 32 * g.ldb + k0); acc[j] = __builtin_amdgcn_mfma_f32_32x32x16_bf16(b, a, acc[j], 0, 0, 0); }
            }
            if constexpr (PAIR) {
#pragma unroll
                for (int j = 0; j < 2; ++j)
#pragma unroll
                    for (int q = 0; q < 4; ++q) { const f32x4 gv = {acc[j][4 * q], acc[j][4 * q + 1], acc[j][4 * q + 2], acc[j][4 * q + 3]};
                        const f32x4 uv = {acc[j + 2][4 * q], acc[j + 2][4 * q + 1], acc[j + 2][4 * q + 2], acc[j + 2][4 * q + 3]};
                        E.st4x2(u, grow, u.pn * 128 + cbs[j] * 32 + 8 * q + 4 * hi, gv, uv); }
            } else {
#pragma unroll
                for (int j = 0; j < 4; ++j)
#pragma unroll
                    for (int q = 0; q < 4; ++q) { const f32x4 v = {acc[j][4 * q], acc[j][4 * q + 1], acc[j][4 * q + 2], acc[j][4 * q + 3]};
                        E.st4(u, grow, u.pn * 256 + cbs[j] * 32 + 8 * q + 4 * hi, v); }
            }
        }
    }
}

namespace pg8 {
constexpr int BK = 64, HALF = 128, HTB = HALF * BK * 2, STAGE_BYTES = 8 * HTB;
__device__ __forceinline__ int lds_byte(int r, int c) { const int st = (r >> 4) * 2 + (c >> 5), rr = r & 15, cc = c & 31, ob = rr * 64 + cc * 2; return st * 1024 + (ob ^ (((ob >> 9) & 1) << 5)); }
__device__ __forceinline__ void stage_rc(int b, int& R, int& C) { const int st = b / 1024, sb = b % 1024, swz = sb ^ (((sb >> 9) & 1) << 5); R = (st >> 1) * 16 + swz / 64; C = (st & 1) * 32 + (swz % 64) / 2; }
__device__ __forceinline__ int perm32(int rho) { const int n = rho >> 4, i = rho & 15; return 8 * (i >> 2) + 4 * n + (i & 3); }
template <bool PAIR, class Epi>
__device__ __forceinline__ void run_epi(const Epi& E, const f32x4 (&acc)[2][2][4][2], const Unit& u, int wr, int wc, int fr, int fq) {
    if constexpr (Epi::TILE) { E.tile(acc, u, wr, wc, fr, fq); return; } else {
#pragma unroll
    for (int ai = 0; ai < 2; ++ai)
#pragma unroll
        for (int m = 0; m < 4; ++m) { const int grow = u.pm * 256 + ai * HALF + wr * 64 + m * 16 + fr;
            if constexpr (PAIR) {
#pragma unroll
                for (int n = 0; n < 2; ++n) E.st4x2(u, grow, u.pn * 128 + wc * 32 + 8 * fq + 4 * n, acc[ai][0][m][n], acc[ai][1][m][n]);
            } else {
#pragma unroll
                for (int bj = 0; bj < 2; ++bj)
#pragma unroll
                    for (int n = 0; n < 2; ++n) E.st4(u, grow, u.pn * 256 + bj * HALF + wc * 32 + 8 * fq + 4 * n, acc[ai][bj][m][n]);
            }
            __builtin_amdgcn_sched_barrier(0); }
    }
}
template <bool PAIR, bool GATH, class Sched, class Epi>
__device__ __forceinline__ void gemm_phase(const int tid, LAS unsigned char* lds, const GemmDesc g, const Sched& S, const Epi& E) {
    const int wid = __builtin_amdgcn_readfirstlane(tid >> 6), lane = tid & 63, wr = wid >> 2, wc = wid & 3, fr = lane & 15, fq = lane >> 4;
    const int K = g.K, nt = K / BK;
    unsigned voffA[2], voffB[2]; int RA[2], CA[2];
#define PG8_VOFFS() do { const int t_ = wid * 64 + hw_lane(); _Pragma("unroll") for (int i = 0; i < 2; ++i) { int R, C; stage_rc(t_ * 16 + i * 8192, R, C); const int Rb = (R & ~31) + perm32(R & 31); RA[i] = R; CA[i] = C * 2; \
        voffA[i] = (unsigned)(R * g.lda + C) * 2u; voffB[i] = (unsigned)(Rb * g.ldb + C) * 2u; } } while (0)
    PG8_VOFFS();
    unsigned cvA[2][2], nvA[2][2];
#define PG8_GVOFF(U, V) do { if constexpr (GATH) { _Pragma("unroll") for (int h_ = 0; h_ < 2; ++h_) _Pragma("unroll") for (int i_ = 0; i_ < 2; ++i_) \
        V[h_][i_] = (unsigned)g.tok[(U).pm * 256 + h_ * HALF + RA[i_]] * (unsigned)(g.lda * 2) + (unsigned)CA[i_]; } } while (0)
    const size_t kstep = (size_t)(BK * 2);
    const size_t hstepA = (size_t)HALF * g.lda * 2, hstepB = (size_t)HALF * g.ldb * 2;
    const unsigned ldsw = (unsigned)wid * 1024u;
    const int aoff = lds_byte(wr * 64 + fr, fq * 8), boff = lds_byte(wc * 32 + fr, fq * 8);
#define PG8_SA(b, h) (((b) * 2 + (h)) * HTB)
#define PG8_SB(b, h) ((4 + (b) * 2 + (h)) * HTB)
#define PG8_STAGE(bufoff, gbase, voff) do { _Pragma("unroll") for (int _i = 0; _i < 2; ++_i) \
        __builtin_amdgcn_global_load_lds((const unsigned*)((const char*)(gbase) + (voff)[_i]), (LAS unsigned*)(lds + (bufoff) + ldsw + _i * 8192), 16, 0, 0); } while (0)
#define PG8_STA(b, h, base, V) do { if constexpr (GATH) PG8_STAGE(PG8_SA(b, h), base, V[h]); else PG8_STAGE(PG8_SA(b, h), (base) + (h) * hstepA, voffA); } while (0)
#define PG8_LDA(dst, b, h) do { _Pragma("unroll") for (int m = 0; m < 4; ++m) _Pragma("unroll") for (int k = 0; k < 2; ++k) dst[m][k] = *(const LAS bf16x8*)(lds + PG8_SA(b, h) + aoff + m * 2048 + k * 1024); } while (0)
#define PG8_LDB(dst, b, h) do { _Pragma("unroll") for (int n = 0; n < 2; ++n) _Pragma("unroll") for (int k = 0; k < 2; ++k) dst[n][k] = *(const LAS bf16x8*)(lds + PG8_SB(b, h) + boff + n * 2048 + k * 1024); } while (0)
#define PG8_MMA(ai, bj, At, Bt) do { __builtin_amdgcn_s_setprio(1); _Pragma("unroll") for (int m = 0; m < 4; ++m) _Pragma("unroll") for (int n = 0; n < 2; ++n) _Pragma("unroll") for (int k = 0; k < 2; ++k) \
        acc[ai][bj][m][n] = __builtin_amdgcn_mfma_f32_16x16x32_bf16(Bt[n][k], At[m][k], acc[ai][bj][m][n], 0, 0, 0); __builtin_amdgcn_s_setprio(0); } while (0)
#define PG8_WAIT_V(n) asm volatile("s_waitcnt vmcnt(" #n ")" ::: "memory")
#define PG8_WAIT_VN(n) asm volatile("s_waitcnt vmcnt(%0)" :: "n"(n) : "memory")
#define PG8_WAIT_L(n) asm volatile("s_waitcnt lgkmcnt(" #n ")" ::: "memory")
#define PG8_BAR __builtin_amdgcn_s_barrier()
#define PG8_SCHED __builtin_amdgcn_sched_barrier(0)
    Unit cur, nxt; int ui = 0;
    if (!S.next(0, cur)) return;
    bool has_next = S.next(1, nxt);
    f32x4 acc[2][2][4][2];
    float zf = 0.f; asm volatile("" : "+v"(zf)); const f32x4 Z4 = {zf, zf, zf, zf};
#pragma unroll
    for (int a = 0; a < 2; ++a)
#pragma unroll
        for (int b = 0; b < 2; ++b)
#pragma unroll
            for (int m = 0; m < 4; ++m)
#pragma unroll
                for (int n = 0; n < 2; ++n) acc[a][b][m][n] = Z4;
    bf16x8 At[4][2], B0[2][2], B1[2][2];
    const char* cA = (const char*)g.A + (GATH ? (size_t)0 : (size_t)cur.aoff * 2); const char* cB = (const char*)g.Bt + (size_t)cur.boff * 2;
    const char* nA = (has_next && !GATH) ? (const char*)g.A + (size_t)nxt.aoff * 2 : cA; const char* nB = has_next ? (const char*)g.Bt + (size_t)nxt.boff * 2 : cB;
    PG8_GVOFF(cur, cvA);
    if constexpr (GATH) { if (has_next) PG8_GVOFF(nxt, nvA); else { _Pragma("unroll") for (int h_ = 0; h_ < 2; ++h_) _Pragma("unroll") for (int i_ = 0; i_ < 2; ++i_) nvA[h_][i_] = cvA[h_][i_]; } }
    PG8_STAGE(PG8_SB(0, 0), cB, voffB); PG8_STAGE(PG8_SB(0, 1), cB + hstepB, voffB); PG8_STA(0, 0, cA, cvA); PG8_STA(0, 1, cA, cvA);
    PG8_STAGE(PG8_SB(1, 0), cB + kstep, voffB); PG8_STA(1, 0, cA + kstep, cvA); PG8_STAGE(PG8_SB(1, 1), cB + hstepB + kstep, voffB); PG8_STA(1, 1, cA + kstep, cvA);
    PG8_WAIT_V(0);
    if (wr == 1) PG8_BAR;
    PG8_BAR;
    constexpr int WX = 8 + Epi::NST + Epi::NPRE;
#define PG8_WAIT_X() do { if constexpr (WX == 8) PG8_WAIT_V(8); else { if (fst) PG8_WAIT_VN(WX); else PG8_WAIT_V(8); } } while (0)
    for (;;) {
        int fst = 1; asm volatile("" : "+s"(fst));
#pragma unroll 1
        for (int t = 0; t < nt; t += 2) {
            const bool last = (t == nt - 2);
            const char* a1 = cA + (size_t)(t + 1) * kstep;
            const char* a2 = last ? nA : cA + (size_t)(t + 2) * kstep; const char* b2 = last ? nB : cB + (size_t)(t + 2) * kstep;
            const char* a3 = a2 + kstep; const char* b3 = b2 + kstep;
            unsigned sv[2][2];
            if constexpr (GATH) { _Pragma("unroll") for (int h_ = 0; h_ < 2; ++h_) _Pragma("unroll") for (int i_ = 0; i_ < 2; ++i_) sv[h_][i_] = last ? nvA[h_][i_] : cvA[h_][i_]; }
            PG8_LDB(B0, 0, 0); PG8_LDB(B1, 0, 1); PG8_SCHED; PG8_LDA(At, 0, 0); if (!fst) PG8_STA(1, 1, a1, cvA); else { if constexpr (Epi::NPRE == 1) E.prefetch(cur, wid, lane); }
            PG8_WAIT_X(); PG8_WAIT_L(0); PG8_BAR; PG8_MMA(0, 0, At, B0); PG8_MMA(0, 1, At, B1); PG8_BAR; PG8_SCHED;
            PG8_LDA(At, 0, 1); PG8_STAGE(PG8_SB(0, 0), b2, voffB); PG8_STAGE(PG8_SB(0, 1), b2 + hstepB, voffB); PG8_STA(0, 0, a2, sv);
            PG8_WAIT_X(); PG8_WAIT_L(0); PG8_BAR; PG8_MMA(1, 0, At, B0); PG8_MMA(1, 1, At, B1); PG8_BAR; PG8_SCHED;
            PG8_LDB(B0, 1, 0); PG8_LDB(B1, 1, 1); PG8_SCHED; PG8_LDA(At, 1, 0); PG8_STA(0, 1, a2, sv);
            PG8_WAIT_X(); PG8_WAIT_L(0); PG8_BAR; PG8_MMA(0, 0, At, B0); PG8_MMA(0, 1, At, B1); PG8_BAR; PG8_SCHED;
            PG8_LDA(At, 1, 1); PG8_STAGE(PG8_SB(1, 0), b3, voffB); PG8_STAGE(PG8_SB(1, 1), b3 + hstepB, voffB); PG8_STA(1, 0, a3, sv);
            PG8_WAIT_V(8); PG8_WAIT_L(0); PG8_BAR; PG8_MMA(1, 0, At, B0); PG8_MMA(1, 1, At, B1); PG8_BAR; PG8_SCHED;
            fst = 0;
        }
        if (wr == 0) PG8_BAR;
        PG8_STA(1, 1, nA + kstep, nvA);
        Unit nn; const bool has_nn = has_next && S.next(ui + 2, nn);
        unsigned n2vA[2][2];
        if constexpr (GATH) { if (has_nn) PG8_GVOFF(nn, n2vA); else { _Pragma("unroll") for (int h_ = 0; h_ < 2; ++h_) _Pragma("unroll") for (int i_ = 0; i_ < 2; ++i_) n2vA[h_][i_] = nvA[h_][i_]; } }
        { const int le_ = hw_lane(); run_epi<PAIR>(E, acc, cur, wr, wc, le_ & 15, le_ >> 4); }
        if (!has_next) break;
#pragma unroll
        for (int a = 0; a < 2; ++a)
#pragma unroll
            for (int b = 0; b < 2; ++b)
#pragma unroll
                for (int m = 0; m < 4; ++m)
#pragma unroll
                    for (int n = 0; n < 2; ++n) acc[a][b][m][n] = Z4;
        PG8_VOFFS();
        cur = nxt; cA = nA; cB = nB; ++ui;
        if constexpr (GATH) { _Pragma("unroll") for (int h_ = 0; h_ < 2; ++h_) _Pragma("unroll") for (int i_ = 0; i_ < 2; ++i_) { cvA[h_][i_] = nvA[h_][i_]; nvA[h_][i_] = n2vA[h_][i_]; } }
        has_next = has_nn;
        if (has_nn) { nxt = nn; if constexpr (!GATH) nA = (const char*)g.A + (size_t)nn.aoff * 2; nB = (const char*)g.Bt + (size_t)nn.boff * 2; }
        if (wr == 1) PG8_BAR;
    }
#undef PG8_WAIT_X
#undef PG8_VOFFS
    PG8_WAIT_V(0);
    PG8_BAR;
#undef PG8_SA
#undef PG8_SB
#undef PG8_STAGE
#undef PG8_LDA
#undef PG8_STA
#undef PG8_GVOFF
#undef PG8_LDB
#undef PG8_MMA
#undef PG8_WAIT_V
#undef PG8_WAIT_VN
#undef PG8_WAIT_L
#undef PG8_BAR
#undef PG8_SCHED
}
}

struct Args { const float* in[37]; float* out; unsigned char* ws; int lo, hi, pad0, pad1; };
enum { I_X = 0, I_MEM, I_LNIN_G, I_LNIN_B, I_WIN, I_WF, I_BF, I_DWW, I_DWB, I_CLG, I_CLB, I_WPW, I_BPW, I_QG, I_KG, I_MQG, I_WUQ, I_MKG, I_WUKV, I_GRPG, I_WO, I_LN1G, I_LN1B,
       I_WXQ, I_WXK, I_WXV, I_WXO, I_LN2G, I_LN2B, I_WR, I_BR, I_WGU, I_BGU, I_WDN, I_BDN, I_LN3G, I_LN3B };

__device__ __forceinline__ int rope_perm16(int d) { const int half = d >> 4, dd = d & 15; return half * 16 + ((dd < 8) ? 2 * dd : 2 * (dd - 8) + 1); }
__device__ __forceinline__ int rope_perm32(int d) { const int half = d >> 5, dd = d & 31; return half * 32 + ((dd < 16) ? 2 * dd : 2 * (dd - 16) + 1); }
__device__ __forceinline__ int map_row(int mode, int n) {
    switch (mode) {
    case 1: if (n < 256) return -1; if (n < 768) return n; if (n < 1152) { const int m = n - 768; return 768 + (m & ~63) + rope_perm32(m & 63); } if (n < 1664) return n; return 1664 + rope_perm16(n - 1664);
    case 2: { const int h = n / 96, p = n % 96; return h * 128 + (p < 64 ? p : 64 + rope_perm16(p - 64)); }
    case 3: return 512 + n;
    case 4: { const int half = n >> 10, m = n & 1023; return (m >> 7) * 256 + half * 128 + (m & 127); }
    default: return n;
    }
}
__device__ __forceinline__ void cp_item(const float* __restrict__ W, bf16_t* dst, float scale, int item, int lane) {
    const int r0 = (item >> 4) * 64 + (lane >> 4), c0 = (item & 15) * 64 + (lane & 15) * 4;
#pragma unroll
    for (int i = 0; i < 16; ++i) { const f32x4 v = *(const f32x4*)(W + (size_t)(r0 + 4 * i) * 1024 + c0) * scale; u32x2 w; w.x = pk2(v.x, v.y); w.y = pk2(v.z, v.w); *(u32x2*)(dst + (size_t)(r0 + 4 * i) * 1024 + c0) = w; }
}
__device__ __forceinline__ int fnet_j(int cc) { const int jp = cc >> 1, second = cc & 1; return jp == 0 ? (second ? 32 : 0) : (second ? 64 - jp : jp); }
__device__ __forceinline__ void tr_item(const float* __restrict__ W, int N, bf16_t* dst, int ldd, int koff, const float* kgain, float scale, int mode, int rowbase, LAS float* scr, int item, int lane, int kperm = 0) {
    const int nblk = (N + 63) >> 6, kb = item / nblk, nb = item - kb * nblk, k0 = kb * 64, n0 = nb * 64;
    const int nq = (lane & 15) * 4, kq = lane >> 4;
    const bool ok = (n0 + nq) < N;
    f32x4 v[16];
#pragma unroll
    for (int i = 0; i < 16; ++i) { const int kk = 4 * i + kq; const int ksrc = kperm ? (((k0 + kk) & ~63) + fnet_j((k0 + kk) & 63)) : (k0 + kk); v[i] = ok ? *(const f32x4*)(W + (size_t)ksrc * N + n0 + nq) : (f32x4){0.f, 0.f, 0.f, 0.f}; }
#pragma unroll
    for (int i = 0; i < 16; ++i) { const int kk = 4 * i + kq; const float gs = (kgain ? kgain[k0 + kk] : 1.f) * scale;
        scr[kk * 65 + nq + 0] = v[i].x * gs; scr[kk * 65 + nq + 1] = v[i].y * gs; scr[kk * 65 + nq + 2] = v[i].z * gs; scr[kk * 65 + nq + 3] = v[i].w * gs; }
    LDS_WAIT(); asm volatile("" ::: "memory");
    const int c = lane & 7;
#pragma unroll
    for (int j = 0; j < 8; ++j) { const int n = (lane >> 3) + 8 * j;
        if (n0 + n < N) { const int row = map_row(mode, n0 + n);
            if (row >= 0) { const LAS float* s = scr + (8 * c) * 65 + n;
                u32x4 o; o.x = pk2(s[0 * 65], s[1 * 65]); o.y = pk2(s[2 * 65], s[3 * 65]); o.z = pk2(s[4 * 65], s[5 * 65]); o.w = pk2(s[6 * 65], s[7 * 65]);
                *(u32x4*)(dst + (size_t)(rowbase + row) * ldd + koff + k0 + 8 * c) = o; } } }
    LDS_WAIT(); asm volatile("" ::: "memory");
}
constexpr int IT_IN = 16 * 27, IT_UQ = 4 * 6, IT_UKV = 2 * 8, IT_F = 16, IT_SQ = 256, IT_GU = 32 * 512, IT_DN = 32 * 256;
constexpr int IT_SMALL = IT_IN + IT_UQ + IT_UKV + 2 * IT_F + 5 * IT_SQ, IT_MOE = IT_GU + IT_DN;

struct R8 { f32x4 lo, hi; };
__device__ __forceinline__ R8 unpack8(const u32x4 w) { R8 r; r.lo = (f32x4){bflo(w.x), bfhi(w.x), bflo(w.y), bfhi(w.y)}; r.hi = (f32x4){bflo(w.z), bfhi(w.z), bflo(w.w), bfhi(w.w)}; return r; }
__device__ __forceinline__ u32x4 pack8(const R8& r) { return (u32x4){pk2(r.lo.x, r.lo.y), pk2(r.lo.z, r.lo.w), pk2(r.hi.x, r.hi.y), pk2(r.hi.z, r.hi.w)}; }
__device__ __forceinline__ float hsum8(const R8& r) { return ((r.lo.x + r.lo.y) + (r.lo.z + r.lo.w)) + ((r.hi.x + r.hi.y) + (r.hi.z + r.hi.w)); }
__device__ __forceinline__ float hsq8(const R8& r) { return ((r.lo.x * r.lo.x + r.lo.y * r.lo.y) + (r.lo.z * r.lo.z + r.lo.w * r.lo.w)) + ((r.hi.x * r.hi.x + r.hi.y * r.hi.y) + (r.hi.z * r.hi.z + r.hi.w * r.hi.w)); }
template <int NR>
__device__ __forceinline__ void ln_rows(R8 (&v)[NR][2], const float* g, const float* b, int lane) {
    float mean[NR], rstd[NR];
#pragma unroll
    for (int q = 0; q < NR; ++q) mean[q] = hsum8(v[q][0]) + hsum8(v[q][1]);
#pragma unroll
    for (int q = 0; q < NR; ++q) mean[q] = rsum<2>(rsum<1>(mean[q]));
#pragma unroll
    for (int q = 0; q < NR; ++q) mean[q] = rsum<8>(rsum<4>(mean[q]));
#pragma unroll
    for (int q = 0; q < NR; ++q) mean[q] = rsum<32>(rsum<16>(mean[q]));
#pragma unroll
    for (int q = 0; q < NR; ++q) { mean[q] *= (1.f / D);
#pragma unroll
        for (int j = 0; j < 2; ++j) { v[q][j].lo = v[q][j].lo - mean[q]; v[q][j].hi = v[q][j].hi - mean[q]; }
        rstd[q] = hsq8(v[q][0]) + hsq8(v[q][1]); }
#pragma unroll
    for (int q = 0; q < NR; ++q) rstd[q] = rsum<2>(rsum<1>(rstd[q]));
#pragma unroll
    for (int q = 0; q < NR; ++q) rstd[q] = rsum<8>(rsum<4>(rstd[q]));
#pragma unroll
    for (int q = 0; q < NR; ++q) rstd[q] = rsum<32>(rsum<16>(rstd[q]));
#pragma unroll
    for (int j = 0; j < 2; ++j) { const f32x4 g0 = *(const f32x4*)(g + 512 * j + 8 * lane), g1 = *(const f32x4*)(g + 512 * j + 8 * lane + 4), b0 = *(const f32x4*)(b + 512 * j + 8 * lane), b1 = *(const f32x4*)(b + 512 * j + 8 * lane + 4);
#pragma unroll
        for (int q = 0; q < NR; ++q) { const float r = __builtin_amdgcn_rsqf(rstd[q] * (1.f / D) + LN_EPS); v[q][j].lo = v[q][j].lo * r * g0 + b0; v[q][j].hi = v[q][j].hi * r * g1 + b1; } }
}
__device__ __forceinline__ void store_row_bf16(bf16_t* row, const R8 (&v)[2], int lane) {
#pragma unroll
    for (int j = 0; j < 2; ++j) *(u32x4*)(row + 512 * j + 8 * lane) = pack8(v[j]);
}
__device__ __forceinline__ void store_row_f32(float* row, const R8 (&v)[2], int lane) {
#pragma unroll
    for (int j = 0; j < 2; ++j) { *(f32x4*)(row + 512 * j + 8 * lane) = v[j].lo; *(f32x4*)(row + 512 * j + 8 * lane + 4) = v[j].hi; }
}

struct MoeWItem { const float* W; bf16_t* dst; int N, mode, rowbase, k0, n0; };
__device__ __forceinline__ MoeWItem moe_w_item(const Args& a, int it) {
    MoeWItem m; const int l = it / IT_MOE; int r = it - l * IT_MOE; unsigned char* wl = a.ws + WS_W + (size_t)l * WL_SIZE; int item;
    if (r < IT_GU) { const int e = r >> 9; m.W = a.in[I_WGU] + ((size_t)l * NE + e) * 1024 * 2048; m.N = 2048; m.dst = (bf16_t*)(wl + WL_GU); m.mode = 4; m.rowbase = e * 2048; item = r & 511; }
    else { r -= IT_GU; const int e = r >> 8; m.W = a.in[I_WDN] + ((size_t)l * NE + e) * 1024 * 1024; m.N = 1024; m.dst = (bf16_t*)(wl + WL_DN); m.mode = 0; m.rowbase = e * 1024; item = r & 255; }
    const int nblk = m.N >> 6, kb = item / nblk, nb = item - kb * nblk; m.k0 = kb * 64; m.n0 = nb * 64; return m;
}
__device__ __forceinline__ void moe_w_load(const MoeWItem& m, int lane, f32x4 (&v)[16]) {
    const float* src = m.W + (size_t)(m.k0 + 2 * (lane >> 4)) * m.N + m.n0 + (lane & 15) * 4;
#pragma unroll
    for (int i = 0; i < 8; ++i) { v[2 * i] = __builtin_nontemporal_load((const f32x4*)(src + (size_t)(8 * i) * m.N)); v[2 * i + 1] = __builtin_nontemporal_load((const f32x4*)(src + (size_t)(8 * i + 1) * m.N)); }
}
__device__ __forceinline__ void moe_w_finish(const MoeWItem& m, int lane, const f32x4 (&v)[16], LAS float* scr) {
    const int l = lane & 15, kq = lane >> 4; LAS unsigned* sw = (LAS unsigned*)scr;
#pragma unroll
    for (int i = 0; i < 8; ++i) { LAS unsigned* w = sw + (4 * l) * 32 + 4 * (i ^ (l & 7)) + kq;
        w[0] = pk2(v[2 * i].x, v[2 * i + 1].x); w[32] = pk2(v[2 * i].y, v[2 * i + 1].y); w[64] = pk2(v[2 * i].z, v[2 * i + 1].z); w[96] = pk2(v[2 * i].w, v[2 * i + 1].w); }
    LDS_WAIT(); asm volatile("" ::: "memory");
    const int c = lane & 7;
#pragma unroll
    for (int j = 0; j < 8; ++j) { const int n = (lane >> 3) + 8 * j; const int row = map_row(m.mode, m.n0 + n);
        const u32x4 o = *(const LAS u32x4*)(sw + n * 32 + 4 * (c ^ ((n >> 2) & 7)));
        *(u32x4*)(m.dst + (size_t)(m.rowbase + row) * 1024 + m.k0 + 8 * c) = o; }
    LDS_WAIT(); asm volatile("" ::: "memory");
}
__device__ __forceinline__ void moe_weight_items(const int tid, const int bid, const Args& a, LAS unsigned char* lds) {
    const int lane = tid & 63, wave = tid >> 6;
    const int gw = bid * NWAVES + wave, NGW = gridDim.x * NWAVES;
    LAS float* scr = (LAS float*)(lds + wave * 16640);
    static_assert((NLAYER * IT_MOE) % (256 * NWAVES * 2) == 0, "every wave converts an even number of tiles");
    f32x4 va[16], vb[16];
    MoeWItem ma = moe_w_item(a, gw), mb; moe_w_load(ma, lane, va);
#pragma unroll 1
    for (int it = gw; it < NLAYER * IT_MOE; it += 2 * NGW) {
        mb = moe_w_item(a, it + NGW); moe_w_load(mb, lane, vb);
        moe_w_finish(ma, lane, va, scr);
        if (it + 2 * NGW < NLAYER * IT_MOE) { ma = moe_w_item(a, it + 2 * NGW); moe_w_load(ma, lane, va); }
        moe_w_finish(mb, lane, vb, scr);
    }
}
constexpr int IT_TAIL = 4096;
#define MW_IT(x) ((x) + ((x) >= gap_at ? IT_TAIL : 0))
__device__ __forceinline__ void moe_weight_range(const int tid, const int gw, const int NGW, const int lo, const int hi, const int gap_at, const Args& a, LAS unsigned char* lds) {
    const int lane = tid & 63, wave = tid >> 6;
    LAS float* scr = (LAS float*)(lds + wave * 16640);
    static_assert(IT_TAIL % (128 * NWAVES * 2) == 0 && (NLAYER * (IT_MOE - IT_TAIL)) % (256 * NWAVES * 2) == 0 && NLAYER == 2, "every wave converts an even number of tiles");
    f32x4 va[16], vb[16];
    MoeWItem ma = moe_w_item(a, MW_IT(lo + gw)), mb; moe_w_load(ma, lane, va);
#pragma unroll 1
    for (int it = lo + gw; it < hi; it += 2 * NGW) {
        mb = moe_w_item(a, MW_IT(it + NGW)); moe_w_load(mb, lane, vb);
        moe_w_finish(ma, lane, va, scr);
        if (it + 2 * NGW < hi) { ma = moe_w_item(a, MW_IT(it + 2 * NGW)); moe_w_load(ma, lane, va); }
        moe_w_finish(mb, lane, vb, scr);
    }
}
__device__ __forceinline__ void phase_pre0(const int tid, const int bid, const Args& a, LAS unsigned char* lds) {
    const int lane = tid & 63, wave = tid >> 6;
    const int gw = bid * NWAVES + wave, NGW = gridDim.x * NWAVES;
    const long gt = (long)bid * NTHREADS + tid, NGT = (long)gridDim.x * NTHREADS;
    unsigned char* ws = a.ws;
    LAS float* scr = (LAS float*)(lds + wave * 16640);
    for (int it = gw; it < NLAYER * IT_SMALL; it += NGW) {
        const int l = it / IT_SMALL; int r = it - l * IT_SMALL;
        unsigned char* wl = ws + WS_W + (size_t)l * WL_SIZE;
        if (r < IT_IN) { tr_item(a.in[I_WIN] + (size_t)l * 1024 * INC, INC, (bf16_t*)(wl + WL_IN), 1024, 0, nullptr, 1.f, 1, 0, scr, r, lane); continue; } r -= IT_IN;
        if (r < IT_UQ) { tr_item(a.in[I_WUQ] + (size_t)l * 256 * 384, 384, (bf16_t*)(wl + WL_MLA), 384, 0, a.in[I_MQG] + l * 256, QSCALE_M, 2, 0, scr, r, lane); continue; } r -= IT_UQ;
        if (r < IT_UKV) { tr_item(a.in[I_WUKV] + (size_t)l * 128 * 512, 512, (bf16_t*)(wl + WL_MLA), 384, 256, a.in[I_MKG] + l * 128, 1.f, 3, 0, scr, r, lane); continue; } r -= IT_UKV;
        if (r < IT_F) { tr_item(a.in[I_WF] + (size_t)l * 65536, 256, (bf16_t*)(wl + WL_FC), 256, 0, nullptr, 1.f, 0, 0, scr, r, lane, 1); continue; } r -= IT_F;
        if (r < IT_F) { tr_item(a.in[I_WPW] + (size_t)l * 65536, 256, (bf16_t*)(wl + WL_FC), 256, 0, nullptr, 1.f, 0, 256, scr, r, lane); continue; } r -= IT_F;
        if (r < IT_SQ) { tr_item(a.in[I_WO] + (size_t)l * D * D, D, (bf16_t*)(wl + WL_O), D, 0, a.in[I_GRPG] + l * 1024, 1.f, 0, 0, scr, r, lane); continue; } r -= IT_SQ;
        if (r < IT_SQ) { cp_item(a.in[I_WXQ] + (size_t)l * D * D, (bf16_t*)(wl + WL_XQ), QSCALE_X, r, lane); continue; } r -= IT_SQ;
        if (r < IT_SQ) { tr_item(a.in[I_WXK] + (size_t)l * D * D, D, (bf16_t*)(wl + WL_XK), D, 0, nullptr, 1.f, 0, 0, scr, r, lane); continue; } r -= IT_SQ;
        if (r < IT_SQ) { tr_item(a.in[I_WXV] + (size_t)l * D * D, D, (bf16_t*)(wl + WL_XV), D, 0, nullptr, 1.f, 0, 0, scr, r, lane); continue; } r -= IT_SQ;
        { tr_item(a.in[I_WXO] + (size_t)l * D * D, D, (bf16_t*)(wl + WL_XO), D, 0, nullptr, 1.f, 0, 0, scr, r, lane); }
    }
    for (long idx = gt; idx < (long)NLAYER * 256 * 1024; idx += NGT) {
        const int l = (int)(idx >> 18), k = (int)(idx >> 8) & 1023, n = (int)idx & 255, g = n >> 6, cc = n & 63, jp = cc >> 1, second = cc & 1;
        const int mult = (jp == 0 && second) ? 32 : jp; const bool use_cos = (second == 0) || (jp == 0);
        const float* w = a.in[I_WIN] + ((size_t)l * 1024 + k) * INC + g * 64; float acc = 0.f;
#pragma unroll 8
        for (int c = 0; c < 64; ++c) { const float fr = (float)((mult * c) & 63) * (1.f / 64.f); const float cv = __builtin_amdgcn_cosf(fr), sv = -__builtin_amdgcn_sinf(fr); acc += w[c] * (use_cos ? cv : sv); }
        ((bf16_t*)(ws + WS_W + (size_t)l * WL_SIZE + WL_IN))[(size_t)n * 1024 + k] = (bf16_t)f2bf(acc);
    }
    for (long idx = gt; idx < (long)NLAYER * 96 * 1024; idx += NGT) { const int l = (int)(idx / (96 * 1024)); const long r = idx % (96 * 1024);
        ((bf16_t*)(ws + WS_W + (size_t)l * WL_SIZE + WL_IN))[(size_t)INC * 1024 + r] = 0; }
    for (long idx = gt; idx < (long)NLAYER * 1024 * 384; idx += NGT) { const int l = (int)(idx / (1024 * 384)); const int r = (int)(idx % (1024 * 384)), row = r / 384, k = r % 384;
        const bool pad = (row < 512) ? (k >= 256 || (row & 127) >= 96) : (k < 256);
        if (pad) ((bf16_t*)(ws + WS_W + (size_t)l * WL_SIZE + WL_MLA))[r] = 0; }
    for (long idx = gt; idx < (long)NLAYER * 32 * 1024; idx += NGT) { const int l = (int)(idx >> 15), e = (int)(idx >> 10) & 31, k = (int)idx & 1023;
        const float w = a.in[I_WR][((size_t)l * 1024 + k) * 32 + e]; const unsigned hb = f2bf(w); const unsigned lb = f2bf(w - bf2f(hb));
        bf16_t* wr = (bf16_t*)(ws + WS_W + (size_t)l * WL_SIZE + WL_RT); wr[e * 1024 + k] = (bf16_t)hb; wr[32768 + e * 1024 + k] = (bf16_t)lb; }
    for (long idx = gt; idx < (long)NB * MEML * D / 4; idx += NGT) { const f32x4 v = *(const f32x4*)(a.in[I_MEM] + idx * 4); u32x2 w; w.x = pk2(v.x, v.y); w.y = pk2(v.z, v.w); *(u32x2*)((bf16_t*)(ws + WS_MEMB) + idx * 4) = w; }
    for (int m0 = gw; m0 < T; m0 += 4 * NGW) { R8 v[4][2];
#pragma unroll
        for (int q = 0; q < 4; ++q) { const float* xr = a.in[I_X] + (size_t)(m0 + q * NGW) * D;
#pragma unroll
            for (int j = 0; j < 2; ++j) { v[q][j].lo = *(const f32x4*)(xr + 512 * j + 8 * lane); v[q][j].hi = *(const f32x4*)(xr + 512 * j + 8 * lane + 4); } }
        ln_rows<4>(v, a.in[I_LNIN_G], a.in[I_LNIN_B], lane);
#pragma unroll
        for (int q = 0; q < 4; ++q) store_row_bf16((bf16_t*)(ws + WS_HB) + (size_t)(m0 + q * NGW) * D, v[q], lane); }
}

struct LayerCtx {
    int l; unsigned char* ws; unsigned char* wl;
    bf16_t *Z, *FC, *QG, *KG, *CQKV, *KR, *QKVM, *Y, *XQ, *PB, *XO, *XS, *ACT, *YS, *HB;
    float *YMIX, *RS; bf16_t* FB;
    int *RE, *RR, *DEST, *TOK; float* GATE; unsigned* cnt;
};
__device__ __forceinline__ LayerCtx make_ctx(const Args& a, int l) {
    LayerCtx c; c.l = l; c.ws = a.ws; c.wl = a.ws + WS_W + (size_t)l * WL_SIZE; unsigned char* r = a.ws + WS_R;
    c.Z = (bf16_t*)(r + R_Z); c.FC = (bf16_t*)(r + R_FC); c.QG = (bf16_t*)(r + R_QG); c.KG = (bf16_t*)(r + R_KG); c.CQKV = (bf16_t*)(r + R_CQKV); c.KR = (bf16_t*)(r + R_KR);
    c.QKVM = (bf16_t*)(r + R_QKVM); c.YMIX = (float*)(r + R_YMIX); c.Y = (bf16_t*)(r + R_Y);
    c.XQ = (bf16_t*)(r + R_XQ); c.RS = (float*)(a.ws + WS_F + 64 * MiB); c.PB = (bf16_t*)(r + R_PB); c.XO = (bf16_t*)(r + R_XO);
    c.XS = (bf16_t*)(r + R_XS); c.ACT = (bf16_t*)(r + R_ACT); c.YS = (bf16_t*)(r + R_XS);
    c.HB = (bf16_t*)(a.ws + WS_HB); c.FB = (bf16_t*)(a.ws + WS_F);
    c.RE = (int*)(a.ws + WS_ROUTE); c.RR = c.RE + T * 4; c.GATE = (float*)(c.RR + T * 4); c.DEST = (int*)(c.GATE + T * 4);
    c.cnt = (unsigned*)(a.ws + WS_CTL) + CW_CNT + MAXWG * 32 * l; c.TOK = (int*)(a.ws + WS_CTL) + CW_TOK;
    return c;
}
constexpr float L2_THETA = 13.287712379549449f;

__device__ __forceinline__ void conv_item(const int tid, const Args& a, const LayerCtx& c, int item, LAS unsigned char* lds) {
    const int lane = tid & 63, wave = tid >> 6;
    LAS float* U = (LAS float*)lds; LAS float* CO = (LAS float*)lds;
    const int t0 = item * 64, b = t0 >> 13, s0 = t0 & (SEQ - 1);
#pragma unroll
    for (int i = 0; i < 6; ++i) { const int idx = tid + NTHREADS * i, row = idx >> 5, c8 = (idx & 31) * 8, sq = s0 - 15 + row;
        if (row < 94) { f32x4 u0 = {0.f, 0.f, 0.f, 0.f}, u1 = {0.f, 0.f, 0.f, 0.f};
            if (sq >= 0 && sq < SEQ) { const bf16_t* z = c.Z + (size_t)(b * SEQ + sq) * ZC; const R8 av = unpack8(*(const u32x4*)(z + ZC_CA + c8)), gv = unpack8(*(const u32x4*)(z + ZC_CG + c8));
#pragma unroll
                for (int e = 0; e < 4; ++e) { u0[e] = av.lo[e] * sigmoidf_(gv.lo[e]); u1[e] = av.hi[e] * sigmoidf_(gv.hi[e]); } }
            *(LAS f32x4*)(U + row * 256 + c8) = u0; *(LAS f32x4*)(U + row * 256 + c8 + 4) = u1; } }
    __syncthreads();
    { const int ch = tid & 255, half = tid >> 8; const float* dw = a.in[I_DWW] + (size_t)c.l * 31 * 256 + ch; const float bias = a.in[I_DWB][c.l * 256 + ch];
      float wv[31], win[62];
#pragma unroll
      for (int w = 0; w < 31; ++w) wv[w] = dw[w * 256];
#pragma unroll
      for (int r = 0; r < 62; ++r) win[r] = U[(half * 32 + r) * 256 + ch];
      __syncthreads();
#pragma unroll
      for (int o = 0; o < 32; ++o) { float acc = bias;
#pragma unroll
          for (int w = 0; w < 31; ++w) acc += win[o + w] * wv[w];
          CO[(half * 32 + o) * 256 + ch] = acc; } }
    __syncthreads();
    { const float* cg = a.in[I_CLG] + c.l * 256; const float* cb = a.in[I_CLB] + c.l * 256;
      const f32x4 gg = *(const f32x4*)(cg + 4 * lane), bb = *(const f32x4*)(cb + 4 * lane);
#pragma unroll
      for (int q0 = 0; q0 < 8; q0 += 4) { f32x4 x[4]; float mean[4], var[4];
#pragma unroll
          for (int q = 0; q < 4; ++q) { x[q] = *(const LAS f32x4*)(CO + (wave * 8 + q0 + q) * 256 + 4 * lane); mean[q] = (x[q].x + x[q].y) + (x[q].z + x[q].w); }
#pragma unroll
          for (int q = 0; q < 4; ++q) mean[q] = wave_sum(mean[q]);
#pragma unroll
          for (int q = 0; q < 4; ++q) { x[q] = x[q] - mean[q] * (1.f / 256.f); var[q] = (x[q].x * x[q].x + x[q].y * x[q].y) + (x[q].z * x[q].z + x[q].w * x[q].w); }
#pragma unroll
          for (int q = 0; q < 4; ++q) var[q] = wave_sum(var[q]);
#pragma unroll
          for (int q = 0; q < 4; ++q) { const float rstd = __builtin_amdgcn_rsqf(var[q] * (1.f / 256.f) + LN_EPS); f32x4 y = x[q] * rstd * gg + bb;
#pragma unroll
              for (int e = 0; e < 4; ++e) y[e] = y[e] * sigmoidf_(y[e]);
              u32x2 w; w.x = pk2(y.x, y.y); w.y = pk2(y.z, y.w); *(u32x2*)(c.FC + (size_t)(t0 + wave * 8 + q0 + q) * 512 + 256 + 4 * lane) = w; } } }
    __syncthreads();
}

struct QkRaw { u32x2 q; unsigned k; u32x2 cq; unsigned ckv; unsigned kr; };
struct QkConst { float qg0, qg1, qg2, qg3, kg0, kg1, fq0, fq1, fk, fr; };
__device__ __forceinline__ QkConst qkprep_const(const Args& a, const LayerCtx& c, int lane) { QkConst k;
    { const int p = 4 * (lane & 15), half = p >> 5, i0 = (p & 31) >> 1; const float* qg = a.in[I_QG] + c.l * 64 + half * 32;
      k.qg0 = qg[i0]; k.qg1 = qg[16 + i0]; k.qg2 = qg[i0 + 1]; k.qg3 = qg[16 + i0 + 1];
      k.fq0 = __builtin_amdgcn_exp2f(-(float)i0 * (L2_THETA / 16.f)); k.fq1 = __builtin_amdgcn_exp2f(-(float)(i0 + 1) * (L2_THETA / 16.f)); }
    { const int p = (2 * lane) & 63, half = p >> 5, i0 = (p & 31) >> 1; const float* kg = a.in[I_KG] + c.l * 64 + half * 32;
      k.kg0 = kg[i0]; k.kg1 = kg[16 + i0]; k.fk = __builtin_amdgcn_exp2f(-(float)i0 * (L2_THETA / 16.f)); }
    k.fr = __builtin_amdgcn_exp2f(-(float)(lane & 7) * (L2_THETA / 8.f)); return k; }
__device__ __forceinline__ QkRaw qkprep_load(const LayerCtx& c, int t, int lane) { const bf16_t* z = c.Z + (size_t)t * ZC; QkRaw r;
    r.q = *(const u32x2*)(z + ZC_Q + 4 * lane); r.k = *(const unsigned*)(z + ZC_K + 2 * lane); r.cq = *(const u32x2*)(z + ZC_CQ + 4 * lane); r.ckv = *(const unsigned*)(z + ZC_CKV + 2 * lane);
    r.kr = (lane < 16) ? *(const unsigned*)(z + ZC_KR + 2 * lane) : 0u; return r; }
__device__ __forceinline__ void qkprep_row(const LayerCtx& c, int t, int lane, const QkRaw& raw, const QkConst& kc) {
    const int s = t & (SEQ - 1); const float prow = (float)(s >> 6), pcol = (float)(s & 63);
    {
        const u32x2 w = raw.q; float x0 = bflo(w.x), x1 = bfhi(w.x), x2 = bflo(w.y), x3 = bfhi(w.y);
        float ss = (x0 * x0 + x1 * x1) + (x2 * x2 + x3 * x3);
        ss = rsum<1>(ss); ss = rsum<2>(ss); ss = rsum<4>(ss); ss = rsum<8>(ss);
        const float rstd = __builtin_amdgcn_rsqf(ss * (1.f / 64.f) + RMS_EPS);
        const int half = (lane & 15) >> 3;
        x0 *= rstd * kc.qg0; x1 *= rstd * kc.qg1; x2 *= rstd * kc.qg2; x3 *= rstd * kc.qg3;
        const float pos = half ? pcol : prow;
        rope2(x0, x1, pos * kc.fq0); rope2(x2, x3, pos * kc.fq1);
        u32x2 o; o.x = pk2(x0 * QSCALE_G, x1 * QSCALE_G); o.y = pk2(x2 * QSCALE_G, x3 * QSCALE_G); *(u32x2*)(c.QG + (size_t)t * 256 + 4 * lane) = o;
    }
    {
        const unsigned w = raw.k; float x0 = bflo(w), x1 = bfhi(w);
        float ss = x0 * x0 + x1 * x1;
        ss = rsum<1>(ss); ss = rsum<2>(ss); ss = rsum<4>(ss); ss = rsum<8>(ss); ss = rsum<16>(ss);
        const float rstd = __builtin_amdgcn_rsqf(ss * (1.f / 64.f) + RMS_EPS);
        const int half = (lane >> 4) & 1;
        x0 *= rstd * kc.kg0; x1 *= rstd * kc.kg1;
        rope2(x0, x1, (half ? pcol : prow) * kc.fk);
        *(unsigned*)(c.KG + (size_t)t * 128 + 2 * lane) = pk2(x0, x1);
    }
    {
        const u32x2 w = raw.cq; const float x0 = bflo(w.x), x1 = bfhi(w.x), x2 = bflo(w.y), x3 = bfhi(w.y);
        const float rstd = __builtin_amdgcn_rsqf(wave_sum((x0 * x0 + x1 * x1) + (x2 * x2 + x3 * x3)) * (1.f / 256.f) + RMS_EPS);
        u32x2 o; o.x = pk2(x0 * rstd, x1 * rstd); o.y = pk2(x2 * rstd, x3 * rstd); *(u32x2*)(c.CQKV + (size_t)t * 384 + 4 * lane) = o;
    }
    {
        const unsigned w = raw.ckv; const float x0 = bflo(w), x1 = bfhi(w);
        const float rstd = __builtin_amdgcn_rsqf(wave_sum(x0 * x0 + x1 * x1) * (1.f / 128.f) + RMS_EPS);
        *(unsigned*)(c.CQKV + (size_t)t * 384 + 256 + 2 * lane) = pk2(x0 * rstd, x1 * rstd);
    }
    if (lane < 16) {
        const unsigned w = raw.kr; float x0 = bflo(w), x1 = bfhi(w);
        const int half = lane >> 3;
        rope2(x0, x1, (half ? pcol : prow) * kc.fr);
        *(unsigned*)(c.KR + (size_t)t * 32 + 2 * lane) = pk2(x0, x1);
    }
}

__device__ __forceinline__ void dft_table(const int tid, LAS unsigned char* lds) {
    LAS f32x2* tw = (LAS f32x2*)lds;
    for (int m = tid; m < SEQ; m += NTHREADS) { const float x = (float)m * (1.f / 4096.f); tw[m] = (f32x2){cospif(x), sinpif(x)}; }
    __syncthreads();
}

namespace fft {
constexpr int L_XI = 16384, L_FI = 32768, L_CS = 65536;
__device__ __forceinline__ float cosrev(float x) { return __builtin_amdgcn_cosf(x); }
__device__ __forceinline__ float sinrev(float x) { return __builtin_amdgcn_sinf(x); }
__device__ __forceinline__ void build_table(const int tid, LAS unsigned char* lds) {
#pragma unroll 1
    for (int e = tid; e < 4096; e += NTHREADS) { const int lane = e & 63, cs = (e >> 6) & 1, ks = (e >> 7) & 7, nb = e >> 10; const int k1 = 32 * nb + (lane & 31), h = lane >> 5;
        unsigned w[4];
#pragma unroll
        for (int j = 0; j < 4; ++j) { const int m0 = ((16 * ks + 8 * h + 2 * j) * k1) & 127, m1 = ((16 * ks + 8 * h + 2 * j + 1) * k1) & 127; const float f0 = (float)m0 * (1.f / 128.f), f1 = (float)m1 * (1.f / 128.f);
            w[j] = cs ? pk2(sinrev(f0), sinrev(f1)) : pk2(cosrev(f0), cosrev(f1)); }
        *(LAS u32x4*)(lds + L_CS + e * 16) = (u32x4){w[0], w[1], w[2], w[3]}; }
}
struct F64Frags { bf16x8 c[2][2], s[2][2]; };
__device__ __forceinline__ void build_f64(const int tid, F64Frags& F) {
    const int wid = tid >> 6, lane = tid & 63, r32 = lane & 31, hi = lane >> 5, k2 = 32 * (wid >> 2) + r32;
#pragma unroll
    for (int mb = 0; mb < 2; ++mb)
#pragma unroll
        for (int st = 0; st < 2; ++st) { unsigned wc[4], wsn[4];
#pragma unroll
            for (int jj = 0; jj < 4; ++jj) { const int j0 = 2 * jj, j1 = 2 * jj + 1;
                const int sa = 32 * mb + 16 * st + 8 * (j0 >> 2) + 4 * hi + (j0 & 3), sb = 32 * mb + 16 * st + 8 * (j1 >> 2) + 4 * hi + (j1 & 3);
                const float fa = (float)((sa * k2) & 63) * (1.f / 64.f), fb = (float)((sb * k2) & 63) * (1.f / 64.f);
                wc[jj] = pk2(cosrev(fa), cosrev(fb)); wsn[jj] = pk2(sinrev(fa), sinrev(fb)); }
            F.c[mb][st] = __builtin_bit_cast(bf16x8, (u32x4){wc[0], wc[1], wc[2], wc[3]}); F.s[mb][st] = __builtin_bit_cast(bf16x8, (u32x4){wsn[0], wsn[1], wsn[2], wsn[3]}); }
}
__device__ __forceinline__ bf16x8 negbf(bf16x8 x) { u32x4 w = __builtin_bit_cast(u32x4, x); w ^= 0x80008000u; return __builtin_bit_cast(bf16x8, w); }
__device__ __forceinline__ void unit(const int tid, const LayerCtx& c, const unsigned* ZTb, const int u, LAS unsigned char* lds, const F64Frags& F) {
    const int wid = tid >> 6, lane = tid & 63, r32 = lane & 31, hi = lane >> 5, nb = wid & 3, kb = wid >> 2;
    const int b = u >> 7, g = (u >> 5) & 3, jp = u & 31;
    const unsigned* zp = ZTb + ((size_t)(b * 128 + g * 32 + jp)) * 8192;
#pragma unroll 4
    for (int i = 0; i < 16; ++i) { const int sx = tid + NTHREADS * i, s2 = sx & 63, s1 = sx >> 6; const unsigned w = zp[sx];
        const int off = s2 * 256 + ((((s1 >> 3) ^ (s2 & 15))) << 4) + (s1 & 7) * 2;
        *(LAS unsigned short*)(lds + off) = (unsigned short)(w & 0xffffu); *(LAS unsigned short*)(lds + L_XI + off) = (unsigned short)(w >> 16); }
    __syncthreads();
    f32x16 GR[2], GI[2];
#pragma unroll
    for (int mb = 0; mb < 2; ++mb) { GR[mb] = f32x16{}; GI[mb] = f32x16{}; }
#pragma unroll
    for (int ks = 0; ks < 8; ++ks) {
        const bf16x8 cf = *(const LAS bf16x8*)(lds + L_CS + ((nb * 8 + ks) * 2 + 0) * 1024 + lane * 16), sf = *(const LAS bf16x8*)(lds + L_CS + ((nb * 8 + ks) * 2 + 1) * 1024 + lane * 16);
#pragma unroll
        for (int mb = 0; mb < 2; ++mb) { const int row = 32 * mb + r32, off = row * 256 + (((2 * ks + hi) ^ (row & 15)) << 4);
            const bf16x8 xr = *(const LAS bf16x8*)(lds + off), xi = *(const LAS bf16x8*)(lds + L_XI + off); const bf16x8 nxr = negbf(xr);
            GR[mb] = __builtin_amdgcn_mfma_f32_32x32x16_bf16(xr, cf, GR[mb], 0, 0, 0); GR[mb] = __builtin_amdgcn_mfma_f32_32x32x16_bf16(xi, sf, GR[mb], 0, 0, 0);
            GI[mb] = __builtin_amdgcn_mfma_f32_32x32x16_bf16(xi, cf, GI[mb], 0, 0, 0); GI[mb] = __builtin_amdgcn_mfma_f32_32x32x16_bf16(nxr, sf, GI[mb], 0, 0, 0); }
    }
    const int k1 = 32 * nb + r32;
    bf16x8 ar[2][2], ai[2][2];
#pragma unroll
    for (int mb = 0; mb < 2; ++mb) {
#pragma unroll
        for (int r = 0; r < 16; ++r) { const int s2v = 32 * mb + (r & 3) + 8 * (r >> 2) + 4 * hi; const float fr = (float)((s2v * k1) & (SEQ - 1)) * (1.f / 8192.f);
            const float tc = cosrev(fr), ts = sinrev(fr), gr = GR[mb][r], gi = GI[mb][r]; GR[mb][r] = gr * tc + gi * ts; GI[mb][r] = gi * tc - gr * ts; }
#pragma unroll
        for (int st = 0; st < 2; ++st) {
            const u32x4 wr = {pk2(GR[mb][8 * st], GR[mb][8 * st + 1]), pk2(GR[mb][8 * st + 2], GR[mb][8 * st + 3]), pk2(GR[mb][8 * st + 4], GR[mb][8 * st + 5]), pk2(GR[mb][8 * st + 6], GR[mb][8 * st + 7])};
            const u32x4 wi = {pk2(GI[mb][8 * st], GI[mb][8 * st + 1]), pk2(GI[mb][8 * st + 2], GI[mb][8 * st + 3]), pk2(GI[mb][8 * st + 4], GI[mb][8 * st + 5]), pk2(GI[mb][8 * st + 6], GI[mb][8 * st + 7])};
            ar[mb][st] = __builtin_bit_cast(bf16x8, wr); ai[mb][st] = __builtin_bit_cast(bf16x8, wi); }
    }
    __syncthreads();
    f32x16 ZR = f32x16{}, ZI = f32x16{};
#pragma unroll
    for (int mb = 0; mb < 2; ++mb)
#pragma unroll
        for (int st = 0; st < 2; ++st) { const bf16x8 nar = negbf(ar[mb][st]);
            ZR = __builtin_amdgcn_mfma_f32_32x32x16_bf16(ar[mb][st], F.c[mb][st], ZR, 0, 0, 0); ZR = __builtin_amdgcn_mfma_f32_32x32x16_bf16(ai[mb][st], F.s[mb][st], ZR, 0, 0, 0);
            ZI = __builtin_amdgcn_mfma_f32_32x32x16_bf16(ai[mb][st], F.c[mb][st], ZI, 0, 0, 0); ZI = __builtin_amdgcn_mfma_f32_32x32x16_bf16(nar, F.s[mb][st], ZI, 0, 0, 0); }
    { const int k2 = 32 * kb + r32;
#pragma unroll
      for (int q = 0; q < 4; ++q) { const int kk = k2 * 128 + 32 * nb + 8 * q + 4 * hi;
          *(LAS f32x4*)(lds + kk * 4) = (f32x4){ZR[4 * q], ZR[4 * q + 1], ZR[4 * q + 2], ZR[4 * q + 3]}; *(LAS f32x4*)(lds + L_FI + kk * 4) = (f32x4){ZI[4 * q], ZI[4 * q + 1], ZI[4 * q + 2], ZI[4 * q + 3]}; } }
    __syncthreads();
    bf16_t* op = c.FC + (size_t)b * SEQ * 512 + g * 64 + 2 * jp;
#pragma unroll 4
    for (int i = 0; i < 16; ++i) { const int k = tid + NTHREADS * i, kr = (SEQ - k) & (SEQ - 1);
        const float a0 = *(const LAS float*)(lds + k * 4), a1 = *(const LAS float*)(lds + kr * 4); float y0 = a0, y1 = a1;
        if (jp == 0) { const float b0 = *(const LAS float*)(lds + L_FI + k * 4), b1 = *(const LAS float*)(lds + L_FI + kr * 4); y0 = 0.5f * (a0 + a1); y1 = 0.5f * (b0 + b1); }
        *(unsigned*)(op + (size_t)k * 512) = pk2(y0, y1); }
    __syncthreads();
}
}

struct AttnSrc { const bf16_t* Q; int qp; const bf16_t* K; int kp; const bf16_t* K2; int k2p; const bf16_t* V; int vp; bf16_t* O; int op; };
__device__ __forceinline__ AttnSrc gqa_src(unsigned char* ws, int b, int h) {
    AttnSrc A; const size_t r0 = (size_t)b * SEQ; unsigned char* r = ws + WS_R;
    A.Q = (const bf16_t*)(r + R_QG) + r0 * 256 + h * 64; A.qp = 256; A.K = (const bf16_t*)(r + R_KG) + r0 * 128 + (h >> 1) * 64; A.kp = 128; A.K2 = nullptr; A.k2p = 0;
    A.V = (const bf16_t*)(r + R_Z) + r0 * ZC + ZC_V + (h >> 1) * 64; A.vp = ZC; A.O = (bf16_t*)(r + R_YMIX) + r0 * 512 + h * 64; A.op = 512; return A;
}
__device__ __forceinline__ AttnSrc mla_src(unsigned char* ws, int b, int h) {
    AttnSrc A; const size_t r0 = (size_t)b * SEQ; unsigned char* r = ws + WS_R; const bf16_t* qkvm = (const bf16_t*)(r + R_QKVM);
    A.Q = qkvm + r0 * 1024 + h * 128; A.qp = 1024; A.K = qkvm + r0 * 1024 + 512 + h * 128; A.kp = 1024; A.K2 = (const bf16_t*)(r + R_KR) + r0 * 32; A.k2p = 32;
    A.V = qkvm + r0 * 1024 + 512 + h * 128 + 64; A.vp = 1024; A.O = (bf16_t*)(r + R_YMIX) + r0 * 512 + 256 + h * 64; A.op = 512; return A;
}

namespace att {
using s16x4 = __attribute__((ext_vector_type(4))) short;
constexpr float ATT_THR = 8.f;
#define ATT_SBAR() __builtin_amdgcn_sched_barrier(0)
__device__ __forceinline__ int crow(int r, int hi) { return (r & 3) + 8 * (r >> 2) + 4 * hi; }
__device__ __forceinline__ unsigned cvtpk(float lo, float hi) { unsigned r; asm volatile("v_cvt_pk_bf16_f32 %0, %1, %2" : "=v"(r) : "v"(lo), "v"(hi)); return r; }
template <int KROW> __device__ __forceinline__ int kswz(int row, int colB) { return (KROW == 128) ? row * 128 + (colB ^ (((row >> 1) & 7) << 4)) : row * 256 + (colB ^ ((row & 15) << 4)); }
__device__ __forceinline__ void partialSM(f32x16& p0, f32x16& p1, float& m_reg, f32x16& negm, float& alpha, const bool first) {
    float pa = fmaxf(fmaxf(p0[0], p0[1]), p0[2]), pb = fmaxf(fmaxf(p1[0], p1[1]), p1[2]);
#pragma unroll
    for (int r = 3; r < 15; r += 2) { pa = fmaxf(fmaxf(pa, p0[r]), p0[r + 1]); pb = fmaxf(fmaxf(pb, p1[r]), p1[r + 1]); }
    float pmax = fmaxf(fmaxf(pa, pb), fmaxf(p0[15], p1[15]));
    { auto rr = __builtin_amdgcn_permlane32_swap(__float_as_uint(pmax), __float_as_uint(pmax), false, false); pmax = fmaxf(__uint_as_float(rr[0]), __uint_as_float(rr[1])); }
    alpha = 1.f;
    if (first || !__all(pmax <= ATT_THR)) {
        const float delta = first ? pmax : fmaxf(pmax, 0.f);
        m_reg += delta; alpha = first ? 1.f : __builtin_amdgcn_exp2f(-delta);
#pragma unroll
        for (int r = 0; r < 16; ++r) { p0[r] -= delta; p1[r] -= delta; negm[r] = -m_reg; }
    }
#pragma unroll
    for (int r = 0; r < 16; ++r) p0[r] = __builtin_amdgcn_exp2f(p0[r]);
}
__device__ __forceinline__ void finishSM(f32x16& p0, f32x16& p1, bf16x8& pa0, bf16x8& pa1, bf16x8& pa2, bf16x8& pa3, float& lsum) {
#pragma unroll
    for (int r = 0; r < 16; ++r) p1[r] = __builtin_amdgcn_exp2f(p1[r]);
    { hwf2 a = hwf2{p0[0], p0[1]} + hwf2{p1[0], p1[1]};
#pragma unroll
      for (int r = 2; r < 16; r += 2) a += hwf2{p0[r], p0[r + 1]} + hwf2{p1[r], p1[r + 1]};
      lsum += a.x + a.y; }
#define ATT_PK4(P, BASE, OUT) do { unsigned a0 = cvtpk(P[BASE + 0], P[BASE + 1]), a1 = cvtpk(P[BASE + 2], P[BASE + 3]);   \
    unsigned b0 = cvtpk(P[BASE + 4], P[BASE + 5]), b1 = cvtpk(P[BASE + 6], P[BASE + 7]);                              \
    u32x4 w = {a0, a1, b0, b1}; OUT = __builtin_bit_cast(bf16x8, w); } while (0)
    ATT_PK4(p0, 0, pa0); ATT_PK4(p0, 8, pa1); ATT_PK4(p1, 0, pa2); ATT_PK4(p1, 8, pa3);
#undef ATT_PK4
}
template <int DK, int KROW>
__device__ __forceinline__ void qkt(f32x16& p0, f32x16& p1, const LAS unsigned char* Ks, const bf16x8* qr, const f32x16& negm, int r32, int hi) {
#pragma unroll
    for (int d0 = 0; d0 < DK / 16; ++d0) { const int cb = (d0 * 16 + hi * 8) * 2;
        const bf16x8 b0 = *(const LAS bf16x8*)(Ks + kswz<KROW>(r32, cb));
        const bf16x8 b1 = *(const LAS bf16x8*)(Ks + kswz<KROW>(32 + r32, cb));
        if (d0 == 0) { p0 = __builtin_amdgcn_mfma_f32_32x32x16_bf16(b0, qr[0], negm, 0, 0, 0); p1 = __builtin_amdgcn_mfma_f32_32x32x16_bf16(b1, qr[0], negm, 0, 0, 0); }
        else { p0 = __builtin_amdgcn_mfma_f32_32x32x16_bf16(b0, qr[d0], p0, 0, 0, 0); p1 = __builtin_amdgcn_mfma_f32_32x32x16_bf16(b1, qr[d0], p1, 0, 0, 0); } }
}
__device__ __forceinline__ int v_rd_base(int lane) { return ((lane & 3) << 3) | (((lane >> 2) & 3) << 6) | (((lane >> 4) & 1) << 5) | (((lane >> 5) & 1) << 8); }
constexpr int v_rd_off(int d0, int ks, int half) { return d0 * 512 + ks * 2048 + half * 1024; }
template <int OFF> __device__ __forceinline__ s16x4 tr_read(int vb) { s16x4 r; asm volatile("ds_read_b64_tr_b16 %0, %1 offset:%2" : "=&v"(r) : "v"(vb), "i"(OFF) : "memory"); return r; }
template <int KS> __device__ __forceinline__ void pv_half(f32x16* o, int vb, bf16x8 paA, bf16x8 paB) {
    const s16x4 a0 = tr_read<v_rd_off(0, KS, 0)>(vb), b0 = tr_read<v_rd_off(0, KS, 1)>(vb), c0 = tr_read<v_rd_off(1, KS, 0)>(vb), d0 = tr_read<v_rd_off(1, KS, 1)>(vb);
    const s16x4 a1 = tr_read<v_rd_off(0, KS + 1, 0)>(vb), b1 = tr_read<v_rd_off(0, KS + 1, 1)>(vb), c1 = tr_read<v_rd_off(1, KS + 1, 0)>(vb), d1 = tr_read<v_rd_off(1, KS + 1, 1)>(vb);
    asm volatile("s_waitcnt lgkmcnt(0)" ::: "memory"); ATT_SBAR();
#define ATT_PK(L, H) (bf16x8){L[0], L[1], L[2], L[3], H[0], H[1], H[2], H[3]}
    o[0] = __builtin_amdgcn_mfma_f32_32x32x16_bf16(paA, ATT_PK(a0, b0), o[0], 0, 0, 0); o[1] = __builtin_amdgcn_mfma_f32_32x32x16_bf16(paA, ATT_PK(c0, d0), o[1], 0, 0, 0);
    o[0] = __builtin_amdgcn_mfma_f32_32x32x16_bf16(paB, ATT_PK(a1, b1), o[0], 0, 0, 0); o[1] = __builtin_amdgcn_mfma_f32_32x32x16_bf16(paB, ATT_PK(c1, d1), o[1], 0, 0, 0);
#undef ATT_PK
}
__device__ __forceinline__ void pv_d0(f32x16* o, int vb, bf16x8 pa0, bf16x8 pa1, bf16x8 pa2, bf16x8 pa3) { pv_half<0>(o, vb, pa0, pa1); pv_half<2>(o, vb, pa2, pa3); }

#define ATT_WAITBAR(N) asm volatile("s_waitcnt vmcnt(" #N ") lgkmcnt(0)\n\ts_barrier" ::: "memory")
template <int DK>
__device__ __forceinline__ void unit(const int tid, const AttnSrc& A, const int q0, LAS unsigned char* lds) {
    constexpr int QP = (DK == 64) ? 256 : 1024, KP = (DK == 64) ? 128 : 1024, K2P = 32, VP = (DK == 64) ? ZC : 1024, OP = 512;
    constexpr int KROW = (DK == 64) ? 128 : 256, SHM_K = 64 * KROW, SHM_V = 64 * 64 * 2, ND = DK / 16, NT = SEQ / 64, NKI = SHM_K / 8192;
    const int wid = __builtin_amdgcn_readfirstlane(tid >> 6), lane = tid & 63, r32 = lane & 31, hi = lane >> 5;
    LAS unsigned char* V_lds = lds; LAS unsigned char* K_lds = lds + 3 * SHM_V;
    LAS float* al_l = (LAS float*)(lds + 3 * SHM_V + 3 * SHM_K) + wid * 32;
    float m_reg = 0.f, lsum = 0.f; f32x16 o[2] = {}; f32x16 negm = f32x16{}; bf16x8 qr[ND];
    const int qrow = q0 + wid * 32 + r32;
    const bf16_t* Qw = A.Q + (size_t)qrow * QP + hi * 8;
#pragma unroll
    for (int d0 = 0; d0 < ND; ++d0) qr[d0] = *(const bf16x8*)(Qw + d0 * 16);
    if constexpr (DK > 64) {
        const int sq = qrow & (SEQ - 1); const float prow = (float)(sq >> 6), pcol = (float)(sq & 63);
#pragma unroll
        for (int d0 = 4; d0 < 6; ++d0) { u32x4 w = __builtin_bit_cast(u32x4, qr[d0]); const float pos = (d0 == 4) ? prow : pcol;
#pragma unroll
            for (int j = 0; j < 4; ++j) { float x0 = bflo(w[j]), x1 = bfhi(w[j]); rope2(x0, x1, pos * __builtin_amdgcn_exp2f(-(float)(4 * hi + j) * (13.287712379549449f / 8.f))); w[j] = pk2i(x0, x1); }
            qr[d0] = __builtin_bit_cast(bf16x8, w); }
    }
    const bf16_t* Vsrc; const bf16_t* Ksrc[NKI]; int kstepE[NKI];
    { const int kk = 8 * wid + ((lane & 31) >> 2), kv = kk; Vsrc = A.V + (size_t)kv * VP + 32 * (lane >> 5) + 8 * (lane & 3); }
#pragma unroll
    for (int i = 0; i < NKI; ++i) {
        if constexpr (DK == 64) { const int row = 8 * wid + (lane >> 3), chunk = (lane & 7) ^ ((row >> 1) & 7); Ksrc[i] = A.K + (size_t)row * KP + chunk * 8; kstepE[i] = KP; }
        else { const int row = 4 * (i * 8 + wid) + (lane >> 4), chunk = (lane & 15) ^ (row & 15);
            if (chunk >= 8 && chunk < 12) { Ksrc[i] = A.K2 + (size_t)row * K2P + (chunk - 8) * 8; kstepE[i] = K2P; }
            else { Ksrc[i] = A.K + (size_t)row * KP + (chunk < 8 ? chunk : 0) * 8; kstepE[i] = KP; } }
    }
    const unsigned ldsw = (unsigned)wid * 1024u;
#define ATT_DMA_V(t, slot) __builtin_amdgcn_global_load_lds((const unsigned*)(Vsrc + (size_t)(t) * 64 * VP), (LAS unsigned*)(V_lds + (slot) * SHM_V + ldsw), 16, 0, 0)
#define ATT_DMA_K(t, slot) do { _Pragma("unroll") for (int i_ = 0; i_ < NKI; ++i_) \
        __builtin_amdgcn_global_load_lds((const unsigned*)(Ksrc[i_] + (size_t)(t) * 64 * kstepE[i_]), (LAS unsigned*)(K_lds + (slot) * SHM_K + i_ * 8192 + ldsw), 16, 0, 0); } while (0)
    const int vb0 = (int)(uintptr_t)V_lds + v_rd_base(lane);
#define ATT_RESC(a) do { if (__any((a) < 1.f)) { if (hi == 0) al_l[r32] = (a); asm volatile("s_waitcnt lgkmcnt(0)" ::: "memory"); \
    _Pragma("unroll") for (int d = 0; d < 2; ++d) _Pragma("unroll") for (int r = 0; r < 16; ++r) o[d][r] *= al_l[crow(r, hi)]; lsum *= (a); } } while (0)
    f32x16 pA0, pA1, pB0, pB1; float alA, alB; bf16x8 pa0, pa1, pa2, pa3;
    ATT_DMA_K(0, 0); ATT_DMA_V(0, 0); ATT_DMA_K(1, 1);
    ATT_WAITBAR(0);
    ATT_DMA_K(2, 2); ATT_DMA_V(1, 1);
    qkt<DK, KROW>(pA0, pA1, K_lds, qr, negm, r32, hi); partialSM(pA0, pA1, m_reg, negm, alA, true);
    if constexpr (NKI == 1) ATT_WAITBAR(2); else ATT_WAITBAR(3);
#define ATT_STEP(PC0, PC1, PP0, PP1, ALC, j, SK, SV) do { \
        const bool hk_ = (j) + 2 < NT, hv_ = (j) + 1 < NT; \
        if (hk_) ATT_DMA_K((j) + 2, ((SK) + 2) % 3); if (hv_) ATT_DMA_V((j) + 1, ((SV) + 2) % 3); \
        ATT_SBAR(); qkt<DK, KROW>(PC0, PC1, K_lds + (SK) * SHM_K, qr, negm, r32, hi); \
        finishSM(PP0, PP1, pa0, pa1, pa2, pa3, lsum); ATT_SBAR(); \
        pv_d0(o, vb0 + (SV) * SHM_V, pa0, pa1, pa2, pa3); partialSM(PC0, PC1, m_reg, negm, ALC, false); \
        if (hk_) { if constexpr (NKI == 1) ATT_WAITBAR(2); else ATT_WAITBAR(3); } else if (hv_) ATT_WAITBAR(1); else ATT_WAITBAR(0); \
        ATT_RESC(ALC); } while (0)
    static_assert((NT - 2) % 6 == 0, "steps 1 .. NT-2 are a whole number of 6-step periods");
#pragma unroll 1
    for (int j = 1; j + 1 < NT; j += 6) {
        ATT_STEP(pB0, pB1, pA0, pA1, alB, j,     1, 0);
        ATT_STEP(pA0, pA1, pB0, pB1, alA, j + 1, 2, 1);
        ATT_STEP(pB0, pB1, pA0, pA1, alB, j + 2, 0, 2);
        ATT_STEP(pA0, pA1, pB0, pB1, alA, j + 3, 1, 0);
        ATT_STEP(pB0, pB1, pA0, pA1, alB, j + 4, 2, 1);
        ATT_STEP(pA0, pA1, pB0, pB1, alA, j + 5, 0, 2);
    }
    ATT_STEP(pB0, pB1, pA0, pA1, alB, NT - 1, (NT - 1) % 3, (NT - 2) % 3);
    finishSM(pB0, pB1, pa0, pa1, pa2, pa3, lsum); ATT_SBAR();
    pv_d0(o, vb0 + ((NT - 1) % 3) * SHM_V, pa0, pa1, pa2, pa3);
    float rli[16];
    { auto rr = __builtin_amdgcn_permlane32_swap(__float_as_uint(lsum), __float_as_uint(lsum), false, false); const float lt = __uint_as_float(rr[0]) + __uint_as_float(rr[1]);
      asm volatile("s_waitcnt lgkmcnt(0)" ::: "memory"); if (hi == 0) al_l[r32] = lt; asm volatile("s_waitcnt lgkmcnt(0)" ::: "memory");
#pragma unroll
      for (int r = 0; r < 16; ++r) rli[r] = __builtin_amdgcn_rcpf(al_l[crow(r, hi)]); }
    bf16_t* Ow = A.O + (size_t)(q0 + wid * 32) * OP + ((lane & 1) ? 32 + r32 - 1 : r32);
#pragma unroll
    for (int r = 0; r < 16; ++r) { const float a0 = o[0][r] * rli[r], a1 = o[1][r] * rli[r];
        const float got = dppf<0xB1>((lane & 1) ? a0 : a1);
        *(unsigned*)(Ow + (size_t)crow(r, hi) * OP) = (lane & 1) ? pk2(got, a1) : pk2(a0, got); }
    ATT_WAITBAR(0);
#undef ATT_DMA_V
#undef ATT_DMA_K
#undef ATT_RESC
#undef ATT_STEP
}
#undef ATT_WAITBAR
#undef ATT_SBAR
}

__device__ __forceinline__ void grpnorm_hi_rows8(const LayerCtx& c, int t0, int tstride, int lane) {
    R8 v[8]; float ss[8];
#pragma unroll
    for (int q = 0; q < 8; ++q) { v[q] = unpack8(*(const u32x4*)((const bf16_t*)c.YMIX + (size_t)(t0 + q * tstride) * 512 + 8 * lane)); ss[q] = hsq8(v[q]); }
#pragma unroll
    for (int q = 0; q < 8; ++q) { float x = ss[q]; x = rsum<1>(x); x = rsum<2>(x); x = rsum<4>(x); x = rsum<8>(x); ss[q] = rsum<16>(x); }
#pragma unroll
    for (int q = 0; q < 8; ++q) { const float r = __builtin_amdgcn_rsqf(ss[q] * (1.f / 256.f) + RMS_EPS);
        *(u32x4*)(c.Y + (size_t)(t0 + q * tstride) * 1024 + 512 + 8 * lane) = pk8(v[q].lo * r, v[q].hi * r); }
}
template <int NR>
__device__ __forceinline__ void resln_load(const LayerCtx& c, int t0, int tstride, int lane, u32x4 (&hw)[NR][2], u32x4 (&fw)[NR][2]) {
#pragma unroll
    for (int q = 0; q < NR; ++q) { const bf16_t* hr = c.HB + (size_t)(t0 + q * tstride) * D; const bf16_t* fr = c.FB + (size_t)(t0 + q * tstride) * D;
#pragma unroll
        for (int j = 0; j < 2; ++j) { hw[q][j] = *(const u32x4*)(hr + 512 * j + 8 * lane); fw[q][j] = *(const u32x4*)(fr + 512 * j + 8 * lane); } }
}
template <int NR>
__device__ __forceinline__ void resln_finish(const LayerCtx& c, int t0, int tstride, const float* g, const float* b, int lane, const u32x4 (&hw)[NR][2], const u32x4 (&fw)[NR][2], R8 (&v)[NR][2]) {
#pragma unroll
    for (int q = 0; q < NR; ++q)
#pragma unroll
        for (int j = 0; j < 2; ++j) { const R8 h = unpack8(hw[q][j]), f = unpack8(fw[q][j]); v[q][j].lo = h.lo * DN_ALPHA + f.lo; v[q][j].hi = h.hi * DN_ALPHA + f.hi; }
    ln_rows<NR>(v, g, b, lane);
#pragma unroll
    for (int q = 0; q < NR; ++q) store_row_bf16(c.HB + (size_t)(t0 + q * tstride) * D, v[q], lane);
}
template <int NR>
__device__ __forceinline__ void resln_rows(const LayerCtx& c, int t0, int tstride, const float* g, const float* b, int lane, R8 (&v)[NR][2]) {
    u32x4 hw[NR][2], fw[NR][2];
    resln_load<NR>(c, t0, tstride, lane, hw, fw);
    resln_finish<NR>(c, t0, tstride, g, b, lane, hw, fw, v);
}
constexpr int RT_LO = 65536, RT_LOGT = 40960;
__device__ __forceinline__ void ln2_router_group(const int tid, const Args& a, const LayerCtx& c, const int grp, const int grp_next, LAS unsigned char* lds, const bf16x8 (&bh)[8], const bf16x8 (&bl)[8], LAS unsigned* lcnt, u32x4 (&hw)[4][2], u32x4 (&fw)[4][2]) {
    const int wid = tid >> 6, lane = tid & 63, r32 = lane & 31, hi = lane >> 5;
    { R8 v[4][2];
      resln_finish<4>(c, grp * 32 + wid * 4, 1, a.in[I_LN2G] + c.l * D, a.in[I_LN2B] + c.l * D, lane, hw, fw, v);
#pragma unroll
      for (int q = 0; q < 4; ++q) { const int row = wid * 4 + q;
#pragma unroll
          for (int j = 0; j < 2; ++j) { const int chunk = 64 * j + lane; const int off = row * 2048 + ((chunk ^ (row & 15)) << 4);
              const R8 x = v[q][j]; const unsigned h0 = f2bf(x.lo.x), h1 = f2bf(x.lo.y), h2 = f2bf(x.lo.z), h3 = f2bf(x.lo.w), h4 = f2bf(x.hi.x), h5 = f2bf(x.hi.y), h6 = f2bf(x.hi.z), h7 = f2bf(x.hi.w);
              const u32x4 wh = {h0 | (h1 << 16), h2 | (h3 << 16), h4 | (h5 << 16), h6 | (h7 << 16)};
              const u32x4 wl = {pk2(x.lo.x - bf2f(h0), x.lo.y - bf2f(h1)), pk2(x.lo.z - bf2f(h2), x.lo.w - bf2f(h3)), pk2(x.hi.x - bf2f(h4), x.hi.y - bf2f(h5)), pk2(x.hi.z - bf2f(h6), x.hi.w - bf2f(h7))};
              *(LAS u32x4*)(lds + off) = wh; *(LAS u32x4*)(lds + RT_LO + off) = wl; } } }
    resln_load<4>(c, (grp_next < T / 32 ? grp_next : grp) * 32 + wid * 4, 1, lane, hw, fw);
    __syncthreads();
    f32x16 acc = f32x16{};
#pragma unroll
    for (int ks = 0; ks < 8; ++ks) { const int chunk = 16 * wid + 2 * ks + hi; const int off = r32 * 2048 + ((chunk ^ (r32 & 15)) << 4);
        const bf16x8 ah = *(const LAS bf16x8*)(lds + off), al = *(const LAS bf16x8*)(lds + RT_LO + off);
        acc = __builtin_amdgcn_mfma_f32_32x32x16_bf16(ah, bh[ks], acc, 0, 0, 0); acc = __builtin_amdgcn_mfma_f32_32x32x16_bf16(ah, bl[ks], acc, 0, 0, 0); acc = __builtin_amdgcn_mfma_f32_32x32x16_bf16(al, bh[ks], acc, 0, 0, 0); }
    __syncthreads();
    { LAS float* red = (LAS float*)lds;
#pragma unroll
      for (int r = 0; r < 16; ++r) { const int tok = (r & 3) + 8 * (r >> 2) + 4 * hi; red[(wid * 32 + tok) * 33 + r32] = acc[r]; } }
    __syncthreads();
    { const LAS float* red = (const LAS float*)lds; LAS float* logt = (LAS float*)(lds + RT_LOGT); const float* br = a.in[I_BR] + c.l * 32;
#pragma unroll
      for (int i = 0; i < 2; ++i) { const int idx = tid + NTHREADS * i, tok = idx >> 5, e = idx & 31; float sres = br[e];
#pragma unroll
          for (int w = 0; w < 8; ++w) sres += red[(w * 32 + tok) * 33 + e];
          logt[tok * 33 + e] = sres; } }
    __syncthreads();
    { const LAS float* logt = (const LAS float*)(lds + RT_LOGT);
#pragma unroll 1
      for (int q = 0; q < 4; ++q) { const int tok = wid * 4 + q, t = grp * 32 + tok;
          float mine = (lane < 32) ? logt[tok * 33 + lane] : -3.0e38f;
          float tv[4]; int ti[4];
#pragma unroll
          for (int k = 0; k < 4; ++k) { const float best = wave_max(mine); const unsigned long long mk = __ballot(mine == best); const int bi = __ffsll((long long)mk) - 1;
              tv[k] = best; ti[k] = bi; if (lane == bi) mine = -3.0e38f; }
          const float e1 = __expf(tv[1] - tv[0]), e2 = __expf(tv[2] - tv[0]), e3 = __expf(tv[3] - tv[0]); const float rs = 1.f / (1.f + e1 + e2 + e3);
          if (lane < 4) { const int e = lane == 0 ? ti[0] : lane == 1 ? ti[1] : lane == 2 ? ti[2] : ti[3]; const float gt = (lane == 0 ? 1.f : lane == 1 ? e1 : lane == 2 ? e2 : e3) * rs;
              const unsigned rank = __hip_atomic_fetch_add(lcnt + e, 1u, __ATOMIC_RELAXED, __HIP_MEMORY_SCOPE_WORKGROUP);
              c.RE[t * 4 + lane] = e; c.RR[t * 4 + lane] = (int)rank; c.GATE[t * 4 + lane] = gt; } } }
    __syncthreads();
}
constexpr int TBL_OFF = 131072, TBL_PSTART = TBL_OFF + 2304, TBL_NBLK = TBL_PSTART + 256, TBL_WBASE = TBL_NBLK + 64, TBL_CNT = TBL_WBASE + 128, TBL_PART = TBL_OFF + 4096, TBL_LCNT = TBL_OFF + 8192;
__device__ __forceinline__ void moe_tables(const int tid, const int bid, const LayerCtx& c, LAS unsigned char* lds) {
    LAS int* blk_e = (LAS int*)(lds + TBL_OFF); LAS int* pstart = (LAS int*)(lds + TBL_PSTART); LAS int* nblk = (LAS int*)(lds + TBL_NBLK); LAS int* wbase = (LAS int*)(lds + TBL_WBASE);
    LAS int* cntL = (LAS int*)(lds + TBL_CNT); LAS int* part = (LAS int*)(lds + TBL_PART);
    { const int e = tid & 31, pr = tid >> 5; int tot = 0, pf = 0;
#pragma unroll 4
      for (int w = pr * 16; w < pr * 16 + 16; ++w) { const int v = (int)__hip_atomic_load(c.cnt + w * 32 + e, RLX_AGENT); tot += v; pf += (w < bid) ? v : 0; }
      part[pr * 32 + e] = tot; part[512 + pr * 32 + e] = pf; }
    __syncthreads();
    if (tid < 32) { int tot = 0, pf = 0;
#pragma unroll 4
        for (int pr = 0; pr < 16; ++pr) { tot += part[pr * 32 + tid]; pf += part[512 + pr * 32 + tid]; }
        cntL[tid] = tot; wbase[tid] = pf; }
    __syncthreads();
    if (tid < 32) { int pos = 0;
#pragma unroll 1
        for (int e = 0; e < tid; ++e) pos += (cntL[e] + 255) >> 8;
        pstart[tid] = pos * 256; wbase[tid] += pos * 256;
        if (tid == 31) nblk[0] = pos + ((cntL[31] + 255) >> 8); }
    __syncthreads();
#pragma unroll 1
    for (int rb = tid; rb < MOE_MAXBLK; rb += NTHREADS) { int e = 0;
#pragma unroll 1
        for (int q = 1; q < NE; ++q) e += (pstart[q] <= rb * 256) ? 1 : 0;
        blk_e[rb] = e; }
    __syncthreads();
}
__device__ __forceinline__ void gather_rows2(const LayerCtx& c, int t0, int lane, const LAS int* wbase) {
    u32x4 hv[2][2]; int dest[2][4];
#pragma unroll
    for (int q = 0; q < 2; ++q) { const int t = t0 + q;
        hv[q][0] = *(const u32x4*)(c.HB + (size_t)t * D + 8 * lane); hv[q][1] = *(const u32x4*)(c.HB + (size_t)t * D + 512 + 8 * lane);
        const u32x4 e4 = *(const u32x4*)(c.RE + t * 4), r4 = *(const u32x4*)(c.RR + t * 4);
#pragma unroll
        for (int k = 0; k < 4; ++k) dest[q][k] = wbase[e4[k]] + (int)r4[k]; }
#pragma unroll
    for (int q = 0; q < 2; ++q) { const int t = t0 + q;
#pragma unroll
        for (int k = 0; k < 4; ++k) { *(u32x4*)(c.XS + (size_t)dest[q][k] * D + 8 * lane) = hv[q][0]; *(u32x4*)(c.XS + (size_t)dest[q][k] * D + 512 + 8 * lane) = hv[q][1]; }
        if (lane == 0) *(u32x4*)(c.DEST + t * 4) = (u32x4){(unsigned)dest[q][0], (unsigned)dest[q][1], (unsigned)dest[q][2], (unsigned)dest[q][3]}; }
}
__device__ __forceinline__ void combine_idx(const LayerCtx& c, int t0, int tstride, u32x4 (&dn)[2], f32x4 (&gn)[2]) {
#pragma unroll
    for (int q = 0; q < 2; ++q) { const int t = t0 + q * tstride; dn[q] = *(const u32x4*)(c.DEST + t * 4); gn[q] = *(const f32x4*)(c.GATE + t * 4); } }
__device__ __forceinline__ void combine_rows2(const Args& a, const LayerCtx& c, int t0, int tnext, int tstride, int lane, float* out2, u32x4 (&dn)[2], f32x4 (&gn)[2]) {
    u32x4 d4[2]; f32x4 g4[2]; u32x4 hw[2][2], yw[2][4][2];
#pragma unroll
    for (int q = 0; q < 2; ++q) { const int t = t0 + q * tstride; d4[q] = dn[q]; g4[q] = gn[q];
        hw[q][0] = *(const u32x4*)(c.HB + (size_t)t * D + 8 * lane); hw[q][1] = *(const u32x4*)(c.HB + (size_t)t * D + 512 + 8 * lane); }
#pragma unroll
    for (int q = 0; q < 2; ++q)
#pragma unroll
        for (int k = 0; k < 4; ++k) { const bf16_t* y = c.YS + (size_t)d4[q][k] * D; yw[q][k][0] = *(const u32x4*)(y + 8 * lane); yw[q][k][1] = *(const u32x4*)(y + 512 + 8 * lane); }
    combine_idx(c, tnext, tstride, dn, gn);
    R8 v[2][2];
#pragma unroll
    for (int q = 0; q < 2; ++q)
#pragma unroll
        for (int j = 0; j < 2; ++j) { const R8 h = unpack8(hw[q][j]); v[q][j].lo = h.lo * DN_ALPHA; v[q][j].hi = h.hi * DN_ALPHA;
#pragma unroll
            for (int k = 0; k < 4; ++k) { const R8 y = unpack8(yw[q][k][j]); v[q][j].lo += y.lo * g4[q][k]; v[q][j].hi += y.hi * g4[q][k]; } }
    ln_rows<2>(v, a.in[I_LN3G] + c.l * D, a.in[I_LN3B] + c.l * D, lane);
#pragma unroll
    for (int q = 0; q < 2; ++q) { const int t = t0 + q * tstride; store_row_bf16(c.HB + (size_t)t * D, v[q], lane); if (out2) store_row_f32(out2 + (size_t)t * D, v[q], lane); }
}
constexpr int NPH_LAYER = 17, NPH_PRE = 3, NPHASES = NPH_PRE + NLAYER * NPH_LAYER;
#ifndef USE_PG8
#define USE_PG8 1
#endif
#if USE_PG8
#define GEMM_CALL(PAIR, g, S, E) do { int tid_ = tid; asm volatile("" : "+v"(tid_)); pg8::gemm_phase<PAIR, false>(tid_, lds, g, S, E); } while (0)
#define GEMM_CALL_GATHER(PAIR, g, S, E) do { int tid_ = tid; asm volatile("" : "+v"(tid_)); pg8::gemm_phase<PAIR, true>(tid_, lds, g, S, E); } while (0)
#else
#define GEMM_CALL(PAIR, g, S, E) sgemm_phase<PAIR>(tid, g, S, E)
#endif

__global__ void __launch_bounds__(NTHREADS, 2) fwd(Args a) {
    extern __shared__ __attribute__((aligned(16))) unsigned char lds_raw[];
    LAS unsigned char* lds = (LAS unsigned char*)lds_raw;
    volatile LAS unsigned* MISC = (volatile LAS unsigned*)(lds + MISC_OFF);
    const int G = gridDim.x, NGW = G * NWAVES;
    const int wave_s = __builtin_amdgcn_readfirstlane((int)threadIdx.x >> 6);
#define HW_TID() (wave_s * 64 + hw_lane())
    if (threadIdx.x < 64) MISC[threadIdx.x] = 0u;
    __syncthreads();
    unsigned* ctl = (unsigned*)(a.ws + WS_CTL);
    XcdBarrier bar; bar.bar = ctl + CW_BAR; bar.x = 0; bar.st = nullptr;
    if (N_LAUNCH_MODE == 1) bar = xcd_barrier_post(ctl + CW_BAR, MISC + 8, (int)threadIdx.x);
    const int lo = a.lo, hi = a.hi;
#define PH_TID int tid = HW_TID(); asm volatile("" : "+v"(tid)); int bid = blockIdx.x; asm volatile("" : "+s"(bid)); const __attribute__((address_space(4))) Args* ap_ = (const __attribute__((address_space(4))) Args*)__builtin_amdgcn_kernarg_segment_ptr(); asm volatile("" : "+s"(ap_)); const Args& a = *(const Args*)ap_; const int lane = tid & 63, wave = tid >> 6, gw = bid * NWAVES + wave; (void)lane; (void)gw
#define PH_BEGIN int lv = l; asm volatile("" : "+s"(lv)); PH_TID; const LayerCtx c = make_ctx(a, lv)
#define IN(k) (lo <= (k) && (k) < hi)
#define SEAM(k) do { if (N_LAUNCH_MODE == 1 && IN(k) && IN((k) + 1)) xcd_barrier(bar, HW_TID()); } while (0)

    if (IN(0)) { PH_TID; phase_pre0(tid, bid, a, lds); } SEAM(0);
    if (IN(1)) { PH_TID;
        GemmDesc g{(const bf16_t*)a.ws, (const bf16_t*)a.ws, 1024, 1024, 1024}; PreOrder S{G, bid}; EpiPre E{a.ws};
        GEMM_CALL(false, g, S, E);
    } SEAM(1);
    if (IN(2)) { PH_TID;
        GemmDesc g{(const bf16_t*)a.ws, (const bf16_t*)a.ws, 1024, 1024, 256}; Pre2Order S{G, bid}; EpiPre2 E{a.ws};
        GEMM_CALL(false, g, S, E);
    } SEAM(2);

    for (int l = 0; l < NLAYER; ++l) {
        const int pb = NPH_PRE + NPH_LAYER * l;
        if (IN(pb + 0)) { PH_BEGIN;
            GemmDesc g{c.HB, (const bf16_t*)(c.wl + WL_IN), 1024, 1024, 1024}; TileOrder S; S.init(T / 256, ZC / 256, G, bid, 0, 1024, 1024);
            EpiInProj E{c.Z, (unsigned*)(a.ws + WS_ZT)}; GEMM_CALL(false, g, S, E);
            if (bid >= 128) { __syncthreads(); int tw = HW_TID(); asm volatile("" : "+v"(tw)); moe_weight_range(tw, (bid - 128) * NWAVES + (tw >> 6), 128 * NWAVES, lv * IT_MOE + (IT_MOE - IT_TAIL), (lv + 1) * IT_MOE, 0x7fffffff, a, lds); __syncthreads(); }
        } SEAM(pb + 0);
        if (IN(pb + 1)) { PH_BEGIN;
            { fft::build_table(tid, lds); fft::F64Frags FF; fft::build_f64(tid, FF); __syncthreads();
              for (int i = 0; i < 2; ++i) fft::unit(tid, c, (const unsigned*)(a.ws + WS_ZT), ((i * 8 + (bid & 7)) << 5) | (bid >> 3), lds, FF); }
            __syncthreads();
            for (int it = bid; it < T / 64; it += G) conv_item(tid, a, c, it, lds);
            const QkConst kc = qkprep_const(a, c, lane);
            for (int t = gw; t < T; t += 4 * NGW) { QkRaw raw[4];
#pragma unroll
                for (int q = 0; q < 4; ++q) raw[q] = qkprep_load(c, t + q * NGW, lane);
#pragma unroll
                for (int q = 0; q < 4; ++q) qkprep_row(c, t + q * NGW, lane, raw[q], kc); }
        } SEAM(pb + 1);
        if (IN(pb + 2)) { PH_BEGIN;
            { GemmDesc g{c.CQKV, (const bf16_t*)(c.wl + WL_MLA), 384, 384, 384}; TileOrder S; S.init(T / 256, 4, G, bid, 0, 384, 384);
              EpiBf16 E{c.QKVM, 1024, nullptr}; GEMM_CALL(false, g, S, E); }
            { GemmDesc g{c.FC, (const bf16_t*)(c.wl + WL_FC), 512, 256, 256}; TileOrder S; S.init(T / 256, 2, G, bid, 1, 512, 256);
              EpiFCN E{c.Y, a.in[I_BF] + lv * 256, a.in[I_BPW] + lv * 256, lds}; GEMM_CALL(false, g, S, E); }
        } SEAM(pb + 2);
        if (IN(pb + 3)) { PH_BEGIN;
            for (int U = bid; U < 1024; U += G) { const int hx = ((U >> 8) & 1) * 8 + (bid & 7), b = hx >> 2, h = hx & 3, qb = bid >> 3;
                if (lv == 0 && (U >> 8) == ((bid >> 3) & 3)) { int tw = tid; asm volatile("" : "+v"(tw)); moe_weight_range(tw, bid * NWAVES + (tw >> 6), 256 * NWAVES, 0, NLAYER * (IT_MOE - IT_TAIL), IT_MOE - IT_TAIL, a, lds); __syncthreads(); }
                unsigned char* wsb = a.ws; asm volatile("" : "+s"(wsb));
                int tu = tid; asm volatile("" : "+v"(tu));
                if (U < 512) { const AttnSrc A = gqa_src(wsb, b, h); att::unit<64>(tu, A, qb * 256, lds); }
                else         { const AttnSrc A = mla_src(wsb, b, h); att::unit<96>(tu, A, qb * 256, lds); } }
        } SEAM(pb + 3);
        if (IN(pb + 4)) { PH_BEGIN; for (int t = gw; t < T; t += 8 * NGW) grpnorm_hi_rows8(c, t, NGW, lane); } SEAM(pb + 4);
        if (IN(pb + 5)) { PH_BEGIN;
            GemmDesc g{c.Y, (const bf16_t*)(c.wl + WL_O), 1024, 1024, 1024}; TileOrder S; S.init(T / 256, 4, G, bid, 0, 1024, 1024);
            EpiBf16 E{c.FB, 1024, nullptr}; GEMM_CALL(false, g, S, E);
        } SEAM(pb + 5);
        if (IN(pb + 6)) { PH_BEGIN; for (int t = gw; t < T; t += 4 * NGW) { R8 v[4][2]; resln_rows<4>(c, t, NGW, a.in[I_LN1G] + lv * D, a.in[I_LN1B] + lv * D, lane, v); } } SEAM(pb + 6);
        if (IN(pb + 7)) { PH_BEGIN;
            GemmDesc g{c.HB, (const bf16_t*)(a.ws + WS_MT + (size_t)((lv * 2 + 0) * 4) * 2 * MiB), 1024, 1024, 1024}; TileOrder S; S.init(T / 256, 4, G, bid, 4, 1024, 1024);
            EpiXSN E{c.PB, lds}; GEMM_CALL(false, g, S, E);
        } SEAM(pb + 10);
        if (IN(pb + 11)) { PH_BEGIN;
            GemmDesc g{c.PB, (const bf16_t*)(a.ws + WS_MT + (size_t)((lv * 2 + 1) * 4) * 2 * MiB), 1024, 1024, 1024}; TileOrder S; S.init(T / 256, 4, G, bid, 4, 1024, 1024);
            EpiBf16 E{c.FB, 1024, nullptr}; GEMM_CALL(false, g, S, E);
        } SEAM(pb + 11);
        if (IN(pb + 12)) { PH_BEGIN; LAS unsigned* lcnt = (LAS unsigned*)(lds + TBL_LCNT);
            if (tid < 32) lcnt[tid] = 0u;
            bf16x8 bh[8], bl[8];
            { const bf16_t* wr = (const bf16_t*)(c.wl + WL_RT) + (size_t)(lane & 31) * 1024 + 128 * wave + 8 * (lane >> 5);
#pragma unroll
              for (int ks = 0; ks < 8; ++ks) { bh[ks] = *(const bf16x8*)(wr + 16 * ks); bl[ks] = *(const bf16x8*)(wr + 32768 + 16 * ks); } }
            __syncthreads();
            { u32x4 hw[4][2], fw[4][2]; static_assert(MAXWG <= T / 32, "every workgroup has a first group"); resln_load<4>(c, bid * 32 + wave * 4, 1, lane, hw, fw);
              for (int grp = bid; grp < T / 32; grp += G) ln2_router_group(tid, a, c, grp, grp + G, lds, bh, bl, lcnt, hw, fw); }
            __syncthreads();
            if (tid < 32) __hip_atomic_store(c.cnt + bid * 32 + tid, lcnt[tid], RLX_AGENT);
        } SEAM(pb + 12);
        if (IN(pb + 13)) { PH_BEGIN; moe_tables(tid, bid, c, lds); const LAS int* wbase = (const LAS int*)(lds + TBL_WBASE);
            { const int gi = tid >> 7, pr = tid & 127; const int grp = bid + G * gi;
              if (grp < T / 32) { const int t = grp * 32 + (pr >> 2), k = pr & 3; const int dest = wbase[c.RE[t * 4 + k]] + c.RR[t * 4 + k]; c.TOK[dest] = t; c.DEST[t * 4 + k] = dest; } }
        } SEAM(pb + 13);
        if (IN(pb + 14)) { PH_BEGIN;
            const int nblk = *(const LAS int*)(lds + TBL_NBLK);
            GemmDesc g{c.HB, (const bf16_t*)(c.wl + WL_GU), 1024, 1024, 1024, c.TOK}; MoeOrder S{(const LAS int*)(lds + TBL_OFF), nblk, 8, G, bid};
            EpiGU E{c.ACT, a.in[I_BGU] + (size_t)lv * NE * 2048, lds}; GEMM_CALL_GATHER(true, g, S, E);
        } SEAM(pb + 14);
        if (IN(pb + 15)) { PH_BEGIN;
            const int nblk = *(const LAS int*)(lds + TBL_NBLK);
            GemmDesc g{c.ACT, (const bf16_t*)(c.wl + WL_DN), 1024, 1024, 1024}; MoeOrder S{(const LAS int*)(lds + TBL_OFF), nblk, 4, G, bid};
            EpiDown E{c.YS, a.in[I_BDN] + (size_t)lv * NE * 1024, lds}; GEMM_CALL(false, g, S, E);
        } SEAM(pb + 15);
        if (IN(pb + 16)) { PH_BEGIN; u32x4 dn[2]; f32x4 gn[2]; combine_idx(c, gw, NGW, dn, gn);
            for (int t = gw; t < T; t += 2 * NGW) combine_rows2(a, c, t, (t + 2 * NGW < T) ? t + 2 * NGW : t, NGW, lane, (lv == NLAYER - 1) ? a.out : nullptr, dn, gn); } SEAM(pb + 16);
    }
#undef IN
#undef SEAM
}

extern "C" void kernel_launch(void* const* d_in, const int* in_sizes, int n_in, void* d_out, int out_size, void* d_ws, size_t ws_size, hipStream_t stream) {
    static int grid = 0;
    if (grid == 0) {
        if (n_in != 37 || in_sizes[0] != T * D || out_size != T * D || ws_size < WS_END) {
            fprintf(stderr, "kernel_launch: unexpected shapes: n_in %d in0 %d out %d ws %zu (need %zu)\n", n_in, n_in > 0 ? in_sizes[0] : -1, out_size, ws_size, (size_t)WS_END); grid = -1; return; }
        int dev = 0, cus = 0;
        if (hipGetDevice(&dev) != hipSuccess || hipDeviceGetAttribute(&cus, hipDeviceAttributeMultiprocessorCount, dev) != hipSuccess) { grid = -1; return; }
        if (hipFuncSetAttribute((const void*)fwd, hipFuncAttributeMaxDynamicSharedMemorySize, LDS_BYTES) != hipSuccess) { fprintf(stderr, "kernel_launch: hipFuncSetAttribute failed\n"); grid = -1; return; }
        int per_cu = 0;
        if (hipOccupancyMaxActiveBlocksPerMultiprocessor(&per_cu, (const void*)fwd, NTHREADS, LDS_BYTES) != hipSuccess || per_cu < 1) fprintf(stderr, "kernel_launch: occupancy query reports %d\n", per_cu);
        (void)hipGetLastError();
        grid = MAXWG;
        if (cus < MAXWG) fprintf(stderr, "kernel_launch: only %d CUs: the 256-workgroup persistent grid cannot be resident; the grid barrier will time out\n", cus);
    }
    if (grid < 0) return;
    (void)hipMemsetAsync((char*)d_ws + WS_CTL, 0, CTL_ZERO_BYTES, stream);
    Args a{};
    for (int i = 0; i < 37; ++i) a.in[i] = (const float*)d_in[i];
    a.out = (float*)d_out; a.ws = (unsigned char*)d_ws; a.pad0 = 0; a.pad1 = 0;
    if (N_LAUNCH_MODE == 1) { a.lo = 0; a.hi = NPHASES; hipLaunchKernelGGL(fwd, dim3(grid), dim3(NTHREADS), LDS_BYTES, stream, a); }
    else for (int p = 0; p < NPHASES; ++p) { a.lo = p; a.hi = p + 1; hipLaunchKernelGGL(fwd, dim3(grid), dim3(NTHREADS), LDS_BYTES, stream, a); }
    const hipError_t le = hipPeekAtLastError();
    if (le != hipSuccess) fprintf(stderr, "kernel_launch: launch failed: %s\n", hipGetErrorName(le));
}
```
